# Optimizing an MI355X kernel written in HIP

```python
import math
import jax
import jax.numpy as jnp
from jax import lax
import numpy as np

D_MODEL = 1024
BATCH = 1
SEQ = 16384
DEPTH = 4

GRID_W = 64
CTX_LEN = 256
D_FF = 2816
N_MOD = 9
N_BRANCH = 3
FOURIER_GROUPS = 4
FOURIER_CH = 64
RET_HEADS = 6
RET_QK = 32
RET_V = 64
RET_CHUNK = 128
DIFF_HEADS = 6
DIFF_QK = 32
DIFF_V = 64
Q_BLOCK = 128
ROPE_BASE = 10000.0
EPS = 1e-6
F_W = FOURIER_GROUPS * FOURIER_CH
RET_QW = RET_HEADS * RET_QK
RET_VW = RET_HEADS * RET_V
DIFF_QW = DIFF_HEADS * 2 * DIFF_QK
DIFF_VW = DIFF_HEADS * DIFF_V
D_IN = F_W + 2 * RET_QW + 2 * RET_VW + 2 * DIFF_QW + DIFF_VW + N_BRANCH * D_MODEL

kernel_name = "hybrid_fourier_retention_diffattn_dit"


def split_points():
    sizes = (F_W, RET_QW, RET_QW, RET_VW, RET_VW, DIFF_QW, DIFF_QW, DIFF_VW)
    out, acc = [], 0
    for s in sizes:
        acc += s
        out.append(acc)
    return out


def rms_norm(x, g=None):
    xf = x.astype(jnp.float32)
    y = xf * lax.rsqrt(jnp.mean(xf * xf, axis=-1, keepdims=True) + EPS)
    if g is not None:
        y = y * g.astype(jnp.float32)
    return y.astype(x.dtype)


def modulate(h, shift, scale):
    return h * (1.0 + scale) + shift


def swiglu(h, w1, w3, w2):
    return (jax.nn.silu(h @ w1) * (h @ w3)) @ w2


def rope_angles(pos, dim):
    inv = ROPE_BASE ** (-jnp.arange(0, dim, 2, dtype=jnp.float32) / dim)
    return pos[:, None] * inv[None, :]


def apply_rope(x, ang):
    L, k = ang.shape
    shape = (1, L) + (1,) * (x.ndim - 3) + (k,)
    cos = jnp.cos(ang).reshape(shape)
    sin = jnp.sin(ang).reshape(shape)
    xf = x.astype(jnp.float32)
    x1, x2 = xf[..., :k], xf[..., k:]
    return jnp.concatenate([x1 * cos - x2 * sin, x1 * sin + x2 * cos], axis=-1).astype(x.dtype)


def axial_rope(x, ang_row, ang_col):
    half = x.shape[-1] // 2
    return jnp.concatenate([apply_rope(x[..., :half], ang_row), apply_rope(x[..., half:], ang_col)], axis=-1)


def fourier_mix(u):
    B, L, _ = u.shape
    ug = u.astype(jnp.float32).reshape(B, L, FOURIER_GROUPS, FOURIER_CH)
    y = jnp.fft.fft2(ug, axes=(1, 3), norm="ortho").real
    return y.reshape(B, L, F_W).astype(u.dtype)


def retention_scan(q, k, v, log_g, s0):
    B, L, H, dk = q.shape
    dv = v.shape[-1]
    C = RET_CHUNK
    n = L // C
    qc = q.astype(jnp.float32).reshape(B, n, C, H, dk).transpose(1, 0, 3, 2, 4)
    kc = k.astype(jnp.float32).reshape(B, n, C, H, dk).transpose(1, 0, 3, 2, 4)
    vc = v.astype(jnp.float32).reshape(B, n, C, H, dv).transpose(1, 0, 3, 2, 4)
    idx = jnp.arange(C, dtype=jnp.float32)
    diff = idx[:, None] - idx[None, :]
    mask = diff >= 0
    dmat = jnp.where(mask, jnp.exp(log_g[:, None, None] * jnp.where(mask, diff, 0.0)), 0.0)
    q_dec = jnp.exp(log_g[:, None] * (idx + 1.0))[None, :, :, None]
    k_dec = jnp.exp(log_g[:, None] * (C - 1.0 - idx))[None, :, :, None]
    chunk_dec = jnp.exp(log_g * C)[None, :, None, None]

    def step(s, inp):
        qi, ki, vi = inp
        inner = jnp.einsum('bhid,bhjd->bhij', qi, ki) * dmat
        o = jnp.einsum('bhij,bhjv->bhiv', inner, vi) + jnp.einsum('bhid,bhdv->bhiv', qi, s) * q_dec
        s = s * chunk_dec + jnp.einsum('bhjd,bhjv->bhdv', ki * k_dec, vi)
        return s, o

    _, o = lax.scan(step, s0.astype(jnp.float32), (qc, kc, vc))
    return o.transpose(1, 0, 3, 2, 4).reshape(B, L, H, dv)


def bidir_retention(q, k, v, log_g2, s0_f, s0_b):
    fwd = retention_scan(q, k, v, log_g2[0], s0_f)
    bwd = retention_scan(q[:, ::-1], k[:, ::-1], v[:, ::-1], log_g2[1], s0_b)[:, ::-1]
    return fwd + bwd


def context_states(k, v, log_g2):
    Lc = k.shape[1]
    j = jnp.arange(Lc, dtype=jnp.float32)
    w_f = jnp.exp(log_g2[0][:, None] * (Lc - 1.0 - j))
    w_b = jnp.exp(log_g2[1][:, None] * j)
    kf = k.astype(jnp.float32)
    vf = v.astype(jnp.float32)
    s_f = jnp.einsum('bjhd,hj,bjhv->bhdv', kf, w_f, vf)
    s_b = jnp.einsum('bjhd,hj,bjhv->bhdv', kf, w_b, vf)
    return s_f, s_b


def retention_readout(r, g):
    B, L, H, dv = r.shape
    gf = g.astype(jnp.float32).reshape(B, L, H, dv)
    y = rms_norm(r) * jax.nn.silu(gf)
    return y.reshape(B, L, H * dv).astype(g.dtype)


def diff_attend(q, k, v, lam):
    s = jnp.einsum('bqhmd,bkhmd->bhmqk', q, k).astype(jnp.float32) * (DIFF_QK ** -0.5)
    p = jax.nn.softmax(s, axis=-1)
    a = p[:, :, 0] - lam * p[:, :, 1]
    return jnp.einsum('bhqk,bkhv->bqhv', a.astype(v.dtype), v)


def diff_attend_blocked(q, k, v, lam):
    B, L = q.shape[:2]
    nb = L // Q_BLOCK
    qb = q.reshape((B, nb, Q_BLOCK) + q.shape[2:]).swapaxes(0, 1)
    o = lax.map(lambda blk: diff_attend(blk, k, v, lam), qb)
    return o.swapaxes(0, 1).reshape((B, L) + o.shape[3:])


def diff_readout(o, subln_w, lam_init):
    B, L, H, dv = o.shape
    y = rms_norm(o, subln_w) * (1.0 - lam_init)
    return y.reshape(B, L, H * dv)


def merge_branches(gate_logits, f_out, r_out, d_out, wbf, wbr, wbd, wo):
    g = jax.nn.sigmoid(gate_logits.astype(jnp.float32)).astype(f_out.dtype)
    gf, gr, gd = jnp.split(g, N_BRANCH, axis=-1)
    mixed = gf * (f_out @ wbf) + gr * (r_out @ wbr) + gd * (d_out @ wbd)
    return mixed @ wo


def token_mixer(h, hc, w_in_l, dec_logit, lam_vec, subln_w, wbf, wbr, wbd, wo, lam_init,
                ang_row, ang_col, ang_ret, with_ctx_out):
    B, L, _ = h.shape
    Lc = hc.shape[1]
    cuts = split_points()
    wf, wrq, wrk, wrv, wrg, wdq, wdk, wdv, wgt = jnp.split(w_in_l, cuts, axis=1)
    log_g2 = jax.nn.log_sigmoid(dec_logit.astype(jnp.float32))
    lv = lam_vec.astype(jnp.float32)
    lam = jnp.exp(jnp.sum(lv[0] * lv[1])) - jnp.exp(jnp.sum(lv[2] * lv[3])) + lam_init

    rk_c = (hc @ wrk).reshape(B, Lc, RET_HEADS, RET_QK) * (RET_QK ** -0.5)
    rv_c = (hc @ wrv).reshape(B, Lc, RET_HEADS, RET_V)
    s_f, s_b = context_states(rk_c, rv_c, log_g2)
    dk_c = (hc @ wdk).reshape(B, Lc, DIFF_HEADS, 2, DIFF_QK)
    dv_c = (hc @ wdv).reshape(B, Lc, DIFF_HEADS, DIFF_V)

    p = h @ w_in_l
    u_f, rq, rk, rv, rg, dq, dk, dv, gl = jnp.split(p, cuts, axis=-1)
    f_out = fourier_mix(u_f)
    rq = apply_rope(rq.reshape(B, L, RET_HEADS, RET_QK), ang_ret)
    rk = apply_rope(rk.reshape(B, L, RET_HEADS, RET_QK), ang_ret) * (RET_QK ** -0.5)
    rv = rv.reshape(B, L, RET_HEADS, RET_V)
    r_out = retention_readout(bidir_retention(rq, rk, rv, log_g2, s_f, s_b), rg)
    dq = axial_rope(dq.reshape(B, L, DIFF_HEADS, 2, DIFF_QK), ang_row, ang_col)
    dk = axial_rope(dk.reshape(B, L, DIFF_HEADS, 2, DIFF_QK), ang_row, ang_col)
    dv = dv.reshape(B, L, DIFF_HEADS, DIFF_V)
    k_all = jnp.concatenate([dk_c, dk], axis=1)
    v_all = jnp.concatenate([dv_c, dv], axis=1)
    d_out = diff_readout(diff_attend_blocked(dq, k_all, v_all, lam), subln_w, lam_init)
    y = merge_branches(gl, f_out, r_out, d_out, wbf, wbr, wbd, wo)

    yc = None
    if with_ctx_out:
        f_c = fourier_mix(hc @ wf)
        rq_c = (hc @ wrq).reshape(B, Lc, RET_HEADS, RET_QK)
        zeros = jnp.zeros((B, RET_HEADS, RET_QK, RET_V), jnp.float32)
        r_c = retention_readout(bidir_retention(rq_c, rk_c, rv_c, log_g2, zeros, zeros), hc @ wrg)
        dq_c = (hc @ wdq).reshape(B, Lc, DIFF_HEADS, 2, DIFF_QK)
        d_c = diff_readout(diff_attend(dq_c, dk_c, dv_c, lam), subln_w, lam_init)
        yc = merge_branches(hc @ wgt, f_c, r_c, d_c, wbf, wbr, wbd, wo)
    return y, yc


def setup_inputs(seed: int = 0) -> dict:
    key = jax.random.key(seed)
    ks = jax.random.split(key, 20)
    f32 = jnp.float32

    def nrm(k, shape, scale):
        return jax.random.normal(k, shape, f32) * scale

    base_logit = jnp.log(2.0 ** (5.0 + jnp.arange(RET_HEADS, dtype=f32)) - 1.0)
    return {
        "x": nrm(ks[0], (BATCH, SEQ, D_MODEL), 1.0),
        "c": nrm(ks[1], (BATCH, D_MODEL), 1.0),
        "ctx": nrm(ks[2], (BATCH, CTX_LEN, D_MODEL), 1.0),
        "c_ctx": nrm(ks[3], (D_MODEL,), 1.0),
        "w_ada": nrm(ks[4], (DEPTH, D_MODEL, N_MOD * D_MODEL), 0.5 * D_MODEL ** -0.5),
        "b_ada": nrm(ks[5], (DEPTH, N_MOD * D_MODEL), 0.02),
        "norm_g": 1.0 + nrm(ks[6], (DEPTH, 3, D_MODEL), 0.02),
        "ffn_w1": nrm(ks[7], (DEPTH, 2, D_MODEL, D_FF), D_MODEL ** -0.5),
        "ffn_w3": nrm(ks[8], (DEPTH, 2, D_MODEL, D_FF), D_MODEL ** -0.5),
        "ffn_w2": nrm(ks[9], (DEPTH, 2, D_FF, D_MODEL), D_FF ** -0.5),
        "w_in": nrm(ks[10], (DEPTH, D_MODEL, D_IN), D_MODEL ** -0.5),
        "ret_decay_logit": base_logit + nrm(ks[11], (DEPTH, 2, RET_HEADS), 0.01),
        "diff_lambda": nrm(ks[12], (DEPTH, 4, DIFF_QK), 0.1),
        "diff_subln": 1.0 + nrm(ks[13], (DEPTH, DIFF_V), 0.02),
        "w_branch_f": nrm(ks[14], (DEPTH, F_W, D_MODEL), F_W ** -0.5),
        "w_branch_r": nrm(ks[15], (DEPTH, RET_VW, D_MODEL), RET_VW ** -0.5),
        "w_branch_d": nrm(ks[16], (DEPTH, DIFF_VW, D_MODEL), DIFF_VW ** -0.5),
        "w_out": nrm(ks[17], (DEPTH, D_MODEL, D_MODEL), D_MODEL ** -0.5),
        "final_g": 1.0 + nrm(ks[18], (D_MODEL,), 0.02),
    }


def reference(x, c, ctx, c_ctx, w_ada, b_ada, norm_g, ffn_w1, ffn_w3, ffn_w2, w_in, ret_decay_logit,
              diff_lambda, diff_subln, w_branch_f, w_branch_r, w_branch_d, w_out, final_g):
    B, L, D = x.shape
    n_rows = L // GRID_W
    rows = jnp.repeat(jnp.arange(n_rows, dtype=jnp.float32), GRID_W)
    cols = jnp.tile(jnp.arange(GRID_W, dtype=jnp.float32), n_rows)
    ang_row = rope_angles(rows, DIFF_QK // 2)
    ang_col = rope_angles(cols, DIFF_QK // 2)
    ang_ret = rope_angles(jnp.arange(L, dtype=jnp.float32), RET_QK)
    sc = jax.nn.silu(c)
    scc = jax.nn.silu(c_ctx)
    xc = ctx
    for l in range(DEPTH):
        last = l == DEPTH - 1
        lam_init = 0.8 - 0.6 * math.exp(-0.3 * l)
        m = (sc @ w_ada[l] + b_ada[l]).reshape(B, N_MOD, 1, D)
        mc = (scc @ w_ada[l] + b_ada[l]).reshape(N_MOD, D)
        x = x + 0.5 * m[:, 2] * swiglu(modulate(rms_norm(x, norm_g[l, 0]), m[:, 0], m[:, 1]),
                                       ffn_w1[l, 0], ffn_w3[l, 0], ffn_w2[l, 0])
        xc = xc + 0.5 * mc[2] * swiglu(modulate(rms_norm(xc, norm_g[l, 0]), mc[0], mc[1]),
                                       ffn_w1[l, 0], ffn_w3[l, 0], ffn_w2[l, 0])
        h = modulate(rms_norm(x, norm_g[l, 1]), m[:, 3], m[:, 4])
        hc = modulate(rms_norm(xc, norm_g[l, 1]), mc[3], mc[4])
        y, yc = token_mixer(h, hc, w_in[l], ret_decay_logit[l], diff_lambda[l], diff_subln[l],
                            w_branch_f[l], w_branch_r[l], w_branch_d[l], w_out[l], lam_init,
                            ang_row, ang_col, ang_ret, not last)
        x = x + m[:, 5] * y
        x = x + 0.5 * m[:, 8] * swiglu(modulate(rms_norm(x, norm_g[l, 2]), m[:, 6], m[:, 7]),
                                       ffn_w1[l, 1], ffn_w3[l, 1], ffn_w2[l, 1])
        if not last:
            xc = xc + mc[5] * yc
            xc = xc + 0.5 * mc[8] * swiglu(modulate(rms_norm(xc, norm_g[l, 2]), mc[6], mc[7]),
                                           ffn_w1[l, 1], ffn_w3[l, 1], ffn_w2[l, 1])
    return rms_norm(x, final_g)
```

```cpp
#include <hip/hip_runtime.h>
#include <hip/hip_cooperative_groups.h>
#include <cstdio>
namespace cg = cooperative_groups;
__device__ __forceinline__ int lane_id_v() { int l; asm volatile("v_mbcnt_lo_u32_b32 %0, -1, 0\n\tv_mbcnt_hi_u32_b32 %0, -1, %0" : "=v"(l)); return l; }
#define ltid() ((WV << 6) | lane_id_v())
__device__ __forceinline__ float shx(float v, int m, int lane) { return __int_as_float(__builtin_amdgcn_ds_bpermute((lane ^ m) << 2, __float_as_int(v))); }
namespace pg8 {
#define PG8_LAS __attribute__((address_space(3)))
typedef unsigned short bf16_t;
typedef short bf16x8 __attribute__((ext_vector_type(8)));
typedef float f32x4 __attribute__((ext_vector_type(4)));
typedef unsigned u32x4 __attribute__((ext_vector_type(4)));
constexpr int BM = 256, BK = 64, HALF = 128, HTB = HALF * BK * 2  , STAGE_BYTES = 8 * HTB, NXCD = 8, WGM = 8;

__host__ __device__ __forceinline__ int lds_byte(int r, int c) { const int st = (r >> 4) * 2 + (c >> 5), rr = r & 15, cc = c & 31, ob = rr * 64 + cc * 2; return st * 1024 + (ob ^ (((ob >> 9) & 1) << 5)); }
__host__ __device__ __forceinline__ void stage_rc(int b, int& R, int& C) { const int st = b / 1024, sb = b % 1024, swz = sb ^ (((sb >> 9) & 1) << 5); R = (st >> 1) * 16 + swz / 64; C = (st & 1) * 32 + (swz % 64) / 2; }
__host__ __device__ __forceinline__ int perm32(int rho) { const int n = rho >> 4, i = rho & 15; return 8 * (i >> 2) + 4 * n + (i & 3); }

struct Unit { int pm, pn; };
struct Gemm { const bf16_t* A; const bf16_t* Bt; int M, N, K, lda; };

struct StaticOrder {
    int nM, nN, nwg, G, c;
    __host__ __device__ void init(int M, int N, int G_, int c_) { nM = M / BM; nN = N / BM; nwg = nM * nN; G = G_; c = c_; }
    __host__ __device__ bool next(int i, Unit& u) const {
        const long L = (long)i * G + c; if (L >= nwg) return false;
        int wgid = (int)L; { const int q = nwg / NXCD, r = nwg % NXCD, xcd = wgid % NXCD, off = wgid / NXCD; wgid = (xcd < r ? xcd * (q + 1) : r * (q + 1) + (xcd - r) * q) + off; }
        const int nig = WGM * nN, gid = wgid / nig, fm = gid * WGM, gsz = (nM - fm) < WGM ? (nM - fm) : WGM;
        u.pm = fm + ((wgid % nig) % gsz); u.pn = (wgid % nig) / gsz; return true;
    }
    __device__ __forceinline__ void a_ready(const Unit&) const {}
    __device__ __forceinline__ void done(const Unit&) const {}
};
__device__ __forceinline__ unsigned cvt_pk_bf16(float lo, float hi) { unsigned r; asm volatile("v_cvt_pk_bf16_f32 %0, %1, %2" : "=v"(r) : "v"(lo), "v"(hi)); return r; }
template <class Epi, class Sched, bool STAMP = false>
__device__ __forceinline__ void gemm_phase(const int WV, PG8_LAS unsigned char* lds, const Gemm g, const Sched& S, const Epi& E, unsigned long long* stamps) {
    const int tid = ltid(); const int wid = __builtin_amdgcn_readfirstlane(tid >> 6), lane = tid & 63, wr = wid >> 2, wc = wid & 3, fr = lane & 15, fq = lane >> 4;
    const int K = g.K, nt = K / BK;
    int ts_lo = 0, ts_hi = 0, nts = 0; const unsigned long long rt_entry = STAMP ? (unsigned long long)wall_clock64() : 0ull;
#define PG8_STAMP() do { if (STAMP && wid == 0 && nts < 64) { const unsigned long long _c = (unsigned long long)clock64(); \
        ts_lo = (lane == nts) ? (int)(unsigned)_c : ts_lo; ts_hi = (lane == nts) ? (int)(unsigned)(_c >> 32) : ts_hi; ++nts; } } while (0)
    PG8_STAMP();
    unsigned voffA[2], voffB[2];
#pragma unroll
    for (int i = 0; i < 2; ++i) { int R, C; stage_rc(tid * 16 + i * 8192, R, C); const int Rb = Epi::PERM ? ((R & ~31) + perm32(R & 31)) : R;
        voffA[i] = (unsigned)(R * g.lda + C) * 2u; voffB[i] = (unsigned)(Rb * K + C) * 2u; }
    const size_t kstep = (size_t)(BK * 2);
    const size_t hstep = (size_t)HALF * K * 2;
    const size_t tstep = 2 * hstep; const size_t hstepA = (size_t)HALF * g.lda * 2; const size_t tstepA = 2 * hstepA;
    const unsigned ldsw = (unsigned)wid * 1024u;
    const int aoff = lds_byte(wr * 64 + fr, fq * 8), boff = lds_byte(wc * 32 + fr, fq * 8);
#define PG8_SA(b, h) (((b) * 2 + (h)) * HTB)
#define PG8_SB(b, h) ((4 + (b) * 2 + (h)) * HTB)
#define PG8_STAGE(bufoff, gbase, voff) do { _Pragma("unroll") for (int _i = 0; _i < 2; ++_i) \
        __builtin_amdgcn_global_load_lds((const unsigned*)((const char*)(gbase) + (voff)[_i]), (PG8_LAS unsigned*)(lds + (bufoff) + ldsw + _i * 8192), 16, 0, 0); } while (0)
#define PG8_LDA(dst, b, h) do { _Pragma("unroll") for (int m = 0; m < 4; ++m) _Pragma("unroll") for (int k = 0; k < 2; ++k) dst[m][k] = *(const PG8_LAS bf16x8*)(lds + PG8_SA(b, h) + aoff + m * 2048 + k * 1024); } while (0)
#define PG8_LDB(dst, b, h) do { _Pragma("unroll") for (int n = 0; n < 2; ++n) _Pragma("unroll") for (int k = 0; k < 2; ++k) dst[n][k] = *(const PG8_LAS bf16x8*)(lds + PG8_SB(b, h) + boff + n * 2048 + k * 1024); } while (0)
#define PG8_MMA(ai, bj, At, Bt) do { __builtin_amdgcn_s_setprio(1); _Pragma("unroll") for (int m = 0; m < 4; ++m) _Pragma("unroll") for (int n = 0; n < 2; ++n) _Pragma("unroll") for (int k = 0; k < 2; ++k) \
        acc[ai][bj][m][n] = __builtin_amdgcn_mfma_f32_16x16x32_bf16(Bt[n][k], At[m][k], acc[ai][bj][m][n], 0, 0, 0); __builtin_amdgcn_s_setprio(0); } while (0)
#define PG8_WAIT_V(n) asm volatile("s_waitcnt vmcnt(" #n ")" ::: "memory")
#define PG8_WAIT_L(n) asm volatile("s_waitcnt lgkmcnt(" #n ")" ::: "memory")
#define PG8_BAR __builtin_amdgcn_s_barrier()
#define PG8_SCHED __builtin_amdgcn_sched_barrier(0)
    Unit cur, nxt; int ui = 0;
    if (!S.next(0, cur)) return;
    f32x4 acc[2][2][4][2];
#pragma unroll
    for (int a = 0; a < 2; ++a)
#pragma unroll
        for (int b = 0; b < 2; ++b)
#pragma unroll
            for (int m = 0; m < 4; ++m)
#pragma unroll
                for (int n = 0; n < 2; ++n) acc[a][b][m][n] = (f32x4){0.f, 0.f, 0.f, 0.f};
    bf16x8 At[4][2], B0[2][2], B1[2][2];
    const char* cA = (const char*)g.A + (size_t)cur.pm * tstepA; const char* cB = (const char*)g.Bt + (size_t)cur.pn * tstep;
    S.a_ready(cur);
    PG8_STAGE(PG8_SB(0, 0), cB, voffB); PG8_STAGE(PG8_SA(0, 0), cA, voffA); PG8_STAGE(PG8_SB(0, 1), cB + hstep, voffB); PG8_STAGE(PG8_SA(0, 1), cA + hstepA, voffA);
    if (wr == 1) PG8_BAR;
    PG8_WAIT_V(4); PG8_BAR;
    PG8_STAGE(PG8_SB(1, 0), cB + kstep, voffB); PG8_STAGE(PG8_SA(1, 0), cA + kstep, voffA); PG8_STAGE(PG8_SB(1, 1), cB + hstep + kstep, voffB);
    PG8_WAIT_V(6); PG8_BAR;
    PG8_STAMP();
    for (;;) {
        const bool has_next = S.next(ui + 1, nxt);
        const char* nA = has_next ? (const char*)g.A + (size_t)nxt.pm * tstepA : cA; const char* nB = has_next ? (const char*)g.Bt + (size_t)nxt.pn * tstep : cB;
        for (int t = 0; t < nt; t += 2) {
            const bool last = (t == nt - 2);
            const char* a1 = cA + (size_t)(t + 1) * kstep;
            const char* a2 = last ? nA : cA + (size_t)(t + 2) * kstep; const char* b2 = last ? nB : cB + (size_t)(t + 2) * kstep;
            const char* a3 = a2 + kstep; const char* b3 = b2 + kstep;
            if (last && has_next) S.a_ready(nxt);
            PG8_LDB(B0, 0, 0); PG8_SCHED; PG8_LDA(At, 0, 0); PG8_STAGE(PG8_SA(1, 1), a1 + hstepA, voffA);
            PG8_WAIT_L(8); PG8_BAR; PG8_WAIT_L(0); PG8_MMA(0, 0, At, B0); PG8_BAR; PG8_SCHED;
            PG8_LDB(B1, 0, 1); PG8_STAGE(PG8_SB(0, 0), b2, voffB);
            PG8_BAR; PG8_WAIT_L(0); PG8_MMA(0, 1, At, B1); PG8_BAR;
            PG8_LDA(At, 0, 1); PG8_STAGE(PG8_SA(0, 0), a2, voffA);
            PG8_BAR; PG8_WAIT_L(0); PG8_MMA(1, 0, At, B0); PG8_BAR; PG8_SCHED;
            PG8_STAGE(PG8_SB(0, 1), b2 + hstep, voffB);
            PG8_WAIT_V(6); PG8_BAR; PG8_MMA(1, 1, At, B1); PG8_BAR;
            PG8_LDB(B0, 1, 0); PG8_SCHED; PG8_LDA(At, 1, 0); PG8_STAGE(PG8_SA(0, 1), a2 + hstepA, voffA);
            PG8_WAIT_L(8); PG8_BAR; PG8_WAIT_L(0); PG8_MMA(0, 0, At, B0); PG8_BAR; PG8_SCHED;
            PG8_LDB(B1, 1, 1); PG8_STAGE(PG8_SB(1, 0), b3, voffB);
            PG8_BAR; PG8_WAIT_L(0); PG8_MMA(0, 1, At, B1); PG8_BAR;
            PG8_LDA(At, 1, 1); PG8_STAGE(PG8_SA(1, 0), a3, voffA);
            PG8_BAR; PG8_WAIT_L(0); PG8_MMA(1, 0, At, B0); PG8_BAR; PG8_SCHED;
            PG8_STAGE(PG8_SB(1, 1), b3 + hstep, voffB);
            PG8_WAIT_V(6); PG8_BAR; PG8_MMA(1, 1, At, B1); PG8_BAR;
        }
        PG8_STAMP();
        if constexpr (!Epi::AFTER_DRAIN) { E(acc, cur, wr, wc, fr, fq); S.done(cur); }
        PG8_STAMP();
        if (!has_next) break;
#pragma unroll
        for (int a = 0; a < 2; ++a)
#pragma unroll
            for (int b = 0; b < 2; ++b)
#pragma unroll
                for (int m = 0; m < 4; ++m)
#pragma unroll
                    for (int n = 0; n < 2; ++n) acc[a][b][m][n] = (f32x4){0.f, 0.f, 0.f, 0.f};
        cur = nxt; cA = nA; cB = nB; ++ui;
    }
    PG8_WAIT_V(0);
    if (wr == 0) PG8_BAR;
    PG8_BAR;
    if constexpr (Epi::AFTER_DRAIN) { E.fused(acc, cur, wr, wc, fr, fq, lds, wid, lane); S.done(cur); }
    PG8_STAMP();
    if (STAMP && wid == 0) { stamps[lane] = lane < nts ? (((unsigned long long)(unsigned)ts_hi << 32) | (unsigned)ts_lo) : 0ull;
        if (lane == 62) stamps[62] = rt_entry; if (lane == 63) stamps[63] = (unsigned long long)wall_clock64(); }
#undef PG8_STAMP
#undef PG8_SA
#undef PG8_SB
#undef PG8_STAGE
#undef PG8_LDA
#undef PG8_LDB
#undef PG8_MMA
#undef PG8_WAIT_V
#undef PG8_WAIT_L
#undef PG8_BAR
#undef PG8_SCHED
}
}
using pg8::bf16_t; using pg8::bf16x8; using pg8::f32x4; using pg8::u32x4; using pg8::cvt_pk_bf16;
typedef float f32x16 __attribute__((ext_vector_type(16)));
typedef short s16x4 __attribute__((ext_vector_type(4)));
typedef unsigned u32x2 __attribute__((ext_vector_type(2)));
#define DI __device__ __forceinline__
#define LAS __attribute__((address_space(3)))
#define MFMA32(a, b, c) __builtin_amdgcn_mfma_f32_32x32x16_bf16((a), (b), (c), 0, 0, 0)

constexpr int L_ = 16384, LC_ = 256, MT_ = 16640, D_ = 1024, DFF_ = 2816, DEPTH_ = 4;
constexpr int NWIN_ = 5888, NPB_ = 2816, NGB_ = 3072;
constexpr int C_FA = 0, C_FB = 256, C_RQ = 512, C_RK = 704, C_RV = 896, C_RG = 1280, C_DQ = 1664, C_DK = 2048, C_DV = 2432;
constexpr int LDS_BYTES = 147456;
constexpr float EPS_ = 1e-6f;

constexpr size_t al256(size_t x) { return (x + 255) & ~(size_t)255; }
constexpr size_t WS_W13 = 0;
constexpr size_t WS_W2  = WS_W13 + (size_t)4 * 2 * 5632 * 1024 * 2;
constexpr size_t WS_WIN = WS_W2 + (size_t)4 * 2 * 1024 * 2816 * 2;
constexpr size_t WS_WBF = WS_WIN + (size_t)4 * 5888 * 1024 * 2;
constexpr size_t WS_WBR = WS_WBF + (size_t)4 * 1024 * 256 * 2;
constexpr size_t WS_WBD = WS_WBR + (size_t)4 * 1024 * 384 * 2;
constexpr size_t WS_WO  = WS_WBD + (size_t)4 * 1024 * 384 * 2;
constexpr size_t WS_X   = WS_WO + (size_t)4 * 1024 * 1024 * 2;
constexpr size_t WS_H   = WS_X + (size_t)MT_ * 1024 * 4;
constexpr size_t WS_BR  = WS_H + (size_t)MT_ * 1024 * 2;
constexpr size_t WS_AL  = WS_BR + (size_t)MT_ * 1024 * 2;
constexpr size_t WS_U   = WS_AL;
constexpr size_t WS_PB  = WS_AL;
constexpr size_t WS_GB  = WS_AL + (size_t)MT_ * 2816 * 2;
constexpr size_t WS_V   = WS_GB + (size_t)MT_ * 3072 * 2;
constexpr size_t WS_T   = WS_V + (size_t)128 * 128 * 2 * 256 * 2;
constexpr size_t WS_S   = WS_T + (size_t)130 * 6 * 2 * 2048 * 4;
constexpr size_t WS_MXC = WS_S + (size_t)130 * 6 * 2 * 2048 * 4;
constexpr size_t WS_MOD = WS_MXC + (size_t)256 * 1024 * 4;
constexpr size_t WS_TRET = WS_MOD + (size_t)2 * 4 * 9216 * 4;
constexpr size_t WS_TROW = WS_TRET + (size_t)16384 * 16 * 2 * 4;
constexpr size_t WS_TCOL = WS_TROW + (size_t)256 * 8 * 2 * 4;
constexpr size_t WS_SCAL = WS_TCOL + (size_t)64 * 8 * 2 * 4;
constexpr size_t WS_END = WS_SCAL + 4 * 64 * 4;

__device__ __forceinline__ int lbid() { int t = blockIdx.x; asm volatile("" : "+s"(t)); return t; }
__device__ __forceinline__ int lnb() { int t = gridDim.x; asm volatile("" : "+s"(t)); return t; }
struct Args { const float* in[19]; float* out; unsigned char* ws; };
typedef const Args __attribute__((address_space(4)))* KArgs;
__device__ __forceinline__ KArgs kargs() { KArgs p = (KArgs)__builtin_amdgcn_kernarg_segment_ptr(); asm volatile("" : "+s"(p)); return p; }

DI float bf2f(unsigned v) { return __uint_as_float(v << 16); }
DI bf16_t f2bf(float x) { return (bf16_t)(cvt_pk_bf16(x, 0.f) & 0xffffu); }
DI int crow(int reg, int h) { return (reg & 3) + 8 * (reg >> 2) + 4 * h; }
DI bf16x8 pack_step(const f32x16& x, int s) {
  u32x4 p;
  asm volatile("v_cvt_pk_bf16_f32 %0, %4, %5\n\tv_cvt_pk_bf16_f32 %1, %6, %7\n\tv_cvt_pk_bf16_f32 %2, %8, %9\n\tv_cvt_pk_bf16_f32 %3, %10, %11\n\ts_nop 1"
               : "=&v"(p[0]), "=&v"(p[1]), "=&v"(p[2]), "=&v"(p[3])
               : "v"(x[8 * s]), "v"(x[8 * s + 1]), "v"(x[8 * s + 2]), "v"(x[8 * s + 3]), "v"(x[8 * s + 4]), "v"(x[8 * s + 5]), "v"(x[8 * s + 6]), "v"(x[8 * s + 7]));
  return __builtin_bit_cast(bf16x8, p);
}
DI float silu_f(float a) { return a / (1.0f + __expf(-a)); }
DI float sigmoid_f(float a) { return 1.0f / (1.0f + __expf(-a)); }
DI float wave_sum(float v) {
  const int lane = lane_id_v();
#pragma unroll
  for (int o = 32; o > 0; o >>= 1) v += shx(v, o, lane);
  return v;
}
DI void sincos_acc(float xf, float& s, float& c) {
  const double x = (double)xf;
  const double k = rint(x * 0.63661977236758134308);
  double r = fma(-k, 1.57079632679489655800e+00, x); r = fma(-k, 6.12323399573676603587e-17, r);
  const double r2 = r * r;
  double sp = -1.0 / 39916800.0; sp = fma(sp, r2, 1.0 / 362880.0); sp = fma(sp, r2, -1.0 / 5040.0); sp = fma(sp, r2, 1.0 / 120.0); sp = fma(sp, r2, -1.0 / 6.0); sp = fma(sp * r2, r, r);
  double cp = 1.0 / 479001600.0; cp = fma(cp, r2, -1.0 / 3628800.0); cp = fma(cp, r2, 1.0 / 40320.0); cp = fma(cp, r2, -1.0 / 720.0); cp = fma(cp, r2, 1.0 / 24.0); cp = fma(cp, r2, -0.5); cp = fma(cp, r2, 1.0);
  const int q = ((int)(long long)k) & 3;
  const double sv = (q == 0) ? sp : (q == 1) ? cp : (q == 2) ? -sp : -cp;
  const double cv = (q == 0) ? cp : (q == 1) ? -sp : (q == 2) ? -cp : sp;
  s = (float)sv; c = (float)cv;
}
__constant__ float INV16[16] = {1.0f, 0.5623413324356079f, 0.3162277638912201f, 0.17782793939113617f, 0.10000000149011612f, 0.05623413249850273f, 0.03162277489900589f, 0.017782794311642647f,
                             0.009999999776482582f, 0.005623413249850273f, 0.003162277629598975f, 0.0017782794311642647f, 0.0010000000474974513f, 0.000562341301701963f, 0.0003162277571391314f, 0.00017782794020604342f};
struct ConvJob { const float* src; const float* src2; bf16_t* dst; int N, K, ld, kind; };
DI ConvJob conv_job(KArgs a, int j) {
  const int l = j / 9, kd = j % 9; ConvJob J; J.src2 = nullptr; J.kind = 0;
  unsigned char* ws = a->ws;
  switch (kd) {
    case 0: case 1: { const int f = kd; J.src = a->in[7] + (size_t)(l * 2 + f) * 1024 * 2816; J.src2 = a->in[8] + (size_t)(l * 2 + f) * 1024 * 2816; J.dst = (bf16_t*)(ws + WS_W13) + (size_t)(l * 2 + f) * 5632 * 1024; J.N = 5632; J.K = 1024; J.ld = 2816; J.kind = 1; break; }
    case 2: case 3: { const int f = kd - 2; J.src = a->in[9] + (size_t)(l * 2 + f) * 2816 * 1024; J.dst = (bf16_t*)(ws + WS_W2) + (size_t)(l * 2 + f) * 1024 * 2816; J.N = 1024; J.K = 2816; J.ld = 1024; break; }
    case 4: { J.src = a->in[10] + (size_t)l * 1024 * 5632; J.dst = (bf16_t*)(ws + WS_WIN) + (size_t)l * 5888 * 1024; J.N = 5888; J.K = 1024; J.ld = 5632; J.kind = 2; break; }
    case 5: { J.src = a->in[14] + (size_t)l * 256 * 1024; J.dst = (bf16_t*)(ws + WS_WBF) + (size_t)l * 1024 * 256; J.N = 1024; J.K = 256; J.ld = 1024; break; }
    case 6: { J.src = a->in[15] + (size_t)l * 384 * 1024; J.dst = (bf16_t*)(ws + WS_WBR) + (size_t)l * 1024 * 384; J.N = 1024; J.K = 384; J.ld = 1024; break; }
    case 7: { J.src = a->in[16] + (size_t)l * 384 * 1024; J.dst = (bf16_t*)(ws + WS_WBD) + (size_t)l * 1024 * 384; J.N = 1024; J.K = 384; J.ld = 1024; break; }
    default: { J.src = a->in[17] + (size_t)l * 1024 * 1024; J.dst = (bf16_t*)(ws + WS_WO) + (size_t)l * 1024 * 1024; J.N = 1024; J.K = 1024; J.ld = 1024; break; }
  }
  return J;
}
DI int axial_perm(int s) { return s < 8 ? s : (s < 16 ? s + 8 : (s < 24 ? s - 8 : s)); }

DI void prologue(int WV, KArgs a, unsigned char* smem) {
  const int tid = ltid(), nb = lnb(), bid = lbid();
  float* t = (float*)smem;
  float* tr = t + 64 * 65;
  {
    constexpr int tiles_per_layer = 1408 * 2 + 704 * 2 + 1472 + 64 + 96 + 96 + 256;
    const int nn = tid & 63, kq = tid >> 6;
#pragma unroll 1
    for (int g = bid; g < 4 * tiles_per_layer; g += nb) {
      const int l = g / tiles_per_layer; int rem = g % tiles_per_layer; int kd;
      if (rem < 1408) kd = 0; else if (rem < 2816) { kd = 1; rem -= 1408; } else if (rem < 3520) { kd = 2; rem -= 2816; } else if (rem < 4224) { kd = 3; rem -= 3520; }
      else if (rem < 5696) { kd = 4; rem -= 4224; } else if (rem < 5760) { kd = 5; rem -= 5696; } else if (rem < 5856) { kd = 6; rem -= 5760; } else if (rem < 5952) { kd = 7; rem -= 5856; } else { kd = 8; rem -= 5952; }
      const ConvJob J = conv_job(a, l * 9 + kd);
      const int nkt = J.K / 64; const int n0 = (rem / nkt) * 64, k0 = (rem % nkt) * 64;
      const bool fold = (J.kind == 2) && (n0 < 512);
      const float* sp = J.src; int col = n0 + nn;
      if (J.kind == 1) { const int n = n0 + nn, gi = n >> 5, s = n & 31; sp = (s < 16) ? J.src : J.src2; col = 16 * gi + (s & 15); }
      else if (J.kind == 2) {
        const int n = n0 + nn;
        if (fold) col = (n0 & 192) + nn;
        else { col = n - 256; if (n >= C_DQ && n < C_DV) { const int s = n & 31; col = (n - 256 - s) + axial_perm(s); } }
      }
      const float* cp = sp + (size_t)(k0 + kq) * J.ld + col;
      float lv[8];
#pragma unroll
      for (int i = 0; i < 8; ++i) lv[i] = cp[(size_t)(8 * i) * J.ld];
#pragma unroll
      for (int i = 0; i < 8; ++i) t[nn * 65 + kq + 8 * i] = lv[i];
      if (fold && tid < 64) { const float ang = (float)tid * (1.0f / 32.0f); tr[tid] = (n0 >= 256) ? sinpif(ang) : cospif(ang); }
      __syncthreads();
      if (!fold) {
#pragma unroll
        for (int i = 0; i < 4; ++i) {
          const int e = tid + i * 512, n2 = e >> 5, kp = (e & 31) * 2;
          *(unsigned*)(J.dst + (size_t)(n0 + n2) * J.K + k0 + kp) = cvt_pk_bf16(t[n2 * 65 + kp], t[n2 * 65 + kp + 1]);
        }
      } else {
#pragma unroll 1
        for (int i = 0; i < 8; ++i) {
          const int m = kq + 8 * i, kk = nn;
          float acc = 0.f;
#pragma unroll 8
          for (int c = 0; c < 64; ++c) acc += t[c * 65 + kk] * tr[(m * c) & 63];
          J.dst[(size_t)(n0 + m) * J.K + k0 + kk] = f2bf(acc);
        }
      }
      __syncthreads();
    }
  }
  {
    float* sc = (float*)smem; float* scc = sc + 1024; float* red = scc + 1024;
    __syncthreads();
    for (int i = tid; i < 1024; i += 512) { sc[i] = silu_f(a->in[1][i]); scc[i] = silu_f(a->in[3][i]); }
    __syncthreads();
    float* MOD = (float*)(a->ws + WS_MOD);
    for (int it = bid; it < 4 * 72; it += nb) {
      const int l = it / 72, cb = it % 72;
      const int cgp = tid & 31, ks = tid >> 5;
      const float* wp = a->in[4] + ((size_t)l * 1024 + ks * 64) * 9216 + cb * 128 + cgp * 4;
      f32x4 am = {0.f, 0.f, 0.f, 0.f}, ac = {0.f, 0.f, 0.f, 0.f};
#pragma unroll 8
      for (int k = 0; k < 64; ++k) { const f32x4 w = *(const f32x4*)(wp + (size_t)k * 9216); am += w * sc[ks * 64 + k]; ac += w * scc[ks * 64 + k]; }
#pragma unroll
      for (int j = 0; j < 4; ++j) { red[(ks * 128 + cgp * 4 + j) * 2] = am[j]; red[(ks * 128 + cgp * 4 + j) * 2 + 1] = ac[j]; }
      __syncthreads();
      if (tid < 256) {
        const int col = tid >> 1, which = tid & 1; float s = 0.f;
#pragma unroll
        for (int q = 0; q < 16; ++q) s += red[(q * 128 + col) * 2 + which];
        const int gc = cb * 128 + col;
        MOD[(size_t)(which * 4 + l) * 9216 + gc] = s + a->in[5][(size_t)l * 9216 + gc];
      }
      __syncthreads();
    }
  }
  {
    float* TRET = (float*)(a->ws + WS_TRET); float* TROW = (float*)(a->ws + WS_TROW); float* TCOL = (float*)(a->ws + WS_TCOL);
    const int gt = bid * 512 + tid, gn = nb * 512;
    for (int e = gt; e < 16384 * 16; e += gn) { const int p = e >> 4, i = e & 15; float s, c; sincos_acc((float)p * INV16[i], s, c); TRET[2 * e] = c; TRET[2 * e + 1] = s; }
    for (int e = gt; e < 256 * 8; e += gn) { const int p = e >> 3, i = e & 7; float s, c; sincos_acc((float)p * INV16[2 * i], s, c); TROW[2 * e] = c; TROW[2 * e + 1] = s; }
    for (int e = gt; e < 64 * 8; e += gn) { const int p = e >> 3, i = e & 7; float s, c; sincos_acc((float)p * INV16[2 * i], s, c); TCOL[2 * e] = c; TCOL[2 * e + 1] = s; }
    if (bid == 0 && tid < 4) {
      const int l = tid; float* S = (float*)(a->ws + WS_SCAL) + l * 64;
      const float* lv = a->in[12] + l * 128; float d01 = 0.f, d23 = 0.f;
      for (int i = 0; i < 32; ++i) { d01 += lv[i] * lv[32 + i]; d23 += lv[64 + i] * lv[96 + i]; }
      const float lam_init = 0.8f - 0.6f * expf(-0.3f * (float)l);
      S[0] = expf(d01) - expf(d23) + lam_init; S[1] = lam_init;
      for (int i = 0; i < 12; ++i) { const float x = a->in[11][l * 12 + i]; S[4 + i] = -log1pf(expf(-x)); }
      for (int i = 0; i < 12; ++i) ((unsigned*)S)[16 + i] = 0u;
    }
  }
}
DI void norm_phase(int WV, KArgs a, int l, int which, bool first) {
  const int tid = ltid(), lane = tid & 63, wave = tid >> 6;
  const float* g = a->in[6] + (size_t)(l * 3 + which) * 1024;
  const float* mod = (const float*)(a->ws + WS_MOD) + (size_t)l * 9216;
  const float* modc = (const float*)(a->ws + WS_MOD) + (size_t)(4 + l) * 9216;
  float* X = (float*)(a->ws + WS_X); bf16_t* H = (bf16_t*)(a->ws + WS_H);
  for (int r = lbid() * 8 + wave; r < MT_; r += lnb() * 8) {
    const float* src = first ? (r < L_ ? a->in[0] + (size_t)r * 1024 : a->in[2] + (size_t)(r - L_) * 1024) : X + (size_t)r * 1024;
    f32x4 v[4]; float ss = 0.f;
#pragma unroll
    for (int i = 0; i < 4; ++i) { v[i] = *(const f32x4*)(src + i * 256 + lane * 4); ss += v[i][0] * v[i][0] + v[i][1] * v[i][1] + v[i][2] * v[i][2] + v[i][3] * v[i][3]; }
    ss = wave_sum(ss);
    const float rstd = rsqrtf(ss * (1.0f / 1024.0f) + EPS_);
    const float* mm = (r < L_) ? mod : modc;
#pragma unroll
    for (int i = 0; i < 4; ++i) {
      const int c = i * 256 + lane * 4;
      const f32x4 gg = *(const f32x4*)(g + c), sh = *(const f32x4*)(mm + (which * 3) * 1024 + c), sc = *(const f32x4*)(mm + (which * 3 + 1) * 1024 + c);
      f32x4 y;
#pragma unroll
      for (int j = 0; j < 4; ++j) y[j] = v[i][j] * rstd * gg[j] * (1.0f + sc[j]) + sh[j];
      u32x2 w; w.x = cvt_pk_bf16(y[0], y[1]); w.y = cvt_pk_bf16(y[2], y[3]);
      *(u32x2*)(H + (size_t)r * 1024 + c) = w;
      if (first) *(f32x4*)(X + (size_t)r * 1024 + c) = v[i];
    }
  }
}
DI void final_norm(int WV, KArgs a) {
  const int tid = ltid(), lane = tid & 63, wave = tid >> 6;
  const float* g = a->in[18]; const float* X = (const float*)(a->ws + WS_X);
  for (int r = lbid() * 8 + wave; r < L_; r += lnb() * 8) {
    f32x4 v[4]; float ss = 0.f;
#pragma unroll
    for (int i = 0; i < 4; ++i) { v[i] = *(const f32x4*)(X + (size_t)r * 1024 + i * 256 + lane * 4); ss += v[i][0] * v[i][0] + v[i][1] * v[i][1] + v[i][2] * v[i][2] + v[i][3] * v[i][3]; }
    ss = wave_sum(ss);
    const float rstd = rsqrtf(ss * (1.0f / 1024.0f) + EPS_);
#pragma unroll
    for (int i = 0; i < 4; ++i) { const int c = i * 256 + lane * 4; const f32x4 gg = *(const f32x4*)(g + c); f32x4 y; for (int j = 0; j < 4; ++j) y[j] = v[i][j] * rstd * gg[j]; *(f32x4*)(a->out + (size_t)r * 1024 + c) = y; }
  }
}

using pg8::Unit; using pg8::HALF; using pg8::BM;
struct EpiSwiglu {
  static constexpr bool PERM = false, AFTER_DRAIN = false;
  bf16_t* U;
  DI void operator()(const f32x4 (&acc)[2][2][4][2], const Unit& u, int wr, int wc, int fr_, int fq_) const {
    const int ln_ = lane_id_v(), fr = ln_ & 15, fq = ln_ >> 4;
#pragma unroll
    for (int ai = 0; ai < 2; ++ai)
#pragma unroll
      for (int m = 0; m < 4; ++m) {
        const int r = u.pm * BM + ai * HALF + wr * 64 + m * 16 + fr;
#pragma unroll
        for (int bj = 0; bj < 2; ++bj) {
          const int gi = u.pn * 8 + bj * 4 + wc;
          const f32x4 x = acc[ai][bj][m][0], y = acc[ai][bj][m][1];
          u32x2 w; w.x = cvt_pk_bf16(silu_f(x[0]) * y[0], silu_f(x[1]) * y[1]); w.y = cvt_pk_bf16(silu_f(x[2]) * y[2], silu_f(x[3]) * y[3]);
          *(u32x2*)(U + (size_t)r * DFF_ + gi * 16 + fq * 4) = w;
        }
        __builtin_amdgcn_sched_barrier(0);
      }
  }
};
struct EpiResid {
  static constexpr bool PERM = false, AFTER_DRAIN = false;
  float* X; const float* gate; float scale;
  DI void operator()(const f32x4 (&acc)[2][2][4][2], const Unit& u, int wr, int wc, int fr_, int fq_) const {
    const int ln_ = lane_id_v(), fr = ln_ & 15, fq = ln_ >> 4;
#pragma unroll
    for (int bj = 0; bj < 2; ++bj)
#pragma unroll
      for (int n = 0; n < 2; ++n) {
        const int c = u.pn * BM + bj * HALF + wc * 32 + n * 16 + fq * 4;
        const f32x4 gv = *(const f32x4*)(gate + c) * scale;
#pragma unroll
        for (int ai = 0; ai < 2; ++ai)
#pragma unroll
          for (int m = 0; m < 4; ++m) {
            const int r = u.pm * BM + ai * HALF + wr * 64 + m * 16 + fr;
            float* p = X + (size_t)r * 1024 + c;
            *(f32x4*)p = *(const f32x4*)p + gv * acc[ai][bj][m][n];
          }
      }
  }
};
template <int STEP> struct EpiMerge {
  static constexpr bool PERM = false, AFTER_DRAIN = false;
  float* MX; const bf16_t* G; bf16_t* Hout;
  DI void operator()(const f32x4 (&acc)[2][2][4][2], const Unit& u, int wr, int wc, int fr_, int fq_) const {
    const int ln_ = lane_id_v(), fr = ln_ & 15, fq = ln_ >> 4;
#pragma unroll
    for (int ai = 0; ai < 2; ++ai)
#pragma unroll
      for (int bj = 0; bj < 2; ++bj)
#pragma unroll
        for (int n = 0; n < 2; ++n) {
          const int c = u.pn * BM + bj * HALF + wc * 32 + n * 16 + fq * 4;
          const int r0 = u.pm * BM + ai * HALF + wr * 64 + fr;
          u32x2 gw[4]; f32x4 old[4];
#pragma unroll
          for (int m = 0; m < 4; ++m) {
            gw[m] = *(const u32x2*)(G + (size_t)(r0 + m * 16) * NGB_ + c);
            if (STEP > 0) old[m] = *(const f32x4*)(MX + (size_t)(r0 + m * 16) * 1024 + c);
          }
#pragma unroll
          for (int m = 0; m < 4; ++m) {
            f32x4 gv; gv[0] = bf2f(gw[m].x & 0xffffu); gv[1] = bf2f(gw[m].x >> 16); gv[2] = bf2f(gw[m].y & 0xffffu); gv[3] = bf2f(gw[m].y >> 16);
            f32x4 v = gv * acc[ai][bj][m][n];
            if (STEP > 0) v += old[m];
            if (STEP < 2) *(f32x4*)(MX + (size_t)(r0 + m * 16) * 1024 + c) = v;
            else { u32x2 w; w.x = cvt_pk_bf16(v[0], v[1]); w.y = cvt_pk_bf16(v[2], v[3]); *(u32x2*)(Hout + (size_t)(r0 + m * 16) * 1024 + c) = w; }
          }
          __builtin_amdgcn_sched_barrier(0);
        }
  }
};
struct EpiWin {
  static constexpr bool PERM = false, AFTER_DRAIN = false;
  bf16_t* PB; bf16_t* GB; const float* TRET; const float* TROW; const float* TCOL; unsigned* kmax;
  DI void operator()(const f32x4 (&acc)[2][2][4][2], const Unit& u, int wr, int wc, int fr_, int fq_) const {
    const int ln_ = lane_id_v(), fr = ln_ & 15, fq = ln_ >> 4;
#pragma unroll
    for (int bj = 0; bj < 2; ++bj) {
      const int cb = u.pn * BM + bj * HALF + wc * 32;
      float kmx = 0.f;
#pragma unroll
      for (int ai = 0; ai < 2; ++ai)
#pragma unroll
        for (int m = 0; m < 4; ++m) {
          const int r = u.pm * BM + ai * HALF + wr * 64 + m * 16 + fr;
          f32x4 x0 = acc[ai][bj][m][0], x1 = acc[ai][bj][m][1];
          if (cb >= NPB_) {
#pragma unroll
            for (int j = 0; j < 4; ++j) { x0[j] = sigmoid_f(x0[j]); x1[j] = sigmoid_f(x1[j]); }
            u32x2 w0, w1; w0.x = cvt_pk_bf16(x0[0], x0[1]); w0.y = cvt_pk_bf16(x0[2], x0[3]); w1.x = cvt_pk_bf16(x1[0], x1[1]); w1.y = cvt_pk_bf16(x1[2], x1[3]);
            bf16_t* p = GB + (size_t)r * NGB_ + (cb - NPB_) + fq * 4;
            *(u32x2*)p = w0; *(u32x2*)(p + 16) = w1;
            __builtin_amdgcn_sched_barrier(0);
            continue;
          }
          if (cb >= C_RQ && cb < C_RV) {
            if (r < L_) {
              const f32x4* tp = (const f32x4*)(TRET + ((size_t)r * 16 + fq * 4) * 2);
              const f32x4 t0 = tp[0], t1 = tp[1];
              const float cs[4] = {t0[0], t0[2], t1[0], t1[2]}, sn[4] = {t0[1], t0[3], t1[1], t1[3]};
#pragma unroll
              for (int j = 0; j < 4; ++j) { const float a_ = x0[j], b_ = x1[j]; x0[j] = a_ * cs[j] - b_ * sn[j]; x1[j] = a_ * sn[j] + b_ * cs[j]; }
            }
            if (cb >= C_RK) { x0 *= 0.17677669529663687f; x1 *= 0.17677669529663687f; }
          } else if (cb >= C_RG && cb < C_DQ) {
#pragma unroll
            for (int j = 0; j < 4; ++j) { x0[j] = silu_f(x0[j]); x1[j] = silu_f(x1[j]); }
          } else if (cb >= C_DQ && cb < C_DV) {
            if (r < L_) {
              const float* tb = (fq < 2) ? (TROW + ((size_t)(r >> 6) * 8 + fq * 4) * 2) : (TCOL + ((size_t)(r & 63) * 8 + (fq - 2) * 4) * 2);
              const f32x4 t0 = ((const f32x4*)tb)[0], t1 = ((const f32x4*)tb)[1];
              const float cs[4] = {t0[0], t0[2], t1[0], t1[2]}, sn[4] = {t0[1], t0[3], t1[1], t1[3]};
#pragma unroll
              for (int j = 0; j < 4; ++j) { const float a_ = x0[j], b_ = x1[j]; x0[j] = a_ * cs[j] - b_ * sn[j]; x1[j] = a_ * sn[j] + b_ * cs[j]; }
            }
            if (cb < C_DK) { x0 *= 0.25503486f; x1 *= 0.25503486f; }
            else { float ss = 0.f;
#pragma unroll
              for (int j = 0; j < 4; ++j) ss += x0[j] * x0[j] + x1[j] * x1[j];
              ss += shx(ss, 16, lane_id_v()); ss += shx(ss, 32, lane_id_v()); kmx = fmaxf(kmx, ss); }
          }
          u32x2 w0, w1; w0.x = cvt_pk_bf16(x0[0], x0[1]); w0.y = cvt_pk_bf16(x0[2], x0[3]); w1.x = cvt_pk_bf16(x1[0], x1[1]); w1.y = cvt_pk_bf16(x1[2], x1[3]);
          bf16_t* p = PB + (size_t)r * NPB_ + cb + fq * 4;
          *(u32x2*)p = w0; *(u32x2*)(p + 16) = w1;
          __builtin_amdgcn_sched_barrier(0);
        }
      if (cb >= C_DK && cb < C_DV) {
#pragma unroll
        for (int o = 1; o < 16; o <<= 1) kmx = fmaxf(kmx, shx(kmx, o, lane_id_v()));
        if (lane_id_v() == 0) atomicMax(kmax + ((cb - C_DK) >> 5), __float_as_uint(kmx));
      }
    }
  }
};
template <class F> DI void ctx_gemm32(int WV, const bf16_t* A, int lda, const bf16_t* Bt, int K, int N, unsigned char* smem, F epi) {
  const int tid = ltid(), lane = tid & 63, wave = tid >> 6, r31 = lane & 31, h = lane >> 5;
  float* red = (float*)smem;
  const int ntn = N / 32, ntiles = 8 * ntn, kper = K / 8;
  for (int tile = lbid(); tile < ntiles; tile += lnb()) {
    const int tm = tile / ntn, tn = tile % ntn;
    f32x16 acc; for (int i = 0; i < 16; ++i) acc[i] = 0.f;
    const bf16_t* ap = A + (size_t)(tm * 32 + r31) * lda + wave * kper + 8 * h;
    const bf16_t* bp = Bt + (size_t)(tn * 32 + r31) * K + wave * kper + 8 * h;
    for (int kk = 0; kk < kper; kk += 16) { const bf16x8 av = *(const bf16x8*)(ap + kk), bv = *(const bf16x8*)(bp + kk); acc = MFMA32(av, bv, acc); }
#pragma unroll
    for (int i = 0; i < 16; ++i) red[(wave * 16 + i) * 64 + lane] = acc[i];
    __syncthreads();
#pragma unroll
    for (int q = 0; q < 2; ++q) {
      const int o = tid + q * 512, i = o >> 6, ln = o & 63; float s = 0.f;
#pragma unroll
      for (int w = 0; w < 8; ++w) s += red[(w * 16 + i) * 64 + ln];
      epi(tm * 32 + crow(i, ln >> 5), tn * 32 + (ln & 31), s);
    }
    __syncthreads();
  }
}

constexpr int FR_LD = 136;
DI void fourier_tables(int WV, unsigned char* smem) {
  bf16_t* Cw = (bf16_t*)smem; bf16_t* Sw = Cw + 128 * FR_LD;
  for (int e = ltid(); e < 128 * 128; e += 512) { const int a_ = e >> 7, b_ = e & 127; const float x = (float)((a_ * b_) & 127) * (1.0f / 64.0f); Cw[a_ * FR_LD + b_] = f2bf(cospif(x)); Sw[a_ * FR_LD + b_] = f2bf(sinpif(x)); }
}
DI void fourier_load(int WV, const bf16_t* src, size_t rs, size_t po, unsigned char* smem) {
  bf16_t* dA = (bf16_t*)smem + 2 * 128 * FR_LD;
#pragma unroll
  for (int i = 0; i < 4; ++i) {
    const int id = ltid() + 512 * i, seg = id & 7, part = (id >> 3) & 1, row = id >> 4;
    const bf16x8 v = *(const bf16x8*)(src + (size_t)row * rs + (size_t)part * po + seg * 8);
    bf16_t* d = dA + part * 64 * FR_LD + (seg * 8) * FR_LD + row;
#pragma unroll
    for (int e = 0; e < 8; ++e) d[e * FR_LD] = (bf16_t)v[e];
  }
}
DI void fourier_stage1(int WV, KArgs a, unsigned char* smem) {
  const int tid = ltid(), lane = tid & 63, wave = tid >> 6, r31 = lane & 31, h = lane >> 5, rb = wave & 3, cbk = wave >> 2;
  const bf16_t* PB = (const bf16_t*)(a->ws + WS_PB); bf16_t* V = (bf16_t*)(a->ws + WS_V);
  const bf16_t* Cw = (const bf16_t*)smem; const bf16_t* Sw = Cw + 128 * FR_LD; const bf16_t* dA = Sw + 128 * FR_LD; const bf16_t* dB = dA + 64 * FR_LD;
  for (int it = lbid(); it < 512; it += lnb()) {
    const int t2 = it >> 2, c0 = (it & 3) * 64;
    __syncthreads();
    fourier_load(WV, PB + (size_t)t2 * NPB_ + C_FA + c0, (size_t)128 * NPB_, (size_t)(C_FB - C_FA), smem);
    __syncthreads();
    f32x16 R, nI; for (int i = 0; i < 16; ++i) { R[i] = 0.f; nI[i] = 0.f; }
#pragma unroll
    for (int s = 0; s < 8; ++s) {
      const bf16x8 cw = *(const bf16x8*)(Cw + (32 * rb + r31) * FR_LD + 16 * s + 8 * h), sw = *(const bf16x8*)(Sw + (32 * rb + r31) * FR_LD + 16 * s + 8 * h);
      const bf16x8 af = *(const bf16x8*)(dA + (32 * cbk + r31) * FR_LD + 16 * s + 8 * h), bfv = *(const bf16x8*)(dB + (32 * cbk + r31) * FR_LD + 16 * s + 8 * h);
      bf16x8 nb; for (int e = 0; e < 8; ++e) nb[e] = (short)(bfv[e] ^ (short)0x8000);
      R = MFMA32(cw, af, R); R = MFMA32(sw, nb, R); nI = MFMA32(sw, af, nI); nI = MFMA32(cw, bfv, nI);
    }
    const int col = c0 + 32 * cbk + r31;
#pragma unroll
    for (int i = 0; i < 16; ++i) {
      const int k1 = 32 * rb + crow(i, h);
      const float x = (float)(k1 * t2) * (1.0f / 8192.0f); const float ct = cospif(x), st = sinpif(x);
      const float vre = R[i] * ct - nI[i] * st, vim = -nI[i] * ct - R[i] * st;
      bf16_t* vp = V + ((size_t)(k1 * 128 + t2) * 2) * 256 + col;
      vp[0] = f2bf(vre); vp[256] = f2bf(vim);
    }
  }
}
DI void fourier_stage2(int WV, KArgs a, unsigned char* smem) {
  const int tid = ltid(), lane = tid & 63, wave = tid >> 6, r31 = lane & 31, h = lane >> 5, rb = wave & 3, cbk = wave >> 2;
  const bf16_t* V = (const bf16_t*)(a->ws + WS_V); bf16_t* BR = (bf16_t*)(a->ws + WS_BR);
  const bf16_t* Cw = (const bf16_t*)smem; const bf16_t* Sw = Cw + 128 * FR_LD; const bf16_t* dA = Sw + 128 * FR_LD; const bf16_t* dB = dA + 64 * FR_LD;
  for (int it = lbid(); it < 512; it += lnb()) {
    const int k1 = it >> 2, c0 = (it & 3) * 64;
    __syncthreads();
    fourier_load(WV, V + (size_t)k1 * 128 * 512 + c0, (size_t)512, (size_t)256, smem);
    __syncthreads();
    f32x16 Y; for (int i = 0; i < 16; ++i) Y[i] = 0.f;
#pragma unroll
    for (int s = 0; s < 8; ++s) {
      const bf16x8 cw = *(const bf16x8*)(Cw + (32 * rb + r31) * FR_LD + 16 * s + 8 * h), sw = *(const bf16x8*)(Sw + (32 * rb + r31) * FR_LD + 16 * s + 8 * h);
      const bf16x8 vr = *(const bf16x8*)(dA + (32 * cbk + r31) * FR_LD + 16 * s + 8 * h), vi = *(const bf16x8*)(dB + (32 * cbk + r31) * FR_LD + 16 * s + 8 * h);
      Y = MFMA32(cw, vr, Y); Y = MFMA32(sw, vi, Y);
    }
    const int col = c0 + 32 * cbk + r31;
#pragma unroll
    for (int i = 0; i < 16; ++i) { const int k2 = 32 * rb + crow(i, h); BR[(size_t)(k1 + 128 * k2) * 1024 + col] = f2bf(Y[i] * (1.0f / 1024.0f)); }
  }
}
DI void fourier_ctx(int WV, KArgs a) {
  const int tid = ltid();
  const bf16_t* PB = (const bf16_t*)(a->ws + WS_PB) + (size_t)L_ * NPB_; bf16_t* BR = (bf16_t*)(a->ws + WS_BR) + (size_t)L_ * 1024;
  for (int k = lbid(); k < 256; k += lnb()) {
    if (tid < 256) {
      float acc = 0.f;
      for (int t = 0; t < 256; ++t) {
        const float x = (float)((k * t) & 255) * (1.0f / 128.0f);
        acc += cospif(x) * bf2f(PB[(size_t)t * NPB_ + C_FA + tid]) - sinpif(x) * bf2f(PB[(size_t)t * NPB_ + C_FB + tid]);
      }
      BR[(size_t)k * 1024 + tid] = f2bf(acc * (1.0f / 128.0f));
    }
  }
}
DI int chunk_row0(int ci) { return ci < 128 ? ci * 128 : L_ + (ci - 128) * 128; }
DI void ret_states(int WV, KArgs a, int l, unsigned char* smem) {
  const int tid = ltid();
  const bf16_t* PB = (const bf16_t*)(a->ws + WS_PB); float* T = (float*)(a->ws + WS_T);
  const float* S = (const float*)(a->ws + WS_SCAL) + l * 64;
  float* kL = (float*)smem; float* vL = kL + 128 * 33; float* wf = vL + 128 * 64; float* wb = wf + 128;
  for (int it = lbid(); it < 130 * 6; it += lnb()) {
    const int ci = it / 6, hh = it % 6, r0 = chunk_row0(ci);
    __syncthreads();
    { const int row = tid >> 2, seg = tid & 3; const bf16x8 v = *(const bf16x8*)(PB + (size_t)(r0 + row) * NPB_ + C_RK + hh * 32 + seg * 8);
#pragma unroll
      for (int e = 0; e < 8; ++e) kL[row * 33 + seg * 8 + e] = bf2f((unsigned)(unsigned short)v[e]); }
#pragma unroll
    for (int q = 0; q < 2; ++q) { const int id = tid + 512 * q, row = id >> 3, seg = id & 7; const bf16x8 v = *(const bf16x8*)(PB + (size_t)(r0 + row) * NPB_ + C_RV + hh * 64 + seg * 8);
#pragma unroll
      for (int e = 0; e < 8; ++e) vL[row * 64 + seg * 8 + e] = bf2f((unsigned)(unsigned short)v[e]); }
    if (tid < 128) { wf[tid] = expf(S[4 + hh] * (float)(127 - tid)); wb[tid] = expf(S[10 + hh] * (float)tid); }
    __syncthreads();
    const int d = tid >> 4, v4 = (tid & 15) * 4;
    f32x4 af = {0.f, 0.f, 0.f, 0.f}, ab = {0.f, 0.f, 0.f, 0.f};
#pragma unroll 4
    for (int j = 0; j < 128; ++j) { const float kd = kL[j * 33 + d]; const f32x4 vv = *(const f32x4*)(vL + j * 64 + v4); af += vv * (kd * wf[j]); ab += vv * (kd * wb[j]); }
    float* tp = T + ((size_t)(ci * 6 + hh) * 2) * 2048 + d * 64 + v4;
    *(f32x4*)tp = af; *(f32x4*)(tp + 2048) = ab;
  }
}
DI void ret_scan(int WV, KArgs a, int l) {
  const int gt = lbid() * 512 + ltid();
  if (gt >= 6 * 2 * 2048) return;
  const int idx = gt & 2047, dir = (gt >> 11) & 1, hh = gt >> 12;
  const float* T = (const float*)(a->ws + WS_T); float* S = (float*)(a->ws + WS_S);
  const float* SC = (const float*)(a->ws + WS_SCAL) + l * 64;
  const float dec = expf(SC[4 + dir * 6 + hh] * 128.0f);
  const size_t base = (size_t)(hh * 2 + dir) * 2048 + idx; const size_t cs = (size_t)6 * 2 * 2048;
  const float tc0 = T[base + 128 * cs], tc1 = T[base + 129 * cs];
  if (dir == 0) {
    float s = tc0 * dec + tc1; S[base + 128 * cs] = 0.f; S[base + 129 * cs] = tc0;
#pragma unroll 8
    for (int i = 0; i < 128; ++i) { S[base + i * cs] = s; s = s * dec + T[base + i * cs]; }
  } else {
    float s = tc0 + dec * tc1; S[base + 129 * cs] = 0.f; S[base + 128 * cs] = tc1;
#pragma unroll 8
    for (int i = 127; i >= 0; --i) { S[base + i * cs] = s; s = s * dec + T[base + i * cs]; }
  }
}
DI void ret_out(int WV, KArgs a, int l, unsigned char* smem) {
  const int tid = ltid(), lane = tid & 63, wave = tid >> 6, r31 = lane & 31, h = lane >> 5, jb = wave & 3, vh = wave >> 2;
  const bf16_t* PB = (const bf16_t*)(a->ws + WS_PB); bf16_t* BR = (bf16_t*)(a->ws + WS_BR); const float* Sg = (const float*)(a->ws + WS_S);
  const float* SC = (const float*)(a->ws + WS_SCAL) + l * 64;
  bf16_t* Kl = (bf16_t*)smem;
  bf16_t* Vt = Kl + 128 * 40;
  bf16_t* SfT = Vt + 64 * 136;
  bf16_t* SbT = SfT + 64 * 40;
  float* pwf = (float*)(SbT + 64 * 40);
  float* pwb = pwf + 128;
  float* ssq = pwb + 128;
  for (int it = lbid(); it < 130 * 6; it += lnb()) {
    const int ci = it / 6, hh = it % 6, r0 = chunk_row0(ci);
    const float lgf = SC[4 + hh], lgb = SC[10 + hh];
    __syncthreads();
    { const int row = tid >> 2, seg = tid & 3; *(bf16x8*)(Kl + row * 40 + seg * 8) = *(const bf16x8*)(PB + (size_t)(r0 + row) * NPB_ + C_RK + hh * 32 + seg * 8); }
#pragma unroll
    for (int q = 0; q < 2; ++q) { const int id = tid + 512 * q, row = id >> 3, seg = id & 7; const bf16x8 v = *(const bf16x8*)(PB + (size_t)(r0 + row) * NPB_ + C_RV + hh * 64 + seg * 8);
#pragma unroll
      for (int e = 0; e < 8; ++e) Vt[(seg * 8 + e) * 136 + row] = (bf16_t)v[e]; }
#pragma unroll
    for (int q = 0; q < 8; ++q) { const int e = tid + 512 * q, dir = e >> 11, idx = e & 2047, d = idx >> 6, v = idx & 63;
      const float sv = Sg[((size_t)(ci * 6 + hh) * 2 + dir) * 2048 + idx]; (dir ? SbT : SfT)[v * 40 + d] = f2bf(sv); }
    if (tid < 128) { pwf[tid] = expf(lgf * (float)tid); pwb[tid] = expf(lgb * (float)tid); }
    const int qrow = r0 + 32 * jb + r31, j = 32 * jb + r31;
    bf16x8 qf[2];
#pragma unroll
    for (int s = 0; s < 2; ++s) qf[s] = *(const bf16x8*)(PB + (size_t)qrow * NPB_ + C_RQ + hh * 32 + 16 * s + 8 * h);
    __syncthreads();
    f32x16 O; for (int i = 0; i < 16; ++i) O[i] = 0.f;
#pragma unroll
    for (int kb = 0; kb < 4; ++kb) {
      f32x16 St; for (int i = 0; i < 16; ++i) St[i] = 0.f;
#pragma unroll
      for (int s = 0; s < 2; ++s) { const bf16x8 kf = *(const bf16x8*)(Kl + (32 * kb + r31) * 40 + 16 * s + 8 * h); St = MFMA32(kf, qf[s], St); }
#pragma unroll
      for (int i = 0; i < 16; ++i) { const int jp = 32 * kb + crow(i, h); const int dl = j - jp; const float dv = dl > 0 ? pwf[dl] : (dl < 0 ? pwb[-dl] : 2.0f); St[i] *= dv; }
#pragma unroll
      for (int s = 0; s < 2; ++s) {
        const bf16x8 pb = pack_step(St, s);
        const bf16_t* vp = Vt + (32 * vh + r31) * 136 + 32 * kb + 16 * s + 4 * h;
        const s16x4 lo = *(const s16x4*)vp, hi = *(const s16x4*)(vp + 8);
        const bf16x8 vf = __builtin_shufflevector(lo, hi, 0, 1, 2, 3, 4, 5, 6, 7);
        O = MFMA32(vf, pb, O);
      }
    }
    f32x16 Of, Ob; for (int i = 0; i < 16; ++i) { Of[i] = 0.f; Ob[i] = 0.f; }
#pragma unroll
    for (int s = 0; s < 2; ++s) {
      const bf16x8 sf = *(const bf16x8*)(SfT + (32 * vh + r31) * 40 + 16 * s + 8 * h), sb = *(const bf16x8*)(SbT + (32 * vh + r31) * 40 + 16 * s + 8 * h);
      Of = MFMA32(sf, qf[s], Of); Ob = MFMA32(sb, qf[s], Ob);
    }
    const float qdf = expf(lgf * (float)(j + 1)), qdb = expf(lgb * (float)(128 - j));
    float ss = 0.f;
#pragma unroll
    for (int i = 0; i < 16; ++i) { O[i] = O[i] + Of[i] * qdf + Ob[i] * qdb; ss += O[i] * O[i]; }
    ss += shx(ss, 32, lane_id_v());
    if (h == 0) ssq[vh * 128 + j] = ss;
    __syncthreads();
    const float rstd = rsqrtf((ssq[j] + ssq[128 + j]) * (1.0f / 64.0f) + EPS_);
#pragma unroll
    for (int g4 = 0; g4 < 4; ++g4) {
      const int v0 = 32 * vh + 8 * g4 + 4 * h;
      const u32x2 gw = *(const u32x2*)(PB + (size_t)qrow * NPB_ + C_RG + hh * 64 + v0);
      const float g0 = bf2f(gw.x & 0xffffu), g1 = bf2f(gw.x >> 16), g2 = bf2f(gw.y & 0xffffu), g3 = bf2f(gw.y >> 16);
      u32x2 w; w.x = cvt_pk_bf16(O[4 * g4] * rstd * g0, O[4 * g4 + 1] * rstd * g1); w.y = cvt_pk_bf16(O[4 * g4 + 2] * rstd * g2, O[4 * g4 + 3] * rstd * g3);
      *(u32x2*)(BR + (size_t)qrow * 1024 + 256 + hh * 64 + v0) = w;
    }
  }
}
constexpr int AT_LD = 72;
DI void attn_phase(int WV, KArgs a, int l, bool with_ctx, unsigned char* smem) {
  const int tid = ltid(), lane = tid & 63, wave = tid >> 6, r31 = lane & 31, h = lane >> 5, qsub = wave & 3, kh = wave >> 2;
  const bf16_t* PB = (const bf16_t*)(a->ws + WS_PB); bf16_t* BR = (bf16_t*)(a->ws + WS_BR);
  const float* SC = (const float*)(a->ws + WS_SCAL) + l * 64;
  const float lam = SC[0], lam_init = SC[1];
  bf16_t* Ks = (bf16_t*)smem;
  bf16_t* Vt = Ks + 2 * 64 * AT_LD;
  float* cmb = (float*)(Vt + 2 * 64 * AT_LD);
  const int nitems = 6 * 128 + (with_ctx ? 12 : 0);
  const int skey = tid >> 3, sseg = tid & 7;
  for (int it = lbid(); it < nitems; it += lnb()) {
    int head, q0, krow0, nt;
    if (it < 768) { head = it >> 7; q0 = (it & 127) * 128; krow0 = 0; nt = MT_ / 64; }
    else { const int e = it - 768; head = e >> 1; q0 = L_ + (e & 1) * 128; krow0 = L_; nt = LC_ / 64; }
    const int qrow = q0 + 32 * qsub + r31;
    bf16x8 qf[2][2];
#pragma unroll
    for (int mp = 0; mp < 2; ++mp)
#pragma unroll
      for (int s = 0; s < 2; ++s) qf[mp][s] = *(const bf16x8*)(PB + (size_t)qrow * NPB_ + C_DQ + head * 64 + mp * 32 + 16 * s + 8 * h);
    float negm[2];
#pragma unroll
    for (int mp = 0; mp < 2; ++mp) {
      float ss = 0.f;
#pragma unroll
      for (int s = 0; s < 2; ++s)
#pragma unroll
        for (int e = 0; e < 8; ++e) { const float x = bf2f((unsigned)(unsigned short)qf[mp][s][e]); ss += x * x; }
      ss += shx(ss, 32, lane_id_v());
      const float kmx = __uint_as_float(((const unsigned*)SC)[16 + head * 2 + mp]);
      negm[mp] = -sqrtf(ss * kmx) * 1.01f;
    }
    f32x16 NM1, NM2; for (int i = 0; i < 16; ++i) { NM1[i] = negm[0]; NM2[i] = negm[1]; }
    f32x16 O1[2], O2[2]; for (int i = 0; i < 16; ++i) { O1[0][i] = 0.f; O1[1][i] = 0.f; O2[0][i] = 0.f; O2[1][i] = 0.f; }
    float l1 = 0.f, l2 = 0.f;
    const bf16_t* kg = PB + (size_t)(krow0 + skey) * NPB_ + C_DK + head * 64 + sseg * 8;
    const bf16_t* vg = PB + (size_t)(krow0 + skey) * NPB_ + C_DV + head * 64 + sseg * 8;
    __syncthreads();
    bf16x8 kreg = *(const bf16x8*)kg, vreg = *(const bf16x8*)vg;
    { *(bf16x8*)(Ks + skey * AT_LD + sseg * 8) = kreg;
#pragma unroll
      for (int e = 0; e < 8; ++e) Vt[(sseg * 8 + e) * AT_LD + skey] = (bf16_t)vreg[e]; }
    __syncthreads();
    for (int t = 0; t < nt; ++t) {
      const int buf = t & 1;
      if (t + 1 < nt) { kreg = *(const bf16x8*)(kg + (size_t)(t + 1) * 64 * NPB_); vreg = *(const bf16x8*)(vg + (size_t)(t + 1) * 64 * NPB_); }
      const bf16_t* ks = Ks + buf * 64 * AT_LD + (32 * kh + r31) * AT_LD + 8 * h;
      const bf16_t* vt = Vt + buf * 64 * AT_LD + r31 * AT_LD + 32 * kh + 4 * h;
      f32x16 S1 = MFMA32(*(const bf16x8*)(ks), qf[0][0], NM1); S1 = MFMA32(*(const bf16x8*)(ks + 16), qf[0][1], S1);
      f32x16 S2 = MFMA32(*(const bf16x8*)(ks + 32), qf[1][0], NM2); S2 = MFMA32(*(const bf16x8*)(ks + 48), qf[1][1], S2);
#pragma unroll
      for (int i = 0; i < 16; ++i) { S1[i] = __builtin_amdgcn_exp2f(S1[i]); l1 += S1[i]; S2[i] = __builtin_amdgcn_exp2f(S2[i]); l2 += S2[i]; }
#pragma unroll
      for (int s = 0; s < 2; ++s) {
        const bf16x8 p1 = pack_step(S1, s), p2 = pack_step(S2, s);
#pragma unroll
        for (int mt = 0; mt < 2; ++mt) {
          const bf16_t* vp = vt + mt * 32 * AT_LD + 16 * s;
          const s16x4 lo = *(const s16x4*)vp, hi = *(const s16x4*)(vp + 8);
          const bf16x8 vf = __builtin_shufflevector(lo, hi, 0, 1, 2, 3, 4, 5, 6, 7);
          O1[mt] = MFMA32(vf, p1, O1[mt]); O2[mt] = MFMA32(vf, p2, O2[mt]);
        }
      }
      if (t + 1 < nt) {
        const int nb = buf ^ 1;
        *(bf16x8*)(Ks + nb * 64 * AT_LD + skey * AT_LD + sseg * 8) = kreg;
#pragma unroll
        for (int e = 0; e < 8; ++e) Vt[nb * 64 * AT_LD + (sseg * 8 + e) * AT_LD + skey] = (bf16_t)vreg[e];
      }
      __syncthreads();
    }
    float* cw = cmb + (size_t)(qsub * 64 + lane) * 66;
    if (kh == 1) {
#pragma unroll
      for (int i = 0; i < 16; ++i) { cw[i] = O1[0][i]; cw[16 + i] = O1[1][i]; cw[32 + i] = O2[0][i]; cw[48 + i] = O2[1][i]; }
      cw[64] = l1; cw[65] = l2;
    }
    __syncthreads();
    if (kh == 0) {
#pragma unroll
      for (int i = 0; i < 16; ++i) { O1[0][i] += cw[i]; O1[1][i] += cw[16 + i]; O2[0][i] += cw[32 + i]; O2[1][i] += cw[48 + i]; }
      l1 += cw[64]; l2 += cw[65];
      l1 += shx(l1, 32, lane_id_v()); l2 += shx(l2, 32, lane_id_v());
      const float i1 = 1.0f / l1, i2 = lam / l2;
      float ss = 0.f;
#pragma unroll
      for (int mt = 0; mt < 2; ++mt)
#pragma unroll
        for (int i = 0; i < 16; ++i) { const float o = O1[mt][i] * i1 - O2[mt][i] * i2; O1[mt][i] = o; ss += o * o; }
      ss += shx(ss, 32, lane_id_v());
      const float sc = rsqrtf(ss * (1.0f / 64.0f) + EPS_) * (1.0f - lam_init);
      const float* sw = a->in[13] + l * 64;
#pragma unroll
      for (int mt = 0; mt < 2; ++mt)
#pragma unroll
        for (int g4 = 0; g4 < 4; ++g4) {
          const int v0 = 32 * mt + 8 * g4 + 4 * h;
          const f32x4 wv = *(const f32x4*)(sw + v0);
          u32x2 w; w.x = cvt_pk_bf16(O1[mt][4 * g4] * sc * wv[0], O1[mt][4 * g4 + 1] * sc * wv[1]); w.y = cvt_pk_bf16(O1[mt][4 * g4 + 2] * sc * wv[2], O1[mt][4 * g4 + 3] * sc * wv[3]);
          *(u32x2*)(BR + (size_t)qrow * 1024 + 640 + head * 64 + v0) = w;
        }
    }
  }
}
template <class Epi> DI void run_gemm(int WV, LAS unsigned char* lds, const bf16_t* A, int lda, const bf16_t* Bt, int M, int N, int K, const Epi& E) {
  pg8::Gemm g; g.A = A; g.Bt = Bt; g.M = M; g.N = N; g.K = K; g.lda = lda;
  pg8::StaticOrder S; S.init(M, N, lnb(), lbid());
  pg8::gemm_phase<Epi, pg8::StaticOrder, false>(WV, lds, g, S, E, nullptr);
}
struct CtxMerge0 { float* MXC; const bf16_t* G; DI void operator()(int r, int c, float v) const { MXC[r * 1024 + c] = bf2f(G[(size_t)r * NGB_ + c]) * v; } };
struct CtxMerge1 { float* MXC; const bf16_t* G; DI void operator()(int r, int c, float v) const { MXC[r * 1024 + c] += bf2f(G[(size_t)r * NGB_ + c]) * v; } };
struct CtxMerge2 { const float* MXC; const bf16_t* G; bf16_t* Hc; DI void operator()(int r, int c, float v) const { Hc[r * 1024 + c] = f2bf(MXC[r * 1024 + c] + bf2f(G[(size_t)r * NGB_ + c]) * v); } };
struct CtxResid { float* Xc; const float* gate; float scale; DI void operator()(int r, int c, float v) const { Xc[r * 1024 + c] += scale * gate[c] * v; } };

DI void phase_win(int WV, int l, unsigned char* smem) {
  KArgs a = kargs(); unsigned char* ws = a->ws;
  EpiWin E; E.PB = (bf16_t*)(ws + WS_PB); E.GB = (bf16_t*)(ws + WS_GB); E.TRET = (const float*)(ws + WS_TRET); E.TROW = (const float*)(ws + WS_TROW); E.TCOL = (const float*)(ws + WS_TCOL);
  E.kmax = (unsigned*)(ws + WS_SCAL) + l * 64 + 16;
  run_gemm(WV, (LAS unsigned char*)smem, (const bf16_t*)(ws + WS_H), 1024, (const bf16_t*)(ws + WS_WIN) + (size_t)l * 5888 * 1024, MT_, NWIN_, 1024, E);
}
DI void phase_merge(int WV, int l, unsigned char* smem) {
  LAS unsigned char* lds = (LAS unsigned char*)smem;
  { KArgs a = kargs(); unsigned char* ws = a->ws; EpiMerge<0> E; E.MX = a->out; E.G = (const bf16_t*)(ws + WS_GB); E.Hout = (bf16_t*)(ws + WS_H);
    run_gemm(WV, lds, (const bf16_t*)(ws + WS_BR), 1024, (const bf16_t*)(ws + WS_WBF) + (size_t)l * 1024 * 256, L_, 1024, 256, E); }
  { KArgs a = kargs(); unsigned char* ws = a->ws; EpiMerge<1> E; E.MX = a->out; E.G = (const bf16_t*)(ws + WS_GB) + 1024; E.Hout = (bf16_t*)(ws + WS_H);
    run_gemm(WV, lds, (const bf16_t*)(ws + WS_BR) + 256, 1024, (const bf16_t*)(ws + WS_WBR) + (size_t)l * 1024 * 384, L_, 1024, 384, E); }
  { KArgs a = kargs(); unsigned char* ws = a->ws; EpiMerge<2> E; E.MX = a->out; E.G = (const bf16_t*)(ws + WS_GB) + 2048; E.Hout = (bf16_t*)(ws + WS_H);
    run_gemm(WV, lds, (const bf16_t*)(ws + WS_BR) + 640, 1024, (const bf16_t*)(ws + WS_WBD) + (size_t)l * 1024 * 384, L_, 1024, 384, E); }
  { KArgs a = kargs(); unsigned char* ws = a->ws;
    const bf16_t* BRc = (const bf16_t*)(ws + WS_BR) + (size_t)L_ * 1024; const bf16_t* GBc = (const bf16_t*)(ws + WS_GB) + (size_t)L_ * NGB_;
    CtxMerge0 e0; e0.MXC = (float*)(ws + WS_MXC); e0.G = GBc;
    ctx_gemm32(WV, BRc, 1024, (const bf16_t*)(ws + WS_WBF) + (size_t)l * 1024 * 256, 256, 1024, smem, e0);
    CtxMerge1 e1; e1.MXC = (float*)(ws + WS_MXC); e1.G = GBc + 1024;
    ctx_gemm32(WV, BRc + 256, 1024, (const bf16_t*)(ws + WS_WBR) + (size_t)l * 1024 * 384, 384, 1024, smem, e1);
    CtxMerge2 e2; e2.MXC = (const float*)(ws + WS_MXC); e2.G = GBc + 2048; e2.Hc = (bf16_t*)(ws + WS_H) + (size_t)L_ * 1024;
    ctx_gemm32(WV, BRc + 640, 1024, (const bf16_t*)(ws + WS_WBD) + (size_t)l * 1024 * 384, 384, 1024, smem, e2); }
}
DI void phase_wo(int WV, int l, unsigned char* smem) {
  { KArgs a = kargs(); unsigned char* ws = a->ws; EpiResid E; E.X = (float*)(ws + WS_X); E.gate = (const float*)(ws + WS_MOD) + (size_t)l * 9216 + 5 * 1024; E.scale = 1.0f;
    run_gemm(WV, (LAS unsigned char*)smem, (const bf16_t*)(ws + WS_H), 1024, (const bf16_t*)(ws + WS_WO) + (size_t)l * 1024 * 1024, L_, 1024, 1024, E); }
  { KArgs a = kargs(); unsigned char* ws = a->ws; CtxResid e; e.Xc = (float*)(ws + WS_X) + (size_t)L_ * 1024; e.gate = (const float*)(ws + WS_MOD) + (size_t)(4 + l) * 9216 + 5 * 1024; e.scale = 1.0f;
    ctx_gemm32(WV, (const bf16_t*)(ws + WS_H) + (size_t)L_ * 1024, 1024, (const bf16_t*)(ws + WS_WO) + (size_t)l * 1024 * 1024, 1024, 1024, smem, e); }
}
DI void phase_g1(int WV, int l, int f, unsigned char* smem) {
  KArgs a = kargs(); unsigned char* ws = a->ws; EpiSwiglu E; E.U = (bf16_t*)(ws + WS_U);
  run_gemm(WV, (LAS unsigned char*)smem, (const bf16_t*)(ws + WS_H), 1024, (const bf16_t*)(ws + WS_W13) + (size_t)(l * 2 + f) * 5632 * 1024, MT_, 5632, 1024, E);
}
DI void phase_g2(int WV, int l, int f, unsigned char* smem) {
  const int gi = f == 0 ? 2 : 8;
  { KArgs a = kargs(); unsigned char* ws = a->ws; EpiResid E; E.X = (float*)(ws + WS_X); E.gate = (const float*)(ws + WS_MOD) + (size_t)l * 9216 + gi * 1024; E.scale = 0.5f;
    run_gemm(WV, (LAS unsigned char*)smem, (const bf16_t*)(ws + WS_U), 2816, (const bf16_t*)(ws + WS_W2) + (size_t)(l * 2 + f) * 1024 * 2816, L_, 1024, 2816, E); }
  { KArgs a = kargs(); unsigned char* ws = a->ws; CtxResid e; e.Xc = (float*)(ws + WS_X) + (size_t)L_ * 1024; e.gate = (const float*)(ws + WS_MOD) + (size_t)(4 + l) * 9216 + gi * 1024; e.scale = 0.5f;
    ctx_gemm32(WV, (const bf16_t*)(ws + WS_U) + (size_t)L_ * 2816, 2816, (const bf16_t*)(ws + WS_W2) + (size_t)(l * 2 + f) * 1024 * 2816, 2816, 1024, smem, e); }
}

__global__ void __launch_bounds__(512, 2) mega(Args a_unused) {
  extern __shared__ __attribute__((aligned(16))) unsigned char smem[];
  cg::grid_group grid = cg::this_grid();
  const int WV = __builtin_amdgcn_readfirstlane((int)(threadIdx.x >> 6));
#ifndef NO_PRO
  prologue(WV, kargs(), smem);
#endif
  grid.sync();
#pragma unroll 1
  for (int l = 0; l < DEPTH_; ++l) {
#pragma unroll 1
    for (int f = 0; f < 2; ++f) {
      if (f == 1) {
        norm_phase(WV, kargs(), l, 1, false);
        grid.sync();
        phase_win(WV, l, smem);
        grid.sync();
#ifndef NO_MIXA
        fourier_tables(WV, smem); __syncthreads(); fourier_stage1(WV, kargs(), smem); fourier_ctx(WV, kargs()); __syncthreads(); ret_states(WV, kargs(), l, smem);
#endif
        grid.sync();
#ifndef NO_MIXB
        ret_scan(WV, kargs(), l); __syncthreads(); fourier_tables(WV, smem); __syncthreads(); fourier_stage2(WV, kargs(), smem);
#endif
        grid.sync();
#ifndef NO_RETOUT
        ret_out(WV, kargs(), l, smem); __syncthreads();
#endif
#ifndef NO_ATTN
        attn_phase(WV, kargs(), l, l < DEPTH_ - 1, smem);
#endif
        grid.sync();
        phase_merge(WV, l, smem);
        grid.sync();
        phase_wo(WV, l, smem);
        grid.sync();
      }
      norm_phase(WV, kargs(), l, f == 0 ? 0 : 2, l == 0 && f == 0);
      grid.sync();
      phase_g1(WV, l, f, smem);
      grid.sync();
      phase_g2(WV, l, f, smem);
      grid.sync();
    }
  }
  final_norm(WV, kargs());
}

extern "C" void kernel_launch(void* const* d_in, const int* in_sizes, int n_in, void* d_out, int out_size, void* d_ws, size_t ws_size, hipStream_t stream) {
  static int grid = 0;
  if (grid == 0) {
    int dev = 0, cus = 0, per_cu = 0;
    (void)hipGetDevice(&dev); (void)hipDeviceGetAttribute(&cus, hipDeviceAttributeMultiprocessorCount, dev);
    if (hipFuncSetAttribute((const void*)mega, hipFuncAttributeMaxDynamicSharedMemorySize, LDS_BYTES) != hipSuccess) fprintf(stderr, "kernel_launch: hipFuncSetAttribute failed\n");
    if (hipOccupancyMaxActiveBlocksPerMultiprocessor(&per_cu, (const void*)mega, 512, LDS_BYTES) != hipSuccess || per_cu < 1) fprintf(stderr, "kernel_launch: occupancy query says %d blocks per CU\n", per_cu);
    (void)hipGetLastError();
    grid = cus > 0 ? cus : 256;
    if (ws_size < WS_END) { fprintf(stderr, "kernel_launch: workspace too small: %zu < %zu\n", ws_size, (size_t)WS_END); }
  }
  Args a{};
  for (int i = 0; i < 19; ++i) a.in[i] = (const float*)d_in[i];
  a.out = (float*)d_out; a.ws = (unsigned char*)d_ws;
  void* args[] = {&a};
  hipError_t e = hipLaunchCooperativeKernel((const void*)mega, dim3(grid), dim3(512), args, LDS_BYTES, stream);
  if (e != hipSuccess) fprintf(stderr, "kernel_launch: cooperative launch failed: %s (grid %d)\n", hipGetErrorString(e), grid);
}
```

```cpp
#include <hip/hip_runtime.h>
#include <hip/hip_cooperative_groups.h>
#include <cstdio>
namespace cg = cooperative_groups;
__device__ __forceinline__ int lane_id_v() { int l; asm volatile("v_mbcnt_lo_u32_b32 %0, -1, 0\n\tv_mbcnt_hi_u32_b32 %0, -1, %0" : "=v"(l)); return l; }
#define ltid() ((WV << 6) | lane_id_v())
__device__ __forceinline__ float shx(float v, int m, int lane) { return __int_as_float(__builtin_amdgcn_ds_bpermute((lane ^ m) << 2, __float_as_int(v))); }
namespace pg8 {
#define PG8_LAS __attribute__((address_space(3)))
typedef unsigned short bf16_t;
typedef short bf16x8 __attribute__((ext_vector_type(8)));
typedef float f32x4 __attribute__((ext_vector_type(4)));
typedef unsigned u32x4 __attribute__((ext_vector_type(4)));
constexpr int BM = 256, BK = 64, HALF = 128, HTB = HALF * BK * 2  , STAGE_BYTES = 8 * HTB, NXCD = 8, WGM = 8;

__host__ __device__ __forceinline__ int lds_byte(int r, int c) { const int st = (r >> 4) * 2 + (c >> 5), rr = r & 15, cc = c & 31, ob = rr * 64 + cc * 2; return st * 1024 + (ob ^ (((ob >> 9) & 1) << 5)); }
__host__ __device__ __forceinline__ void stage_rc(int b, int& R, int& C) { const int st = b / 1024, sb = b % 1024, swz = sb ^ (((sb >> 9) & 1) << 5); R = (st >> 1) * 16 + swz / 64; C = (st & 1) * 32 + (swz % 64) / 2; }
__host__ __device__ __forceinline__ int perm32(int rho) { const int n = rho >> 4, i = rho & 15; return 8 * (i >> 2) + 4 * n + (i & 3); }

struct Unit { int pm, pn; };
struct Gemm { const bf16_t* A; const bf16_t* Bt; int M, N, K, lda; };

struct StaticOrder {
    int nM, nN, nwg, G, c;
    __host__ __device__ void init(int M, int N, int G_, int c_) { nM = M / BM; nN = N / BM; nwg = nM * nN; G = G_; c = c_; }
    __host__ __device__ bool next(int i, Unit& u) const {
        const long L = (long)i * G + c; if (L >= nwg) return false;
        int wgid = (int)L; { const int q = nwg / NXCD, r = nwg % NXCD, xcd = wgid % NXCD, off = wgid / NXCD; wgid = (xcd < r ? xcd * (q + 1) : r * (q + 1) + (xcd - r) * q) + off; }
        const int nig = WGM * nN, gid = wgid / nig, fm = gid * WGM, gsz = (nM - fm) < WGM ? (nM - fm) : WGM;
        u.pm = fm + ((wgid % nig) % gsz); u.pn = (wgid % nig) / gsz; return true;
    }
    __device__ __forceinline__ void a_ready(const Unit&) const {}
    __device__ __forceinline__ void done(const Unit&) const {}
};
__device__ __forceinline__ unsigned cvt_pk_bf16(float lo, float hi) { unsigned r; asm volatile("v_cvt_pk_bf16_f32 %0, %1, %2" : "=v"(r) : "v"(lo), "v"(hi)); return r; }
template <class Epi, class Sched, bool STAMP = false>
__device__ __forceinline__ void gemm_phase(const int WV, PG8_LAS unsigned char* lds, const Gemm g, const Sched& S, const Epi& E, unsigned long long* stamps) {
    const int tid = ltid(); const int wid = __builtin_amdgcn_readfirstlane(tid >> 6), lane = tid & 63, wr = wid >> 2, wc = wid & 3, fr = lane & 15, fq = lane >> 4;
    const int K = g.K, nt = K / BK;
    int ts_lo = 0, ts_hi = 0, nts = 0; const unsigned long long rt_entry = STAMP ? (unsigned long long)wall_clock64() : 0ull;
#define PG8_STAMP() do { if (STAMP && wid == 0 && nts < 64) { const unsigned long long _c = (unsigned long long)clock64(); \
        ts_lo = (lane == nts) ? (int)(unsigned)_c : ts_lo; ts_hi = (lane == nts) ? (int)(unsigned)(_c >> 32) : ts_hi; ++nts; } } while (0)
    PG8_STAMP();
    unsigned voffA[2], voffB[2];
#pragma unroll
    for (int i = 0; i < 2; ++i) { int R, C; stage_rc(tid * 16 + i * 8192, R, C); const int Rb = Epi::PERM ? ((R & ~31) + perm32(R & 31)) : R;
        voffA[i] = (unsigned)(R * g.lda + C) * 2u; voffB[i] = (unsigned)(Rb * K + C) * 2u; }
    const size_t kstep = (size_t)(BK * 2);
    const size_t hstep = (size_t)HALF * K * 2;
    const size_t tstep = 2 * hstep; const size_t hstepA = (size_t)HALF * g.lda * 2; const size_t tstepA = 2 * hstepA;
    const unsigned ldsw = (unsigned)wid * 1024u;
    const int aoff = lds_byte(wr * 64 + fr, fq * 8), boff = lds_byte(wc * 32 + fr, fq * 8);
#define PG8_SA(b, h) (((b) * 2 + (h)) * HTB)
#define PG8_SB(b, h) ((4 + (b) * 2 + (h)) * HTB)
#define PG8_STAGE(bufoff, gbase, voff) do { _Pragma("unroll") for (int _i = 0; _i < 2; ++_i) \
        __builtin_amdgcn_global_load_lds((const unsigned*)((const char*)(gbase) + (voff)[_i]), (PG8_LAS unsigned*)(lds + (bufoff) + ldsw + _i * 8192), 16, 0, 0); } while (0)
#define PG8_LDA(dst, b, h) do { _Pragma("unroll") for (int m = 0; m < 4; ++m) _Pragma("unroll") for (int k = 0; k < 2; ++k) dst[m][k] = *(const PG8_LAS bf16x8*)(lds + PG8_SA(b, h) + aoff + m * 2048 + k * 1024); } while (0)
#define PG8_LDB(dst, b, h) do { _Pragma("unroll") for (int n = 0; n < 2; ++n) _Pragma("unroll") for (int k = 0; k < 2; ++k) dst[n][k] = *(const PG8_LAS bf16x8*)(lds + PG8_SB(b, h) + boff + n * 2048 + k * 1024); } while (0)
#define PG8_MMA(ai, bj, At, Bt) do { __builtin_amdgcn_s_setprio(1); _Pragma("unroll") for (int m = 0; m < 4; ++m) _Pragma("unroll") for (int n = 0; n < 2; ++n) _Pragma("unroll") for (int k = 0; k < 2; ++k) \
        acc[ai][bj][m][n] = __builtin_amdgcn_mfma_f32_16x16x32_bf16(Bt[n][k], At[m][k], acc[ai][bj][m][n], 0, 0, 0); __builtin_amdgcn_s_setprio(0); } while (0)
#define PG8_WAIT_V(n) asm volatile("s_waitcnt vmcnt(" #n ")" ::: "memory")
#define PG8_WAIT_L(n) asm volatile("s_waitcnt lgkmcnt(" #n ")" ::: "memory")
#define PG8_BAR __builtin_amdgcn_s_barrier()
#define PG8_SCHED __builtin_amdgcn_sched_barrier(0)
    Unit cur, nxt; int ui = 0;
    if (!S.next(0, cur)) return;
    f32x4 acc[2][2][4][2];
#pragma unroll
    for (int a = 0; a < 2; ++a)
#pragma unroll
        for (int b = 0; b < 2; ++b)
#pragma unroll
            for (int m = 0; m < 4; ++m)
#pragma unroll
                for (int n = 0; n < 2; ++n) acc[a][b][m][n] = (f32x4){0.f, 0.f, 0.f, 0.f};
    bf16x8 At[4][2], B0[2][2], B1[2][2];
    const char* cA = (const char*)g.A + (size_t)cur.pm * tstepA; const char* cB = (const char*)g.Bt + (size_t)cur.pn * tstep;
    S.a_ready(cur);
    PG8_STAGE(PG8_SB(0, 0), cB, voffB); PG8_STAGE(PG8_SA(0, 0), cA, voffA); PG8_STAGE(PG8_SB(0, 1), cB + hstep, voffB); PG8_STAGE(PG8_SA(0, 1), cA + hstepA, voffA);
    if (wr == 1) PG8_BAR;
    PG8_WAIT_V(4); PG8_BAR;
    PG8_STAGE(PG8_SB(1, 0), cB + kstep, voffB); PG8_STAGE(PG8_SA(1, 0), cA + kstep, voffA); PG8_STAGE(PG8_SB(1, 1), cB + hstep + kstep, voffB);
    PG8_WAIT_V(6); PG8_BAR;
    PG8_STAMP();
    for (;;) {
        const bool has_next = S.next(ui + 1, nxt);
        const char* nA = has_next ? (const char*)g.A + (size_t)nxt.pm * tstepA : cA; const char* nB = has_next ? (const char*)g.Bt + (size_t)nxt.pn * tstep : cB;
        for (int t = 0; t < nt; t += 2) {
            const bool last = (t == nt - 2);
            const char* a1 = cA + (size_t)(t + 1) * kstep;
            const char* a2 = last ? nA : cA + (size_t)(t + 2) * kstep; const char* b2 = last ? nB : cB + (size_t)(t + 2) * kstep;
            const char* a3 = a2 + kstep; const char* b3 = b2 + kstep;
            if (last && has_next) S.a_ready(nxt);
            PG8_LDB(B0, 0, 0); PG8_SCHED; PG8_LDA(At, 0, 0); PG8_STAGE(PG8_SA(1, 1), a1 + hstepA, voffA);
            PG8_WAIT_L(8); PG8_BAR; PG8_WAIT_L(0); PG8_MMA(0, 0, At, B0); PG8_BAR; PG8_SCHED;
            PG8_LDB(B1, 0, 1); PG8_STAGE(PG8_SB(0, 0), b2, voffB);
            PG8_BAR; PG8_WAIT_L(0); PG8_MMA(0, 1, At, B1); PG8_BAR;
            PG8_LDA(At, 0, 1); PG8_STAGE(PG8_SA(0, 0), a2, voffA);
            PG8_BAR; PG8_WAIT_L(0); PG8_MMA(1, 0, At, B0); PG8_BAR; PG8_SCHED;
            PG8_STAGE(PG8_SB(0, 1), b2 + hstep, voffB);
            PG8_WAIT_V(6); PG8_BAR; PG8_MMA(1, 1, At, B1); PG8_BAR;
            PG8_LDB(B0, 1, 0); PG8_SCHED; PG8_LDA(At, 1, 0); PG8_STAGE(PG8_SA(0, 1), a2 + hstepA, voffA);
            PG8_WAIT_L(8); PG8_BAR; PG8_WAIT_L(0); PG8_MMA(0, 0, At, B0); PG8_BAR; PG8_SCHED;
            PG8_LDB(B1, 1, 1); PG8_STAGE(PG8_SB(1, 0), b3, voffB);
            PG8_BAR; PG8_WAIT_L(0); PG8_MMA(0, 1, At, B1); PG8_BAR;
            PG8_LDA(At, 1, 1); PG8_STAGE(PG8_SA(1, 0), a3, voffA);
            PG8_BAR; PG8_WAIT_L(0); PG8_MMA(1, 0, At, B0); PG8_BAR; PG8_SCHED;
            PG8_STAGE(PG8_SB(1, 1), b3 + hstep, voffB);
            PG8_WAIT_V(6); PG8_BAR; PG8_MMA(1, 1, At, B1); PG8_BAR;
        }
        PG8_STAMP();
        if constexpr (!Epi::AFTER_DRAIN) { E(acc, cur, wr, wc, fr, fq); S.done(cur); }
        PG8_STAMP();
        if (!has_next) break;
#pragma unroll
        for (int a = 0; a < 2; ++a)
#pragma unroll
            for (int b = 0; b < 2; ++b)
#pragma unroll
                for (int m = 0; m < 4; ++m)
#pragma unroll
                    for (int n = 0; n < 2; ++n) acc[a][b][m][n] = (f32x4){0.f, 0.f, 0.f, 0.f};
        cur = nxt; cA = nA; cB = nB; ++ui;
    }
    PG8_WAIT_V(0);
    if (wr == 0) PG8_BAR;
    PG8_BAR;
    if constexpr (Epi::AFTER_DRAIN) { E.fused(acc, cur, wr, wc, fr, fq, lds, wid, lane); S.done(cur); }
    PG8_STAMP();
    if (STAMP && wid == 0) { stamps[lane] = lane < nts ? (((unsigned long long)(unsigned)ts_hi << 32) | (unsigned)ts_lo) : 0ull;
        if (lane == 62) stamps[62] = rt_entry; if (lane == 63) stamps[63] = (unsigned long long)wall_clock64(); }
#undef PG8_STAMP
#undef PG8_SA
#undef PG8_SB
#undef PG8_STAGE
#undef PG8_LDA
#undef PG8_LDB
#undef PG8_MMA
#undef PG8_WAIT_V
#undef PG8_WAIT_L
#undef PG8_BAR
#undef PG8_SCHED
}
}
using pg8::bf16_t; using pg8::bf16x8; using pg8::f32x4; using pg8::u32x4; using pg8::cvt_pk_bf16;
typedef float f32x16 __attribute__((ext_vector_type(16)));
typedef short s16x4 __attribute__((ext_vector_type(4)));
typedef unsigned u32x2 __attribute__((ext_vector_type(2)));
#define DI __device__ __forceinline__
#define LAS __attribute__((address_space(3)))
#define MFMA32(a, b, c) __builtin_amdgcn_mfma_f32_32x32x16_bf16((a), (b), (c), 0, 0, 0)

constexpr int L_ = 16384, LC_ = 256, MT_ = 16640, D_ = 1024, DFF_ = 2816, DEPTH_ = 4;
constexpr int NWIN_ = 5888, NPB_ = 2816, NGB_ = 3072;
constexpr int C_FA = 0, C_FB = 256, C_RQ = 512, C_RK = 704, C_RV = 896, C_RG = 1280, C_DQ = 1664, C_DK = 2048, C_DV = 2432;
constexpr int LDS_BYTES = 147456;
constexpr float EPS_ = 1e-6f;

constexpr size_t al256(size_t x) { return (x + 255) & ~(size_t)255; }
constexpr size_t WS_W13 = 0;
constexpr size_t WS_W2  = WS_W13 + (size_t)4 * 2 * 5632 * 1024 * 2;
constexpr size_t WS_WIN = WS_W2 + (size_t)4 * 2 * 1024 * 2816 * 2;
constexpr size_t WS_WBF = WS_WIN + (size_t)4 * 5888 * 1024 * 2;
constexpr size_t WS_WBR = WS_WBF + (size_t)4 * 1024 * 256 * 2;
constexpr size_t WS_WBD = WS_WBR + (size_t)4 * 1024 * 384 * 2;
constexpr size_t WS_WO  = WS_WBD + (size_t)4 * 1024 * 384 * 2;
constexpr size_t WS_X   = WS_WO + (size_t)4 * 1024 * 1024 * 2;
constexpr size_t WS_H   = WS_X + (size_t)MT_ * 1024 * 4;
constexpr size_t WS_BR  = WS_H + (size_t)MT_ * 1024 * 2;
constexpr size_t WS_AL  = WS_BR + (size_t)MT_ * 1024 * 2;
constexpr size_t WS_U   = WS_AL;
constexpr size_t WS_PB  = WS_AL;
constexpr size_t WS_GB  = WS_AL + (size_t)MT_ * 2816 * 2;
constexpr size_t WS_V   = WS_GB + (size_t)MT_ * 3072 * 2;
constexpr size_t WS_T   = WS_V + (size_t)128 * 128 * 2 * 256 * 2;
constexpr size_t WS_S   = WS_T + (size_t)130 * 6 * 2 * 2048 * 4;
constexpr size_t WS_MXC = WS_S + (size_t)130 * 6 * 2 * 2048 * 4;
constexpr size_t WS_MOD = WS_MXC + (size_t)256 * 1024 * 4;
constexpr size_t WS_TRET = WS_MOD + (size_t)2 * 4 * 9216 * 4;
constexpr size_t WS_TROW = WS_TRET + (size_t)16384 * 16 * 2 * 4;
constexpr size_t WS_TCOL = WS_TROW + (size_t)256 * 8 * 2 * 4;
constexpr size_t WS_SCAL = WS_TCOL + (size_t)64 * 8 * 2 * 4;
constexpr size_t WS_BAR = WS_SCAL + 4 * 64 * 4;
constexpr size_t WS_END = WS_BAR + 256;

__device__ __forceinline__ int lbid() { int t = blockIdx.x; asm volatile("" : "+s"(t)); return t; }
__device__ __forceinline__ int lnb() { int t = gridDim.x; asm volatile("" : "+s"(t)); return t; }
struct Args { const float* in[19]; float* out; unsigned char* ws; };
typedef const Args __attribute__((address_space(4)))* KArgs;
__device__ __forceinline__ KArgs kargs() { KArgs p = (KArgs)__builtin_amdgcn_kernarg_segment_ptr(); asm volatile("" : "+s"(p)); return p; }

DI float bf2f(unsigned v) { return __uint_as_float(v << 16); }
DI bf16_t f2bf(float x) { return (bf16_t)(cvt_pk_bf16(x, 0.f) & 0xffffu); }
DI int crow(int reg, int h) { return (reg & 3) + 8 * (reg >> 2) + 4 * h; }
DI bf16x8 pack_step(const f32x16& x, int s) {
  u32x4 p;
  asm volatile("v_cvt_pk_bf16_f32 %0, %4, %5\n\tv_cvt_pk_bf16_f32 %1, %6, %7\n\tv_cvt_pk_bf16_f32 %2, %8, %9\n\tv_cvt_pk_bf16_f32 %3, %10, %11\n\ts_nop 1"
               : "=&v"(p[0]), "=&v"(p[1]), "=&v"(p[2]), "=&v"(p[3])
               : "v"(x[8 * s]), "v"(x[8 * s + 1]), "v"(x[8 * s + 2]), "v"(x[8 * s + 3]), "v"(x[8 * s + 4]), "v"(x[8 * s + 5]), "v"(x[8 * s + 6]), "v"(x[8 * s + 7]));
  return __builtin_bit_cast(bf16x8, p);
}
DI float silu_f(float a) { return a / (1.0f + __expf(-a)); }
DI float sigmoid_f(float a) { return 1.0f / (1.0f + __expf(-a)); }
DI float wave_sum(float v) {
  const int lane = lane_id_v();
#pragma unroll
  for (int o = 32; o > 0; o >>= 1) v += shx(v, o, lane);
  return v;
}
DI void sincos_acc(float xf, float& s, float& c) {
  const double x = (double)xf;
  const double k = rint(x * 0.63661977236758134308);
  double r = fma(-k, 1.57079632679489655800e+00, x); r = fma(-k, 6.12323399573676603587e-17, r);
  const double r2 = r * r;
  double sp = -1.0 / 39916800.0; sp = fma(sp, r2, 1.0 / 362880.0); sp = fma(sp, r2, -1.0 / 5040.0); sp = fma(sp, r2, 1.0 / 120.0); sp = fma(sp, r2, -1.0 / 6.0); sp = fma(sp * r2, r, r);
  double cp = 1.0 / 479001600.0; cp = fma(cp, r2, -1.0 / 3628800.0); cp = fma(cp, r2, 1.0 / 40320.0); cp = fma(cp, r2, -1.0 / 720.0); cp = fma(cp, r2, 1.0 / 24.0); cp = fma(cp, r2, -0.5); cp = fma(cp, r2, 1.0);
  const int q = ((int)(long long)k) & 3;
  const double sv = (q == 0) ? sp : (q == 1) ? cp : (q == 2) ? -sp : -cp;
  const double cv = (q == 0) ? cp : (q == 1) ? -sp : (q == 2) ? -cp : sp;
  s = (float)sv; c = (float)cv;
}
__constant__ float INV16[16] = {1.0f, 0.5623413324356079f, 0.3162277638912201f, 0.17782793939113617f, 0.10000000149011612f, 0.05623413249850273f, 0.03162277489900589f, 0.017782794311642647f,
                             0.009999999776482582f, 0.005623413249850273f, 0.003162277629598975f, 0.0017782794311642647f, 0.0010000000474974513f, 0.000562341301701963f, 0.0003162277571391314f, 0.00017782794020604342f};
struct ConvJob { const float* src; const float* src2; bf16_t* dst; int N, K, ld, kind; };
DI ConvJob conv_job(KArgs a, int j) {
  const int l = j / 9, kd = j % 9; ConvJob J; J.src2 = nullptr; J.kind = 0;
  unsigned char* ws = a->ws;
  switch (kd) {
    case 0: case 1: { const int f = kd; J.src = a->in[7] + (size_t)(l * 2 + f) * 1024 * 2816; J.src2 = a->in[8] + (size_t)(l * 2 + f) * 1024 * 2816; J.dst = (bf16_t*)(ws + WS_W13) + (size_t)(l * 2 + f) * 5632 * 1024; J.N = 5632; J.K = 1024; J.ld = 2816; J.kind = 1; break; }
    case 2: case 3: { const int f = kd - 2; J.src = a->in[9] + (size_t)(l * 2 + f) * 2816 * 1024; J.dst = (bf16_t*)(ws + WS_W2) + (size_t)(l * 2 + f) * 1024 * 2816; J.N = 1024; J.K = 2816; J.ld = 1024; break; }
    case 4: { J.src = a->in[10] + (size_t)l * 1024 * 5632; J.dst = (bf16_t*)(ws + WS_WIN) + (size_t)l * 5888 * 1024; J.N = 5888; J.K = 1024; J.ld = 5632; J.kind = 2; break; }
    case 5: { J.src = a->in[14] + (size_t)l * 256 * 1024; J.dst = (bf16_t*)(ws + WS_WBF) + (size_t)l * 1024 * 256; J.N = 1024; J.K = 256; J.ld = 1024; break; }
    case 6: { J.src = a->in[15] + (size_t)l * 384 * 1024; J.dst = (bf16_t*)(ws + WS_WBR) + (size_t)l * 1024 * 384; J.N = 1024; J.K = 384; J.ld = 1024; break; }
    case 7: { J.src = a->in[16] + (size_t)l * 384 * 1024; J.dst = (bf16_t*)(ws + WS_WBD) + (size_t)l * 1024 * 384; J.N = 1024; J.K = 384; J.ld = 1024; break; }
    default: { J.src = a->in[17] + (size_t)l * 1024 * 1024; J.dst = (bf16_t*)(ws + WS_WO) + (size_t)l * 1024 * 1024; J.N = 1024; J.K = 1024; J.ld = 1024; break; }
  }
  return J;
}
DI int axial_perm(int s) { return s < 8 ? s : (s < 16 ? s + 8 : (s < 24 ? s - 8 : s)); }

DI void prologue(int WV, KArgs a, unsigned char* smem) {
  const int tid = ltid(), nb = lnb(), bid = lbid();
  float* t = (float*)smem;
  float* tr = t + 64 * 65;
  {
    constexpr int tiles_per_layer = 1408 * 2 + 704 * 2 + 1472 + 64 + 96 + 96 + 256;
    const int nn = tid & 63, kq = tid >> 6;
#pragma unroll 1
    for (int g = bid; g < 4 * tiles_per_layer; g += nb) {
      const int l = g / tiles_per_layer; int rem = g % tiles_per_layer; int kd;
      if (rem < 1408) kd = 0; else if (rem < 2816) { kd = 1; rem -= 1408; } else if (rem < 3520) { kd = 2; rem -= 2816; } else if (rem < 4224) { kd = 3; rem -= 3520; }
      else if (rem < 5696) { kd = 4; rem -= 4224; } else if (rem < 5760) { kd = 5; rem -= 5696; } else if (rem < 5856) { kd = 6; rem -= 5760; } else if (rem < 5952) { kd = 7; rem -= 5856; } else { kd = 8; rem -= 5952; }
      const ConvJob J = conv_job(a, l * 9 + kd);
      const int nkt = J.K / 64; const int n0 = (rem / nkt) * 64, k0 = (rem % nkt) * 64;
      const bool fold = (J.kind == 2) && (n0 < 512);
      const float* sp = J.src; int col = n0 + nn;
      if (J.kind == 1) { const int n = n0 + nn, gi = n >> 5, s = n & 31; sp = (s < 16) ? J.src : J.src2; col = 16 * gi + (s & 15); }
      else if (J.kind == 2) {
        const int n = n0 + nn;
        if (fold) col = (n0 & 192) + nn;
        else { col = n - 256; if (n >= C_DQ && n < C_DV) { const int s = n & 31; col = (n - 256 - s) + axial_perm(s); } }
      }
      const float* cp = sp + (size_t)(k0 + kq) * J.ld + col;
      float lv[8];
#pragma unroll
      for (int i = 0; i < 8; ++i) lv[i] = cp[(size_t)(8 * i) * J.ld];
#pragma unroll
      for (int i = 0; i < 8; ++i) t[nn * 65 + kq + 8 * i] = lv[i];
      if (fold && tid < 64) { const float ang = (float)tid * (1.0f / 32.0f); tr[tid] = (n0 >= 256) ? sinpif(ang) : cospif(ang); }
      __syncthreads();
      if (!fold) {
#pragma unroll
        for (int i = 0; i < 4; ++i) {
          const int e = tid + i * 512, n2 = e >> 5, kp = (e & 31) * 2;
          *(unsigned*)(J.dst + (size_t)(n0 + n2) * J.K + k0 + kp) = cvt_pk_bf16(t[n2 * 65 + kp], t[n2 * 65 + kp + 1]);
        }
      } else {
#pragma unroll 1
        for (int i = 0; i < 8; ++i) {
          const int m = kq + 8 * i, kk = nn;
          float acc = 0.f;
#pragma unroll 8
          for (int c = 0; c < 64; ++c) acc += t[c * 65 + kk] * tr[(m * c) & 63];
          J.dst[(size_t)(n0 + m) * J.K + k0 + kk] = f2bf(acc);
        }
      }
      __syncthreads();
    }
  }
  {
    float* sc = (float*)smem; float* scc = sc + 1024; float* red = scc + 1024;
    __syncthreads();
    for (int i = tid; i < 1024; i += 512) { sc[i] = silu_f(a->in[1][i]); scc[i] = silu_f(a->in[3][i]); }
    __syncthreads();
    float* MOD = (float*)(a->ws + WS_MOD);
    for (int it = bid; it < 4 * 72; it += nb) {
      const int l = it / 72, cb = it % 72;
      const int cgp = tid & 31, ks = tid >> 5;
      const float* wp = a->in[4] + ((size_t)l * 1024 + ks * 64) * 9216 + cb * 128 + cgp * 4;
      f32x4 am = {0.f, 0.f, 0.f, 0.f}, ac = {0.f, 0.f, 0.f, 0.f};
#pragma unroll 8
      for (int k = 0; k < 64; ++k) { const f32x4 w = *(const f32x4*)(wp + (size_t)k * 9216); am += w * sc[ks * 64 + k]; ac += w * scc[ks * 64 + k]; }
#pragma unroll
      for (int j = 0; j < 4; ++j) { red[(ks * 128 + cgp * 4 + j) * 2] = am[j]; red[(ks * 128 + cgp * 4 + j) * 2 + 1] = ac[j]; }
      __syncthreads();
      if (tid < 256) {
        const int col = tid >> 1, which = tid & 1; float s = 0.f;
#pragma unroll
        for (int q = 0; q < 16; ++q) s += red[(q * 128 + col) * 2 + which];
        const int gc = cb * 128 + col;
        MOD[(size_t)(which * 4 + l) * 9216 + gc] = s + a->in[5][(size_t)l * 9216 + gc];
      }
      __syncthreads();
    }
  }
  {
    float* TRET = (float*)(a->ws + WS_TRET); float* TROW = (float*)(a->ws + WS_TROW); float* TCOL = (float*)(a->ws + WS_TCOL);
    const int gt = bid * 512 + tid, gn = nb * 512;
    for (int e = gt; e < 16384 * 16; e += gn) { const int p = e >> 4, i = e & 15; float s, c; sincos_acc((float)p * INV16[i], s, c); TRET[2 * e] = c; TRET[2 * e + 1] = s; }
    for (int e = gt; e < 256 * 8; e += gn) { const int p = e >> 3, i = e & 7; float s, c; sincos_acc((float)p * INV16[2 * i], s, c); TROW[2 * e] = c; TROW[2 * e + 1] = s; }
    for (int e = gt; e < 64 * 8; e += gn) { const int p = e >> 3, i = e & 7; float s, c; sincos_acc((float)p * INV16[2 * i], s, c); TCOL[2 * e] = c; TCOL[2 * e + 1] = s; }
    if (bid == 0 && tid < 4) {
      const int l = tid; float* S = (float*)(a->ws + WS_SCAL) + l * 64;
      const float* lv = a->in[12] + l * 128; float d01 = 0.f, d23 = 0.f;
      for (int i = 0; i < 32; ++i) { d01 += lv[i] * lv[32 + i]; d23 += lv[64 + i] * lv[96 + i]; }
      const float lam_init = 0.8f - 0.6f * expf(-0.3f * (float)l);
      S[0] = expf(d01) - expf(d23) + lam_init; S[1] = lam_init;
      for (int i = 0; i < 12; ++i) { const float x = a->in[11][l * 12 + i]; S[4 + i] = -log1pf(expf(-x)); }
      for (int i = 0; i < 12; ++i) ((unsigned*)S)[16 + i] = 0u;
    }
  }
}
DI void norm_phase(int WV, KArgs a, int l, int which, bool first) {
  const int tid = ltid(), lane = tid & 63, wave = tid >> 6;
  const float* g = a->in[6] + (size_t)(l * 3 + which) * 1024;
  const float* mod = (const float*)(a->ws + WS_MOD) + (size_t)l * 9216;
  const float* modc = (const float*)(a->ws + WS_MOD) + (size_t)(4 + l) * 9216;
  float* X = (float*)(a->ws + WS_X); bf16_t* H = (bf16_t*)(a->ws + WS_H);
  for (int r = lbid() * 8 + wave; r < MT_; r += lnb() * 8) {
    const float* src = first ? (r < L_ ? a->in[0] + (size_t)r * 1024 : a->in[2] + (size_t)(r - L_) * 1024) : X + (size_t)r * 1024;
    f32x4 v[4]; float ss = 0.f;
#pragma unroll
    for (int i = 0; i < 4; ++i) { v[i] = *(const f32x4*)(src + i * 256 + lane * 4); ss += v[i][0] * v[i][0] + v[i][1] * v[i][1] + v[i][2] * v[i][2] + v[i][3] * v[i][3]; }
    ss = wave_sum(ss);
    const float rstd = rsqrtf(ss * (1.0f / 1024.0f) + EPS_);
    const float* mm = (r < L_) ? mod : modc;
#pragma unroll
    for (int i = 0; i < 4; ++i) {
      const int c = i * 256 + lane * 4;
      const f32x4 gg = *(const f32x4*)(g + c), sh = *(const f32x4*)(mm + (which * 3) * 1024 + c), sc = *(const f32x4*)(mm + (which * 3 + 1) * 1024 + c);
      f32x4 y;
#pragma unroll
      for (int j = 0; j < 4; ++j) y[j] = v[i][j] * rstd * gg[j] * (1.0f + sc[j]) + sh[j];
      u32x2 w; w.x = cvt_pk_bf16(y[0], y[1]); w.y = cvt_pk_bf16(y[2], y[3]);
      *(u32x2*)(H + (size_t)r * 1024 + c) = w;
      if (first) *(f32x4*)(X + (size_t)r * 1024 + c) = v[i];
    }
  }
}
DI void final_norm(int WV, KArgs a) {
  const int tid = ltid(), lane = tid & 63, wave = tid >> 6;
  const float* g = a->in[18]; const float* X = (const float*)(a->ws + WS_X);
  for (int r = lbid() * 8 + wave; r < L_; r += lnb() * 8) {
    f32x4 v[4]; float ss = 0.f;
#pragma unroll
    for (int i = 0; i < 4; ++i) { v[i] = *(const f32x4*)(X + (size_t)r * 1024 + i * 256 + lane * 4); ss += v[i][0] * v[i][0] + v[i][1] * v[i][1] + v[i][2] * v[i][2] + v[i][3] * v[i][3]; }
    ss = wave_sum(ss);
    const float rstd = rsqrtf(ss * (1.0f / 1024.0f) + EPS_);
#pragma unroll
    for (int i = 0; i < 4; ++i) { const int c = i * 256 + lane * 4; const f32x4 gg = *(const f32x4*)(g + c); f32x4 y; for (int j = 0; j < 4; ++j) y[j] = v[i][j] * rstd * gg[j]; *(f32x4*)(a->out + (size_t)r * 1024 + c) = y; }
  }
}

using pg8::Unit; using pg8::HALF; using pg8::BM;
struct EpiSwiglu {
  static constexpr bool PERM = false, AFTER_DRAIN = false;
  bf16_t* U;
  DI void operator()(const f32x4 (&acc)[2][2][4][2], const Unit& u, int wr, int wc, int fr_, int fq_) const {
    const int ln_ = lane_id_v(), fr = ln_ & 15, fq = ln_ >> 4;
#pragma unroll
    for (int ai = 0; ai < 2; ++ai)
#pragma unroll
      for (int m = 0; m < 4; ++m) {
        const int r = u.pm * BM + ai * HALF + wr * 64 + m * 16 + fr;
#pragma unroll
        for (int bj = 0; bj < 2; ++bj) {
          const int gi = u.pn * 8 + bj * 4 + wc;
          const f32x4 x = acc[ai][bj][m][0], y = acc[ai][bj][m][1];
          u32x2 w; w.x = cvt_pk_bf16(silu_f(x[0]) * y[0], silu_f(x[1]) * y[1]); w.y = cvt_pk_bf16(silu_f(x[2]) * y[2], silu_f(x[3]) * y[3]);
          *(u32x2*)(U + (size_t)r * DFF_ + gi * 16 + fq * 4) = w;
        }
        __builtin_amdgcn_sched_barrier(0);
      }
  }
};
struct EpiResid {
  static constexpr bool PERM = false, AFTER_DRAIN = false;
  float* X; const float* gate; float scale;
  DI void operator()(const f32x4 (&acc)[2][2][4][2], const Unit& u, int wr, int wc, int fr_, int fq_) const {
    const int ln_ = lane_id_v(), fr = ln_ & 15, fq = ln_ >> 4;
#pragma unroll
    for (int bj = 0; bj < 2; ++bj)
#pragma unroll
      for (int n = 0; n < 2; ++n) {
        const int c = u.pn * BM + bj * HALF + wc * 32 + n * 16 + fq * 4;
        const f32x4 gv = *(const f32x4*)(gate + c) * scale;
#pragma unroll
        for (int ai = 0; ai < 2; ++ai)
#pragma unroll
          for (int m = 0; m < 4; ++m) {
            const int r = u.pm * BM + ai * HALF + wr * 64 + m * 16 + fr;
            float* p = X + (size_t)r * 1024 + c;
            *(f32x4*)p = *(const f32x4*)p + gv * acc[ai][bj][m][n];
          }
      }
  }
};
template <int STEP> struct EpiMerge {
  static constexpr bool PERM = false, AFTER_DRAIN = false;
  float* MX; const bf16_t* G; bf16_t* Hout;
  DI void operator()(const f32x4 (&acc)[2][2][4][2], const Unit& u, int wr, int wc, int fr_, int fq_) const {
    const int ln_ = lane_id_v(), fr = ln_ & 15, fq = ln_ >> 4;
#pragma unroll
    for (int ai = 0; ai < 2; ++ai)
#pragma unroll
      for (int bj = 0; bj < 2; ++bj)
#pragma unroll
        for (int n = 0; n < 2; ++n) {
          const int c = u.pn * BM + bj * HALF + wc * 32 + n * 16 + fq * 4;
          const int r0 = u.pm * BM + ai * HALF + wr * 64 + fr;
          u32x2 gw[4]; f32x4 old[4];
#pragma unroll
          for (int m = 0; m < 4; ++m) {
            gw[m] = *(const u32x2*)(G + (size_t)(r0 + m * 16) * NGB_ + c);
            if (STEP > 0) old[m] = *(const f32x4*)(MX + (size_t)(r0 + m * 16) * 1024 + c);
          }
#pragma unroll
          for (int m = 0; m < 4; ++m) {
            f32x4 gv; gv[0] = bf2f(gw[m].x & 0xffffu); gv[1] = bf2f(gw[m].x >> 16); gv[2] = bf2f(gw[m].y & 0xffffu); gv[3] = bf2f(gw[m].y >> 16);
            f32x4 v = gv * acc[ai][bj][m][n];
            if (STEP > 0) v += old[m];
            if (STEP < 2) *(f32x4*)(MX + (size_t)(r0 + m * 16) * 1024 + c) = v;
            else { u32x2 w; w.x = cvt_pk_bf16(v[0], v[1]); w.y = cvt_pk_bf16(v[2], v[3]); *(u32x2*)(Hout + (size_t)(r0 + m * 16) * 1024 + c) = w; }
          }
          __builtin_amdgcn_sched_barrier(0);
        }
  }
};
struct EpiWin {
  static constexpr bool PERM = false, AFTER_DRAIN = false;
  bf16_t* PB; bf16_t* GB; const float* TRET; const float* TROW; const float* TCOL; unsigned* kmax;
  DI void operator()(const f32x4 (&acc)[2][2][4][2], const Unit& u, int wr, int wc, int fr_, int fq_) const {
    const int ln_ = lane_id_v(), fr = ln_ & 15, fq = ln_ >> 4;
#pragma unroll
    for (int bj = 0; bj < 2; ++bj) {
      const int cb = u.pn * BM + bj * HALF + wc * 32;
      float kmx = 0.f;
#pragma unroll
      for (int ai = 0; ai < 2; ++ai)
#pragma unroll
        for (int m = 0; m < 4; ++m) {
          const int r = u.pm * BM + ai * HALF + wr * 64 + m * 16 + fr;
          f32x4 x0 = acc[ai][bj][m][0], x1 = acc[ai][bj][m][1];
          if (cb >= NPB_) {
#pragma unroll
            for (int j = 0; j < 4; ++j) { x0[j] = sigmoid_f(x0[j]); x1[j] = sigmoid_f(x1[j]); }
            u32x2 w0, w1; w0.x = cvt_pk_bf16(x0[0], x0[1]); w0.y = cvt_pk_bf16(x0[2], x0[3]); w1.x = cvt_pk_bf16(x1[0], x1[1]); w1.y = cvt_pk_bf16(x1[2], x1[3]);
            bf16_t* p = GB + (size_t)r * NGB_ + (cb - NPB_) + fq * 4;
            *(u32x2*)p = w0; *(u32x2*)(p + 16) = w1;
            __builtin_amdgcn_sched_barrier(0);
            continue;
          }
          if (cb >= C_RQ && cb < C_RV) {
            if (r < L_) {
              const f32x4* tp = (const f32x4*)(TRET + ((size_t)r * 16 + fq * 4) * 2);
              const f32x4 t0 = tp[0], t1 = tp[1];
              const float cs[4] = {t0[0], t0[2], t1[0], t1[2]}, sn[4] = {t0[1], t0[3], t1[1], t1[3]};
#pragma unroll
              for (int j = 0; j < 4; ++j) { const float a_ = x0[j], b_ = x1[j]; x0[j] = a_ * cs[j] - b_ * sn[j]; x1[j] = a_ * sn[j] + b_ * cs[j]; }
            }
            if (cb >= C_RK) { x0 *= 0.17677669529663687f; x1 *= 0.17677669529663687f; }
          } else if (cb >= C_RG && cb < C_DQ) {
#pragma unroll
            for (int j = 0; j < 4; ++j) { x0[j] = silu_f(x0[j]); x1[j] = silu_f(x1[j]); }
          } else if (cb >= C_DQ && cb < C_DV) {
            if (r < L_) {
              const float* tb = (fq < 2) ? (TROW + ((size_t)(r >> 6) * 8 + fq * 4) * 2) : (TCOL + ((size_t)(r & 63) * 8 + (fq - 2) * 4) * 2);
              const f32x4 t0 = ((const f32x4*)tb)[0], t1 = ((const f32x4*)tb)[1];
              const float cs[4] = {t0[0], t0[2], t1[0], t1[2]}, sn[4] = {t0[1], t0[3], t1[1], t1[3]};
#pragma unroll
              for (int j = 0; j < 4; ++j) { const float a_ = x0[j], b_ = x1[j]; x0[j] = a_ * cs[j] - b_ * sn[j]; x1[j] = a_ * sn[j] + b_ * cs[j]; }
            }
            if (cb < C_DK) { x0 *= 0.25503486f; x1 *= 0.25503486f; }
            else { float ss = 0.f;
#pragma unroll
              for (int j = 0; j < 4; ++j) ss += x0[j] * x0[j] + x1[j] * x1[j];
              ss += shx(ss, 16, lane_id_v()); ss += shx(ss, 32, lane_id_v()); kmx = fmaxf(kmx, ss); }
          }
          u32x2 w0, w1; w0.x = cvt_pk_bf16(x0[0], x0[1]); w0.y = cvt_pk_bf16(x0[2], x0[3]); w1.x = cvt_pk_bf16(x1[0], x1[1]); w1.y = cvt_pk_bf16(x1[2], x1[3]);
          bf16_t* p = PB + (size_t)r * NPB_ + cb + fq * 4;
          *(u32x2*)p = w0; *(u32x2*)(p + 16) = w1;
          __builtin_amdgcn_sched_barrier(0);
        }
      if (cb >= C_DK && cb < C_DV) {
#pragma unroll
        for (int o = 1; o < 16; o <<= 1) kmx = fmaxf(kmx, shx(kmx, o, lane_id_v()));
        if (lane_id_v() == 0) atomicMax(kmax + ((cb - C_DK) >> 5), __float_as_uint(kmx));
      }
    }
  }
};
template <class F> DI void ctx_gemm32(int WV, const bf16_t* A, int lda, const bf16_t* Bt, int K, int N, unsigned char* smem, F epi) {
  const int tid = ltid(), lane = tid & 63, wave = tid >> 6, r31 = lane & 31, h = lane >> 5;
  float* red = (float*)smem;
  const int ntn = N / 32, ntiles = 8 * ntn, kper = K / 8;
  for (int tile = lbid(); tile < ntiles; tile += lnb()) {
    const int tm = tile / ntn, tn = tile % ntn;
    f32x16 acc; for (int i = 0; i < 16; ++i) acc[i] = 0.f;
    const bf16_t* ap = A + (size_t)(tm * 32 + r31) * lda + wave * kper + 8 * h;
    const bf16_t* bp = Bt + (size_t)(tn * 32 + r31) * K + wave * kper + 8 * h;
    for (int kk = 0; kk < kper; kk += 16) { const bf16x8 av = *(const bf16x8*)(ap + kk), bv = *(const bf16x8*)(bp + kk); acc = MFMA32(av, bv, acc); }
#pragma unroll
    for (int i = 0; i < 16; ++i) red[(wave * 16 + i) * 64 + lane] = acc[i];
    __syncthreads();
#pragma unroll
    for (int q = 0; q < 2; ++q) {
      const int o = tid + q * 512, i = o >> 6, ln = o & 63; float s = 0.f;
#pragma unroll
      for (int w = 0; w < 8; ++w) s += red[(w * 16 + i) * 64 + ln];
      epi(tm * 32 + crow(i, ln >> 5), tn * 32 + (ln & 31), s);
    }
    __syncthreads();
  }
}

constexpr int FR_LD = 136;
DI void fourier_tables(int WV, unsigned char* smem) {
  bf16_t* Cw = (bf16_t*)smem; bf16_t* Sw = Cw + 128 * FR_LD;
  for (int e = ltid(); e < 128 * 128; e += 512) { const int a_ = e >> 7, b_ = e & 127; const float x = (float)((a_ * b_) & 127) * (1.0f / 64.0f); Cw[a_ * FR_LD + b_] = f2bf(cospif(x)); Sw[a_ * FR_LD + b_] = f2bf(sinpif(x)); }
}
DI void fourier_load(int WV, const bf16_t* src, size_t rs, size_t po, unsigned char* smem) {
  bf16_t* dA = (bf16_t*)smem + 2 * 128 * FR_LD;
#pragma unroll
  for (int i = 0; i < 4; ++i) {
    const int id = ltid() + 512 * i, seg = id & 7, part = (id >> 3) & 1, row = id >> 4;
    const bf16x8 v = *(const bf16x8*)(src + (size_t)row * rs + (size_t)part * po + seg * 8);
    bf16_t* d = dA + part * 64 * FR_LD + (seg * 8) * FR_LD + row;
#pragma unroll
    for (int e = 0; e < 8; ++e) d[e * FR_LD] = (bf16_t)v[e];
  }
}
DI void fourier_stage1(int WV, KArgs a, unsigned char* smem) {
  const int tid = ltid(), lane = tid & 63, wave = tid >> 6, r31 = lane & 31, h = lane >> 5, rb = wave & 3, cbk = wave >> 2;
  const bf16_t* PB = (const bf16_t*)(a->ws + WS_PB); bf16_t* V = (bf16_t*)(a->ws + WS_V);
  const bf16_t* Cw = (const bf16_t*)smem; const bf16_t* Sw = Cw + 128 * FR_LD; const bf16_t* dA = Sw + 128 * FR_LD; const bf16_t* dB = dA + 64 * FR_LD;
  for (int it = lbid(); it < 512; it += lnb()) {
    const int t2 = it >> 2, c0 = (it & 3) * 64;
    __syncthreads();
    fourier_load(WV, PB + (size_t)t2 * NPB_ + C_FA + c0, (size_t)128 * NPB_, (size_t)(C_FB - C_FA), smem);
    __syncthreads();
    f32x16 R, nI; for (int i = 0; i < 16; ++i) { R[i] = 0.f; nI[i] = 0.f; }
#pragma unroll
    for (int s = 0; s < 8; ++s) {
      const bf16x8 cw = *(const bf16x8*)(Cw + (32 * rb + r31) * FR_LD + 16 * s + 8 * h), sw = *(const bf16x8*)(Sw + (32 * rb + r31) * FR_LD + 16 * s + 8 * h);
      const bf16x8 af = *(const bf16x8*)(dA + (32 * cbk + r31) * FR_LD + 16 * s + 8 * h), bfv = *(const bf16x8*)(dB + (32 * cbk + r31) * FR_LD + 16 * s + 8 * h);
      bf16x8 nb; for (int e = 0; e < 8; ++e) nb[e] = (short)(bfv[e] ^ (short)0x8000);
      R = MFMA32(cw, af, R); R = MFMA32(sw, nb, R); nI = MFMA32(sw, af, nI); nI = MFMA32(cw, bfv, nI);
    }
    const int col = c0 + 32 * cbk + r31;
#pragma unroll
    for (int i = 0; i < 16; ++i) {
      const int k1 = 32 * rb + crow(i, h);
      const float x = (float)(k1 * t2) * (1.0f / 8192.0f); const float ct = cospif(x), st = sinpif(x);
      const float vre = R[i] * ct - nI[i] * st, vim = -nI[i] * ct - R[i] * st;
      bf16_t* vp = V + ((size_t)(k1 * 128 + t2) * 2) * 256 + col;
      vp[0] = f2bf(vre); vp[256] = f2bf(vim);
    }
  }
}
DI void fourier_stage2(int WV, KArgs a, unsigned char* smem) {
  const int tid = ltid(), lane = tid & 63, wave = tid >> 6, r31 = lane & 31, h = lane >> 5, rb = wave & 3, cbk = wave >> 2;
  const bf16_t* V = (const bf16_t*)(a->ws + WS_V); bf16_t* BR = (bf16_t*)(a->ws + WS_BR);
  const bf16_t* Cw = (const bf16_t*)smem; const bf16_t* Sw = Cw + 128 * FR_LD; const bf16_t* dA = Sw + 128 * FR_LD; const bf16_t* dB = dA + 64 * FR_LD;
  for (int it = lbid(); it < 512; it += lnb()) {
    const int k1 = it >> 2, c0 = (it & 3) * 64;
    __syncthreads();
    fourier_load(WV, V + (size_t)k1 * 128 * 512 + c0, (size_t)512, (size_t)256, smem);
    __syncthreads();
    f32x16 Y; for (int i = 0; i < 16; ++i) Y[i] = 0.f;
#pragma unroll
    for (int s = 0; s < 8; ++s) {
      const bf16x8 cw = *(const bf16x8*)(Cw + (32 * rb + r31) * FR_LD + 16 * s + 8 * h), sw = *(const bf16x8*)(Sw + (32 * rb + r31) * FR_LD + 16 * s + 8 * h);
      const bf16x8 vr = *(const bf16x8*)(dA + (32 * cbk + r31) * FR_LD + 16 * s + 8 * h), vi = *(const bf16x8*)(dB + (32 * cbk + r31) * FR_LD + 16 * s + 8 * h);
      Y = MFMA32(cw, vr, Y); Y = MFMA32(sw, vi, Y);
    }
    const int col = c0 + 32 * cbk + r31;
#pragma unroll
    for (int i = 0; i < 16; ++i) { const int k2 = 32 * rb + crow(i, h); BR[(size_t)(k1 + 128 * k2) * 1024 + col] = f2bf(Y[i] * (1.0f / 1024.0f)); }
  }
}
DI void fourier_ctx(int WV, KArgs a) {
  const int tid = ltid();
  const bf16_t* PB = (const bf16_t*)(a->ws + WS_PB) + (size_t)L_ * NPB_; bf16_t* BR = (bf16_t*)(a->ws + WS_BR) + (size_t)L_ * 1024;
  for (int k = lbid(); k < 256; k += lnb()) {
    if (tid < 256) {
      float acc = 0.f;
      for (int t = 0; t < 256; ++t) {
        const float x = (float)((k * t) & 255) * (1.0f / 128.0f);
        acc += cospif(x) * bf2f(PB[(size_t)t * NPB_ + C_FA + tid]) - sinpif(x) * bf2f(PB[(size_t)t * NPB_ + C_FB + tid]);
      }
      BR[(size_t)k * 1024 + tid] = f2bf(acc * (1.0f / 128.0f));
    }
  }
}
DI int chunk_row0(int ci) { return ci < 128 ? ci * 128 : L_ + (ci - 128) * 128; }
DI void ret_states(int WV, KArgs a, int l, unsigned char* smem) {
  const int tid = ltid();
  const bf16_t* PB = (const bf16_t*)(a->ws + WS_PB); float* T = (float*)(a->ws + WS_T);
  const float* S = (const float*)(a->ws + WS_SCAL) + l * 64;
  float* kL = (float*)smem; float* vL = kL + 128 * 33; float* wf = vL + 128 * 64; float* wb = wf + 128;
  for (int it = lbid(); it < 130 * 6; it += lnb()) {
    const int ci = it / 6, hh = it % 6, r0 = chunk_row0(ci);
    __syncthreads();
    { const int row = tid >> 2, seg = tid & 3; const bf16x8 v = *(const bf16x8*)(PB + (size_t)(r0 + row) * NPB_ + C_RK + hh * 32 + seg * 8);
#pragma unroll
      for (int e = 0; e < 8; ++e) kL[row * 33 + seg * 8 + e] = bf2f((unsigned)(unsigned short)v[e]); }
#pragma unroll
    for (int q = 0; q < 2; ++q) { const int id = tid + 512 * q, row = id >> 3, seg = id & 7; const bf16x8 v = *(const bf16x8*)(PB + (size_t)(r0 + row) * NPB_ + C_RV + hh * 64 + seg * 8);
#pragma unroll
      for (int e = 0; e < 8; ++e) vL[row * 64 + seg * 8 + e] = bf2f((unsigned)(unsigned short)v[e]); }
    if (tid < 128) { wf[tid] = expf(S[4 + hh] * (float)(127 - tid)); wb[tid] = expf(S[10 + hh] * (float)tid); }
    __syncthreads();
    const int d = tid >> 4, v4 = (tid & 15) * 4;
    f32x4 af = {0.f, 0.f, 0.f, 0.f}, ab = {0.f, 0.f, 0.f, 0.f};
#pragma unroll 4
    for (int j = 0; j < 128; ++j) { const float kd = kL[j * 33 + d]; const f32x4 vv = *(const f32x4*)(vL + j * 64 + v4); af += vv * (kd * wf[j]); ab += vv * (kd * wb[j]); }
    float* tp = T + ((size_t)(ci * 6 + hh) * 2) * 2048 + d * 64 + v4;
    *(f32x4*)tp = af; *(f32x4*)(tp + 2048) = ab;
  }
}
DI void ret_scan(int WV, KArgs a, int l) {
  const int gt = lbid() * 512 + ltid();
  if (gt >= 6 * 2 * 2048) return;
  const int idx = gt & 2047, dir = (gt >> 11) & 1, hh = gt >> 12;
  const float* T = (const float*)(a->ws + WS_T); float* S = (float*)(a->ws + WS_S);
  const float* SC = (const float*)(a->ws + WS_SCAL) + l * 64;
  const float dec = expf(SC[4 + dir * 6 + hh] * 128.0f);
  const size_t base = (size_t)(hh * 2 + dir) * 2048 + idx; const size_t cs = (size_t)6 * 2 * 2048;
  const float tc0 = T[base + 128 * cs], tc1 = T[base + 129 * cs];
  if (dir == 0) {
    float s = tc0 * dec + tc1; S[base + 128 * cs] = 0.f; S[base + 129 * cs] = tc0;
#pragma unroll 8
    for (int i = 0; i < 128; ++i) { S[base + i * cs] = s; s = s * dec + T[base + i * cs]; }
  } else {
    float s = tc0 + dec * tc1; S[base + 129 * cs] = 0.f; S[base + 128 * cs] = tc1;
#pragma unroll 8
    for (int i = 127; i >= 0; --i) { S[base + i * cs] = s; s = s * dec + T[base + i * cs]; }
  }
}
DI void ret_out(int WV, KArgs a, int l, unsigned char* smem) {
  const int tid = ltid(), lane = tid & 63, wave = tid >> 6, r31 = lane & 31, h = lane >> 5, jb = wave & 3, vh = wave >> 2;
  const bf16_t* PB = (const bf16_t*)(a->ws + WS_PB); bf16_t* BR = (bf16_t*)(a->ws + WS_BR); const float* Sg = (const float*)(a->ws + WS_S);
  const float* SC = (const float*)(a->ws + WS_SCAL) + l * 64;
  bf16_t* Kl = (bf16_t*)smem;
  bf16_t* Vt = Kl + 128 * 40;
  bf16_t* SfT = Vt + 64 * 136;
  bf16_t* SbT = SfT + 64 * 40;
  float* pwf = (float*)(SbT + 64 * 40);
  float* pwb = pwf + 128;
  float* ssq = pwb + 128;
  for (int it = lbid(); it < 130 * 6; it += lnb()) {
    const int ci = it / 6, hh = it % 6, r0 = chunk_row0(ci);
    const float lgf = SC[4 + hh], lgb = SC[10 + hh];
    __syncthreads();
    { const int row = tid >> 2, seg = tid & 3; *(bf16x8*)(Kl + row * 40 + seg * 8) = *(const bf16x8*)(PB + (size_t)(r0 + row) * NPB_ + C_RK + hh * 32 + seg * 8); }
#pragma unroll
    for (int q = 0; q < 2; ++q) { const int id = tid + 512 * q, row = id >> 3, seg = id & 7; const bf16x8 v = *(const bf16x8*)(PB + (size_t)(r0 + row) * NPB_ + C_RV + hh * 64 + seg * 8);
#pragma unroll
      for (int e = 0; e < 8; ++e) Vt[(seg * 8 + e) * 136 + row] = (bf16_t)v[e]; }
#pragma unroll
    for (int q = 0; q < 8; ++q) { const int e = tid + 512 * q, dir = e >> 11, idx = e & 2047, d = idx >> 6, v = idx & 63;
      const float sv = Sg[((size_t)(ci * 6 + hh) * 2 + dir) * 2048 + idx]; (dir ? SbT : SfT)[v * 40 + d] = f2bf(sv); }
    if (tid < 128) { pwf[tid] = expf(lgf * (float)tid); pwb[tid] = expf(lgb * (float)tid); }
    const int qrow = r0 + 32 * jb + r31, j = 32 * jb + r31;
    bf16x8 qf[2];
#pragma unroll
    for (int s = 0; s < 2; ++s) qf[s] = *(const bf16x8*)(PB + (size_t)qrow * NPB_ + C_RQ + hh * 32 + 16 * s + 8 * h);
    __syncthreads();
    f32x16 O; for (int i = 0; i < 16; ++i) O[i] = 0.f;
#pragma unroll
    for (int kb = 0; kb < 4; ++kb) {
      f32x16 St; for (int i = 0; i < 16; ++i) St[i] = 0.f;
#pragma unroll
      for (int s = 0; s < 2; ++s) { const bf16x8 kf = *(const bf16x8*)(Kl + (32 * kb + r31) * 40 + 16 * s + 8 * h); St = MFMA32(kf, qf[s], St); }
#pragma unroll
      for (int i = 0; i < 16; ++i) { const int jp = 32 * kb + crow(i, h); const int dl = j - jp; const float dv = dl > 0 ? pwf[dl] : (dl < 0 ? pwb[-dl] : 2.0f); St[i] *= dv; }
#pragma unroll
      for (int s = 0; s < 2; ++s) {
        const bf16x8 pb = pack_step(St, s);
        const bf16_t* vp = Vt + (32 * vh + r31) * 136 + 32 * kb + 16 * s + 4 * h;
        const s16x4 lo = *(const s16x4*)vp, hi = *(const s16x4*)(vp + 8);
        const bf16x8 vf = __builtin_shufflevector(lo, hi, 0, 1, 2, 3, 4, 5, 6, 7);
        O = MFMA32(vf, pb, O);
      }
    }
    f32x16 Of, Ob; for (int i = 0; i < 16; ++i) { Of[i] = 0.f; Ob[i] = 0.f; }
#pragma unroll
    for (int s = 0; s < 2; ++s) {
      const bf16x8 sf = *(const bf16x8*)(SfT + (32 * vh + r31) * 40 + 16 * s + 8 * h), sb = *(const bf16x8*)(SbT + (32 * vh + r31) * 40 + 16 * s + 8 * h);
      Of = MFMA32(sf, qf[s], Of); Ob = MFMA32(sb, qf[s], Ob);
    }
    const float qdf = expf(lgf * (float)(j + 1)), qdb = expf(lgb * (float)(128 - j));
    float ss = 0.f;
#pragma unroll
    for (int i = 0; i < 16; ++i) { O[i] = O[i] + Of[i] * qdf + Ob[i] * qdb; ss += O[i] * O[i]; }
    ss += shx(ss, 32, lane_id_v());
    if (h == 0) ssq[vh * 128 + j] = ss;
    __syncthreads();
    const float rstd = rsqrtf((ssq[j] + ssq[128 + j]) * (1.0f / 64.0f) + EPS_);
#pragma unroll
    for (int g4 = 0; g4 < 4; ++g4) {
      const int v0 = 32 * vh + 8 * g4 + 4 * h;
      const u32x2 gw = *(const u32x2*)(PB + (size_t)qrow * NPB_ + C_RG + hh * 64 + v0);
      const float g0 = bf2f(gw.x & 0xffffu), g1 = bf2f(gw.x >> 16), g2 = bf2f(gw.y & 0xffffu), g3 = bf2f(gw.y >> 16);
      u32x2 w; w.x = cvt_pk_bf16(O[4 * g4] * rstd * g0, O[4 * g4 + 1] * rstd * g1); w.y = cvt_pk_bf16(O[4 * g4 + 2] * rstd * g2, O[4 * g4 + 3] * rstd * g3);
      *(u32x2*)(BR + (size_t)qrow * 1024 + 256 + hh * 64 + v0) = w;
    }
  }
}
constexpr int AT_LD = 72;
DI void attn_phase(int WV, KArgs a, int l, bool with_ctx, unsigned char* smem) {
  const int tid = ltid(), lane = tid & 63, wave = tid >> 6, r31 = lane & 31, h = lane >> 5, qsub = wave & 3, kh = wave >> 2;
  const bf16_t* PB = (const bf16_t*)(a->ws + WS_PB); bf16_t* BR = (bf16_t*)(a->ws + WS_BR);
  const float* SC = (const float*)(a->ws + WS_SCAL) + l * 64;
  const float lam = SC[0], lam_init = SC[1];
  bf16_t* Ks = (bf16_t*)smem;
  bf16_t* Vt = Ks + 2 * 64 * AT_LD;
  float* cmb = (float*)(Vt + 2 * 64 * AT_LD);
  const int nitems = 6 * 128 + (with_ctx ? 12 : 0);
  const int skey = tid >> 3, sseg = tid & 7;
  for (int it = lbid(); it < nitems; it += lnb()) {
    int head, q0, krow0, nt;
    if (it < 768) { head = it >> 7; q0 = (it & 127) * 128; krow0 = 0; nt = MT_ / 64; }
    else { const int e = it - 768; head = e >> 1; q0 = L_ + (e & 1) * 128; krow0 = L_; nt = LC_ / 64; }
    const int qrow = q0 + 32 * qsub + r31;
    bf16x8 qf[2][2];
#pragma unroll
    for (int mp = 0; mp < 2; ++mp)
#pragma unroll
      for (int s = 0; s < 2; ++s) qf[mp][s] = *(const bf16x8*)(PB + (size_t)qrow * NPB_ + C_DQ + head * 64 + mp * 32 + 16 * s + 8 * h);
    float negm[2];
#pragma unroll
    for (int mp = 0; mp < 2; ++mp) {
      float ss = 0.f;
#pragma unroll
      for (int s = 0; s < 2; ++s)
#pragma unroll
        for (int e = 0; e < 8; ++e) { const float x = bf2f((unsigned)(unsigned short)qf[mp][s][e]); ss += x * x; }
      ss += shx(ss, 32, lane_id_v());
      const float kmx = __uint_as_float(((const unsigned*)SC)[16 + head * 2 + mp]);
      negm[mp] = -sqrtf(ss * kmx) * 1.01f;
    }
    f32x16 NM1, NM2; for (int i = 0; i < 16; ++i) { NM1[i] = negm[0]; NM2[i] = negm[1]; }
    f32x16 O1[2], O2[2]; for (int i = 0; i < 16; ++i) { O1[0][i] = 0.f; O1[1][i] = 0.f; O2[0][i] = 0.f; O2[1][i] = 0.f; }
    float l1 = 0.f, l2 = 0.f;
    const bf16_t* kg = PB + (size_t)(krow0 + skey) * NPB_ + C_DK + head * 64 + sseg * 8;
    const bf16_t* vg = PB + (size_t)(krow0 + skey) * NPB_ + C_DV + head * 64 + sseg * 8;
    __syncthreads();
    bf16x8 kreg = *(const bf16x8*)kg, vreg = *(const bf16x8*)vg;
    { *(bf16x8*)(Ks + skey * AT_LD + sseg * 8) = kreg;
#pragma unroll
      for (int e = 0; e < 8; ++e) Vt[(sseg * 8 + e) * AT_LD + skey] = (bf16_t)vreg[e]; }
    __syncthreads();
    for (int t = 0; t < nt; ++t) {
      const int buf = t & 1;
      if (t + 1 < nt) { kreg = *(const bf16x8*)(kg + (size_t)(t + 1) * 64 * NPB_); vreg = *(const bf16x8*)(vg + (size_t)(t + 1) * 64 * NPB_); }
      const bf16_t* ks = Ks + buf * 64 * AT_LD + (32 * kh + r31) * AT_LD + 8 * h;
      const bf16_t* vt = Vt + buf * 64 * AT_LD + r31 * AT_LD + 32 * kh + 4 * h;
      f32x16 S1 = MFMA32(*(const bf16x8*)(ks), qf[0][0], NM1); S1 = MFMA32(*(const bf16x8*)(ks + 16), qf[0][1], S1);
      f32x16 S2 = MFMA32(*(const bf16x8*)(ks + 32), qf[1][0], NM2); S2 = MFMA32(*(const bf16x8*)(ks + 48), qf[1][1], S2);
#pragma unroll
      for (int i = 0; i < 16; ++i) { S1[i] = __builtin_amdgcn_exp2f(S1[i]); l1 += S1[i]; S2[i] = __builtin_amdgcn_exp2f(S2[i]); l2 += S2[i]; }
#pragma unroll
      for (int s = 0; s < 2; ++s) {
        const bf16x8 p1 = pack_step(S1, s), p2 = pack_step(S2, s);
#pragma unroll
        for (int mt = 0; mt < 2; ++mt) {
          const bf16_t* vp = vt + mt * 32 * AT_LD + 16 * s;
          const s16x4 lo = *(const s16x4*)vp, hi = *(const s16x4*)(vp + 8);
          const bf16x8 vf = __builtin_shufflevector(lo, hi, 0, 1, 2, 3, 4, 5, 6, 7);
          O1[mt] = MFMA32(vf, p1, O1[mt]); O2[mt] = MFMA32(vf, p2, O2[mt]);
        }
      }
      if (t + 1 < nt) {
        const int nb = buf ^ 1;
        *(bf16x8*)(Ks + nb * 64 * AT_LD + skey * AT_LD + sseg * 8) = kreg;
#pragma unroll
        for (int e = 0; e < 8; ++e) Vt[nb * 64 * AT_LD + (sseg * 8 + e) * AT_LD + skey] = (bf16_t)vreg[e];
      }
      __syncthreads();
    }
    float* cw = cmb + (size_t)(qsub * 64 + lane) * 66;
    if (kh == 1) {
#pragma unroll
      for (int i = 0; i < 16; ++i) { cw[i] = O1[0][i]; cw[16 + i] = O1[1][i]; cw[32 + i] = O2[0][i]; cw[48 + i] = O2[1][i]; }
      cw[64] = l1; cw[65] = l2;
    }
    __syncthreads();
    if (kh == 0) {
#pragma unroll
      for (int i = 0; i < 16; ++i) { O1[0][i] += cw[i]; O1[1][i] += cw[16 + i]; O2[0][i] += cw[32 + i]; O2[1][i] += cw[48 + i]; }
      l1 += cw[64]; l2 += cw[65];
      l1 += shx(l1, 32, lane_id_v()); l2 += shx(l2, 32, lane_id_v());
      const float i1 = 1.0f / l1, i2 = lam / l2;
      float ss = 0.f;
#pragma unroll
      for (int mt = 0; mt < 2; ++mt)
#pragma unroll
        for (int i = 0; i < 16; ++i) { const float o = O1[mt][i] * i1 - O2[mt][i] * i2; O1[mt][i] = o; ss += o * o; }
      ss += shx(ss, 32, lane_id_v());
      const float sc = rsqrtf(ss * (1.0f / 64.0f) + EPS_) * (1.0f - lam_init);
      const float* sw = a->in[13] + l * 64;
#pragma unroll
      for (int mt = 0; mt < 2; ++mt)
#pragma unroll
        for (int g4 = 0; g4 < 4; ++g4) {
          const int v0 = 32 * mt + 8 * g4 + 4 * h;
          const f32x4 wv = *(const f32x4*)(sw + v0);
          u32x2 w; w.x = cvt_pk_bf16(O1[mt][4 * g4] * sc * wv[0], O1[mt][4 * g4 + 1] * sc * wv[1]); w.y = cvt_pk_bf16(O1[mt][4 * g4 + 2] * sc * wv[2], O1[mt][4 * g4 + 3] * sc * wv[3]);
          *(u32x2*)(BR + (size_t)qrow * 1024 + 640 + head * 64 + v0) = w;
        }
    }
  }
}
template <class Epi> DI void run_gemm(int WV, LAS unsigned char* lds, const bf16_t* A, int lda, const bf16_t* Bt, int M, int N, int K, const Epi& E) {
  pg8::Gemm g; g.A = A; g.Bt = Bt; g.M = M; g.N = N; g.K = K; g.lda = lda;
  pg8::StaticOrder S; S.init(M, N, lnb(), lbid());
  pg8::gemm_phase<Epi, pg8::StaticOrder, false>(WV, lds, g, S, E, nullptr);
}
struct CtxMerge0 { float* MXC; const bf16_t* G; DI void operator()(int r, int c, float v) const { MXC[r * 1024 + c] = bf2f(G[(size_t)r * NGB_ + c]) * v; } };
struct CtxMerge1 { float* MXC; const bf16_t* G; DI void operator()(int r, int c, float v) const { MXC[r * 1024 + c] += bf2f(G[(size_t)r * NGB_ + c]) * v; } };
struct CtxMerge2 { const float* MXC; const bf16_t* G; bf16_t* Hc; DI void operator()(int r, int c, float v) const { Hc[r * 1024 + c] = f2bf(MXC[r * 1024 + c] + bf2f(G[(size_t)r * NGB_ + c]) * v); } };
struct CtxResid { float* Xc; const float* gate; float scale; DI void operator()(int r, int c, float v) const { Xc[r * 1024 + c] += scale * gate[c] * v; } };

DI void phase_win(int WV, int l, unsigned char* smem) {
  KArgs a = kargs(); unsigned char* ws = a->ws;
  EpiWin E; E.PB = (bf16_t*)(ws + WS_PB); E.GB = (bf16_t*)(ws + WS_GB); E.TRET = (const float*)(ws + WS_TRET); E.TROW = (const float*)(ws + WS_TROW); E.TCOL = (const float*)(ws + WS_TCOL);
  E.kmax = (unsigned*)(ws + WS_SCAL) + l * 64 + 16;
  run_gemm(WV, (LAS unsigned char*)smem, (const bf16_t*)(ws + WS_H), 1024, (const bf16_t*)(ws + WS_WIN) + (size_t)l * 5888 * 1024, MT_, NWIN_, 1024, E);
}
DI void phase_merge(int WV, int l, unsigned char* smem) {
  LAS unsigned char* lds = (LAS unsigned char*)smem;
  { KArgs a = kargs(); unsigned char* ws = a->ws; EpiMerge<0> E; E.MX = a->out; E.G = (const bf16_t*)(ws + WS_GB); E.Hout = (bf16_t*)(ws + WS_H);
    run_gemm(WV, lds, (const bf16_t*)(ws + WS_BR), 1024, (const bf16_t*)(ws + WS_WBF) + (size_t)l * 1024 * 256, L_, 1024, 256, E); }
  { KArgs a = kargs(); unsigned char* ws = a->ws; EpiMerge<1> E; E.MX = a->out; E.G = (const bf16_t*)(ws + WS_GB) + 1024; E.Hout = (bf16_t*)(ws + WS_H);
    run_gemm(WV, lds, (const bf16_t*)(ws + WS_BR) + 256, 1024, (const bf16_t*)(ws + WS_WBR) + (size_t)l * 1024 * 384, L_, 1024, 384, E); }
  { KArgs a = kargs(); unsigned char* ws = a->ws; EpiMerge<2> E; E.MX = a->out; E.G = (const bf16_t*)(ws + WS_GB) + 2048; E.Hout = (bf16_t*)(ws + WS_H);
    run_gemm(WV, lds, (const bf16_t*)(ws + WS_BR) + 640, 1024, (const bf16_t*)(ws + WS_WBD) + (size_t)l * 1024 * 384, L_, 1024, 384, E); }
  { KArgs a = kargs(); unsigned char* ws = a->ws;
    const bf16_t* BRc = (const bf16_t*)(ws + WS_BR) + (size_t)L_ * 1024; const bf16_t* GBc = (const bf16_t*)(ws + WS_GB) + (size_t)L_ * NGB_;
    CtxMerge0 e0; e0.MXC = (float*)(ws + WS_MXC); e0.G = GBc;
    ctx_gemm32(WV, BRc, 1024, (const bf16_t*)(ws + WS_WBF) + (size_t)l * 1024 * 256, 256, 1024, smem, e0);
    CtxMerge1 e1; e1.MXC = (float*)(ws + WS_MXC); e1.G = GBc + 1024;
    ctx_gemm32(WV, BRc + 256, 1024, (const bf16_t*)(ws + WS_WBR) + (size_t)l * 1024 * 384, 384, 1024, smem, e1);
    CtxMerge2 e2; e2.MXC = (const float*)(ws + WS_MXC); e2.G = GBc + 2048; e2.Hc = (bf16_t*)(ws + WS_H) + (size_t)L_ * 1024;
    ctx_gemm32(WV, BRc + 640, 1024, (const bf16_t*)(ws + WS_WBD) + (size_t)l * 1024 * 384, 384, 1024, smem, e2); }
}
DI void phase_wo(int WV, int l, unsigned char* smem) {
  { KArgs a = kargs(); unsigned char* ws = a->ws; EpiResid E; E.X = (float*)(ws + WS_X); E.gate = (const float*)(ws + WS_MOD) + (size_t)l * 9216 + 5 * 1024; E.scale = 1.0f;
    run_gemm(WV, (LAS unsigned char*)smem, (const bf16_t*)(ws + WS_H), 1024, (const bf16_t*)(ws + WS_WO) + (size_t)l * 1024 * 1024, L_, 1024, 1024, E); }
  { KArgs a = kargs(); unsigned char* ws = a->ws; CtxResid e; e.Xc = (float*)(ws + WS_X) + (size_t)L_ * 1024; e.gate = (const float*)(ws + WS_MOD) + (size_t)(4 + l) * 9216 + 5 * 1024; e.scale = 1.0f;
    ctx_gemm32(WV, (const bf16_t*)(ws + WS_H) + (size_t)L_ * 1024, 1024, (const bf16_t*)(ws + WS_WO) + (size_t)l * 1024 * 1024, 1024, 1024, smem, e); }
}
DI void phase_g1(int WV, int l, int f, unsigned char* smem) {
  KArgs a = kargs(); unsigned char* ws = a->ws; EpiSwiglu E; E.U = (bf16_t*)(ws + WS_U);
  run_gemm(WV, (LAS unsigned char*)smem, (const bf16_t*)(ws + WS_H), 1024, (const bf16_t*)(ws + WS_W13) + (size_t)(l * 2 + f) * 5632 * 1024, MT_, 5632, 1024, E);
}
DI void phase_g2(int WV, int l, int f, unsigned char* smem) {
  const int gi = f == 0 ? 2 : 8;
  { KArgs a = kargs(); unsigned char* ws = a->ws; EpiResid E; E.X = (float*)(ws + WS_X); E.gate = (const float*)(ws + WS_MOD) + (size_t)l * 9216 + gi * 1024; E.scale = 0.5f;
    run_gemm(WV, (LAS unsigned char*)smem, (const bf16_t*)(ws + WS_U), 2816, (const bf16_t*)(ws + WS_W2) + (size_t)(l * 2 + f) * 1024 * 2816, L_, 1024, 2816, E); }
  { KArgs a = kargs(); unsigned char* ws = a->ws; CtxResid e; e.Xc = (float*)(ws + WS_X) + (size_t)L_ * 1024; e.gate = (const float*)(ws + WS_MOD) + (size_t)(4 + l) * 9216 + gi * 1024; e.scale = 0.5f;
    ctx_gemm32(WV, (const bf16_t*)(ws + WS_U) + (size_t)L_ * 2816, 2816, (const bf16_t*)(ws + WS_W2) + (size_t)(l * 2 + f) * 1024 * 2816, 2816, 1024, smem, e); }
}

DI void grid_bar(int WV, unsigned& gen) {
  asm volatile("s_waitcnt vmcnt(0)" ::: "memory");
  __syncthreads();
  gen += 1;
  if (ltid() == 0) {
    unsigned* cnt = (unsigned*)(kargs()->ws + WS_BAR);
    __builtin_amdgcn_fence(__ATOMIC_RELEASE, "agent");
    asm volatile("s_waitcnt vmcnt(0)" ::: "memory");
    __hip_atomic_fetch_add(cnt, 1u, __ATOMIC_RELAXED, __HIP_MEMORY_SCOPE_AGENT);
    const unsigned target = gen * (unsigned)lnb();
    while (__hip_atomic_load(cnt, __ATOMIC_RELAXED, __HIP_MEMORY_SCOPE_AGENT) < target) __builtin_amdgcn_s_sleep(2);
    __builtin_amdgcn_fence(__ATOMIC_ACQUIRE, "agent");
    asm volatile("s_waitcnt vmcnt(0)" ::: "memory");
  }
  __syncthreads();
}

__global__ void __launch_bounds__(512, 2) mega(Args a_unused) {
  extern __shared__ __attribute__((aligned(16))) unsigned char smem[];
  cg::grid_group grid = cg::this_grid();
  const int WV = __builtin_amdgcn_readfirstlane((int)(threadIdx.x >> 6));
#ifndef NO_PRO
  prologue(WV, kargs(), smem);
#endif
  grid.sync();
  unsigned gen = 0;
#pragma unroll 1
  for (int l = 0; l < DEPTH_; ++l) {
#pragma unroll 1
    for (int f = 0; f < 2; ++f) {
      if (f == 1) {
        norm_phase(WV, kargs(), l, 1, false);
        grid_bar(WV, gen);
        phase_win(WV, l, smem);
        grid_bar(WV, gen);
#ifndef NO_MIXA
        fourier_tables(WV, smem); __syncthreads(); fourier_stage1(WV, kargs(), smem); fourier_ctx(WV, kargs()); __syncthreads(); ret_states(WV, kargs(), l, smem);
#endif
        grid_bar(WV, gen);
#ifndef NO_MIXB
        ret_scan(WV, kargs(), l); __syncthreads(); fourier_tables(WV, smem); __syncthreads(); fourier_stage2(WV, kargs(), smem);
#endif
        grid_bar(WV, gen);
#ifndef NO_RETOUT
        ret_out(WV, kargs(), l, smem); __syncthreads();
#endif
#ifndef NO_ATTN
        attn_phase(WV, kargs(), l, l < DEPTH_ - 1, smem);
#endif
        grid_bar(WV, gen);
        phase_merge(WV, l, smem);
        grid_bar(WV, gen);
        phase_wo(WV, l, smem);
        grid_bar(WV, gen);
      }
      norm_phase(WV, kargs(), l, f == 0 ? 0 : 2, l == 0 && f == 0);
      grid_bar(WV, gen);
      phase_g1(WV, l, f, smem);
      grid_bar(WV, gen);
      phase_g2(WV, l, f, smem);
      grid_bar(WV, gen);
    }
  }
  final_norm(WV, kargs());
}

extern "C" void kernel_launch(void* const* d_in, const int* in_sizes, int n_in, void* d_out, int out_size, void* d_ws, size_t ws_size, hipStream_t stream) {
  static int grid = 0;
  if (grid == 0) {
    int dev = 0, cus = 0, per_cu = 0;
    (void)hipGetDevice(&dev); (void)hipDeviceGetAttribute(&cus, hipDeviceAttributeMultiprocessorCount, dev);
    if (hipFuncSetAttribute((const void*)mega, hipFuncAttributeMaxDynamicSharedMemorySize, LDS_BYTES) != hipSuccess) fprintf(stderr, "kernel_launch: hipFuncSetAttribute failed\n");
    if (hipOccupancyMaxActiveBlocksPerMultiprocessor(&per_cu, (const void*)mega, 512, LDS_BYTES) != hipSuccess || per_cu < 1) fprintf(stderr, "kernel_launch: occupancy query says %d blocks per CU\n", per_cu);
    (void)hipGetLastError();
    grid = cus > 0 ? cus : 256;
    if (ws_size < WS_END) { fprintf(stderr, "kernel_launch: workspace too small: %zu < %zu\n", ws_size, (size_t)WS_END); }
  }
  Args a{};
  for (int i = 0; i < 19; ++i) a.in[i] = (const float*)d_in[i];
  a.out = (float*)d_out; a.ws = (unsigned char*)d_ws;
  (void)hipMemsetAsync((unsigned char*)d_ws + WS_BAR, 0, 256, stream);
  void* args[] = {&a};
  hipError_t e = hipLaunchCooperativeKernel((const void*)mega, dim3(grid), dim3(512), args, LDS_BYTES, stream);
  if (e != hipSuccess) fprintf(stderr, "kernel_launch: cooperative launch failed: %s (grid %d)\n", hipGetErrorString(e), grid);
}
```

```cpp
#include <hip/hip_runtime.h>
#include <hip/hip_cooperative_groups.h>
#include <cstdio>
namespace cg = cooperative_groups;
__device__ __forceinline__ int lane_id_v() { int l; asm volatile("v_mbcnt_lo_u32_b32 %0, -1, 0\n\tv_mbcnt_hi_u32_b32 %0, -1, %0" : "=v"(l)); return l; }
#define ltid() ((WV << 6) | lane_id_v())
__device__ __forceinline__ float shx(float v, int m, int lane) { return __int_as_float(__builtin_amdgcn_ds_bpermute((lane ^ m) << 2, __float_as_int(v))); }
namespace pg8 {
#define PG8_LAS __attribute__((address_space(3)))
typedef unsigned short bf16_t;
typedef short bf16x8 __attribute__((ext_vector_type(8)));
typedef float f32x4 __attribute__((ext_vector_type(4)));
typedef unsigned u32x4 __attribute__((ext_vector_type(4)));
constexpr int BM = 256, BK = 64, HALF = 128, HTB = HALF * BK * 2  , STAGE_BYTES = 8 * HTB, NXCD = 8, WGM = 8;

__host__ __device__ __forceinline__ int lds_byte(int r, int c) { const int st = (r >> 4) * 2 + (c >> 5), rr = r & 15, cc = c & 31, ob = rr * 64 + cc * 2; return st * 1024 + (ob ^ (((ob >> 9) & 1) << 5)); }
__host__ __device__ __forceinline__ void stage_rc(int b, int& R, int& C) { const int st = b / 1024, sb = b % 1024, swz = sb ^ (((sb >> 9) & 1) << 5); R = (st >> 1) * 16 + swz / 64; C = (st & 1) * 32 + (swz % 64) / 2; }
__host__ __device__ __forceinline__ int perm32(int rho) { const int n = rho >> 4, i = rho & 15; return 8 * (i >> 2) + 4 * n + (i & 3); }

struct Unit { int pm, pn; };
struct Gemm { const bf16_t* A; const bf16_t* Bt; int M, N, K, lda; };

struct StaticOrder {
    int nM, nN, nwg, G, c;
    __host__ __device__ void init(int M, int N, int G_, int c_) { nM = M / BM; nN = N / BM; nwg = nM * nN; G = G_; c = c_; }
    __host__ __device__ bool next(int i, Unit& u) const {
        const long L = (long)i * G + c; if (L >= nwg) return false;
        int wgid = (int)L; { const int q = nwg / NXCD, r = nwg % NXCD, xcd = wgid % NXCD, off = wgid / NXCD; wgid = (xcd < r ? xcd * (q + 1) : r * (q + 1) + (xcd - r) * q) + off; }
        const int nig = WGM * nN, gid = wgid / nig, fm = gid * WGM, gsz = (nM - fm) < WGM ? (nM - fm) : WGM;
        u.pm = fm + ((wgid % nig) % gsz); u.pn = (wgid % nig) / gsz; return true;
    }
    __device__ __forceinline__ void a_ready(const Unit&) const {}
    __device__ __forceinline__ void done(const Unit&) const {}
};
__device__ __forceinline__ unsigned cvt_pk_bf16(float lo, float hi) { unsigned r; asm volatile("v_cvt_pk_bf16_f32 %0, %1, %2" : "=v"(r) : "v"(lo), "v"(hi)); return r; }
template <class Epi, class Sched, bool STAMP = false>
__device__ __forceinline__ void gemm_phase(const int WV, PG8_LAS unsigned char* lds, const Gemm g, const Sched& S, const Epi& E, unsigned long long* stamps) {
    const int tid = ltid(); const int wid = __builtin_amdgcn_readfirstlane(tid >> 6), lane = tid & 63, wr = wid >> 2, wc = wid & 3, fr = lane & 15, fq = lane >> 4;
    const int K = g.K, nt = K / BK;
    int ts_lo = 0, ts_hi = 0, nts = 0; const unsigned long long rt_entry = STAMP ? (unsigned long long)wall_clock64() : 0ull;
#define PG8_STAMP() do { if (STAMP && wid == 0 && nts < 64) { const unsigned long long _c = (unsigned long long)clock64(); \
        ts_lo = (lane == nts) ? (int)(unsigned)_c : ts_lo; ts_hi = (lane == nts) ? (int)(unsigned)(_c >> 32) : ts_hi; ++nts; } } while (0)
    PG8_STAMP();
    unsigned voffA[2], voffB[2];
#pragma unroll
    for (int i = 0; i < 2; ++i) { int R, C; stage_rc(tid * 16 + i * 8192, R, C); const int Rb = Epi::PERM ? ((R & ~31) + perm32(R & 31)) : R;
        voffA[i] = (unsigned)(R * g.lda + C) * 2u; voffB[i] = (unsigned)(Rb * K + C) * 2u; }
    const size_t kstep = (size_t)(BK * 2);
    const size_t hstep = (size_t)HALF * K * 2;
    const size_t tstep = 2 * hstep; const size_t hstepA = (size_t)HALF * g.lda * 2; const size_t tstepA = 2 * hstepA;
    const unsigned ldsw = (unsigned)wid * 1024u;
    const int aoff = lds_byte(wr * 64 + fr, fq * 8), boff = lds_byte(wc * 32 + fr, fq * 8);
#define PG8_SA(b, h) (((b) * 2 + (h)) * HTB)
#define PG8_SB(b, h) ((4 + (b) * 2 + (h)) * HTB)
#define PG8_STAGE(bufoff, gbase, voff) do { _Pragma("unroll") for (int _i = 0; _i < 2; ++_i) \
        __builtin_amdgcn_global_load_lds((const unsigned*)((const char*)(gbase) + (voff)[_i]), (PG8_LAS unsigned*)(lds + (bufoff) + ldsw + _i * 8192), 16, 0, 0); } while (0)
#define PG8_LDA(dst, b, h) do { _Pragma("unroll") for (int m = 0; m < 4; ++m) _Pragma("unroll") for (int k = 0; k < 2; ++k) dst[m][k] = *(const PG8_LAS bf16x8*)(lds + PG8_SA(b, h) + aoff + m * 2048 + k * 1024); } while (0)
#define PG8_LDB(dst, b, h) do { _Pragma("unroll") for (int n = 0; n < 2; ++n) _Pragma("unroll") for (int k = 0; k < 2; ++k) dst[n][k] = *(const PG8_LAS bf16x8*)(lds + PG8_SB(b, h) + boff + n * 2048 + k * 1024); } while (0)
#define PG8_MMA(ai, bj, At, Bt) do { __builtin_amdgcn_s_setprio(1); _Pragma("unroll") for (int m = 0; m < 4; ++m) _Pragma("unroll") for (int n = 0; n < 2; ++n) _Pragma("unroll") for (int k = 0; k < 2; ++k) \
        acc[ai][bj][m][n] = __builtin_amdgcn_mfma_f32_16x16x32_bf16(Bt[n][k], At[m][k], acc[ai][bj][m][n], 0, 0, 0); __builtin_amdgcn_s_setprio(0); } while (0)
#define PG8_WAIT_V(n) asm volatile("s_waitcnt vmcnt(" #n ")" ::: "memory")
#define PG8_WAIT_L(n) asm volatile("s_waitcnt lgkmcnt(" #n ")" ::: "memory")
#define PG8_BAR __builtin_amdgcn_s_barrier()
#define PG8_SCHED __builtin_amdgcn_sched_barrier(0)
    Unit cur, nxt; int ui = 0;
    if (!S.next(0, cur)) return;
    f32x4 acc[2][2][4][2];
#pragma unroll
    for (int a = 0; a < 2; ++a)
#pragma unroll
        for (int b = 0; b < 2; ++b)
#pragma unroll
            for (int m = 0; m < 4; ++m)
#pragma unroll
                for (int n = 0; n < 2; ++n) acc[a][b][m][n] = (f32x4){0.f, 0.f, 0.f, 0.f};
    bf16x8 At[4][2], B0[2][2], B1[2][2];
    const char* cA = (const char*)g.A + (size_t)cur.pm * tstepA; const char* cB = (const char*)g.Bt + (size_t)cur.pn * tstep;
    S.a_ready(cur);
    PG8_STAGE(PG8_SB(0, 0), cB, voffB); PG8_STAGE(PG8_SA(0, 0), cA, voffA); PG8_STAGE(PG8_SB(0, 1), cB + hstep, voffB); PG8_STAGE(PG8_SA(0, 1), cA + hstepA, voffA);
    if (wr == 1) PG8_BAR;
    PG8_WAIT_V(4); PG8_BAR;
    PG8_STAGE(PG8_SB(1, 0), cB + kstep, voffB); PG8_STAGE(PG8_SA(1, 0), cA + kstep, voffA); PG8_STAGE(PG8_SB(1, 1), cB + hstep + kstep, voffB);
    PG8_WAIT_V(6); PG8_BAR;
    PG8_STAMP();
    for (;;) {
        const bool has_next = S.next(ui + 1, nxt);
        const char* nA = has_next ? (const char*)g.A + (size_t)nxt.pm * tstepA : cA; const char* nB = has_next ? (const char*)g.Bt + (size_t)nxt.pn * tstep : cB;
        for (int t = 0; t < nt; t += 2) {
            const bool last = (t == nt - 2);
            const char* a1 = cA + (size_t)(t + 1) * kstep;
            const char* a2 = last ? nA : cA + (size_t)(t + 2) * kstep; const char* b2 = last ? nB : cB + (size_t)(t + 2) * kstep;
            const char* a3 = a2 + kstep; const char* b3 = b2 + kstep;
            if (last && has_next) S.a_ready(nxt);
            PG8_LDB(B0, 0, 0); PG8_SCHED; PG8_LDA(At, 0, 0); PG8_STAGE(PG8_SA(1, 1), a1 + hstepA, voffA);
            PG8_WAIT_L(8); PG8_BAR; PG8_WAIT_L(0); PG8_MMA(0, 0, At, B0); PG8_BAR; PG8_SCHED;
            PG8_LDB(B1, 0, 1); PG8_STAGE(PG8_SB(0, 0), b2, voffB);
            PG8_BAR; PG8_WAIT_L(0); PG8_MMA(0, 1, At, B1); PG8_BAR;
            PG8_LDA(At, 0, 1); PG8_STAGE(PG8_SA(0, 0), a2, voffA);
            PG8_BAR; PG8_WAIT_L(0); PG8_MMA(1, 0, At, B0); PG8_BAR; PG8_SCHED;
            PG8_STAGE(PG8_SB(0, 1), b2 + hstep, voffB);
            PG8_WAIT_V(6); PG8_BAR; PG8_MMA(1, 1, At, B1); PG8_BAR;
            PG8_LDB(B0, 1, 0); PG8_SCHED; PG8_LDA(At, 1, 0); PG8_STAGE(PG8_SA(0, 1), a2 + hstepA, voffA);
            PG8_WAIT_L(8); PG8_BAR; PG8_WAIT_L(0); PG8_MMA(0, 0, At, B0); PG8_BAR; PG8_SCHED;
            PG8_LDB(B1, 1, 1); PG8_STAGE(PG8_SB(1, 0), b3, voffB);
            PG8_BAR; PG8_WAIT_L(0); PG8_MMA(0, 1, At, B1); PG8_BAR;
            PG8_LDA(At, 1, 1); PG8_STAGE(PG8_SA(1, 0), a3, voffA);
            PG8_BAR; PG8_WAIT_L(0); PG8_MMA(1, 0, At, B0); PG8_BAR; PG8_SCHED;
            PG8_STAGE(PG8_SB(1, 1), b3 + hstep, voffB);
            PG8_WAIT_V(6); PG8_BAR; PG8_MMA(1, 1, At, B1); PG8_BAR;
        }
        PG8_STAMP();
        if constexpr (!Epi::AFTER_DRAIN) { E(acc, cur, wr, wc, fr, fq); S.done(cur); }
        PG8_STAMP();
        if (!has_next) break;
#pragma unroll
        for (int a = 0; a < 2; ++a)
#pragma unroll
            for (int b = 0; b < 2; ++b)
#pragma unroll
                for (int m = 0; m < 4; ++m)
#pragma unroll
                    for (int n = 0; n < 2; ++n) acc[a][b][m][n] = (f32x4){0.f, 0.f, 0.f, 0.f};
        cur = nxt; cA = nA; cB = nB; ++ui;
    }
    PG8_WAIT_V(0);
    if (wr == 0) PG8_BAR;
    PG8_BAR;
    if constexpr (Epi::AFTER_DRAIN) { E.fused(acc, cur, wr, wc, fr, fq, lds, wid, lane); S.done(cur); }
    PG8_STAMP();
    if (STAMP && wid == 0) { stamps[lane] = lane < nts ? (((unsigned long long)(unsigned)ts_hi << 32) | (unsigned)ts_lo) : 0ull;
        if (lane == 62) stamps[62] = rt_entry; if (lane == 63) stamps[63] = (unsigned long long)wall_clock64(); }
#undef PG8_STAMP
#undef PG8_SA
#undef PG8_SB
#undef PG8_STAGE
#undef PG8_LDA
#undef PG8_LDB
#undef PG8_MMA
#undef PG8_WAIT_V
#undef PG8_WAIT_L
#undef PG8_BAR
#undef PG8_SCHED
}
}
using pg8::bf16_t; using pg8::bf16x8; using pg8::f32x4; using pg8::u32x4; using pg8::cvt_pk_bf16;
typedef float f32x16 __attribute__((ext_vector_type(16)));
typedef short s16x4 __attribute__((ext_vector_type(4)));
typedef unsigned u32x2 __attribute__((ext_vector_type(2)));
#define DI __device__ __forceinline__
#define LAS __attribute__((address_space(3)))
#define MFMA32(a, b, c) __builtin_amdgcn_mfma_f32_32x32x16_bf16((a), (b), (c), 0, 0, 0)

constexpr int L_ = 16384, LC_ = 256, MT_ = 16640, D_ = 1024, DFF_ = 2816, DEPTH_ = 4;
constexpr int NWIN_ = 5888, NPB_ = 2816, NGB_ = 3072;
constexpr int C_FA = 0, C_FB = 256, C_RQ = 512, C_RK = 704, C_RV = 896, C_RG = 1280, C_DQ = 1664, C_DK = 2048, C_DV = 2432;
constexpr int LDS_BYTES = 147456;
constexpr float EPS_ = 1e-6f;

constexpr size_t al256(size_t x) { return (x + 255) & ~(size_t)255; }
constexpr size_t WS_W13 = 0;
constexpr size_t WS_W2  = WS_W13 + (size_t)4 * 2 * 5632 * 1024 * 2;
constexpr size_t WS_WIN = WS_W2 + (size_t)4 * 2 * 1024 * 2816 * 2;
constexpr size_t WS_WBF = WS_WIN + (size_t)4 * 5888 * 1024 * 2;
constexpr size_t WS_WBR = WS_WBF + (size_t)4 * 1024 * 256 * 2;
constexpr size_t WS_WBD = WS_WBR + (size_t)4 * 1024 * 384 * 2;
constexpr size_t WS_WO  = WS_WBD + (size_t)4 * 1024 * 384 * 2;
constexpr size_t WS_X   = WS_WO + (size_t)4 * 1024 * 1024 * 2;
constexpr size_t WS_H   = WS_X + (size_t)MT_ * 1024 * 4;
constexpr size_t WS_BR  = WS_H + (size_t)MT_ * 1024 * 2;
constexpr size_t WS_AL  = WS_BR + (size_t)MT_ * 1024 * 2;
constexpr size_t WS_U   = WS_AL;
constexpr size_t WS_PB  = WS_AL;
constexpr size_t WS_GB  = WS_AL + (size_t)MT_ * 2816 * 2;
constexpr size_t WS_V   = WS_GB + (size_t)MT_ * 3072 * 2;
constexpr size_t WS_T   = WS_V + (size_t)128 * 128 * 2 * 256 * 2;
constexpr size_t WS_S   = WS_T + (size_t)130 * 6 * 2 * 2048 * 4;
constexpr size_t WS_MXC = WS_S + (size_t)130 * 6 * 2 * 2048 * 4;
constexpr size_t WS_MOD = WS_MXC + (size_t)256 * 1024 * 4;
constexpr size_t WS_TRET = WS_MOD + (size_t)2 * 4 * 9216 * 4;
constexpr size_t WS_TROW = WS_TRET + (size_t)16384 * 16 * 2 * 4;
constexpr size_t WS_TCOL = WS_TROW + (size_t)256 * 8 * 2 * 4;
constexpr size_t WS_SCAL = WS_TCOL + (size_t)64 * 8 * 2 * 4;
constexpr size_t WS_BAR = WS_SCAL + 4 * 64 * 4;
constexpr size_t WS_END = WS_BAR + 256;

__device__ __forceinline__ int lbid() { int t = blockIdx.x; asm volatile("" : "+s"(t)); return t; }
__device__ __forceinline__ int lnb() { int t = gridDim.x; asm volatile("" : "+s"(t)); return t; }
struct Args { const float* in[19]; float* out; unsigned char* ws; };
typedef const Args __attribute__((address_space(4)))* KArgs;
__device__ __forceinline__ KArgs kargs() { KArgs p = (KArgs)__builtin_amdgcn_kernarg_segment_ptr(); asm volatile("" : "+s"(p)); return p; }

DI float bf2f(unsigned v) { return __uint_as_float(v << 16); }
DI bf16_t f2bf(float x) { return (bf16_t)(cvt_pk_bf16(x, 0.f) & 0xffffu); }
DI int crow(int reg, int h) { return (reg & 3) + 8 * (reg >> 2) + 4 * h; }
DI bf16x8 pack_step(const f32x16& x, int s) {
  u32x4 p;
  asm volatile("v_cvt_pk_bf16_f32 %0, %4, %5\n\tv_cvt_pk_bf16_f32 %1, %6, %7\n\tv_cvt_pk_bf16_f32 %2, %8, %9\n\tv_cvt_pk_bf16_f32 %3, %10, %11\n\ts_nop 1"
               : "=&v"(p[0]), "=&v"(p[1]), "=&v"(p[2]), "=&v"(p[3])
               : "v"(x[8 * s]), "v"(x[8 * s + 1]), "v"(x[8 * s + 2]), "v"(x[8 * s + 3]), "v"(x[8 * s + 4]), "v"(x[8 * s + 5]), "v"(x[8 * s + 6]), "v"(x[8 * s + 7]));
  return __builtin_bit_cast(bf16x8, p);
}
DI float silu_f(float a) { return a / (1.0f + __expf(-a)); }
DI float sigmoid_f(float a) { return 1.0f / (1.0f + __expf(-a)); }
DI float wave_sum(float v) {
  const int lane = lane_id_v();
#pragma unroll
  for (int o = 32; o > 0; o >>= 1) v += shx(v, o, lane);
  return v;
}
DI void sincos_acc(float xf, float& s, float& c) {
  const double x = (double)xf;
  const double k = rint(x * 0.63661977236758134308);
  double r = fma(-k, 1.57079632679489655800e+00, x); r = fma(-k, 6.12323399573676603587e-17, r);
  const double r2 = r * r;
  double sp = -1.0 / 39916800.0; sp = fma(sp, r2, 1.0 / 362880.0); sp = fma(sp, r2, -1.0 / 5040.0); sp = fma(sp, r2, 1.0 / 120.0); sp = fma(sp, r2, -1.0 / 6.0); sp = fma(sp * r2, r, r);
  double cp = 1.0 / 479001600.0; cp = fma(cp, r2, -1.0 / 3628800.0); cp = fma(cp, r2, 1.0 / 40320.0); cp = fma(cp, r2, -1.0 / 720.0); cp = fma(cp, r2, 1.0 / 24.0); cp = fma(cp, r2, -0.5); cp = fma(cp, r2, 1.0);
  const int q = ((int)(long long)k) & 3;
  const double sv = (q == 0) ? sp : (q == 1) ? cp : (q == 2) ? -sp : -cp;
  const double cv = (q == 0) ? cp : (q == 1) ? -sp : (q == 2) ? -cp : sp;
  s = (float)sv; c = (float)cv;
}
__constant__ float INV16[16] = {1.0f, 0.5623413324356079f, 0.3162277638912201f, 0.17782793939113617f, 0.10000000149011612f, 0.05623413249850273f, 0.03162277489900589f, 0.017782794311642647f,
                             0.009999999776482582f, 0.005623413249850273f, 0.003162277629598975f, 0.0017782794311642647f, 0.0010000000474974513f, 0.000562341301701963f, 0.0003162277571391314f, 0.00017782794020604342f};
struct ConvJob { const float* src; const float* src2; bf16_t* dst; int N, K, ld, kind; };
DI ConvJob conv_job(KArgs a, int j) {
  const int l = j / 9, kd = j % 9; ConvJob J; J.src2 = nullptr; J.kind = 0;
  unsigned char* ws = a->ws;
  switch (kd) {
    case 0: case 1: { const int f = kd; J.src = a->in[7] + (size_t)(l * 2 + f) * 1024 * 2816; J.src2 = a->in[8] + (size_t)(l * 2 + f) * 1024 * 2816; J.dst = (bf16_t*)(ws + WS_W13) + (size_t)(l * 2 + f) * 5632 * 1024; J.N = 5632; J.K = 1024; J.ld = 2816; J.kind = 1; break; }
    case 2: case 3: { const int f = kd - 2; J.src = a->in[9] + (size_t)(l * 2 + f) * 2816 * 1024; J.dst = (bf16_t*)(ws + WS_W2) + (size_t)(l * 2 + f) * 1024 * 2816; J.N = 1024; J.K = 2816; J.ld = 1024; break; }
    case 4: { J.src = a->in[10] + (size_t)l * 1024 * 5632; J.dst = (bf16_t*)(ws + WS_WIN) + (size_t)l * 5888 * 1024; J.N = 5888; J.K = 1024; J.ld = 5632; J.kind = 2; break; }
    case 5: { J.src = a->in[14] + (size_t)l * 256 * 1024; J.dst = (bf16_t*)(ws + WS_WBF) + (size_t)l * 1024 * 256; J.N = 1024; J.K = 256; J.ld = 1024; break; }
    case 6: { J.src = a->in[15] + (size_t)l * 384 * 1024; J.dst = (bf16_t*)(ws + WS_WBR) + (size_t)l * 1024 * 384; J.N = 1024; J.K = 384; J.ld = 1024; break; }
    case 7: { J.src = a->in[16] + (size_t)l * 384 * 1024; J.dst = (bf16_t*)(ws + WS_WBD) + (size_t)l * 1024 * 384; J.N = 1024; J.K = 384; J.ld = 1024; break; }
    default: { J.src = a->in[17] + (size_t)l * 1024 * 1024; J.dst = (bf16_t*)(ws + WS_WO) + (size_t)l * 1024 * 1024; J.N = 1024; J.K = 1024; J.ld = 1024; break; }
  }
  return J;
}
DI int axial_perm(int s) { return s < 8 ? s : (s < 16 ? s + 8 : (s < 24 ? s - 8 : s)); }

DI void prologue(int WV, KArgs a, unsigned char* smem) {
  const int tid = ltid(), nb = lnb(), bid = lbid();
  float* t = (float*)smem;
  float* tr = t + 64 * 65;
  {
    constexpr int tiles_per_layer = 1408 * 2 + 704 * 2 + 1472 + 64 + 96 + 96 + 256;
    const int nn = tid & 63, kq = tid >> 6;
#pragma unroll 1
    for (int g = bid; g < 4 * tiles_per_layer; g += nb) {
      const int l = g / tiles_per_layer; int rem = g % tiles_per_layer; int kd;
      if (rem < 1408) kd = 0; else if (rem < 2816) { kd = 1; rem -= 1408; } else if (rem < 3520) { kd = 2; rem -= 2816; } else if (rem < 4224) { kd = 3; rem -= 3520; }
      else if (rem < 5696) { kd = 4; rem -= 4224; } else if (rem < 5760) { kd = 5; rem -= 5696; } else if (rem < 5856) { kd = 6; rem -= 5760; } else if (rem < 5952) { kd = 7; rem -= 5856; } else { kd = 8; rem -= 5952; }
      const ConvJob J = conv_job(a, l * 9 + kd);
      const int nkt = J.K / 64; const int n0 = (rem / nkt) * 64, k0 = (rem % nkt) * 64;
      const bool fold = (J.kind == 2) && (n0 < 512);
      const float* sp = J.src; int col = n0 + nn;
      if (J.kind == 1) { const int n = n0 + nn, gi = n >> 5, s = n & 31; sp = (s < 16) ? J.src : J.src2; col = 16 * gi + (s & 15); }
      else if (J.kind == 2) {
        const int n = n0 + nn;
        if (fold) col = (n0 & 192) + nn;
        else { col = n - 256; if (n >= C_DQ && n < C_DV) { const int s = n & 31; col = (n - 256 - s) + axial_perm(s); } }
      }
      const float* cp = sp + (size_t)(k0 + kq) * J.ld + col;
      float lv[8];
#pragma unroll
      for (int i = 0; i < 8; ++i) lv[i] = cp[(size_t)(8 * i) * J.ld];
#pragma unroll
      for (int i = 0; i < 8; ++i) t[nn * 65 + kq + 8 * i] = lv[i];
      if (fold && tid < 64) { const float ang = (float)tid * (1.0f / 32.0f); tr[tid] = (n0 >= 256) ? sinpif(ang) : cospif(ang); }
      __syncthreads();
      if (!fold) {
#pragma unroll
        for (int i = 0; i < 4; ++i) {
          const int e = tid + i * 512, n2 = e >> 5, kp = (e & 31) * 2;
          *(unsigned*)(J.dst + (size_t)(n0 + n2) * J.K + k0 + kp) = cvt_pk_bf16(t[n2 * 65 + kp], t[n2 * 65 + kp + 1]);
        }
      } else {
#pragma unroll 1
        for (int i = 0; i < 8; ++i) {
          const int m = kq + 8 * i, kk = nn;
          float acc = 0.f;
#pragma unroll 8
          for (int c = 0; c < 64; ++c) acc += t[c * 65 + kk] * tr[(m * c) & 63];
          J.dst[(size_t)(n0 + m) * J.K + k0 + kk] = f2bf(acc);
        }
      }
      __syncthreads();
    }
  }
  {
    float* sc = (float*)smem; float* scc = sc + 1024; float* red = scc + 1024;
    __syncthreads();
    for (int i = tid; i < 1024; i += 512) { sc[i] = silu_f(a->in[1][i]); scc[i] = silu_f(a->in[3][i]); }
    __syncthreads();
    float* MOD = (float*)(a->ws + WS_MOD);
    for (int it = bid; it < 4 * 72; it += nb) {
      const int l = it / 72, cb = it % 72;
      const int cgp = tid & 31, ks = tid >> 5;
      const float* wp = a->in[4] + ((size_t)l * 1024 + ks * 64) * 9216 + cb * 128 + cgp * 4;
      f32x4 am = {0.f, 0.f, 0.f, 0.f}, ac = {0.f, 0.f, 0.f, 0.f};
#pragma unroll 8
      for (int k = 0; k < 64; ++k) { const f32x4 w = *(const f32x4*)(wp + (size_t)k * 9216); am += w * sc[ks * 64 + k]; ac += w * scc[ks * 64 + k]; }
#pragma unroll
      for (int j = 0; j < 4; ++j) { red[(ks * 128 + cgp * 4 + j) * 2] = am[j]; red[(ks * 128 + cgp * 4 + j) * 2 + 1] = ac[j]; }
      __syncthreads();
      if (tid < 256) {
        const int col = tid >> 1, which = tid & 1; float s = 0.f;
#pragma unroll
        for (int q = 0; q < 16; ++q) s += red[(q * 128 + col) * 2 + which];
        const int gc = cb * 128 + col;
        MOD[(size_t)(which * 4 + l) * 9216 + gc] = s + a->in[5][(size_t)l * 9216 + gc];
      }
      __syncthreads();
    }
  }
  {
    float* TRET = (float*)(a->ws + WS_TRET); float* TROW = (float*)(a->ws + WS_TROW); float* TCOL = (float*)(a->ws + WS_TCOL);
    const int gt = bid * 512 + tid, gn = nb * 512;
    for (int e = gt; e < 16384 * 16; e += gn) { const int p = e >> 4, i = e & 15; float s, c; sincos_acc((float)p * INV16[i], s, c); TRET[2 * e] = c; TRET[2 * e + 1] = s; }
    for (int e = gt; e < 256 * 8; e += gn) { const int p = e >> 3, i = e & 7; float s, c; sincos_acc((float)p * INV16[2 * i], s, c); TROW[2 * e] = c; TROW[2 * e + 1] = s; }
    for (int e = gt; e < 64 * 8; e += gn) { const int p = e >> 3, i = e & 7; float s, c; sincos_acc((float)p * INV16[2 * i], s, c); TCOL[2 * e] = c; TCOL[2 * e + 1] = s; }
    if (bid == 0 && tid < 4) {
      const int l = tid; float* S = (float*)(a->ws + WS_SCAL) + l * 64;
      const float* lv = a->in[12] + l * 128; float d01 = 0.f, d23 = 0.f;
      for (int i = 0; i < 32; ++i) { d01 += lv[i] * lv[32 + i]; d23 += lv[64 + i] * lv[96 + i]; }
      const float lam_init = 0.8f - 0.6f * expf(-0.3f * (float)l);
      S[0] = expf(d01) - expf(d23) + lam_init; S[1] = lam_init;
      for (int i = 0; i < 12; ++i) { const float x = a->in[11][l * 12 + i]; S[4 + i] = -log1pf(expf(-x)); }
      for (int i = 0; i < 12; ++i) ((unsigned*)S)[16 + i] = 0u;
    }
  }
}
DI void norm_phase(int WV, KArgs a, int l, int which, bool first) {
  const int tid = ltid(), lane = tid & 63, wave = tid >> 6;
  const float* g = a->in[6] + (size_t)(l * 3 + which) * 1024;
  const float* mod = (const float*)(a->ws + WS_MOD) + (size_t)l * 9216;
  const float* modc = (const float*)(a->ws + WS_MOD) + (size_t)(4 + l) * 9216;
  float* X = (float*)(a->ws + WS_X); bf16_t* H = (bf16_t*)(a->ws + WS_H);
  for (int r = lbid() * 8 + wave; r < MT_; r += lnb() * 8) {
    const float* src = first ? (r < L_ ? a->in[0] + (size_t)r * 1024 : a->in[2] + (size_t)(r - L_) * 1024) : X + (size_t)r * 1024;
    f32x4 v[4]; float ss = 0.f;
#pragma unroll
    for (int i = 0; i < 4; ++i) { v[i] = *(const f32x4*)(src + i * 256 + lane * 4); ss += v[i][0] * v[i][0] + v[i][1] * v[i][1] + v[i][2] * v[i][2] + v[i][3] * v[i][3]; }
    ss = wave_sum(ss);
    const float rstd = rsqrtf(ss * (1.0f / 1024.0f) + EPS_);
    const float* mm = (r < L_) ? mod : modc;
#pragma unroll
    for (int i = 0; i < 4; ++i) {
      const int c = i * 256 + lane * 4;
      const f32x4 gg = *(const f32x4*)(g + c), sh = *(const f32x4*)(mm + (which * 3) * 1024 + c), sc = *(const f32x4*)(mm + (which * 3 + 1) * 1024 + c);
      f32x4 y;
#pragma unroll
      for (int j = 0; j < 4; ++j) y[j] = v[i][j] * rstd * gg[j] * (1.0f + sc[j]) + sh[j];
      u32x2 w; w.x = cvt_pk_bf16(y[0], y[1]); w.y = cvt_pk_bf16(y[2], y[3]);
      *(u32x2*)(H + (size_t)r * 1024 + c) = w;
      if (first) *(f32x4*)(X + (size_t)r * 1024 + c) = v[i];
    }
  }
}
DI void final_norm(int WV, KArgs a) {
  const int tid = ltid(), lane = tid & 63, wave = tid >> 6;
  const float* g = a->in[18]; const float* X = (const float*)(a->ws + WS_X);
  for (int r = lbid() * 8 + wave; r < L_; r += lnb() * 8) {
    f32x4 v[4]; float ss = 0.f;
#pragma unroll
    for (int i = 0; i < 4; ++i) { v[i] = *(const f32x4*)(X + (size_t)r * 1024 + i * 256 + lane * 4); ss += v[i][0] * v[i][0] + v[i][1] * v[i][1] + v[i][2] * v[i][2] + v[i][3] * v[i][3]; }
    ss = wave_sum(ss);
    const float rstd = rsqrtf(ss * (1.0f / 1024.0f) + EPS_);
#pragma unroll
    for (int i = 0; i < 4; ++i) { const int c = i * 256 + lane * 4; const f32x4 gg = *(const f32x4*)(g + c); f32x4 y; for (int j = 0; j < 4; ++j) y[j] = v[i][j] * rstd * gg[j]; *(f32x4*)(a->out + (size_t)r * 1024 + c) = y; }
  }
}

using pg8::Unit; using pg8::HALF; using pg8::BM;
struct EpiSwiglu {
  static constexpr bool PERM = false, AFTER_DRAIN = false;
  bf16_t* U;
  DI void operator()(const f32x4 (&acc)[2][2][4][2], const Unit& u, int wr, int wc, int fr_, int fq_) const {
    const int ln_ = lane_id_v(), fr = ln_ & 15, fq = ln_ >> 4;
#pragma unroll
    for (int ai = 0; ai < 2; ++ai)
#pragma unroll
      for (int m = 0; m < 4; ++m) {
        const int r = u.pm * BM + ai * HALF + wr * 64 + m * 16 + fr;
#pragma unroll
        for (int bj = 0; bj < 2; ++bj) {
          const int gi = u.pn * 8 + bj * 4 + wc;
          const f32x4 x = acc[ai][bj][m][0], y = acc[ai][bj][m][1];
          u32x2 w; w.x = cvt_pk_bf16(silu_f(x[0]) * y[0], silu_f(x[1]) * y[1]); w.y = cvt_pk_bf16(silu_f(x[2]) * y[2], silu_f(x[3]) * y[3]);
          *(u32x2*)(U + (size_t)r * DFF_ + gi * 16 + fq * 4) = w;
        }
        __builtin_amdgcn_sched_barrier(0);
      }
  }
};
struct EpiResid {
  static constexpr bool PERM = false, AFTER_DRAIN = false;
  float* X; const float* gate; float scale;
  DI void operator()(const f32x4 (&acc)[2][2][4][2], const Unit& u, int wr, int wc, int fr_, int fq_) const {
    const int ln_ = lane_id_v(), fr = ln_ & 15, fq = ln_ >> 4;
#pragma unroll
    for (int bj = 0; bj < 2; ++bj)
#pragma unroll
      for (int n = 0; n < 2; ++n) {
        const int c = u.pn * BM + bj * HALF + wc * 32 + n * 16 + fq * 4;
        const f32x4 gv = *(const f32x4*)(gate + c) * scale;
#pragma unroll
        for (int ai = 0; ai < 2; ++ai)
#pragma unroll
          for (int m = 0; m < 4; ++m) {
            const int r = u.pm * BM + ai * HALF + wr * 64 + m * 16 + fr;
            float* p = X + (size_t)r * 1024 + c;
            *(f32x4*)p = *(const f32x4*)p + gv * acc[ai][bj][m][n];
          }
      }
  }
};
template <int STEP> struct EpiMerge {
  static constexpr bool PERM = false, AFTER_DRAIN = false;
  float* MX; const bf16_t* G; bf16_t* Hout;
  DI void operator()(const f32x4 (&acc)[2][2][4][2], const Unit& u, int wr, int wc, int fr_, int fq_) const {
    const int ln_ = lane_id_v(), fr = ln_ & 15, fq = ln_ >> 4;
#pragma unroll
    for (int ai = 0; ai < 2; ++ai)
#pragma unroll
      for (int bj = 0; bj < 2; ++bj)
#pragma unroll
        for (int n = 0; n < 2; ++n) {
          const int c = u.pn * BM + bj * HALF + wc * 32 + n * 16 + fq * 4;
          const int r0 = u.pm * BM + ai * HALF + wr * 64 + fr;
          u32x2 gw[4]; f32x4 old[4];
#pragma unroll
          for (int m = 0; m < 4; ++m) {
            gw[m] = *(const u32x2*)(G + (size_t)(r0 + m * 16) * NGB_ + c);
            if (STEP > 0) old[m] = *(const f32x4*)(MX + (size_t)(r0 + m * 16) * 1024 + c);
          }
#pragma unroll
          for (int m = 0; m < 4; ++m) {
            f32x4 gv; gv[0] = bf2f(gw[m].x & 0xffffu); gv[1] = bf2f(gw[m].x >> 16); gv[2] = bf2f(gw[m].y & 0xffffu); gv[3] = bf2f(gw[m].y >> 16);
            f32x4 v = gv * acc[ai][bj][m][n];
            if (STEP > 0) v += old[m];
            if (STEP < 2) *(f32x4*)(MX + (size_t)(r0 + m * 16) * 1024 + c) = v;
            else { u32x2 w; w.x = cvt_pk_bf16(v[0], v[1]); w.y = cvt_pk_bf16(v[2], v[3]); *(u32x2*)(Hout + (size_t)(r0 + m * 16) * 1024 + c) = w; }
          }
          __builtin_amdgcn_sched_barrier(0);
        }
  }
};
struct EpiWin {
  static constexpr bool PERM = false, AFTER_DRAIN = false;
  bf16_t* PB; bf16_t* GB; const float* TRET; const float* TROW; const float* TCOL; unsigned* kmax;
  DI void operator()(const f32x4 (&acc)[2][2][4][2], const Unit& u, int wr, int wc, int fr_, int fq_) const {
    const int ln_ = lane_id_v(), fr = ln_ & 15, fq = ln_ >> 4;
#pragma unroll
    for (int bj = 0; bj < 2; ++bj) {
      const int cb = u.pn * BM + bj * HALF + wc * 32;
      float kmx = 0.f;
#pragma unroll
      for (int ai = 0; ai < 2; ++ai)
#pragma unroll
        for (int m = 0; m < 4; ++m) {
          const int r = u.pm * BM + ai * HALF + wr * 64 + m * 16 + fr;
          f32x4 x0 = acc[ai][bj][m][0], x1 = acc[ai][bj][m][1];
          if (cb >= NPB_) {
#pragma unroll
            for (int j = 0; j < 4; ++j) { x0[j] = sigmoid_f(x0[j]); x1[j] = sigmoid_f(x1[j]); }
            u32x2 w0, w1; w0.x = cvt_pk_bf16(x0[0], x0[1]); w0.y = cvt_pk_bf16(x0[2], x0[3]); w1.x = cvt_pk_bf16(x1[0], x1[1]); w1.y = cvt_pk_bf16(x1[2], x1[3]);
            bf16_t* p = GB + (size_t)r * NGB_ + (cb - NPB_) + fq * 4;
            *(u32x2*)p = w0; *(u32x2*)(p + 16) = w1;
            __builtin_amdgcn_sched_barrier(0);
            continue;
          }
          if (cb >= C_RQ && cb < C_RV) {
            if (r < L_) {
              const f32x4* tp = (const f32x4*)(TRET + ((size_t)r * 16 + fq * 4) * 2);
              const f32x4 t0 = tp[0], t1 = tp[1];
              const float cs[4] = {t0[0], t0[2], t1[0], t1[2]}, sn[4] = {t0[1], t0[3], t1[1], t1[3]};
#pragma unroll
              for (int j = 0; j < 4; ++j) { const float a_ = x0[j], b_ = x1[j]; x0[j] = a_ * cs[j] - b_ * sn[j]; x1[j] = a_ * sn[j] + b_ * cs[j]; }
            }
            if (cb >= C_RK) { x0 *= 0.17677669529663687f; x1 *= 0.17677669529663687f; }
          } else if (cb >= C_RG && cb < C_DQ) {
#pragma unroll
            for (int j = 0; j < 4; ++j) { x0[j] = silu_f(x0[j]); x1[j] = silu_f(x1[j]); }
          } else if (cb >= C_DQ && cb < C_DV) {
            if (r < L_) {
              const float* tb = (fq < 2) ? (TROW + ((size_t)(r >> 6) * 8 + fq * 4) * 2) : (TCOL + ((size_t)(r & 63) * 8 + (fq - 2) * 4) * 2);
              const f32x4 t0 = ((const f32x4*)tb)[0], t1 = ((const f32x4*)tb)[1];
              const float cs[4] = {t0[0], t0[2], t1[0], t1[2]}, sn[4] = {t0[1], t0[3], t1[1], t1[3]};
#pragma unroll
              for (int j = 0; j < 4; ++j) { const float a_ = x0[j], b_ = x1[j]; x0[j] = a_ * cs[j] - b_ * sn[j]; x1[j] = a_ * sn[j] + b_ * cs[j]; }
            }
            if (cb < C_DK) { x0 *= 0.25503486f; x1 *= 0.25503486f; }
            else { float ss = 0.f;
#pragma unroll
              for (int j = 0; j < 4; ++j) ss += x0[j] * x0[j] + x1[j] * x1[j];
              ss += shx(ss, 16, lane_id_v()); ss += shx(ss, 32, lane_id_v()); kmx = fmaxf(kmx, ss); }
          }
          u32x2 w0, w1; w0.x = cvt_pk_bf16(x0[0], x0[1]); w0.y = cvt_pk_bf16(x0[2], x0[3]); w1.x = cvt_pk_bf16(x1[0], x1[1]); w1.y = cvt_pk_bf16(x1[2], x1[3]);
          bf16_t* p = PB + (size_t)r * NPB_ + cb + fq * 4;
          *(u32x2*)p = w0; *(u32x2*)(p + 16) = w1;
          __builtin_amdgcn_sched_barrier(0);
        }
      if (cb >= C_DK && cb < C_DV) {
#pragma unroll
        for (int o = 1; o < 16; o <<= 1) kmx = fmaxf(kmx, shx(kmx, o, lane_id_v()));
        if (lane_id_v() == 0) atomicMax(kmax + ((cb - C_DK) >> 5), __float_as_uint(kmx));
      }
    }
  }
};
template <class F> DI void ctx_gemm32(int WV, const bf16_t* A, int lda, const bf16_t* Bt, int K, int N, unsigned char* smem, F epi) {
  const int tid = ltid(), lane = tid & 63, wave = tid >> 6, r31 = lane & 31, h = lane >> 5;
  float* red = (float*)smem;
  const int ntn = N / 32, ntiles = 8 * ntn, kper = K / 8;
  for (int tile = lbid(); tile < ntiles; tile += lnb()) {
    const int tm = tile / ntn, tn = tile % ntn;
    f32x16 acc; for (int i = 0; i < 16; ++i) acc[i] = 0.f;
    const bf16_t* ap = A + (size_t)(tm * 32 + r31) * lda + wave * kper + 8 * h;
    const bf16_t* bp = Bt + (size_t)(tn * 32 + r31) * K + wave * kper + 8 * h;
    int kk = 0;
    for (; kk + 64 <= kper; kk += 64) {
      bf16x8 av[4], bv[4];
#pragma unroll
      for (int q = 0; q < 4; ++q) { av[q] = *(const bf16x8*)(ap + kk + 16 * q); bv[q] = *(const bf16x8*)(bp + kk + 16 * q); }
#pragma unroll
      for (int q = 0; q < 4; ++q) acc = MFMA32(av[q], bv[q], acc);
    }
    for (; kk < kper; kk += 16) { const bf16x8 av = *(const bf16x8*)(ap + kk), bv = *(const bf16x8*)(bp + kk); acc = MFMA32(av, bv, acc); }
#pragma unroll
    for (int i = 0; i < 16; ++i) red[(wave * 16 + i) * 64 + lane] = acc[i];
    __syncthreads();
#pragma unroll
    for (int q = 0; q < 2; ++q) {
      const int o = tid + q * 512, i = o >> 6, ln = o & 63; float s = 0.f;
#pragma unroll
      for (int w = 0; w < 8; ++w) s += red[(w * 16 + i) * 64 + ln];
      epi(tm * 32 + crow(i, ln >> 5), tn * 32 + (ln & 31), s);
    }
    __syncthreads();
  }
}

constexpr int FR_LD = 136;
DI void fourier_tables(int WV, unsigned char* smem) {
  bf16_t* Cw = (bf16_t*)smem; bf16_t* Sw = Cw + 128 * FR_LD;
  for (int e = ltid(); e < 128 * 128; e += 512) { const int a_ = e >> 7, b_ = e & 127; const float x = (float)((a_ * b_) & 127) * (1.0f / 64.0f); Cw[a_ * FR_LD + b_] = f2bf(cospif(x)); Sw[a_ * FR_LD + b_] = f2bf(sinpif(x)); }
}
DI void fourier_load(int WV, const bf16_t* src, size_t rs, size_t po, unsigned char* smem) {
  bf16_t* dA = (bf16_t*)smem + 2 * 128 * FR_LD;
#pragma unroll
  for (int i = 0; i < 4; ++i) {
    const int id = ltid() + 512 * i, seg = id & 7, part = (id >> 3) & 1, row = id >> 4;
    const bf16x8 v = *(const bf16x8*)(src + (size_t)row * rs + (size_t)part * po + seg * 8);
    bf16_t* d = dA + part * 64 * FR_LD + (seg * 8) * FR_LD + row;
#pragma unroll
    for (int e = 0; e < 8; ++e) d[e * FR_LD] = (bf16_t)v[e];
  }
}
DI void fourier_stage1(int WV, KArgs a, unsigned char* smem) {
  const int tid = ltid(), lane = tid & 63, wave = tid >> 6, r31 = lane & 31, h = lane >> 5, rb = wave & 3, cbk = wave >> 2;
  const bf16_t* PB = (const bf16_t*)(a->ws + WS_PB); bf16_t* V = (bf16_t*)(a->ws + WS_V);
  const bf16_t* Cw = (const bf16_t*)smem; const bf16_t* Sw = Cw + 128 * FR_LD; const bf16_t* dA = Sw + 128 * FR_LD; const bf16_t* dB = dA + 64 * FR_LD;
  for (int it = lbid(); it < 512; it += lnb()) {
    const int t2 = it >> 2, c0 = (it & 3) * 64;
    __syncthreads();
    fourier_load(WV, PB + (size_t)t2 * NPB_ + C_FA + c0, (size_t)128 * NPB_, (size_t)(C_FB - C_FA), smem);
    __syncthreads();
    f32x16 R, nI; for (int i = 0; i < 16; ++i) { R[i] = 0.f; nI[i] = 0.f; }
#pragma unroll
    for (int s = 0; s < 8; ++s) {
      const bf16x8 cw = *(const bf16x8*)(Cw + (32 * rb + r31) * FR_LD + 16 * s + 8 * h), sw = *(const bf16x8*)(Sw + (32 * rb + r31) * FR_LD + 16 * s + 8 * h);
      const bf16x8 af = *(const bf16x8*)(dA + (32 * cbk + r31) * FR_LD + 16 * s + 8 * h), bfv = *(const bf16x8*)(dB + (32 * cbk + r31) * FR_LD + 16 * s + 8 * h);
      bf16x8 nb; for (int e = 0; e < 8; ++e) nb[e] = (short)(bfv[e] ^ (short)0x8000);
      R = MFMA32(cw, af, R); R = MFMA32(sw, nb, R); nI = MFMA32(sw, af, nI); nI = MFMA32(cw, bfv, nI);
    }
    const int col = c0 + 32 * cbk + r31;
#pragma unroll
    for (int i = 0; i < 16; ++i) {
      const int k1 = 32 * rb + crow(i, h);
      const float x = (float)(k1 * t2) * (1.0f / 8192.0f); const float ct = cospif(x), st = sinpif(x);
      const float vre = R[i] * ct - nI[i] * st, vim = -nI[i] * ct - R[i] * st;
      bf16_t* vp = V + ((size_t)(k1 * 128 + t2) * 2) * 256 + col;
      vp[0] = f2bf(vre); vp[256] = f2bf(vim);
    }
  }
}
DI void fourier_stage2(int WV, KArgs a, unsigned char* smem) {
  const int tid = ltid(), lane = tid & 63, wave = tid >> 6, r31 = lane & 31, h = lane >> 5, rb = wave & 3, cbk = wave >> 2;
  const bf16_t* V = (const bf16_t*)(a->ws + WS_V); bf16_t* BR = (bf16_t*)(a->ws + WS_BR);
  const bf16_t* Cw = (const bf16_t*)smem; const bf16_t* Sw = Cw + 128 * FR_LD; const bf16_t* dA = Sw + 128 * FR_LD; const bf16_t* dB = dA + 64 * FR_LD;
  for (int it = lbid(); it < 512; it += lnb()) {
    const int k1 = it >> 2, c0 = (it & 3) * 64;
    __syncthreads();
    fourier_load(WV, V + (size_t)k1 * 128 * 512 + c0, (size_t)512, (size_t)256, smem);
    __syncthreads();
    f32x16 Y; for (int i = 0; i < 16; ++i) Y[i] = 0.f;
#pragma unroll
    for (int s = 0; s < 8; ++s) {
      const bf16x8 cw = *(const bf16x8*)(Cw + (32 * rb + r31) * FR_LD + 16 * s + 8 * h), sw = *(const bf16x8*)(Sw + (32 * rb + r31) * FR_LD + 16 * s + 8 * h);
      const bf16x8 vr = *(const bf16x8*)(dA + (32 * cbk + r31) * FR_LD + 16 * s + 8 * h), vi = *(const bf16x8*)(dB + (32 * cbk + r31) * FR_LD + 16 * s + 8 * h);
      Y = MFMA32(cw, vr, Y); Y = MFMA32(sw, vi, Y);
    }
    const int col = c0 + 32 * cbk + r31;
#pragma unroll
    for (int i = 0; i < 16; ++i) { const int k2 = 32 * rb + crow(i, h); BR[(size_t)(k1 + 128 * k2) * 1024 + col] = f2bf(Y[i] * (1.0f / 1024.0f)); }
  }
}
DI void fourier_ctx(int WV, KArgs a) {
  const int tid = ltid();
  const bf16_t* PB = (const bf16_t*)(a->ws + WS_PB) + (size_t)L_ * NPB_; bf16_t* BR = (bf16_t*)(a->ws + WS_BR) + (size_t)L_ * 1024;
  for (int k = lbid(); k < 256; k += lnb()) {
    if (tid < 256) {
      float acc = 0.f;
      for (int t = 0; t < 256; ++t) {
        const float x = (float)((k * t) & 255) * (1.0f / 128.0f);
        acc += cospif(x) * bf2f(PB[(size_t)t * NPB_ + C_FA + tid]) - sinpif(x) * bf2f(PB[(size_t)t * NPB_ + C_FB + tid]);
      }
      BR[(size_t)k * 1024 + tid] = f2bf(acc * (1.0f / 128.0f));
    }
  }
}
DI int chunk_row0(int ci) { return ci < 128 ? ci * 128 : L_ + (ci - 128) * 128; }
DI void ret_states(int WV, KArgs a, int l, unsigned char* smem) {
  const int tid = ltid();
  const bf16_t* PB = (const bf16_t*)(a->ws + WS_PB); float* T = (float*)(a->ws + WS_T);
  const float* S = (const float*)(a->ws + WS_SCAL) + l * 64;
  float* kL = (float*)smem; float* vL = kL + 128 * 33; float* wf = vL + 128 * 64; float* wb = wf + 128;
  for (int it = lbid(); it < 130 * 6; it += lnb()) {
    const int ci = it / 6, hh = it % 6, r0 = chunk_row0(ci);
    __syncthreads();
    { const int row = tid >> 2, seg = tid & 3; const bf16x8 v = *(const bf16x8*)(PB + (size_t)(r0 + row) * NPB_ + C_RK + hh * 32 + seg * 8);
#pragma unroll
      for (int e = 0; e < 8; ++e) kL[row * 33 + seg * 8 + e] = bf2f((unsigned)(unsigned short)v[e]); }
#pragma unroll
    for (int q = 0; q < 2; ++q) { const int id = tid + 512 * q, row = id >> 3, seg = id & 7; const bf16x8 v = *(const bf16x8*)(PB + (size_t)(r0 + row) * NPB_ + C_RV + hh * 64 + seg * 8);
#pragma unroll
      for (int e = 0; e < 8; ++e) vL[row * 64 + seg * 8 + e] = bf2f((unsigned)(unsigned short)v[e]); }
    if (tid < 128) { wf[tid] = expf(S[4 + hh] * (float)(127 - tid)); wb[tid] = expf(S[10 + hh] * (float)tid); }
    __syncthreads();
    const int d = tid >> 4, v4 = (tid & 15) * 4;
    f32x4 af = {0.f, 0.f, 0.f, 0.f}, ab = {0.f, 0.f, 0.f, 0.f};
#pragma unroll 4
    for (int j = 0; j < 128; ++j) { const float kd = kL[j * 33 + d]; const f32x4 vv = *(const f32x4*)(vL + j * 64 + v4); af += vv * (kd * wf[j]); ab += vv * (kd * wb[j]); }
    float* tp = T + ((size_t)(ci * 6 + hh) * 2) * 2048 + d * 64 + v4;
    *(f32x4*)tp = af; *(f32x4*)(tp + 2048) = ab;
  }
}
DI void ret_scan(int WV, KArgs a, int l) {
  const int gt = lbid() * 512 + ltid();
  if (gt >= 6 * 2 * 2048) return;
  const int idx = gt & 2047, dir = (gt >> 11) & 1, hh = gt >> 12;
  const float* T = (const float*)(a->ws + WS_T); float* S = (float*)(a->ws + WS_S);
  const float* SC = (const float*)(a->ws + WS_SCAL) + l * 64;
  const float dec = expf(SC[4 + dir * 6 + hh] * 128.0f);
  const size_t base = (size_t)(hh * 2 + dir) * 2048 + idx; const size_t cs = (size_t)6 * 2 * 2048;
  const float tc0 = T[base + 128 * cs], tc1 = T[base + 129 * cs];
  if (dir == 0) {
    float s = tc0 * dec + tc1; S[base + 128 * cs] = 0.f; S[base + 129 * cs] = tc0;
#pragma unroll 8
    for (int i = 0; i < 128; ++i) { S[base + i * cs] = s; s = s * dec + T[base + i * cs]; }
  } else {
    float s = tc0 + dec * tc1; S[base + 129 * cs] = 0.f; S[base + 128 * cs] = tc1;
#pragma unroll 8
    for (int i = 127; i >= 0; --i) { S[base + i * cs] = s; s = s * dec + T[base + i * cs]; }
  }
}
DI void ret_out(int WV, KArgs a, int l, unsigned char* smem) {
  const int tid = ltid(), lane = tid & 63, wave = tid >> 6, r31 = lane & 31, h = lane >> 5, jb = wave & 3, vh = wave >> 2;
  const bf16_t* PB = (const bf16_t*)(a->ws + WS_PB); bf16_t* BR = (bf16_t*)(a->ws + WS_BR); const float* Sg = (const float*)(a->ws + WS_S);
  const float* SC = (const float*)(a->ws + WS_SCAL) + l * 64;
  bf16_t* Kl = (bf16_t*)smem;
  bf16_t* Vt = Kl + 128 * 40;
  bf16_t* SfT = Vt + 64 * 136;
  bf16_t* SbT = SfT + 64 * 40;
  float* pwf = (float*)(SbT + 64 * 40);
  float* pwb = pwf + 128;
  float* ssq = pwb + 128;
  for (int it = lbid(); it < 130 * 6; it += lnb()) {
    const int ci = it / 6, hh = it % 6, r0 = chunk_row0(ci);
    const float lgf = SC[4 + hh], lgb = SC[10 + hh];
    __syncthreads();
    { const int row = tid >> 2, seg = tid & 3; *(bf16x8*)(Kl + row * 40 + seg * 8) = *(const bf16x8*)(PB + (size_t)(r0 + row) * NPB_ + C_RK + hh * 32 + seg * 8); }
#pragma unroll
    for (int q = 0; q < 2; ++q) { const int id = tid + 512 * q, row = id >> 3, seg = id & 7; const bf16x8 v = *(const bf16x8*)(PB + (size_t)(r0 + row) * NPB_ + C_RV + hh * 64 + seg * 8);
#pragma unroll
      for (int e = 0; e < 8; ++e) Vt[(seg * 8 + e) * 136 + row] = (bf16_t)v[e]; }
#pragma unroll
    for (int q = 0; q < 8; ++q) { const int e = tid + 512 * q, dir = e >> 11, idx = e & 2047, d = idx >> 6, v = idx & 63;
      const float sv = Sg[((size_t)(ci * 6 + hh) * 2 + dir) * 2048 + idx]; (dir ? SbT : SfT)[v * 40 + d] = f2bf(sv); }
    if (tid < 128) { pwf[tid] = expf(lgf * (float)tid); pwb[tid] = expf(lgb * (float)tid); }
    const int qrow = r0 + 32 * jb + r31, j = 32 * jb + r31;
    bf16x8 qf[2];
#pragma unroll
    for (int s = 0; s < 2; ++s) qf[s] = *(const bf16x8*)(PB + (size_t)qrow * NPB_ + C_RQ + hh * 32 + 16 * s + 8 * h);
    __syncthreads();
    f32x16 O; for (int i = 0; i < 16; ++i) O[i] = 0.f;
#pragma unroll
    for (int kb = 0; kb < 4; ++kb) {
      f32x16 St; for (int i = 0; i < 16; ++i) St[i] = 0.f;
#pragma unroll
      for (int s = 0; s < 2; ++s) { const bf16x8 kf = *(const bf16x8*)(Kl + (32 * kb + r31) * 40 + 16 * s + 8 * h); St = MFMA32(kf, qf[s], St); }
#pragma unroll
      for (int i = 0; i < 16; ++i) { const int jp = 32 * kb + crow(i, h); const int dl = j - jp; const float dv = dl > 0 ? pwf[dl] : (dl < 0 ? pwb[-dl] : 2.0f); St[i] *= dv; }
#pragma unroll
      for (int s = 0; s < 2; ++s) {
        const bf16x8 pb = pack_step(St, s);
        const bf16_t* vp = Vt + (32 * vh + r31) * 136 + 32 * kb + 16 * s + 4 * h;
        const s16x4 lo = *(const s16x4*)vp, hi = *(const s16x4*)(vp + 8);
        const bf16x8 vf = __builtin_shufflevector(lo, hi, 0, 1, 2, 3, 4, 5, 6, 7);
        O = MFMA32(vf, pb, O);
      }
    }
    f32x16 Of, Ob; for (int i = 0; i < 16; ++i) { Of[i] = 0.f; Ob[i] = 0.f; }
#pragma unroll
    for (int s = 0; s < 2; ++s) {
      const bf16x8 sf = *(const bf16x8*)(SfT + (32 * vh + r31) * 40 + 16 * s + 8 * h), sb = *(const bf16x8*)(SbT + (32 * vh + r31) * 40 + 16 * s + 8 * h);
      Of = MFMA32(sf, qf[s], Of); Ob = MFMA32(sb, qf[s], Ob);
    }
    const float qdf = expf(lgf * (float)(j + 1)), qdb = expf(lgb * (float)(128 - j));
    float ss = 0.f;
#pragma unroll
    for (int i = 0; i < 16; ++i) { O[i] = O[i] + Of[i] * qdf + Ob[i] * qdb; ss += O[i] * O[i]; }
    ss += shx(ss, 32, lane_id_v());
    if (h == 0) ssq[vh * 128 + j] = ss;
    __syncthreads();
    const float rstd = rsqrtf((ssq[j] + ssq[128 + j]) * (1.0f / 64.0f) + EPS_);
#pragma unroll
    for (int g4 = 0; g4 < 4; ++g4) {
      const int v0 = 32 * vh + 8 * g4 + 4 * h;
      const u32x2 gw = *(const u32x2*)(PB + (size_t)qrow * NPB_ + C_RG + hh * 64 + v0);
      const float g0 = bf2f(gw.x & 0xffffu), g1 = bf2f(gw.x >> 16), g2 = bf2f(gw.y & 0xffffu), g3 = bf2f(gw.y >> 16);
      u32x2 w; w.x = cvt_pk_bf16(O[4 * g4] * rstd * g0, O[4 * g4 + 1] * rstd * g1); w.y = cvt_pk_bf16(O[4 * g4 + 2] * rstd * g2, O[4 * g4 + 3] * rstd * g3);
      *(u32x2*)(BR + (size_t)qrow * 1024 + 256 + hh * 64 + v0) = w;
    }
  }
}
constexpr int AT_LD = 72;
typedef __bf16 bf16x2_t __attribute__((ext_vector_type(2)));
typedef float f32x2_t __attribute__((ext_vector_type(2)));
DI unsigned cvt2(float a, float b) { f32x2_t v = {a, b}; return __builtin_bit_cast(unsigned, __builtin_convertvector(v, bf16x2_t)); }
template <int VAR> DI void attn_phase(int WV, KArgs a, int l, bool with_ctx, unsigned char* smem) {
  const int tid = ltid(), lane = tid & 63, wave = tid >> 6, r31 = lane & 31, h = lane >> 5, qsub = wave & 3, kh = wave >> 2;
  const bf16_t* PB = (const bf16_t*)(a->ws + WS_PB); bf16_t* BR = (bf16_t*)(a->ws + (VAR == 0 ? WS_BR : WS_H));
  const float* SC = (const float*)(a->ws + WS_SCAL) + l * 64;
  const float lam = SC[0], lam_init = SC[1];
  bf16_t* Ks = (bf16_t*)smem;
  bf16_t* Vt = Ks + 2 * 64 * AT_LD;
  float* cmb = (float*)(Vt + 2 * 64 * AT_LD);
  const int nitems = 6 * 128 + (with_ctx ? 12 : 0);
  const int skey = tid >> 3, sseg = tid & 7;
  for (int it = lbid(); it < nitems; it += lnb()) {
    int head, q0, krow0, nt;
    if (it < 768) { head = it >> 7; q0 = (it & 127) * 128; krow0 = 0; nt = MT_ / 64; }
    else { const int e = it - 768; head = e >> 1; q0 = L_ + (e & 1) * 128; krow0 = L_; nt = LC_ / 64; }
    const int qrow = q0 + 32 * qsub + r31;
    bf16x8 qf[2][2];
#pragma unroll
    for (int mp = 0; mp < 2; ++mp)
#pragma unroll
      for (int s = 0; s < 2; ++s) qf[mp][s] = *(const bf16x8*)(PB + (size_t)qrow * NPB_ + C_DQ + head * 64 + mp * 32 + 16 * s + 8 * h);
    float negm = 0.f;
#pragma unroll
    for (int mp = 0; mp < 2; ++mp) {
      float ss = 0.f;
#pragma unroll
      for (int s = 0; s < 2; ++s)
#pragma unroll
        for (int e = 0; e < 8; ++e) { const float x = bf2f((unsigned)(unsigned short)qf[mp][s][e]); ss += x * x; }
      ss += shx(ss, 32, lane_id_v());
      const float kmx = __uint_as_float(((const unsigned*)SC)[16 + head * 2 + mp]);
      negm = fminf(negm, -sqrtf(ss * kmx) * 1.01f);
    }
    f32x16 NM; for (int i = 0; i < 16; ++i) NM[i] = negm;
    f32x16 O1[2], O2[2]; for (int i = 0; i < 16; ++i) { O1[0][i] = 0.f; O1[1][i] = 0.f; O2[0][i] = 0.f; O2[1][i] = 0.f; }
    f32x16 LS; for (int i = 0; i < 16; ++i) LS[i] = 0.f;
    bf16x8 ones1, ones2; for (int e = 0; e < 8; ++e) { ones1[e] = (r31 < 16) ? (short)0x3F80 : (short)0; ones2[e] = (r31 < 16) ? (short)0 : (short)0x3F80; }
    const bf16_t* kg = PB + (size_t)(krow0 + skey) * NPB_ + C_DK + head * 64 + sseg * 8;
    const bf16_t* vg = PB + (size_t)(krow0 + skey) * NPB_ + C_DV + head * 64 + sseg * 8;
    const int vslot = ((skey & ~12) | ((skey & 4) << 1) | ((skey & 8) >> 1)) ^ (sseg << 3);
    __syncthreads();
    bf16x8 kA = *(const bf16x8*)kg, vA = *(const bf16x8*)vg;
    bf16x8 kB = *(const bf16x8*)(kg + (size_t)64 * NPB_), vB = *(const bf16x8*)(vg + (size_t)64 * NPB_);
    { *(bf16x8*)(Ks + skey * AT_LD + sseg * 8) = kA;
#pragma unroll
      for (int e = 0; e < 8; ++e) Vt[(sseg * 8 + e) * AT_LD + vslot] = (bf16_t)vA[e]; }
    __syncthreads();
    for (int t = 0; t < nt; ++t) {
      const int buf = t & 1;
      const bf16_t* ks = Ks + buf * 64 * AT_LD + (32 * kh + r31) * AT_LD + 8 * h;
      const bf16_t* vt = Vt + buf * 64 * AT_LD + r31 * AT_LD;
      const bf16x8 k00 = *(const bf16x8*)(ks), k01 = *(const bf16x8*)(ks + 16), k10 = *(const bf16x8*)(ks + 32), k11 = *(const bf16x8*)(ks + 48);
      bf16x8 vf[2][2];
#pragma unroll
      for (int s = 0; s < 2; ++s)
#pragma unroll
        for (int mt = 0; mt < 2; ++mt) vf[mt][s] = *(const bf16x8*)(vt + mt * 32 * AT_LD + (((4 * kh + 2 * s + h) ^ ((4 * mt + (r31 >> 3)) & 7)) << 3));
      f32x16 S1 = MFMA32(k00, qf[0][0], NM); f32x16 S2 = MFMA32(k10, qf[1][0], NM); S1 = MFMA32(k01, qf[0][1], S1); S2 = MFMA32(k11, qf[1][1], S2);
      bf16x8 p1[2], p2[2];
      { u32x4 w0, w1;
#pragma unroll
        for (int i = 0; i < 4; ++i) { w0[i] = cvt2(VAR == 1 ? S1[2 * i] * 0.001f : __builtin_amdgcn_exp2f(S1[2 * i]), VAR == 1 ? S1[2 * i + 1] * 0.001f : __builtin_amdgcn_exp2f(S1[2 * i + 1]));
                                       w1[i] = cvt2(VAR == 1 ? S1[8 + 2 * i] * 0.001f : __builtin_amdgcn_exp2f(S1[8 + 2 * i]), VAR == 1 ? S1[9 + 2 * i] * 0.001f : __builtin_amdgcn_exp2f(S1[9 + 2 * i])); }
        p1[0] = __builtin_bit_cast(bf16x8, w0); p1[1] = __builtin_bit_cast(bf16x8, w1); }
      O1[0] = MFMA32(vf[0][0], p1[0], O1[0]); O1[1] = MFMA32(vf[1][0], p1[0], O1[1]); LS = MFMA32(ones1, p1[0], LS);
      O1[0] = MFMA32(vf[0][1], p1[1], O1[0]); O1[1] = MFMA32(vf[1][1], p1[1], O1[1]); LS = MFMA32(ones1, p1[1], LS);
      { u32x4 w0, w1;
#pragma unroll
        for (int i = 0; i < 4; ++i) { w0[i] = cvt2(VAR == 1 ? S2[2 * i] * 0.001f : __builtin_amdgcn_exp2f(S2[2 * i]), VAR == 1 ? S2[2 * i + 1] * 0.001f : __builtin_amdgcn_exp2f(S2[2 * i + 1]));
                                       w1[i] = cvt2(VAR == 1 ? S2[8 + 2 * i] * 0.001f : __builtin_amdgcn_exp2f(S2[8 + 2 * i]), VAR == 1 ? S2[9 + 2 * i] * 0.001f : __builtin_amdgcn_exp2f(S2[9 + 2 * i])); }
        p2[0] = __builtin_bit_cast(bf16x8, w0); p2[1] = __builtin_bit_cast(bf16x8, w1); }
      if (VAR != 5) {
      O2[0] = MFMA32(vf[0][0], p2[0], O2[0]); O2[1] = MFMA32(vf[1][0], p2[0], O2[1]); LS = MFMA32(ones2, p2[0], LS);
      O2[0] = MFMA32(vf[0][1], p2[1], O2[0]); O2[1] = MFMA32(vf[1][1], p2[1], O2[1]); LS = MFMA32(ones2, p2[1], LS); }
      __builtin_amdgcn_sched_group_barrier(0x100, 8, 0);
      __builtin_amdgcn_sched_group_barrier(0x8, 4, 0);
      __builtin_amdgcn_sched_group_barrier(0x402, 24, 0);
#pragma unroll
      for (int i = 0; i < 6; ++i) { __builtin_amdgcn_sched_group_barrier(0x8, 1, 0); __builtin_amdgcn_sched_group_barrier(0x402, 4, 0); }
      __builtin_amdgcn_sched_group_barrier(0x8, 6, 0);
      if (t + 1 < nt) {
        const int nb_ = buf ^ 1;
        *(bf16x8*)(Ks + nb_ * 64 * AT_LD + skey * AT_LD + sseg * 8) = kB;
#pragma unroll
        for (int e = 0; e < 8; ++e) Vt[nb_ * 64 * AT_LD + (sseg * 8 + e) * AT_LD + vslot] = (bf16_t)vB[e];
      }
      if (t + 2 < nt) { kB = *(const bf16x8*)(kg + (size_t)(t + 2) * 64 * NPB_); vB = *(const bf16x8*)(vg + (size_t)(t + 2) * 64 * NPB_); }
      __syncthreads();
    }
    float* cw = cmb + (size_t)(qsub * 64 + lane) * 66;
    if (kh == 1) {
#pragma unroll
      for (int i = 0; i < 16; ++i) { cw[i] = O1[0][i]; cw[16 + i] = O1[1][i]; cw[32 + i] = O2[0][i]; cw[48 + i] = O2[1][i]; }
      cw[64] = LS[0]; cw[65] = LS[8];
    }
    __syncthreads();
    if (kh == 0) {
#pragma unroll
      for (int i = 0; i < 16; ++i) { O1[0][i] += cw[i]; O1[1][i] += cw[16 + i]; O2[0][i] += cw[32 + i]; O2[1][i] += cw[48 + i]; }
      const float l1 = LS[0] + cw[64], l2 = LS[8] + cw[65];
      const float i1 = 1.0f / l1, i2 = lam / l2;
      float ss = 0.f;
#pragma unroll
      for (int mt = 0; mt < 2; ++mt)
#pragma unroll
        for (int i = 0; i < 16; ++i) { const float o = O1[mt][i] * i1 - O2[mt][i] * i2; O1[mt][i] = o; ss += o * o; }
      ss += shx(ss, 32, lane_id_v());
      const float sc = rsqrtf(ss * (1.0f / 64.0f) + EPS_) * (1.0f - lam_init);
      const float* sw = a->in[13] + l * 64;
#pragma unroll
      for (int mt = 0; mt < 2; ++mt)
#pragma unroll
        for (int g4 = 0; g4 < 4; ++g4) {
          const int v0 = 32 * mt + 8 * g4 + 4 * h;
          const f32x4 wv = *(const f32x4*)(sw + v0);
          u32x2 w; w.x = cvt_pk_bf16(O1[mt][4 * g4] * sc * wv[0], O1[mt][4 * g4 + 1] * sc * wv[1]); w.y = cvt_pk_bf16(O1[mt][4 * g4 + 2] * sc * wv[2], O1[mt][4 * g4 + 3] * sc * wv[3]);
          *(u32x2*)(BR + (size_t)qrow * 1024 + 640 + head * 64 + v0) = w;
        }
    }
  }
}
template <class Epi> DI void run_gemm(int WV, LAS unsigned char* lds, const bf16_t* A, int lda, const bf16_t* Bt, int M, int N, int K, const Epi& E) {
  pg8::Gemm g; g.A = A; g.Bt = Bt; g.M = M; g.N = N; g.K = K; g.lda = lda;
  pg8::StaticOrder S; S.init(M, N, lnb(), lbid());
  pg8::gemm_phase<Epi, pg8::StaticOrder, false>(WV, lds, g, S, E, nullptr);
}
struct CtxMerge0 { float* MXC; const bf16_t* G; DI void operator()(int r, int c, float v) const { MXC[r * 1024 + c] = bf2f(G[(size_t)r * NGB_ + c]) * v; } };
struct CtxMerge1 { float* MXC; const bf16_t* G; DI void operator()(int r, int c, float v) const { MXC[r * 1024 + c] += bf2f(G[(size_t)r * NGB_ + c]) * v; } };
struct CtxMerge2 { const float* MXC; const bf16_t* G; bf16_t* Hc; DI void operator()(int r, int c, float v) const { Hc[r * 1024 + c] = f2bf(MXC[r * 1024 + c] + bf2f(G[(size_t)r * NGB_ + c]) * v); } };
struct CtxResid { float* Xc; const float* gate; float scale; DI void operator()(int r, int c, float v) const { Xc[r * 1024 + c] += scale * gate[c] * v; } };

DI void phase_win(int WV, int l, unsigned char* smem) {
  KArgs a = kargs(); unsigned char* ws = a->ws;
  EpiWin E; E.PB = (bf16_t*)(ws + WS_PB); E.GB = (bf16_t*)(ws + WS_GB); E.TRET = (const float*)(ws + WS_TRET); E.TROW = (const float*)(ws + WS_TROW); E.TCOL = (const float*)(ws + WS_TCOL);
  E.kmax = (unsigned*)(ws + WS_SCAL) + l * 64 + 16;
  run_gemm(WV, (LAS unsigned char*)smem, (const bf16_t*)(ws + WS_H), 1024, (const bf16_t*)(ws + WS_WIN) + (size_t)l * 5888 * 1024, MT_, NWIN_, 1024, E);
}
DI void phase_merge(int WV, int l, unsigned char* smem) {
  LAS unsigned char* lds = (LAS unsigned char*)smem;
  { KArgs a = kargs(); unsigned char* ws = a->ws; EpiMerge<0> E; E.MX = a->out; E.G = (const bf16_t*)(ws + WS_GB); E.Hout = (bf16_t*)(ws + WS_H);
    run_gemm(WV, lds, (const bf16_t*)(ws + WS_BR), 1024, (const bf16_t*)(ws + WS_WBF) + (size_t)l * 1024 * 256, L_, 1024, 256, E); }
  { KArgs a = kargs(); unsigned char* ws = a->ws; EpiMerge<1> E; E.MX = a->out; E.G = (const bf16_t*)(ws + WS_GB) + 1024; E.Hout = (bf16_t*)(ws + WS_H);
    run_gemm(WV, lds, (const bf16_t*)(ws + WS_BR) + 256, 1024, (const bf16_t*)(ws + WS_WBR) + (size_t)l * 1024 * 384, L_, 1024, 384, E); }
  { KArgs a = kargs(); unsigned char* ws = a->ws; EpiMerge<2> E; E.MX = a->out; E.G = (const bf16_t*)(ws + WS_GB) + 2048; E.Hout = (bf16_t*)(ws + WS_H);
    run_gemm(WV, lds, (const bf16_t*)(ws + WS_BR) + 640, 1024, (const bf16_t*)(ws + WS_WBD) + (size_t)l * 1024 * 384, L_, 1024, 384, E); }
  { KArgs a = kargs(); unsigned char* ws = a->ws;
    const bf16_t* BRc = (const bf16_t*)(ws + WS_BR) + (size_t)L_ * 1024; const bf16_t* GBc = (const bf16_t*)(ws + WS_GB) + (size_t)L_ * NGB_;
    CtxMerge0 e0; e0.MXC = (float*)(ws + WS_MXC); e0.G = GBc;
    ctx_gemm32(WV, BRc, 1024, (const bf16_t*)(ws + WS_WBF) + (size_t)l * 1024 * 256, 256, 1024, smem, e0);
    CtxMerge1 e1; e1.MXC = (float*)(ws + WS_MXC); e1.G = GBc + 1024;
    ctx_gemm32(WV, BRc + 256, 1024, (const bf16_t*)(ws + WS_WBR) + (size_t)l * 1024 * 384, 384, 1024, smem, e1);
    CtxMerge2 e2; e2.MXC = (const float*)(ws + WS_MXC); e2.G = GBc + 2048; e2.Hc = (bf16_t*)(ws + WS_H) + (size_t)L_ * 1024;
    ctx_gemm32(WV, BRc + 640, 1024, (const bf16_t*)(ws + WS_WBD) + (size_t)l * 1024 * 384, 384, 1024, smem, e2); }
}
DI void phase_wo(int WV, int l, unsigned char* smem) {
  { KArgs a = kargs(); unsigned char* ws = a->ws; EpiResid E; E.X = (float*)(ws + WS_X); E.gate = (const float*)(ws + WS_MOD) + (size_t)l * 9216 + 5 * 1024; E.scale = 1.0f;
    run_gemm(WV, (LAS unsigned char*)smem, (const bf16_t*)(ws + WS_H), 1024, (const bf16_t*)(ws + WS_WO) + (size_t)l * 1024 * 1024, L_, 1024, 1024, E); }
  { KArgs a = kargs(); unsigned char* ws = a->ws; CtxResid e; e.Xc = (float*)(ws + WS_X) + (size_t)L_ * 1024; e.gate = (const float*)(ws + WS_MOD) + (size_t)(4 + l) * 9216 + 5 * 1024; e.scale = 1.0f;
    ctx_gemm32(WV, (const bf16_t*)(ws + WS_H) + (size_t)L_ * 1024, 1024, (const bf16_t*)(ws + WS_WO) + (size_t)l * 1024 * 1024, 1024, 1024, smem, e); }
}
DI void phase_g1(int WV, int l, int f, unsigned char* smem) {
  KArgs a = kargs(); unsigned char* ws = a->ws; EpiSwiglu E; E.U = (bf16_t*)(ws + WS_U);
  run_gemm(WV, (LAS unsigned char*)smem, (const bf16_t*)(ws + WS_H), 1024, (const bf16_t*)(ws + WS_W13) + (size_t)(l * 2 + f) * 5632 * 1024, MT_, 5632, 1024, E);
}
DI void phase_g2(int WV, int l, int f, unsigned char* smem) {
  const int gi = f == 0 ? 2 : 8;
  { KArgs a = kargs(); unsigned char* ws = a->ws; EpiResid E; E.X = (float*)(ws + WS_X); E.gate = (const float*)(ws + WS_MOD) + (size_t)l * 9216 + gi * 1024; E.scale = 0.5f;
    run_gemm(WV, (LAS unsigned char*)smem, (const bf16_t*)(ws + WS_U), 2816, (const bf16_t*)(ws + WS_W2) + (size_t)(l * 2 + f) * 1024 * 2816, L_, 1024, 2816, E); }
  { KArgs a = kargs(); unsigned char* ws = a->ws; CtxResid e; e.Xc = (float*)(ws + WS_X) + (size_t)L_ * 1024; e.gate = (const float*)(ws + WS_MOD) + (size_t)(4 + l) * 9216 + gi * 1024; e.scale = 0.5f;
    ctx_gemm32(WV, (const bf16_t*)(ws + WS_U) + (size_t)L_ * 2816, 2816, (const bf16_t*)(ws + WS_W2) + (size_t)(l * 2 + f) * 1024 * 2816, 2816, 1024, smem, e); }
}

DI void grid_bar(int WV, unsigned& gen) {
  asm volatile("s_waitcnt vmcnt(0)" ::: "memory");
  __syncthreads();
  gen += 1;
  if (ltid() == 0) {
    unsigned* cnt = (unsigned*)(kargs()->ws + WS_BAR);
    __builtin_amdgcn_fence(__ATOMIC_RELEASE, "agent");
    asm volatile("s_waitcnt vmcnt(0)" ::: "memory");
    __hip_atomic_fetch_add(cnt, 1u, __ATOMIC_RELAXED, __HIP_MEMORY_SCOPE_AGENT);
    const unsigned target = gen * (unsigned)lnb();
    while (__hip_atomic_load(cnt, __ATOMIC_RELAXED, __HIP_MEMORY_SCOPE_AGENT) < target) __builtin_amdgcn_s_sleep(2);
    __builtin_amdgcn_fence(__ATOMIC_ACQUIRE, "agent");
    asm volatile("s_waitcnt vmcnt(0)" ::: "memory");
  }
  __syncthreads();
}

__global__ void __launch_bounds__(512, 2) mega(Args a_unused) {
  extern __shared__ __attribute__((aligned(16))) unsigned char smem[];
  cg::grid_group grid = cg::this_grid();
  const int WV = __builtin_amdgcn_readfirstlane((int)(threadIdx.x >> 6));
#ifndef NO_PRO
  prologue(WV, kargs(), smem);
#ifdef PROBE_PRO
  __syncthreads(); prologue(WV, kargs(), smem);
#endif
#endif
  grid.sync();
  unsigned gen = 0;
#pragma unroll 1
  for (int l = 0; l < DEPTH_; ++l) {
#pragma unroll 1
    for (int f = 0; f < 2; ++f) {
      if (f == 1) {
        norm_phase(WV, kargs(), l, 1, false);
        grid_bar(WV, gen);
        phase_win(WV, l, smem);
#ifdef PROBE_WIN
        phase_win(WV, l, smem);
#endif
        grid_bar(WV, gen);
#ifndef NO_MIXA
        fourier_tables(WV, smem); __syncthreads(); fourier_stage1(WV, kargs(), smem); fourier_ctx(WV, kargs()); __syncthreads(); ret_states(WV, kargs(), l, smem);
#ifdef PROBE_MIXA
        __syncthreads();
        fourier_tables(WV, smem); __syncthreads(); fourier_stage1(WV, kargs(), smem); fourier_ctx(WV, kargs()); __syncthreads(); ret_states(WV, kargs(), l, smem);
#endif
#endif
        grid_bar(WV, gen);
#ifndef NO_MIXB
        ret_scan(WV, kargs(), l); __syncthreads(); fourier_tables(WV, smem); __syncthreads(); fourier_stage2(WV, kargs(), smem);
#ifdef PROBE_MIXB
        __syncthreads();
        ret_scan(WV, kargs(), l); __syncthreads(); fourier_tables(WV, smem); __syncthreads(); fourier_stage2(WV, kargs(), smem);
#endif
#endif
        grid_bar(WV, gen);
#ifndef NO_RETOUT
        ret_out(WV, kargs(), l, smem); __syncthreads();
#ifdef PROBE_RET
        ret_out(WV, kargs(), l, smem); __syncthreads();
#endif
#endif
#ifndef NO_ATTN
        attn_phase<0>(WV, kargs(), l, l < DEPTH_ - 1, smem);
#ifdef PROBE_ATTN
        __syncthreads(); attn_phase<PROBE_ATTN>(WV, kargs(), l, l < DEPTH_ - 1, smem);
#endif
#endif
        grid_bar(WV, gen);
        phase_merge(WV, l, smem);
#ifdef PROBE_MERGE
        phase_merge(WV, l, smem);
#endif
        grid_bar(WV, gen);
        phase_wo(WV, l, smem);
        grid_bar(WV, gen);
      }
      norm_phase(WV, kargs(), l, f == 0 ? 0 : 2, l == 0 && f == 0);
      grid_bar(WV, gen);
      phase_g1(WV, l, f, smem);
#ifdef PROBE_G1
      phase_g1(WV, l, f, smem);
#endif
      grid_bar(WV, gen);
      phase_g2(WV, l, f, smem);
      grid_bar(WV, gen);
    }
  }
  final_norm(WV, kargs());
}

extern "C" void kernel_launch(void* const* d_in, const int* in_sizes, int n_in, void* d_out, int out_size, void* d_ws, size_t ws_size, hipStream_t stream) {
  static int grid = 0;
  if (grid == 0) {
    int dev = 0, cus = 0, per_cu = 0;
    (void)hipGetDevice(&dev); (void)hipDeviceGetAttribute(&cus, hipDeviceAttributeMultiprocessorCount, dev);
    if (hipFuncSetAttribute((const void*)mega, hipFuncAttributeMaxDynamicSharedMemorySize, LDS_BYTES) != hipSuccess) fprintf(stderr, "kernel_launch: hipFuncSetAttribute failed\n");
    if (hipOccupancyMaxActiveBlocksPerMultiprocessor(&per_cu, (const void*)mega, 512, LDS_BYTES) != hipSuccess || per_cu < 1) fprintf(stderr, "kernel_launch: occupancy query says %d blocks per CU\n", per_cu);
    (void)hipGetLastError();
    grid = cus > 0 ? cus : 256;
    if (ws_size < WS_END) { fprintf(stderr, "kernel_launch: workspace too small: %zu < %zu\n", ws_size, (size_t)WS_END); }
  }
  Args a{};
  for (int i = 0; i < 19; ++i) a.in[i] = (const float*)d_in[i];
  a.out = (float*)d_out; a.ws = (unsigned char*)d_ws;
  (void)hipMemsetAsync((unsigned char*)d_ws + WS_BAR, 0, 256, stream);
  void* args[] = {&a};
  hipError_t e = hipLaunchCooperativeKernel((const void*)mega, dim3(grid), dim3(512), args, LDS_BYTES, stream);
  if (e != hipSuccess) fprintf(stderr, "kernel_launch: cooperative launch failed: %s (grid %d)\n", hipGetErrorString(e), grid);
}
```

```cpp
#include <hip/hip_runtime.h>
#include <hip/hip_cooperative_groups.h>
#include <cstdio>
namespace cg = cooperative_groups;
__device__ __forceinline__ int lane_id_v() { int l; asm volatile("v_mbcnt_lo_u32_b32 %0, -1, 0\n\tv_mbcnt_hi_u32_b32 %0, -1, %0" : "=v"(l)); return l; }
#define ltid() ((WV << 6) | lane_id_v())
__device__ __forceinline__ float shx(float v, int m, int lane) { return __int_as_float(__builtin_amdgcn_ds_bpermute((lane ^ m) << 2, __float_as_int(v))); }
namespace pg8 {
#define PG8_LAS __attribute__((address_space(3)))
typedef unsigned short bf16_t;
typedef short bf16x8 __attribute__((ext_vector_type(8)));
typedef float f32x4 __attribute__((ext_vector_type(4)));
typedef unsigned u32x4 __attribute__((ext_vector_type(4)));
constexpr int BM = 256, BK = 64, HALF = 128, HTB = HALF * BK * 2  , STAGE_BYTES = 8 * HTB, NXCD = 8, WGM = 8;

__host__ __device__ __forceinline__ int lds_byte(int r, int c) { const int st = (r >> 4) * 2 + (c >> 5), rr = r & 15, cc = c & 31, ob = rr * 64 + cc * 2; return st * 1024 + (ob ^ (((ob >> 9) & 1) << 5)); }
__host__ __device__ __forceinline__ void stage_rc(int b, int& R, int& C) { const int st = b / 1024, sb = b % 1024, swz = sb ^ (((sb >> 9) & 1) << 5); R = (st >> 1) * 16 + swz / 64; C = (st & 1) * 32 + (swz % 64) / 2; }
__host__ __device__ __forceinline__ int perm32(int rho) { const int n = rho >> 4, i = rho & 15; return 8 * (i >> 2) + 4 * n + (i & 3); }

struct Unit { int pm, pn; };
struct Gemm { const bf16_t* A; const bf16_t* Bt; int M, N, K, lda; };

struct StaticOrder {
    int nM, nN, nwg, G, c;
    __host__ __device__ void init(int M, int N, int G_, int c_) { nM = M / BM; nN = N / BM; nwg = nM * nN; G = G_; c = c_; }
    __host__ __device__ bool next(int i, Unit& u) const {
        const long L = (long)i * G + c; if (L >= nwg) return false;
        int wgid = (int)L; { const int q = nwg / NXCD, r = nwg % NXCD, xcd = wgid % NXCD, off = wgid / NXCD; wgid = (xcd < r ? xcd * (q + 1) : r * (q + 1) + (xcd - r) * q) + off; }
        const int nig = WGM * nN, gid = wgid / nig, fm = gid * WGM, gsz = (nM - fm) < WGM ? (nM - fm) : WGM;
        u.pm = fm + ((wgid % nig) % gsz); u.pn = (wgid % nig) / gsz; return true;
    }
    __device__ __forceinline__ void a_ready(const Unit&) const {}
    __device__ __forceinline__ void done(const Unit&) const {}
};
__device__ __forceinline__ unsigned cvt_pk_bf16(float lo, float hi) { unsigned r; asm volatile("v_cvt_pk_bf16_f32 %0, %1, %2" : "=v"(r) : "v"(lo), "v"(hi)); return r; }
template <class Epi, class Sched, bool STAMP = false>
__device__ __forceinline__ void gemm_phase(const int WV, PG8_LAS unsigned char* lds, const Gemm g, const Sched& S, const Epi& E, unsigned long long* stamps) {
    const int tid = ltid(); const int wid = __builtin_amdgcn_readfirstlane(tid >> 6), lane = tid & 63, wr = wid >> 2, wc = wid & 3, fr = lane & 15, fq = lane >> 4;
    const int K = g.K, nt = K / BK;
    int ts_lo = 0, ts_hi = 0, nts = 0; const unsigned long long rt_entry = STAMP ? (unsigned long long)wall_clock64() : 0ull;
#define PG8_STAMP() do { if (STAMP && wid == 0 && nts < 64) { const unsigned long long _c = (unsigned long long)clock64(); \
        ts_lo = (lane == nts) ? (int)(unsigned)_c : ts_lo; ts_hi = (lane == nts) ? (int)(unsigned)(_c >> 32) : ts_hi; ++nts; } } while (0)
    PG8_STAMP();
    unsigned voffA[2], voffB[2];
#pragma unroll
    for (int i = 0; i < 2; ++i) { int R, C; stage_rc(tid * 16 + i * 8192, R, C); const int Rb = Epi::PERM ? ((R & ~31) + perm32(R & 31)) : R;
        voffA[i] = (unsigned)(R * g.lda + C) * 2u; voffB[i] = (unsigned)(Rb * K + C) * 2u; }
    const size_t kstep = (size_t)(BK * 2);
    const size_t hstep = (size_t)HALF * K * 2;
    const size_t tstep = 2 * hstep; const size_t hstepA = (size_t)HALF * g.lda * 2; const size_t tstepA = 2 * hstepA;
    const unsigned ldsw = (unsigned)wid * 1024u;
    const int aoff = lds_byte(wr * 64 + fr, fq * 8), boff = lds_byte(wc * 32 + fr, fq * 8);
#define PG8_SA(b, h) (((b) * 2 + (h)) * HTB)
#define PG8_SB(b, h) ((4 + (b) * 2 + (h)) * HTB)
#define PG8_STAGE(bufoff, gbase, voff) do { _Pragma("unroll") for (int _i = 0; _i < 2; ++_i) \
        __builtin_amdgcn_global_load_lds((const unsigned*)((const char*)(gbase) + (voff)[_i]), (PG8_LAS unsigned*)(lds + (bufoff) + ldsw + _i * 8192), 16, 0, 0); } while (0)
#define PG8_LDA(dst, b, h) do { _Pragma("unroll") for (int m = 0; m < 4; ++m) _Pragma("unroll") for (int k = 0; k < 2; ++k) dst[m][k] = *(const PG8_LAS bf16x8*)(lds + PG8_SA(b, h) + aoff + m * 2048 + k * 1024); } while (0)
#define PG8_LDB(dst, b, h) do { _Pragma("unroll") for (int n = 0; n < 2; ++n) _Pragma("unroll") for (int k = 0; k < 2; ++k) dst[n][k] = *(const PG8_LAS bf16x8*)(lds + PG8_SB(b, h) + boff + n * 2048 + k * 1024); } while (0)
#define PG8_MMA(ai, bj, At, Bt) do { __builtin_amdgcn_s_setprio(1); _Pragma("unroll") for (int m = 0; m < 4; ++m) _Pragma("unroll") for (int n = 0; n < 2; ++n) _Pragma("unroll") for (int k = 0; k < 2; ++k) \
        acc[ai][bj][m][n] = __builtin_amdgcn_mfma_f32_16x16x32_bf16(Bt[n][k], At[m][k], acc[ai][bj][m][n], 0, 0, 0); __builtin_amdgcn_s_setprio(0); } while (0)
#define PG8_WAIT_V(n) asm volatile("s_waitcnt vmcnt(" #n ")" ::: "memory")
#define PG8_WAIT_L(n) asm volatile("s_waitcnt lgkmcnt(" #n ")" ::: "memory")
#define PG8_BAR __builtin_amdgcn_s_barrier()
#define PG8_SCHED __builtin_amdgcn_sched_barrier(0)
    Unit cur, nxt; int ui = 0;
    if (!S.next(0, cur)) return;
    f32x4 acc[2][2][4][2];
#pragma unroll
    for (int a = 0; a < 2; ++a)
#pragma unroll
        for (int b = 0; b < 2; ++b)
#pragma unroll
            for (int m = 0; m < 4; ++m)
#pragma unroll
                for (int n = 0; n < 2; ++n) acc[a][b][m][n] = (f32x4){0.f, 0.f, 0.f, 0.f};
    bf16x8 At[4][2], B0[2][2], B1[2][2];
    const char* cA = (const char*)g.A + (size_t)cur.pm * tstepA; const char* cB = (const char*)g.Bt + (size_t)cur.pn * tstep;
    S.a_ready(cur);
    PG8_STAGE(PG8_SB(0, 0), cB, voffB); PG8_STAGE(PG8_SA(0, 0), cA, voffA); PG8_STAGE(PG8_SB(0, 1), cB + hstep, voffB); PG8_STAGE(PG8_SA(0, 1), cA + hstepA, voffA);
    if (wr == 1) PG8_BAR;
    PG8_WAIT_V(4); PG8_BAR;
    PG8_STAGE(PG8_SB(1, 0), cB + kstep, voffB); PG8_STAGE(PG8_SA(1, 0), cA + kstep, voffA); PG8_STAGE(PG8_SB(1, 1), cB + hstep + kstep, voffB);
    PG8_WAIT_V(6); PG8_BAR;
    PG8_STAMP();
    for (;;) {
        const bool has_next = S.next(ui + 1, nxt);
        const char* nA = has_next ? (const char*)g.A + (size_t)nxt.pm * tstepA : cA; const char* nB = has_next ? (const char*)g.Bt + (size_t)nxt.pn * tstep : cB;
        for (int t = 0; t < nt; t += 2) {
            const bool last = (t == nt - 2);
            const char* a1 = cA + (size_t)(t + 1) * kstep;
            const char* a2 = last ? nA : cA + (size_t)(t + 2) * kstep; const char* b2 = last ? nB : cB + (size_t)(t + 2) * kstep;
            const char* a3 = a2 + kstep; const char* b3 = b2 + kstep;
            if (last && has_next) S.a_ready(nxt);
            PG8_LDB(B0, 0, 0); PG8_SCHED; PG8_LDA(At, 0, 0); PG8_STAGE(PG8_SA(1, 1), a1 + hstepA, voffA);
            PG8_WAIT_L(8); PG8_BAR; PG8_WAIT_L(0); PG8_MMA(0, 0, At, B0); PG8_BAR; PG8_SCHED;
            PG8_LDB(B1, 0, 1); PG8_STAGE(PG8_SB(0, 0), b2, voffB);
            PG8_BAR; PG8_WAIT_L(0); PG8_MMA(0, 1, At, B1); PG8_BAR;
            PG8_LDA(At, 0, 1); PG8_STAGE(PG8_SA(0, 0), a2, voffA);
            PG8_BAR; PG8_WAIT_L(0); PG8_MMA(1, 0, At, B0); PG8_BAR; PG8_SCHED;
            PG8_STAGE(PG8_SB(0, 1), b2 + hstep, voffB);
            PG8_WAIT_V(6); PG8_BAR; PG8_MMA(1, 1, At, B1); PG8_BAR;
            PG8_LDB(B0, 1, 0); PG8_SCHED; PG8_LDA(At, 1, 0); PG8_STAGE(PG8_SA(0, 1), a2 + hstepA, voffA);
            PG8_WAIT_L(8); PG8_BAR; PG8_WAIT_L(0); PG8_MMA(0, 0, At, B0); PG8_BAR; PG8_SCHED;
            PG8_LDB(B1, 1, 1); PG8_STAGE(PG8_SB(1, 0), b3, voffB);
            PG8_BAR; PG8_WAIT_L(0); PG8_MMA(0, 1, At, B1); PG8_BAR;
            PG8_LDA(At, 1, 1); PG8_STAGE(PG8_SA(1, 0), a3, voffA);
            PG8_BAR; PG8_WAIT_L(0); PG8_MMA(1, 0, At, B0); PG8_BAR; PG8_SCHED;
            PG8_STAGE(PG8_SB(1, 1), b3 + hstep, voffB);
            PG8_WAIT_V(6); PG8_BAR; PG8_MMA(1, 1, At, B1); PG8_BAR;
        }
        PG8_STAMP();
        if constexpr (!Epi::AFTER_DRAIN) { E(acc, cur, wr, wc, fr, fq); S.done(cur); }
        PG8_STAMP();
        if (!has_next) break;
#pragma unroll
        for (int a = 0; a < 2; ++a)
#pragma unroll
            for (int b = 0; b < 2; ++b)
#pragma unroll
                for (int m = 0; m < 4; ++m)
#pragma unroll
                    for (int n = 0; n < 2; ++n) acc[a][b][m][n] = (f32x4){0.f, 0.f, 0.f, 0.f};
        cur = nxt; cA = nA; cB = nB; ++ui;
    }
    PG8_WAIT_V(0);
    if (wr == 0) PG8_BAR;
    PG8_BAR;
    if constexpr (Epi::AFTER_DRAIN) { E.fused(acc, cur, wr, wc, fr, fq, lds, wid, lane); S.done(cur); }
    PG8_STAMP();
    if (STAMP && wid == 0) { stamps[lane] = lane < nts ? (((unsigned long long)(unsigned)ts_hi << 32) | (unsigned)ts_lo) : 0ull;
        if (lane == 62) stamps[62] = rt_entry; if (lane == 63) stamps[63] = (unsigned long long)wall_clock64(); }
#undef PG8_STAMP
#undef PG8_SA
#undef PG8_SB
#undef PG8_STAGE
#undef PG8_LDA
#undef PG8_LDB
#undef PG8_MMA
#undef PG8_WAIT_V
#undef PG8_WAIT_L
#undef PG8_BAR
#undef PG8_SCHED
}
}
using pg8::bf16_t; using pg8::bf16x8; using pg8::f32x4; using pg8::u32x4; using pg8::cvt_pk_bf16;
typedef float f32x16 __attribute__((ext_vector_type(16)));
typedef short s16x4 __attribute__((ext_vector_type(4)));
typedef unsigned u32x2 __attribute__((ext_vector_type(2)));
#define DI __device__ __forceinline__
#define LAS __attribute__((address_space(3)))
#define MFMA32(a, b, c) __builtin_amdgcn_mfma_f32_32x32x16_bf16((a), (b), (c), 0, 0, 0)

constexpr int L_ = 16384, LC_ = 256, MT_ = 16640, D_ = 1024, DFF_ = 2816, DEPTH_ = 4;
constexpr int NWIN_ = 5888, NPB_ = 2816, NGB_ = 3072;
constexpr int C_FA = 0, C_FB = 256, C_RQ = 512, C_RK = 704, C_RV = 896, C_RG = 1280, C_DQ = 1664, C_DK = 2048, C_DV = 2432;
constexpr int LDS_BYTES = 147456;
constexpr float EPS_ = 1e-6f;

constexpr size_t al256(size_t x) { return (x + 255) & ~(size_t)255; }
constexpr size_t WS_W13 = 0;
constexpr size_t WS_W2  = WS_W13 + (size_t)4 * 2 * 5632 * 1024 * 2;
constexpr size_t WS_WIN = WS_W2 + (size_t)4 * 2 * 1024 * 2816 * 2;
constexpr size_t WS_WBF = WS_WIN + (size_t)4 * 5888 * 1024 * 2;
constexpr size_t WS_WBR = WS_WBF + (size_t)4 * 1024 * 256 * 2;
constexpr size_t WS_WBD = WS_WBR + (size_t)4 * 1024 * 384 * 2;
constexpr size_t WS_WO  = WS_WBD + (size_t)4 * 1024 * 384 * 2;
constexpr size_t WS_X   = WS_WO + (size_t)4 * 1024 * 1024 * 2;
constexpr size_t WS_H   = WS_X + (size_t)MT_ * 1024 * 4;
constexpr size_t WS_BR  = WS_H + (size_t)MT_ * 1024 * 2;
constexpr size_t WS_AL  = WS_BR + (size_t)MT_ * 1024 * 2;
constexpr size_t WS_U   = WS_AL;
constexpr size_t WS_PB  = WS_AL;
constexpr size_t WS_GB  = WS_AL + (size_t)MT_ * 2816 * 2;
constexpr size_t WS_V   = WS_GB + (size_t)MT_ * 3072 * 2;
constexpr size_t WS_T   = WS_V + (size_t)128 * 128 * 2 * 256 * 2;
constexpr size_t WS_S   = WS_T + (size_t)130 * 6 * 2 * 2048 * 4;
constexpr size_t WS_MXC = WS_S + (size_t)130 * 6 * 2 * 2048 * 4;
constexpr size_t WS_MOD = WS_MXC + (size_t)256 * 1024 * 4;
constexpr size_t WS_TRET = WS_MOD + (size_t)2 * 4 * 9216 * 4;
constexpr size_t WS_TROW = WS_TRET + (size_t)16384 * 16 * 2 * 4;
constexpr size_t WS_TCOL = WS_TROW + (size_t)256 * 8 * 2 * 4;
constexpr size_t WS_SCAL = WS_TCOL + (size_t)64 * 8 * 2 * 4;
constexpr size_t WS_BAR = WS_SCAL + 4 * 64 * 4;
constexpr size_t WS_END = WS_BAR + 256;

__device__ __forceinline__ int lbid() { int t = blockIdx.x; asm volatile("" : "+s"(t)); return t; }
__device__ __forceinline__ int lnb() { int t = gridDim.x; asm volatile("" : "+s"(t)); return t; }
struct Args { const float* in[19]; float* out; unsigned char* ws; };
typedef const Args __attribute__((address_space(4)))* KArgs;
__device__ __forceinline__ KArgs kargs() { KArgs p = (KArgs)__builtin_amdgcn_kernarg_segment_ptr(); asm volatile("" : "+s"(p)); return p; }

DI float bf2f(unsigned v) { return __uint_as_float(v << 16); }
DI bf16_t f2bf(float x) { return (bf16_t)(cvt_pk_bf16(x, 0.f) & 0xffffu); }
DI int crow(int reg, int h) { return (reg & 3) + 8 * (reg >> 2) + 4 * h; }
DI bf16x8 pack_step(const f32x16& x, int s) {
  u32x4 p;
  asm volatile("v_cvt_pk_bf16_f32 %0, %4, %5\n\tv_cvt_pk_bf16_f32 %1, %6, %7\n\tv_cvt_pk_bf16_f32 %2, %8, %9\n\tv_cvt_pk_bf16_f32 %3, %10, %11\n\ts_nop 1"
               : "=&v"(p[0]), "=&v"(p[1]), "=&v"(p[2]), "=&v"(p[3])
               : "v"(x[8 * s]), "v"(x[8 * s + 1]), "v"(x[8 * s + 2]), "v"(x[8 * s + 3]), "v"(x[8 * s + 4]), "v"(x[8 * s + 5]), "v"(x[8 * s + 6]), "v"(x[8 * s + 7]));
  return __builtin_bit_cast(bf16x8, p);
}
DI float silu_f(float a) { return a * __builtin_amdgcn_rcpf(1.0f + __expf(-a)); }
DI float sigmoid_f(float a) { return __builtin_amdgcn_rcpf(1.0f + __expf(-a)); }
DI float wave_sum(float v) {
  const int lane = lane_id_v();
#pragma unroll
  for (int o = 32; o > 0; o >>= 1) v += shx(v, o, lane);
  return v;
}
DI void sincos_acc(float xf, float& s, float& c) {
  const double x = (double)xf;
  const double k = rint(x * 0.63661977236758134308);
  double r = fma(-k, 1.57079632679489655800e+00, x); r = fma(-k, 6.12323399573676603587e-17, r);
  const double r2 = r * r;
  double sp = -1.0 / 39916800.0; sp = fma(sp, r2, 1.0 / 362880.0); sp = fma(sp, r2, -1.0 / 5040.0); sp = fma(sp, r2, 1.0 / 120.0); sp = fma(sp, r2, -1.0 / 6.0); sp = fma(sp * r2, r, r);
  double cp = 1.0 / 479001600.0; cp = fma(cp, r2, -1.0 / 3628800.0); cp = fma(cp, r2, 1.0 / 40320.0); cp = fma(cp, r2, -1.0 / 720.0); cp = fma(cp, r2, 1.0 / 24.0); cp = fma(cp, r2, -0.5); cp = fma(cp, r2, 1.0);
  const int q = ((int)(long long)k) & 3;
  const double sv = (q == 0) ? sp : (q == 1) ? cp : (q == 2) ? -sp : -cp;
  const double cv = (q == 0) ? cp : (q == 1) ? -sp : (q == 2) ? -cp : sp;
  s = (float)sv; c = (float)cv;
}
__constant__ float INV16[16] = {1.0f, 0.5623413324356079f, 0.3162277638912201f, 0.17782793939113617f, 0.10000000149011612f, 0.05623413249850273f, 0.03162277489900589f, 0.017782794311642647f,
                             0.009999999776482582f, 0.005623413249850273f, 0.003162277629598975f, 0.0017782794311642647f, 0.0010000000474974513f, 0.000562341301701963f, 0.0003162277571391314f, 0.00017782794020604342f};
struct ConvJob { const float* src; const float* src2; bf16_t* dst; int N, K, ld, kind; };
DI ConvJob conv_job(KArgs a, int j) {
  const int l = j / 9, kd = j % 9; ConvJob J; J.src2 = nullptr; J.kind = 0;
  unsigned char* ws = a->ws;
  switch (kd) {
    case 0: case 1: { const int f = kd; J.src = a->in[7] + (size_t)(l * 2 + f) * 1024 * 2816; J.src2 = a->in[8] + (size_t)(l * 2 + f) * 1024 * 2816; J.dst = (bf16_t*)(ws + WS_W13) + (size_t)(l * 2 + f) * 5632 * 1024; J.N = 5632; J.K = 1024; J.ld = 2816; J.kind = 1; break; }
    case 2: case 3: { const int f = kd - 2; J.src = a->in[9] + (size_t)(l * 2 + f) * 2816 * 1024; J.dst = (bf16_t*)(ws + WS_W2) + (size_t)(l * 2 + f) * 1024 * 2816; J.N = 1024; J.K = 2816; J.ld = 1024; break; }
    case 4: { J.src = a->in[10] + (size_t)l * 1024 * 5632; J.dst = (bf16_t*)(ws + WS_WIN) + (size_t)l * 5888 * 1024; J.N = 5888; J.K = 1024; J.ld = 5632; J.kind = 2; break; }
    case 5: { J.src = a->in[14] + (size_t)l * 256 * 1024; J.dst = (bf16_t*)(ws + WS_WBF) + (size_t)l * 1024 * 256; J.N = 1024; J.K = 256; J.ld = 1024; break; }
    case 6: { J.src = a->in[15] + (size_t)l * 384 * 1024; J.dst = (bf16_t*)(ws + WS_WBR) + (size_t)l * 1024 * 384; J.N = 1024; J.K = 384; J.ld = 1024; break; }
    case 7: { J.src = a->in[16] + (size_t)l * 384 * 1024; J.dst = (bf16_t*)(ws + WS_WBD) + (size_t)l * 1024 * 384; J.N = 1024; J.K = 384; J.ld = 1024; break; }
    default: { J.src = a->in[17] + (size_t)l * 1024 * 1024; J.dst = (bf16_t*)(ws + WS_WO) + (size_t)l * 1024 * 1024; J.N = 1024; J.K = 1024; J.ld = 1024; break; }
  }
  return J;
}
DI int axial_perm(int s) { return s < 8 ? s : (s < 16 ? s + 8 : (s < 24 ? s - 8 : s)); }

DI void prologue(int WV, KArgs a, unsigned char* smem) {
  const int tid = ltid(), nb = lnb(), bid = lbid();
  float* t = (float*)smem;
  float* tr = t + 64 * 65;
  {
    constexpr int tiles_per_layer = 1408 * 2 + 704 * 2 + 1472 + 64 + 96 + 96 + 256;
    const int nn = tid & 63, kq = tid >> 6;
#pragma unroll 1
    for (int g = bid; g < 4 * tiles_per_layer; g += nb) {
      const int l = g / tiles_per_layer; int rem = g % tiles_per_layer; int kd;
      if (rem < 1408) kd = 0; else if (rem < 2816) { kd = 1; rem -= 1408; } else if (rem < 3520) { kd = 2; rem -= 2816; } else if (rem < 4224) { kd = 3; rem -= 3520; }
      else if (rem < 5696) { kd = 4; rem -= 4224; } else if (rem < 5760) { kd = 5; rem -= 5696; } else if (rem < 5856) { kd = 6; rem -= 5760; } else if (rem < 5952) { kd = 7; rem -= 5856; } else { kd = 8; rem -= 5952; }
      const ConvJob J = conv_job(a, l * 9 + kd);
      const int nkt = J.K / 64; const int n0 = (rem / nkt) * 64, k0 = (rem % nkt) * 64;
      const bool fold = (J.kind == 2) && (n0 < 512);
      const float* sp = J.src; int col = n0 + nn;
      if (J.kind == 1) { const int n = n0 + nn, gi = n >> 5, s = n & 31; sp = (s < 16) ? J.src : J.src2; col = 16 * gi + (s & 15); }
      else if (J.kind == 2) {
        const int n = n0 + nn;
        if (fold) col = (n0 & 192) + nn;
        else { col = n - 256; if (n >= C_DQ && n < C_DV) { const int s = n & 31; col = (n - 256 - s) + axial_perm(s); } }
      }
      const float* cp = sp + (size_t)(k0 + kq) * J.ld + col;
      float lv[8];
#pragma unroll
      for (int i = 0; i < 8; ++i) lv[i] = cp[(size_t)(8 * i) * J.ld];
#pragma unroll
      for (int i = 0; i < 8; ++i) t[nn * 65 + kq + 8 * i] = lv[i];
      if (fold && tid < 64) { const float ang = (float)tid * (1.0f / 32.0f); tr[tid] = (n0 >= 256) ? sinpif(ang) : cospif(ang); }
      __syncthreads();
      if (!fold) {
#pragma unroll
        for (int i = 0; i < 4; ++i) {
          const int e = tid + i * 512, n2 = e >> 5, kp = (e & 31) * 2;
          *(unsigned*)(J.dst + (size_t)(n0 + n2) * J.K + k0 + kp) = cvt_pk_bf16(t[n2 * 65 + kp], t[n2 * 65 + kp + 1]);
        }
      } else {
#pragma unroll 1
        for (int i = 0; i < 8; ++i) {
          const int m = kq + 8 * i, kk = nn;
          float acc = 0.f;
#pragma unroll 8
          for (int c = 0; c < 64; ++c) acc += t[c * 65 + kk] * tr[(m * c) & 63];
          J.dst[(size_t)(n0 + m) * J.K + k0 + kk] = f2bf(acc);
        }
      }
      __syncthreads();
    }
  }
  {
    float* sc = (float*)smem; float* scc = sc + 1024; float* red = scc + 1024;
    __syncthreads();
    for (int i = tid; i < 1024; i += 512) { sc[i] = silu_f(a->in[1][i]); scc[i] = silu_f(a->in[3][i]); }
    __syncthreads();
    float* MOD = (float*)(a->ws + WS_MOD);
    for (int it = bid; it < 4 * 72; it += nb) {
      const int l = it / 72, cb = it % 72;
      const int cgp = tid & 31, ks = tid >> 5;
      const float* wp = a->in[4] + ((size_t)l * 1024 + ks * 64) * 9216 + cb * 128 + cgp * 4;
      f32x4 am = {0.f, 0.f, 0.f, 0.f}, ac = {0.f, 0.f, 0.f, 0.f};
#pragma unroll 8
      for (int k = 0; k < 64; ++k) { const f32x4 w = *(const f32x4*)(wp + (size_t)k * 9216); am += w * sc[ks * 64 + k]; ac += w * scc[ks * 64 + k]; }
#pragma unroll
      for (int j = 0; j < 4; ++j) { red[(ks * 128 + cgp * 4 + j) * 2] = am[j]; red[(ks * 128 + cgp * 4 + j) * 2 + 1] = ac[j]; }
      __syncthreads();
      if (tid < 256) {
        const int col = tid >> 1, which = tid & 1; float s = 0.f;
#pragma unroll
        for (int q = 0; q < 16; ++q) s += red[(q * 128 + col) * 2 + which];
        const int gc = cb * 128 + col;
        MOD[(size_t)(which * 4 + l) * 9216 + gc] = s + a->in[5][(size_t)l * 9216 + gc];
      }
      __syncthreads();
    }
  }
  {
    float* TRET = (float*)(a->ws + WS_TRET); float* TROW = (float*)(a->ws + WS_TROW); float* TCOL = (float*)(a->ws + WS_TCOL);
    const int gt = bid * 512 + tid, gn = nb * 512;
    for (int e = gt; e < 16384 * 16; e += gn) { const int p = e >> 4, i = e & 15; float s, c; sincos_acc((float)p * INV16[i], s, c); TRET[2 * e] = c; TRET[2 * e + 1] = s; }
    for (int e = gt; e < 256 * 8; e += gn) { const int p = e >> 3, i = e & 7; float s, c; sincos_acc((float)p * INV16[2 * i], s, c); TROW[2 * e] = c; TROW[2 * e + 1] = s; }
    for (int e = gt; e < 64 * 8; e += gn) { const int p = e >> 3, i = e & 7; float s, c; sincos_acc((float)p * INV16[2 * i], s, c); TCOL[2 * e] = c; TCOL[2 * e + 1] = s; }
    if (bid == 0 && tid < 4) {
      const int l = tid; float* S = (float*)(a->ws + WS_SCAL) + l * 64;
      const float* lv = a->in[12] + l * 128; float d01 = 0.f, d23 = 0.f;
      for (int i = 0; i < 32; ++i) { d01 += lv[i] * lv[32 + i]; d23 += lv[64 + i] * lv[96 + i]; }
      const float lam_init = 0.8f - 0.6f * expf(-0.3f * (float)l);
      S[0] = expf(d01) - expf(d23) + lam_init; S[1] = lam_init;
      for (int i = 0; i < 12; ++i) { const float x = a->in[11][l * 12 + i]; S[4 + i] = -log1pf(expf(-x)); }
      for (int i = 0; i < 12; ++i) ((unsigned*)S)[16 + i] = 0u;
    }
  }
}
DI void norm_phase(int WV, KArgs a, int l, int which, bool first) {
  const int tid = ltid(), lane = tid & 63, wave = tid >> 6;
  const float* g = a->in[6] + (size_t)(l * 3 + which) * 1024;
  const float* mod = (const float*)(a->ws + WS_MOD) + (size_t)l * 9216;
  const float* modc = (const float*)(a->ws + WS_MOD) + (size_t)(4 + l) * 9216;
  float* X = (float*)(a->ws + WS_X); bf16_t* H = (bf16_t*)(a->ws + WS_H);
  for (int r = lbid() * 8 + wave; r < MT_; r += lnb() * 8) {
    const float* src = first ? (r < L_ ? a->in[0] + (size_t)r * 1024 : a->in[2] + (size_t)(r - L_) * 1024) : X + (size_t)r * 1024;
    f32x4 v[4]; float ss = 0.f;
#pragma unroll
    for (int i = 0; i < 4; ++i) { v[i] = *(const f32x4*)(src + i * 256 + lane * 4); ss += v[i][0] * v[i][0] + v[i][1] * v[i][1] + v[i][2] * v[i][2] + v[i][3] * v[i][3]; }
    ss = wave_sum(ss);
    const float rstd = rsqrtf(ss * (1.0f / 1024.0f) + EPS_);
    const float* mm = (r < L_) ? mod : modc;
#pragma unroll
    for (int i = 0; i < 4; ++i) {
      const int c = i * 256 + lane * 4;
      const f32x4 gg = *(const f32x4*)(g + c), sh = *(const f32x4*)(mm + (which * 3) * 1024 + c), sc = *(const f32x4*)(mm + (which * 3 + 1) * 1024 + c);
      f32x4 y;
#pragma unroll
      for (int j = 0; j < 4; ++j) y[j] = v[i][j] * rstd * gg[j] * (1.0f + sc[j]) + sh[j];
      u32x2 w; w.x = cvt_pk_bf16(y[0], y[1]); w.y = cvt_pk_bf16(y[2], y[3]);
      *(u32x2*)(H + (size_t)r * 1024 + c) = w;
      if (first) *(f32x4*)(X + (size_t)r * 1024 + c) = v[i];
    }
  }
}
DI void final_norm(int WV, KArgs a) {
  const int tid = ltid(), lane = tid & 63, wave = tid >> 6;
  const float* g = a->in[18]; const float* X = (const float*)(a->ws + WS_X);
  for (int r = lbid() * 8 + wave; r < L_; r += lnb() * 8) {
    f32x4 v[4]; float ss = 0.f;
#pragma unroll
    for (int i = 0; i < 4; ++i) { v[i] = *(const f32x4*)(X + (size_t)r * 1024 + i * 256 + lane * 4); ss += v[i][0] * v[i][0] + v[i][1] * v[i][1] + v[i][2] * v[i][2] + v[i][3] * v[i][3]; }
    ss = wave_sum(ss);
    const float rstd = rsqrtf(ss * (1.0f / 1024.0f) + EPS_);
#pragma unroll
    for (int i = 0; i < 4; ++i) { const int c = i * 256 + lane * 4; const f32x4 gg = *(const f32x4*)(g + c); f32x4 y; for (int j = 0; j < 4; ++j) y[j] = v[i][j] * rstd * gg[j]; *(f32x4*)(a->out + (size_t)r * 1024 + c) = y; }
  }
}

using pg8::Unit; using pg8::HALF; using pg8::BM;
struct EpiSwiglu {
  static constexpr bool PERM = false, AFTER_DRAIN = false;
  bf16_t* U;
  DI void operator()(const f32x4 (&acc)[2][2][4][2], const Unit& u, int wr, int wc, int fr_, int fq_) const {
    const int ln_ = lane_id_v(), fr = ln_ & 15, fq = ln_ >> 4;
#pragma unroll
    for (int ai = 0; ai < 2; ++ai)
#pragma unroll
      for (int m = 0; m < 4; ++m) {
        const int r = u.pm * BM + ai * HALF + wr * 64 + m * 16 + fr;
#pragma unroll
        for (int bj = 0; bj < 2; ++bj) {
          const int gi = u.pn * 8 + bj * 4 + wc;
          const f32x4 x = acc[ai][bj][m][0], y = acc[ai][bj][m][1];
          u32x2 w; w.x = cvt_pk_bf16(silu_f(x[0]) * y[0], silu_f(x[1]) * y[1]); w.y = cvt_pk_bf16(silu_f(x[2]) * y[2], silu_f(x[3]) * y[3]);
          *(u32x2*)(U + (size_t)r * DFF_ + gi * 16 + fq * 4) = w;
        }
        __builtin_amdgcn_sched_barrier(0);
      }
  }
};
struct EpiResid {
  static constexpr bool PERM = false, AFTER_DRAIN = false;
  float* X; const float* gate; float scale;
  DI void operator()(const f32x4 (&acc)[2][2][4][2], const Unit& u, int wr, int wc, int fr_, int fq_) const {
    const int ln_ = lane_id_v(), fr = ln_ & 15, fq = ln_ >> 4;
#pragma unroll
    for (int bj = 0; bj < 2; ++bj)
#pragma unroll
      for (int n = 0; n < 2; ++n) {
        const int c = u.pn * BM + bj * HALF + wc * 32 + n * 16 + fq * 4;
        const f32x4 gv = *(const f32x4*)(gate + c) * scale;
#pragma unroll
        for (int ai = 0; ai < 2; ++ai)
#pragma unroll
          for (int m = 0; m < 4; ++m) {
            const int r = u.pm * BM + ai * HALF + wr * 64 + m * 16 + fr;
            float* p = X + (size_t)r * 1024 + c;
            *(f32x4*)p = *(const f32x4*)p + gv * acc[ai][bj][m][n];
          }
      }
  }
};
template <int STEP> struct EpiMerge {
  static constexpr bool PERM = false, AFTER_DRAIN = false;
  float* MX; const bf16_t* G; bf16_t* Hout;
  DI void operator()(const f32x4 (&acc)[2][2][4][2], const Unit& u, int wr, int wc, int fr_, int fq_) const {
    const int ln_ = lane_id_v(), fr = ln_ & 15, fq = ln_ >> 4;
#pragma unroll
    for (int ai = 0; ai < 2; ++ai)
#pragma unroll
      for (int bj = 0; bj < 2; ++bj)
#pragma unroll
        for (int n = 0; n < 2; ++n) {
          const int c = u.pn * BM + bj * HALF + wc * 32 + n * 16 + fq * 4;
          const int r0 = u.pm * BM + ai * HALF + wr * 64 + fr;
          u32x2 gw[4]; f32x4 old[4];
#pragma unroll
          for (int m = 0; m < 4; ++m) {
            gw[m] = *(const u32x2*)(G + (size_t)(r0 + m * 16) * NGB_ + c);
            if (STEP > 0) old[m] = *(const f32x4*)(MX + (size_t)(r0 + m * 16) * 1024 + c);
          }
#pragma unroll
          for (int m = 0; m < 4; ++m) {
            f32x4 gv; gv[0] = bf2f(gw[m].x & 0xffffu); gv[1] = bf2f(gw[m].x >> 16); gv[2] = bf2f(gw[m].y & 0xffffu); gv[3] = bf2f(gw[m].y >> 16);
            f32x4 v = gv * acc[ai][bj][m][n];
            if (STEP > 0) v += old[m];
            if (STEP < 2) *(f32x4*)(MX + (size_t)(r0 + m * 16) * 1024 + c) = v;
            else { u32x2 w; w.x = cvt_pk_bf16(v[0], v[1]); w.y = cvt_pk_bf16(v[2], v[3]); *(u32x2*)(Hout + (size_t)(r0 + m * 16) * 1024 + c) = w; }
          }
          __builtin_amdgcn_sched_barrier(0);
        }
  }
};
struct EpiWin {
  static constexpr bool PERM = false, AFTER_DRAIN = false;
  bf16_t* PB; bf16_t* GB; const float* TRET; const float* TROW; const float* TCOL; unsigned* kmax;
  DI void operator()(const f32x4 (&acc)[2][2][4][2], const Unit& u, int wr, int wc, int fr_, int fq_) const {
    const int ln_ = lane_id_v(), fr = ln_ & 15, fq = ln_ >> 4;
#pragma unroll
    for (int bj = 0; bj < 2; ++bj) {
      const int cb = u.pn * BM + bj * HALF + wc * 32;
      float kmx = 0.f;
#pragma unroll
      for (int ai = 0; ai < 2; ++ai)
#pragma unroll
        for (int m = 0; m < 4; ++m) {
          const int r = u.pm * BM + ai * HALF + wr * 64 + m * 16 + fr;
          f32x4 x0 = acc[ai][bj][m][0], x1 = acc[ai][bj][m][1];
          if (cb >= NPB_) {
#pragma unroll
            for (int j = 0; j < 4; ++j) { x0[j] = sigmoid_f(x0[j]); x1[j] = sigmoid_f(x1[j]); }
            u32x2 w0, w1; w0.x = cvt_pk_bf16(x0[0], x0[1]); w0.y = cvt_pk_bf16(x0[2], x0[3]); w1.x = cvt_pk_bf16(x1[0], x1[1]); w1.y = cvt_pk_bf16(x1[2], x1[3]);
            bf16_t* p = GB + (size_t)r * NGB_ + (cb - NPB_) + fq * 4;
            *(u32x2*)p = w0; *(u32x2*)(p + 16) = w1;
            __builtin_amdgcn_sched_barrier(0);
            continue;
          }
          if (cb >= C_RQ && cb < C_RV) {
            if (r < L_) {
              const f32x4* tp = (const f32x4*)(TRET + ((size_t)r * 16 + fq * 4) * 2);
              const f32x4 t0 = tp[0], t1 = tp[1];
              const float cs[4] = {t0[0], t0[2], t1[0], t1[2]}, sn[4] = {t0[1], t0[3], t1[1], t1[3]};
#pragma unroll
              for (int j = 0; j < 4; ++j) { const float a_ = x0[j], b_ = x1[j]; x0[j] = a_ * cs[j] - b_ * sn[j]; x1[j] = a_ * sn[j] + b_ * cs[j]; }
            }
            if (cb >= C_RK) { x0 *= 0.17677669529663687f; x1 *= 0.17677669529663687f; }
          } else if (cb >= C_RG && cb < C_DQ) {
#pragma unroll
            for (int j = 0; j < 4; ++j) { x0[j] = silu_f(x0[j]); x1[j] = silu_f(x1[j]); }
          } else if (cb >= C_DQ && cb < C_DV) {
            if (r < L_) {
              const float* tb = (fq < 2) ? (TROW + ((size_t)(r >> 6) * 8 + fq * 4) * 2) : (TCOL + ((size_t)(r & 63) * 8 + (fq - 2) * 4) * 2);
              const f32x4 t0 = ((const f32x4*)tb)[0], t1 = ((const f32x4*)tb)[1];
              const float cs[4] = {t0[0], t0[2], t1[0], t1[2]}, sn[4] = {t0[1], t0[3], t1[1], t1[3]};
#pragma unroll
              for (int j = 0; j < 4; ++j) { const float a_ = x0[j], b_ = x1[j]; x0[j] = a_ * cs[j] - b_ * sn[j]; x1[j] = a_ * sn[j] + b_ * cs[j]; }
            }
            if (cb < C_DK) { x0 *= 0.25503486f; x1 *= 0.25503486f; }
            else { float ss = 0.f;
#pragma unroll
              for (int j = 0; j < 4; ++j) ss += x0[j] * x0[j] + x1[j] * x1[j];
              ss += shx(ss, 16, lane_id_v()); ss += shx(ss, 32, lane_id_v()); kmx = fmaxf(kmx, ss); }
          }
          u32x2 w0, w1; w0.x = cvt_pk_bf16(x0[0], x0[1]); w0.y = cvt_pk_bf16(x0[2], x0[3]); w1.x = cvt_pk_bf16(x1[0], x1[1]); w1.y = cvt_pk_bf16(x1[2], x1[3]);
          bf16_t* p = PB + (size_t)r * NPB_ + cb + fq * 4;
          *(u32x2*)p = w0; *(u32x2*)(p + 16) = w1;
          __builtin_amdgcn_sched_barrier(0);
        }
      if (cb >= C_DK && cb < C_DV) {
#pragma unroll
        for (int o = 1; o < 16; o <<= 1) kmx = fmaxf(kmx, shx(kmx, o, lane_id_v()));
        if (lane_id_v() == 0) atomicMax(kmax + ((cb - C_DK) >> 5), __float_as_uint(kmx));
      }
    }
  }
};
template <class F> DI void ctx_gemm32(int WV, const bf16_t* A, int lda, const bf16_t* Bt, int K, int N, unsigned char* smem, F epi) {
  const int tid = ltid(), lane = tid & 63, wave = tid >> 6, r31 = lane & 31, h = lane >> 5;
  float* red = (float*)smem;
  const int ntn = N / 32, ntiles = 8 * ntn, kper = K / 8;
  for (int tile = lbid(); tile < ntiles; tile += lnb()) {
    const int tm = tile / ntn, tn = tile % ntn;
    f32x16 acc; for (int i = 0; i < 16; ++i) acc[i] = 0.f;
    const bf16_t* ap = A + (size_t)(tm * 32 + r31) * lda + wave * kper + 8 * h;
    const bf16_t* bp = Bt + (size_t)(tn * 32 + r31) * K + wave * kper + 8 * h;
    int kk = 0;
    for (; kk + 64 <= kper; kk += 64) {
      bf16x8 av[4], bv[4];
#pragma unroll
      for (int q = 0; q < 4; ++q) { av[q] = *(const bf16x8*)(ap + kk + 16 * q); bv[q] = *(const bf16x8*)(bp + kk + 16 * q); }
#pragma unroll
      for (int q = 0; q < 4; ++q) acc = MFMA32(av[q], bv[q], acc);
    }
    for (; kk < kper; kk += 16) { const bf16x8 av = *(const bf16x8*)(ap + kk), bv = *(const bf16x8*)(bp + kk); acc = MFMA32(av, bv, acc); }
#pragma unroll
    for (int i = 0; i < 16; ++i) red[(wave * 16 + i) * 64 + lane] = acc[i];
    __syncthreads();
#pragma unroll
    for (int q = 0; q < 2; ++q) {
      const int o = tid + q * 512, i = o >> 6, ln = o & 63; float s = 0.f;
#pragma unroll
      for (int w = 0; w < 8; ++w) s += red[(w * 16 + i) * 64 + ln];
      epi(tm * 32 + crow(i, ln >> 5), tn * 32 + (ln & 31), s);
    }
    __syncthreads();
  }
}

constexpr int FR_LD = 136;
DI void fourier_tables(int WV, unsigned char* smem) {
  bf16_t* Cw = (bf16_t*)smem; bf16_t* Sw = Cw + 128 * FR_LD;
  for (int e = ltid(); e < 128 * 128; e += 512) { const int a_ = e >> 7, b_ = e & 127; const float x = (float)((a_ * b_) & 127) * (1.0f / 64.0f); Cw[a_ * FR_LD + b_] = f2bf(cospif(x)); Sw[a_ * FR_LD + b_] = f2bf(sinpif(x)); }
}
DI void fourier_load(int WV, const bf16_t* src, size_t rs, size_t po, unsigned char* smem) {
  bf16_t* dA = (bf16_t*)smem + 2 * 128 * FR_LD;
#pragma unroll
  for (int i = 0; i < 4; ++i) {
    const int id = ltid() + 512 * i, seg = id & 7, part = (id >> 3) & 1, row = id >> 4;
    const bf16x8 v = *(const bf16x8*)(src + (size_t)row * rs + (size_t)part * po + seg * 8);
    bf16_t* d = dA + part * 64 * FR_LD + (seg * 8) * FR_LD + row;
#pragma unroll
    for (int e = 0; e < 8; ++e) d[e * FR_LD] = (bf16_t)v[e];
  }
}
DI void fourier_stage1(int WV, KArgs a, unsigned char* smem) {
  const int tid = ltid(), lane = tid & 63, wave = tid >> 6, r31 = lane & 31, h = lane >> 5, rb = wave & 3, cbk = wave >> 2;
  const bf16_t* PB = (const bf16_t*)(a->ws + WS_PB); bf16_t* V = (bf16_t*)(a->ws + WS_V);
  const bf16_t* Cw = (const bf16_t*)smem; const bf16_t* Sw = Cw + 128 * FR_LD; const bf16_t* dA = Sw + 128 * FR_LD; const bf16_t* dB = dA + 64 * FR_LD;
  for (int it = lbid(); it < 512; it += lnb()) {
    const int t2 = it >> 2, c0 = (it & 3) * 64;
    __syncthreads();
    fourier_load(WV, PB + (size_t)t2 * NPB_ + C_FA + c0, (size_t)128 * NPB_, (size_t)(C_FB - C_FA), smem);
    __syncthreads();
    f32x16 R, nI; for (int i = 0; i < 16; ++i) { R[i] = 0.f; nI[i] = 0.f; }
#pragma unroll
    for (int s = 0; s < 8; ++s) {
      const bf16x8 cw = *(const bf16x8*)(Cw + (32 * rb + r31) * FR_LD + 16 * s + 8 * h), sw = *(const bf16x8*)(Sw + (32 * rb + r31) * FR_LD + 16 * s + 8 * h);
      const bf16x8 af = *(const bf16x8*)(dA + (32 * cbk + r31) * FR_LD + 16 * s + 8 * h), bfv = *(const bf16x8*)(dB + (32 * cbk + r31) * FR_LD + 16 * s + 8 * h);
      bf16x8 nb; for (int e = 0; e < 8; ++e) nb[e] = (short)(bfv[e] ^ (short)0x8000);
      R = MFMA32(cw, af, R); R = MFMA32(sw, nb, R); nI = MFMA32(sw, af, nI); nI = MFMA32(cw, bfv, nI);
    }
    const int col = c0 + 32 * cbk + r31;
#pragma unroll
    for (int i = 0; i < 16; ++i) {
      const int k1 = 32 * rb + crow(i, h);
      const float x = (float)(k1 * t2) * (1.0f / 8192.0f); const float ct = cospif(x), st = sinpif(x);
      const float vre = R[i] * ct - nI[i] * st, vim = -nI[i] * ct - R[i] * st;
      bf16_t* vp = V + ((size_t)(k1 * 128 + t2) * 2) * 256 + col;
      vp[0] = f2bf(vre); vp[256] = f2bf(vim);
    }
  }
}
DI void fourier_stage2(int WV, KArgs a, unsigned char* smem) {
  const int tid = ltid(), lane = tid & 63, wave = tid >> 6, r31 = lane & 31, h = lane >> 5, rb = wave & 3, cbk = wave >> 2;
  const bf16_t* V = (const bf16_t*)(a->ws + WS_V); bf16_t* BR = (bf16_t*)(a->ws + WS_BR);
  const bf16_t* Cw = (const bf16_t*)smem; const bf16_t* Sw = Cw + 128 * FR_LD; const bf16_t* dA = Sw + 128 * FR_LD; const bf16_t* dB = dA + 64 * FR_LD;
  for (int it = lbid(); it < 512; it += lnb()) {
    const int k1 = it >> 2, c0 = (it & 3) * 64;
    __syncthreads();
    fourier_load(WV, V + (size_t)k1 * 128 * 512 + c0, (size_t)512, (size_t)256, smem);
    __syncthreads();
    f32x16 Y; for (int i = 0; i < 16; ++i) Y[i] = 0.f;
#pragma unroll
    for (int s = 0; s < 8; ++s) {
      const bf16x8 cw = *(const bf16x8*)(Cw + (32 * rb + r31) * FR_LD + 16 * s + 8 * h), sw = *(const bf16x8*)(Sw + (32 * rb + r31) * FR_LD + 16 * s + 8 * h);
      const bf16x8 vr = *(const bf16x8*)(dA + (32 * cbk + r31) * FR_LD + 16 * s + 8 * h), vi = *(const bf16x8*)(dB + (32 * cbk + r31) * FR_LD + 16 * s + 8 * h);
      Y = MFMA32(cw, vr, Y); Y = MFMA32(sw, vi, Y);
    }
    const int col = c0 + 32 * cbk + r31;
#pragma unroll
    for (int i = 0; i < 16; ++i) { const int k2 = 32 * rb + crow(i, h); BR[(size_t)(k1 + 128 * k2) * 1024 + col] = f2bf(Y[i] * (1.0f / 1024.0f)); }
  }
}
DI void fourier_ctx(int WV, KArgs a, unsigned char* smem) {
  const int tid = ltid();
  const bf16_t* PB = (const bf16_t*)(a->ws + WS_PB) + (size_t)L_ * NPB_; bf16_t* BR = (bf16_t*)(a->ws + WS_BR) + (size_t)L_ * 1024;
  float* ct = (float*)smem; float* st = ct + 256; float* part = st + 256;
  __syncthreads();
  if (tid < 256) { const float x = (float)tid * (1.0f / 128.0f); ct[tid] = cospif(x); st[tid] = sinpif(x); }
  __syncthreads();
  for (int k = lbid(); k < 256; k += lnb()) {
    const int col = tid & 255, half = tid >> 8;
    float acc = 0.f;
#pragma unroll 8
    for (int t = half * 128; t < half * 128 + 128; ++t) {
      const int idx = (k * t) & 255;
      acc += ct[idx] * bf2f(PB[(size_t)t * NPB_ + C_FA + col]) - st[idx] * bf2f(PB[(size_t)t * NPB_ + C_FB + col]);
    }
    if (half == 1) part[col] = acc;
    __syncthreads();
    if (half == 0) BR[(size_t)k * 1024 + col] = f2bf((acc + part[col]) * (1.0f / 128.0f));
    __syncthreads();
  }
}
DI int chunk_row0(int ci) { return ci < 128 ? ci * 128 : L_ + (ci - 128) * 128; }
DI void ret_states(int WV, KArgs a, int l, unsigned char* smem) {
  const int tid = ltid();
  const bf16_t* PB = (const bf16_t*)(a->ws + WS_PB); float* T = (float*)(a->ws + WS_T);
  const float* S = (const float*)(a->ws + WS_SCAL) + l * 64;
  float* kL = (float*)smem; float* vL = kL + 128 * 33; float* wf = vL + 128 * 64; float* wb = wf + 128;
  for (int it = lbid(); it < 130 * 6; it += lnb()) {
    const int ci = it / 6, hh = it % 6, r0 = chunk_row0(ci);
    __syncthreads();
    { const int row = tid >> 2, seg = tid & 3; const bf16x8 v = *(const bf16x8*)(PB + (size_t)(r0 + row) * NPB_ + C_RK + hh * 32 + seg * 8);
#pragma unroll
      for (int e = 0; e < 8; ++e) kL[row * 33 + seg * 8 + e] = bf2f((unsigned)(unsigned short)v[e]); }
#pragma unroll
    for (int q = 0; q < 2; ++q) { const int id = tid + 512 * q, row = id >> 3, seg = id & 7; const bf16x8 v = *(const bf16x8*)(PB + (size_t)(r0 + row) * NPB_ + C_RV + hh * 64 + seg * 8);
#pragma unroll
      for (int e = 0; e < 8; ++e) vL[row * 64 + seg * 8 + e] = bf2f((unsigned)(unsigned short)v[e]); }
    if (tid < 128) { wf[tid] = expf(S[4 + hh] * (float)(127 - tid)); wb[tid] = expf(S[10 + hh] * (float)tid); }
    __syncthreads();
    const int d = tid >> 4, v4 = (tid & 15) * 4;
    f32x4 af = {0.f, 0.f, 0.f, 0.f}, ab = {0.f, 0.f, 0.f, 0.f};
#pragma unroll 4
    for (int j = 0; j < 128; ++j) { const float kd = kL[j * 33 + d]; const f32x4 vv = *(const f32x4*)(vL + j * 64 + v4); af += vv * (kd * wf[j]); ab += vv * (kd * wb[j]); }
    float* tp = T + ((size_t)(ci * 6 + hh) * 2) * 2048 + d * 64 + v4;
    *(f32x4*)tp = af; *(f32x4*)(tp + 2048) = ab;
  }
}
DI void ret_scan(int WV, KArgs a, int l) {
  const int gt = lbid() * 512 + ltid();
  if (gt >= 6 * 2 * 2048) return;
  const int idx = gt & 2047, dir = (gt >> 11) & 1, hh = gt >> 12;
  const float* T = (const float*)(a->ws + WS_T); float* S = (float*)(a->ws + WS_S);
  const float* SC = (const float*)(a->ws + WS_SCAL) + l * 64;
  const float dec = expf(SC[4 + dir * 6 + hh] * 128.0f);
  const size_t base = (size_t)(hh * 2 + dir) * 2048 + idx; const size_t cs = (size_t)6 * 2 * 2048;
  const float tc0 = T[base + 128 * cs], tc1 = T[base + 129 * cs];
  if (dir == 0) {
    float s = tc0 * dec + tc1; S[base + 128 * cs] = 0.f; S[base + 129 * cs] = tc0;
#pragma unroll 8
    for (int i = 0; i < 128; ++i) { S[base + i * cs] = s; s = s * dec + T[base + i * cs]; }
  } else {
    float s = tc0 + dec * tc1; S[base + 129 * cs] = 0.f; S[base + 128 * cs] = tc1;
#pragma unroll 8
    for (int i = 127; i >= 0; --i) { S[base + i * cs] = s; s = s * dec + T[base + i * cs]; }
  }
}
DI void ret_out(int WV, KArgs a, int l, unsigned char* smem) {
  const int tid = ltid(), lane = tid & 63, wave = tid >> 6, r31 = lane & 31, h = lane >> 5, jb = wave & 3, vh = wave >> 2;
  const bf16_t* PB = (const bf16_t*)(a->ws + WS_PB); bf16_t* BR = (bf16_t*)(a->ws + WS_BR); const float* Sg = (const float*)(a->ws + WS_S);
  const float* SC = (const float*)(a->ws + WS_SCAL) + l * 64;
  bf16_t* Kl = (bf16_t*)smem;
  bf16_t* Vt = Kl + 128 * 40;
  bf16_t* SfT = Vt + 64 * 136;
  bf16_t* SbT = SfT + 64 * 40;
  float* pwf = (float*)(SbT + 64 * 40);
  float* pwb = pwf + 128;
  float* ssq = pwb + 128;
  for (int it = lbid(); it < 130 * 6; it += lnb()) {
    const int ci = it / 6, hh = it % 6, r0 = chunk_row0(ci);
    const float lgf = SC[4 + hh], lgb = SC[10 + hh];
    __syncthreads();
    { const int row = tid >> 2, seg = tid & 3; *(bf16x8*)(Kl + row * 40 + seg * 8) = *(const bf16x8*)(PB + (size_t)(r0 + row) * NPB_ + C_RK + hh * 32 + seg * 8); }
#pragma unroll
    for (int q = 0; q < 2; ++q) { const int id = tid + 512 * q, row = id >> 3, seg = id & 7; const bf16x8 v = *(const bf16x8*)(PB + (size_t)(r0 + row) * NPB_ + C_RV + hh * 64 + seg * 8);
#pragma unroll
      for (int e = 0; e < 8; ++e) Vt[(seg * 8 + e) * 136 + row] = (bf16_t)v[e]; }
#pragma unroll
    for (int q = 0; q < 8; ++q) { const int e = tid + 512 * q, dir = e >> 11, idx = e & 2047, d = idx >> 6, v = idx & 63;
      const float sv = Sg[((size_t)(ci * 6 + hh) * 2 + dir) * 2048 + idx]; (dir ? SbT : SfT)[v * 40 + d] = f2bf(sv); }
    if (tid < 128) { pwf[tid] = expf(lgf * (float)tid); pwb[tid] = expf(lgb * (float)tid); }
    const int qrow = r0 + 32 * jb + r31, j = 32 * jb + r31;
    bf16x8 qf[2];
#pragma unroll
    for (int s = 0; s < 2; ++s) qf[s] = *(const bf16x8*)(PB + (size_t)qrow * NPB_ + C_RQ + hh * 32 + 16 * s + 8 * h);
    __syncthreads();
    f32x16 O; for (int i = 0; i < 16; ++i) O[i] = 0.f;
#pragma unroll
    for (int kb = 0; kb < 4; ++kb) {
      f32x16 St; for (int i = 0; i < 16; ++i) St[i] = 0.f;
#pragma unroll
      for (int s = 0; s < 2; ++s) { const bf16x8 kf = *(const bf16x8*)(Kl + (32 * kb + r31) * 40 + 16 * s + 8 * h); St = MFMA32(kf, qf[s], St); }
#pragma unroll
      for (int i = 0; i < 16; ++i) { const int jp = 32 * kb + crow(i, h); const int dl = j - jp; const float dv = dl > 0 ? pwf[dl] : (dl < 0 ? pwb[-dl] : 2.0f); St[i] *= dv; }
#pragma unroll
      for (int s = 0; s < 2; ++s) {
        const bf16x8 pb = pack_step(St, s);
        const bf16_t* vp = Vt + (32 * vh + r31) * 136 + 32 * kb + 16 * s + 4 * h;
        const s16x4 lo = *(const s16x4*)vp, hi = *(const s16x4*)(vp + 8);
        const bf16x8 vf = __builtin_shufflevector(lo, hi, 0, 1, 2, 3, 4, 5, 6, 7);
        O = MFMA32(vf, pb, O);
      }
    }
    f32x16 Of, Ob; for (int i = 0; i < 16; ++i) { Of[i] = 0.f; Ob[i] = 0.f; }
#pragma unroll
    for (int s = 0; s < 2; ++s) {
      const bf16x8 sf = *(const bf16x8*)(SfT + (32 * vh + r31) * 40 + 16 * s + 8 * h), sb = *(const bf16x8*)(SbT + (32 * vh + r31) * 40 + 16 * s + 8 * h);
      Of = MFMA32(sf, qf[s], Of); Ob = MFMA32(sb, qf[s], Ob);
    }
    const float qdf = expf(lgf * (float)(j + 1)), qdb = expf(lgb * (float)(128 - j));
    float ss = 0.f;
#pragma unroll
    for (int i = 0; i < 16; ++i) { O[i] = O[i] + Of[i] * qdf + Ob[i] * qdb; ss += O[i] * O[i]; }
    ss += shx(ss, 32, lane_id_v());
    if (h == 0) ssq[vh * 128 + j] = ss;
    __syncthreads();
    const float rstd = rsqrtf((ssq[j] + ssq[128 + j]) * (1.0f / 64.0f) + EPS_);
#pragma unroll
    for (int g4 = 0; g4 < 4; ++g4) {
      const int v0 = 32 * vh + 8 * g4 + 4 * h;
      const u32x2 gw = *(const u32x2*)(PB + (size_t)qrow * NPB_ + C_RG + hh * 64 + v0);
      const float g0 = bf2f(gw.x & 0xffffu), g1 = bf2f(gw.x >> 16), g2 = bf2f(gw.y & 0xffffu), g3 = bf2f(gw.y >> 16);
      u32x2 w; w.x = cvt_pk_bf16(O[4 * g4] * rstd * g0, O[4 * g4 + 1] * rstd * g1); w.y = cvt_pk_bf16(O[4 * g4 + 2] * rstd * g2, O[4 * g4 + 3] * rstd * g3);
      *(u32x2*)(BR + (size_t)qrow * 1024 + 256 + hh * 64 + v0) = w;
    }
  }
}
constexpr int AT_LD = 72;
typedef __bf16 bf16x2_t __attribute__((ext_vector_type(2)));
typedef float f32x2_t __attribute__((ext_vector_type(2)));
DI unsigned cvt2(float a, float b) { f32x2_t v = {a, b}; return __builtin_bit_cast(unsigned, __builtin_convertvector(v, bf16x2_t)); }
template <int VAR> DI void attn_phase(int WV, KArgs a, int l, bool with_ctx, unsigned char* smem) {
  const int tid = ltid(), lane = tid & 63, wave = tid >> 6, r31 = lane & 31, h = lane >> 5, qsub = wave & 3, kh = wave >> 2;
  const bf16_t* PB = (const bf16_t*)(a->ws + WS_PB); bf16_t* BR = (bf16_t*)(a->ws + (VAR == 0 ? WS_BR : WS_H));
  const float* SC = (const float*)(a->ws + WS_SCAL) + l * 64;
  const float lam = SC[0], lam_init = SC[1];
  bf16_t* Ks = (bf16_t*)smem;
  bf16_t* Vt = Ks + 2 * 64 * AT_LD;
  float* cmb = (float*)(Vt + 2 * 64 * AT_LD);
  const int nitems = 6 * 128 + (with_ctx ? 12 : 0);
  const int skey = tid >> 3, sseg = tid & 7;
  for (int it = lbid(); it < nitems; it += lnb()) {
    int head, q0, krow0, nt;
    if (it < 768) { head = it >> 7; q0 = (it & 127) * 128; krow0 = 0; nt = MT_ / 64; }
    else { const int e = it - 768; head = e >> 1; q0 = L_ + (e & 1) * 128; krow0 = L_; nt = LC_ / 64; }
    const int qrow = q0 + 32 * qsub + r31;
    bf16x8 qf[2][2];
#pragma unroll
    for (int mp = 0; mp < 2; ++mp)
#pragma unroll
      for (int s = 0; s < 2; ++s) qf[mp][s] = *(const bf16x8*)(PB + (size_t)qrow * NPB_ + C_DQ + head * 64 + mp * 32 + 16 * s + 8 * h);
    float negm = 0.f;
#pragma unroll
    for (int mp = 0; mp < 2; ++mp) {
      float ss = 0.f;
#pragma unroll
      for (int s = 0; s < 2; ++s)
#pragma unroll
        for (int e = 0; e < 8; ++e) { const float x = bf2f((unsigned)(unsigned short)qf[mp][s][e]); ss += x * x; }
      ss += shx(ss, 32, lane_id_v());
      const float kmx = __uint_as_float(((const unsigned*)SC)[16 + head * 2 + mp]);
      negm = fminf(negm, -sqrtf(ss * kmx) * 1.01f);
    }
    f32x16 NM; for (int i = 0; i < 16; ++i) NM[i] = negm;
    f32x16 O1[2], O2[2]; for (int i = 0; i < 16; ++i) { O1[0][i] = 0.f; O1[1][i] = 0.f; O2[0][i] = 0.f; O2[1][i] = 0.f; }
    f32x4 LA = {0.f, 0.f, 0.f, 0.f}, LB = {0.f, 0.f, 0.f, 0.f};
    bf16x8 osel; { const bool on = ((lane & 15) == 0 && ((lane >> 4) & 1) == 0) || ((lane & 15) == 1 && ((lane >> 4) & 1) == 1);
      for (int e = 0; e < 8; ++e) osel[e] = on ? (short)0x3F80 : (short)0; }
#define MFMA16(a_, b_, c_) __builtin_amdgcn_mfma_f32_16x16x32_bf16((a_), (b_), (c_), 0, 0, 0)
    const bf16_t* kg = PB + (size_t)(krow0 + skey) * NPB_ + C_DK + head * 64 + sseg * 8;
    const bf16_t* vg = PB + (size_t)(krow0 + skey) * NPB_ + C_DV + head * 64 + sseg * 8;
    const int vslot = ((skey & ~12) | ((skey & 4) << 1) | ((skey & 8) >> 1)) ^ (sseg << 3);
    __syncthreads();
    bf16x8 kA = *(const bf16x8*)kg, vA = *(const bf16x8*)vg;
    bf16x8 kB = *(const bf16x8*)(kg + (size_t)64 * NPB_), vB = *(const bf16x8*)(vg + (size_t)64 * NPB_);
    { *(bf16x8*)(Ks + skey * AT_LD + sseg * 8) = kA;
#pragma unroll
      for (int e = 0; e < 8; ++e) Vt[(sseg * 8 + e) * AT_LD + vslot] = (bf16_t)vA[e]; }
    __syncthreads();
    for (int t = 0; t < nt; ++t) {
      const int buf = t & 1;
      const bf16_t* ks = Ks + buf * 64 * AT_LD + (32 * kh + r31) * AT_LD + 8 * h;
      const bf16_t* vt = Vt + buf * 64 * AT_LD + r31 * AT_LD;
      const bf16x8 k00 = *(const bf16x8*)(ks), k01 = *(const bf16x8*)(ks + 16), k10 = *(const bf16x8*)(ks + 32), k11 = *(const bf16x8*)(ks + 48);
      bf16x8 vf[2][2];
#pragma unroll
      for (int s = 0; s < 2; ++s)
#pragma unroll
        for (int mt = 0; mt < 2; ++mt) vf[mt][s] = *(const bf16x8*)(vt + mt * 32 * AT_LD + (((4 * kh + 2 * s + h) ^ ((4 * mt + (r31 >> 3)) & 7)) << 3));
      f32x16 S1 = MFMA32(k00, qf[0][0], NM); f32x16 S2 = MFMA32(k10, qf[1][0], NM); S1 = MFMA32(k01, qf[0][1], S1); S2 = MFMA32(k11, qf[1][1], S2);
      bf16x8 p1[2], p2[2];
      { u32x4 w0, w1;
#pragma unroll
        for (int i = 0; i < 4; ++i) { w0[i] = cvt2(VAR == 1 ? S1[2 * i] * 0.001f : __builtin_amdgcn_exp2f(S1[2 * i]), VAR == 1 ? S1[2 * i + 1] * 0.001f : __builtin_amdgcn_exp2f(S1[2 * i + 1]));
                                       w1[i] = cvt2(VAR == 1 ? S1[8 + 2 * i] * 0.001f : __builtin_amdgcn_exp2f(S1[8 + 2 * i]), VAR == 1 ? S1[9 + 2 * i] * 0.001f : __builtin_amdgcn_exp2f(S1[9 + 2 * i])); }
        p1[0] = __builtin_bit_cast(bf16x8, w0); p1[1] = __builtin_bit_cast(bf16x8, w1); }
      O1[0] = MFMA32(vf[0][0], p1[0], O1[0]); O1[1] = MFMA32(vf[1][0], p1[0], O1[1]); LA = MFMA16(osel, p1[0], LA);
      O1[0] = MFMA32(vf[0][1], p1[1], O1[0]); O1[1] = MFMA32(vf[1][1], p1[1], O1[1]); LA = MFMA16(osel, p1[1], LA);
      { u32x4 w0, w1;
#pragma unroll
        for (int i = 0; i < 4; ++i) { w0[i] = cvt2(VAR == 1 ? S2[2 * i] * 0.001f : __builtin_amdgcn_exp2f(S2[2 * i]), VAR == 1 ? S2[2 * i + 1] * 0.001f : __builtin_amdgcn_exp2f(S2[2 * i + 1]));
                                       w1[i] = cvt2(VAR == 1 ? S2[8 + 2 * i] * 0.001f : __builtin_amdgcn_exp2f(S2[8 + 2 * i]), VAR == 1 ? S2[9 + 2 * i] * 0.001f : __builtin_amdgcn_exp2f(S2[9 + 2 * i])); }
        p2[0] = __builtin_bit_cast(bf16x8, w0); p2[1] = __builtin_bit_cast(bf16x8, w1); }
      if (VAR != 5) {
      O2[0] = MFMA32(vf[0][0], p2[0], O2[0]); O2[1] = MFMA32(vf[1][0], p2[0], O2[1]); LB = MFMA16(osel, p2[0], LB);
      O2[0] = MFMA32(vf[0][1], p2[1], O2[0]); O2[1] = MFMA32(vf[1][1], p2[1], O2[1]); LB = MFMA16(osel, p2[1], LB); }
      __builtin_amdgcn_sched_group_barrier(0x100, 8, 0);
      __builtin_amdgcn_sched_group_barrier(0x8, 4, 0);
      __builtin_amdgcn_sched_group_barrier(0x402, 24, 0);
#pragma unroll
      for (int i = 0; i < 6; ++i) { __builtin_amdgcn_sched_group_barrier(0x8, 1, 0); __builtin_amdgcn_sched_group_barrier(0x402, 4, 0); }
      { const int nb_ = buf ^ 1;
        *(bf16x8*)(Ks + nb_ * 64 * AT_LD + skey * AT_LD + sseg * 8) = kB;
#pragma unroll
        for (int e = 0; e < 8; ++e) Vt[nb_ * 64 * AT_LD + (sseg * 8 + e) * AT_LD + vslot] = (bf16_t)vB[e];
        const int tl_ = (t + 2 < nt) ? t + 2 : nt - 1;
        kB = *(const bf16x8*)(kg + (size_t)tl_ * 64 * NPB_); vB = *(const bf16x8*)(vg + (size_t)tl_ * 64 * NPB_); }
#pragma unroll
      for (int i = 0; i < 5; ++i) { __builtin_amdgcn_sched_group_barrier(0x8, 1, 0); __builtin_amdgcn_sched_group_barrier(0x200, 2, 0); }
      __builtin_amdgcn_sched_group_barrier(0x8, 1, 0); __builtin_amdgcn_sched_group_barrier(0x20, 2, 0);
      __syncthreads();
    }
    float* cw = cmb + (size_t)(qsub * 64 + lane) * 66;
    const int sl_ = ((lane & 15) << 2);
    const float a0_ = __int_as_float(__builtin_amdgcn_ds_bpermute(sl_, __float_as_int(LA[0]))), a1_ = __int_as_float(__builtin_amdgcn_ds_bpermute(sl_, __float_as_int(LA[1])));
    const float b0_ = __int_as_float(__builtin_amdgcn_ds_bpermute(sl_, __float_as_int(LB[0]))), b1_ = __int_as_float(__builtin_amdgcn_ds_bpermute(sl_, __float_as_int(LB[1])));
    const float lq1 = (r31 >> 4) ? a1_ : a0_, lq2 = (r31 >> 4) ? b1_ : b0_;
    if (kh == 1) {
#pragma unroll
      for (int i = 0; i < 16; ++i) { cw[i] = O1[0][i]; cw[16 + i] = O1[1][i]; cw[32 + i] = O2[0][i]; cw[48 + i] = O2[1][i]; }
      cw[64] = lq1; cw[65] = lq2;
    }
    __syncthreads();
    if (kh == 0) {
#pragma unroll
      for (int i = 0; i < 16; ++i) { O1[0][i] += cw[i]; O1[1][i] += cw[16 + i]; O2[0][i] += cw[32 + i]; O2[1][i] += cw[48 + i]; }
      const float l1 = lq1 + cw[64], l2 = lq2 + cw[65];
      const float i1 = 1.0f / l1, i2 = lam / l2;
      float ss = 0.f;
#pragma unroll
      for (int mt = 0; mt < 2; ++mt)
#pragma unroll
        for (int i = 0; i < 16; ++i) { const float o = O1[mt][i] * i1 - O2[mt][i] * i2; O1[mt][i] = o; ss += o * o; }
      ss += shx(ss, 32, lane_id_v());
      const float sc = rsqrtf(ss * (1.0f / 64.0f) + EPS_) * (1.0f - lam_init);
      const float* sw = a->in[13] + l * 64;
#pragma unroll
      for (int mt = 0; mt < 2; ++mt)
#pragma unroll
        for (int g4 = 0; g4 < 4; ++g4) {
          const int v0 = 32 * mt + 8 * g4 + 4 * h;
          const f32x4 wv = *(const f32x4*)(sw + v0);
          u32x2 w; w.x = cvt_pk_bf16(O1[mt][4 * g4] * sc * wv[0], O1[mt][4 * g4 + 1] * sc * wv[1]); w.y = cvt_pk_bf16(O1[mt][4 * g4 + 2] * sc * wv[2], O1[mt][4 * g4 + 3] * sc * wv[3]);
          *(u32x2*)(BR + (size_t)qrow * 1024 + 640 + head * 64 + v0) = w;
        }
    }
  }
}
template <class Epi> DI void run_gemm(int WV, LAS unsigned char* lds, const bf16_t* A, int lda, const bf16_t* Bt, int M, int N, int K, const Epi& E) {
  pg8::Gemm g; g.A = A; g.Bt = Bt; g.M = M; g.N = N; g.K = K; g.lda = lda;
  pg8::StaticOrder S; S.init(M, N, lnb(), lbid());
  pg8::gemm_phase<Epi, pg8::StaticOrder, false>(WV, lds, g, S, E, nullptr);
}
struct CtxMerge0 { float* MXC; const bf16_t* G; DI void operator()(int r, int c, float v) const { MXC[r * 1024 + c] = bf2f(G[(size_t)r * NGB_ + c]) * v; } };
struct CtxMerge1 { float* MXC; const bf16_t* G; DI void operator()(int r, int c, float v) const { MXC[r * 1024 + c] += bf2f(G[(size_t)r * NGB_ + c]) * v; } };
struct CtxMerge2 { const float* MXC; const bf16_t* G; bf16_t* Hc; DI void operator()(int r, int c, float v) const { Hc[r * 1024 + c] = f2bf(MXC[r * 1024 + c] + bf2f(G[(size_t)r * NGB_ + c]) * v); } };
struct CtxResid { float* Xc; const float* gate; float scale; DI void operator()(int r, int c, float v) const { Xc[r * 1024 + c] += scale * gate[c] * v; } };

DI void phase_win(int WV, int l, unsigned char* smem) {
  KArgs a = kargs(); unsigned char* ws = a->ws;
  EpiWin E; E.PB = (bf16_t*)(ws + WS_PB); E.GB = (bf16_t*)(ws + WS_GB); E.TRET = (const float*)(ws + WS_TRET); E.TROW = (const float*)(ws + WS_TROW); E.TCOL = (const float*)(ws + WS_TCOL);
  E.kmax = (unsigned*)(ws + WS_SCAL) + l * 64 + 16;
  run_gemm(WV, (LAS unsigned char*)smem, (const bf16_t*)(ws + WS_H), 1024, (const bf16_t*)(ws + WS_WIN) + (size_t)l * 5888 * 1024, MT_, NWIN_, 1024, E);
}
DI void phase_merge(int WV, int l, unsigned char* smem) {
  LAS unsigned char* lds = (LAS unsigned char*)smem;
  { KArgs a = kargs(); unsigned char* ws = a->ws; EpiMerge<0> E; E.MX = a->out; E.G = (const bf16_t*)(ws + WS_GB); E.Hout = (bf16_t*)(ws + WS_H);
    run_gemm(WV, lds, (const bf16_t*)(ws + WS_BR), 1024, (const bf16_t*)(ws + WS_WBF) + (size_t)l * 1024 * 256, L_, 1024, 256, E); }
  { KArgs a = kargs(); unsigned char* ws = a->ws; EpiMerge<1> E; E.MX = a->out; E.G = (const bf16_t*)(ws + WS_GB) + 1024; E.Hout = (bf16_t*)(ws + WS_H);
    run_gemm(WV, lds, (const bf16_t*)(ws + WS_BR) + 256, 1024, (const bf16_t*)(ws + WS_WBR) + (size_t)l * 1024 * 384, L_, 1024, 384, E); }
  { KArgs a = kargs(); unsigned char* ws = a->ws; EpiMerge<2> E; E.MX = a->out; E.G = (const bf16_t*)(ws + WS_GB) + 2048; E.Hout = (bf16_t*)(ws + WS_H);
    run_gemm(WV, lds, (const bf16_t*)(ws + WS_BR) + 640, 1024, (const bf16_t*)(ws + WS_WBD) + (size_t)l * 1024 * 384, L_, 1024, 384, E); }
  { KArgs a = kargs(); unsigned char* ws = a->ws;
    const bf16_t* BRc = (const bf16_t*)(ws + WS_BR) + (size_t)L_ * 1024; const bf16_t* GBc = (const bf16_t*)(ws + WS_GB) + (size_t)L_ * NGB_;
    CtxMerge0 e0; e0.MXC = (float*)(ws + WS_MXC); e0.G = GBc;
    ctx_gemm32(WV, BRc, 1024, (const bf16_t*)(ws + WS_WBF) + (size_t)l * 1024 * 256, 256, 1024, smem, e0);
    CtxMerge1 e1; e1.MXC = (float*)(ws + WS_MXC); e1.G = GBc + 1024;
    ctx_gemm32(WV, BRc + 256, 1024, (const bf16_t*)(ws + WS_WBR) + (size_t)l * 1024 * 384, 384, 1024, smem, e1);
    CtxMerge2 e2; e2.MXC = (const float*)(ws + WS_MXC); e2.G = GBc + 2048; e2.Hc = (bf16_t*)(ws + WS_H) + (size_t)L_ * 1024;
    ctx_gemm32(WV, BRc + 640, 1024, (const bf16_t*)(ws + WS_WBD) + (size_t)l * 1024 * 384, 384, 1024, smem, e2); }
}
DI void phase_wo(int WV, int l, unsigned char* smem) {
  { KArgs a = kargs(); unsigned char* ws = a->ws; EpiResid E; E.X = (float*)(ws + WS_X); E.gate = (const float*)(ws + WS_MOD) + (size_t)l * 9216 + 5 * 1024; E.scale = 1.0f;
    run_gemm(WV, (LAS unsigned char*)smem, (const bf16_t*)(ws + WS_H), 1024, (const bf16_t*)(ws + WS_WO) + (size_t)l * 1024 * 1024, L_, 1024, 1024, E); }
  { KArgs a = kargs(); unsigned char* ws = a->ws; CtxResid e; e.Xc = (float*)(ws + WS_X) + (size_t)L_ * 1024; e.gate = (const float*)(ws + WS_MOD) + (size_t)(4 + l) * 9216 + 5 * 1024; e.scale = 1.0f;
    ctx_gemm32(WV, (const bf16_t*)(ws + WS_H) + (size_t)L_ * 1024, 1024, (const bf16_t*)(ws + WS_WO) + (size_t)l * 1024 * 1024, 1024, 1024, smem, e); }
}
DI void phase_g1(int WV, int l, int f, unsigned char* smem) {
  KArgs a = kargs(); unsigned char* ws = a->ws; EpiSwiglu E; E.U = (bf16_t*)(ws + WS_U);
  run_gemm(WV, (LAS unsigned char*)smem, (const bf16_t*)(ws + WS_H), 1024, (const bf16_t*)(ws + WS_W13) + (size_t)(l * 2 + f) * 5632 * 1024, MT_, 5632, 1024, E);
}
DI void phase_g2(int WV, int l, int f, unsigned char* smem) {
  const int gi = f == 0 ? 2 : 8;
  { KArgs a = kargs(); unsigned char* ws = a->ws; EpiResid E; E.X = (float*)(ws + WS_X); E.gate = (const float*)(ws + WS_MOD) + (size_t)l * 9216 + gi * 1024; E.scale = 0.5f;
    run_gemm(WV, (LAS unsigned char*)smem, (const bf16_t*)(ws + WS_U), 2816, (const bf16_t*)(ws + WS_W2) + (size_t)(l * 2 + f) * 1024 * 2816, L_, 1024, 2816, E); }
  { KArgs a = kargs(); unsigned char* ws = a->ws; CtxResid e; e.Xc = (float*)(ws + WS_X) + (size_t)L_ * 1024; e.gate = (const float*)(ws + WS_MOD) + (size_t)(4 + l) * 9216 + gi * 1024; e.scale = 0.5f;
    ctx_gemm32(WV, (const bf16_t*)(ws + WS_U) + (size_t)L_ * 2816, 2816, (const bf16_t*)(ws + WS_W2) + (size_t)(l * 2 + f) * 1024 * 2816, 2816, 1024, smem, e); }
}

DI void grid_bar(int WV, unsigned& gen) {
  asm volatile("s_waitcnt vmcnt(0)" ::: "memory");
  __syncthreads();
  gen += 1;
  if (ltid() == 0) {
    unsigned* cnt = (unsigned*)(kargs()->ws + WS_BAR);
    __builtin_amdgcn_fence(__ATOMIC_RELEASE, "agent");
    asm volatile("s_waitcnt vmcnt(0)" ::: "memory");
    __hip_atomic_fetch_add(cnt, 1u, __ATOMIC_RELAXED, __HIP_MEMORY_SCOPE_AGENT);
    const unsigned target = gen * (unsigned)lnb();
    while (__hip_atomic_load(cnt, __ATOMIC_RELAXED, __HIP_MEMORY_SCOPE_AGENT) < target) __builtin_amdgcn_s_sleep(2);
    __builtin_amdgcn_fence(__ATOMIC_ACQUIRE, "agent");
    asm volatile("s_waitcnt vmcnt(0)" ::: "memory");
  }
  __syncthreads();
}

__global__ void __launch_bounds__(512, 2) mega(Args a_unused) {
  extern __shared__ __attribute__((aligned(16))) unsigned char smem[];
  cg::grid_group grid = cg::this_grid();
  const int WV = __builtin_amdgcn_readfirstlane((int)(threadIdx.x >> 6));
#ifndef NO_PRO
  prologue(WV, kargs(), smem);
#ifdef PROBE_PRO
  __syncthreads(); prologue(WV, kargs(), smem);
#endif
#endif
  grid.sync();
  unsigned gen = 0;
#pragma unroll 1
  for (int l = 0; l < DEPTH_; ++l) {
#pragma unroll 1
    for (int f = 0; f < 2; ++f) {
      if (f == 1) {
        norm_phase(WV, kargs(), l, 1, false);
        grid_bar(WV, gen);
        phase_win(WV, l, smem);
#ifdef PROBE_WIN
        phase_win(WV, l, smem);
#endif
        grid_bar(WV, gen);
#ifndef NO_MIXA
        fourier_tables(WV, smem); __syncthreads(); fourier_stage1(WV, kargs(), smem); fourier_ctx(WV, kargs(), smem); __syncthreads(); ret_states(WV, kargs(), l, smem);
#ifdef PROBE_MIXA
        __syncthreads();
        fourier_tables(WV, smem); __syncthreads(); fourier_stage1(WV, kargs(), smem); fourier_ctx(WV, kargs(), smem); __syncthreads(); ret_states(WV, kargs(), l, smem);
#endif
#endif
        grid_bar(WV, gen);
#ifndef NO_MIXB
        ret_scan(WV, kargs(), l); __syncthreads(); fourier_tables(WV, smem); __syncthreads(); fourier_stage2(WV, kargs(), smem);
#ifdef PROBE_MIXB
        __syncthreads();
        ret_scan(WV, kargs(), l); __syncthreads(); fourier_tables(WV, smem); __syncthreads(); fourier_stage2(WV, kargs(), smem);
#endif
#endif
        grid_bar(WV, gen);
#ifndef NO_RETOUT
        ret_out(WV, kargs(), l, smem); __syncthreads();
#ifdef PROBE_RET
        ret_out(WV, kargs(), l, smem); __syncthreads();
#endif
#endif
#ifndef NO_ATTN
        attn_phase<0>(WV, kargs(), l, l < DEPTH_ - 1, smem);
#ifdef PROBE_ATTN
        __syncthreads(); attn_phase<PROBE_ATTN>(WV, kargs(), l, l < DEPTH_ - 1, smem);
#endif
#endif
        grid_bar(WV, gen);
        phase_merge(WV, l, smem);
#ifdef PROBE_MERGE
        phase_merge(WV, l, smem);
#endif
        grid_bar(WV, gen);
        phase_wo(WV, l, smem);
        grid_bar(WV, gen);
      }
      norm_phase(WV, kargs(), l, f == 0 ? 0 : 2, l == 0 && f == 0);
      grid_bar(WV, gen);
      phase_g1(WV, l, f, smem);
#ifdef PROBE_G1
      phase_g1(WV, l, f, smem);
#endif
      grid_bar(WV, gen);
      phase_g2(WV, l, f, smem);
      grid_bar(WV, gen);
    }
  }
  final_norm(WV, kargs());
}

extern "C" void kernel_launch(void* const* d_in, const int* in_sizes, int n_in, void* d_out, int out_size, void* d_ws, size_t ws_size, hipStream_t stream) {
  static int grid = 0;
  if (grid == 0) {
    int dev = 0, cus = 0, per_cu = 0;
    (void)hipGetDevice(&dev); (void)hipDeviceGetAttribute(&cus, hipDeviceAttributeMultiprocessorCount, dev);
    if (hipFuncSetAttribute((const void*)mega, hipFuncAttributeMaxDynamicSharedMemorySize, LDS_BYTES) != hipSuccess) fprintf(stderr, "kernel_launch: hipFuncSetAttribute failed\n");
    if (hipOccupancyMaxActiveBlocksPerMultiprocessor(&per_cu, (const void*)mega, 512, LDS_BYTES) != hipSuccess || per_cu < 1) fprintf(stderr, "kernel_launch: occupancy query says %d blocks per CU\n", per_cu);
    (void)hipGetLastError();
    grid = cus > 0 ? cus : 256;
    if (ws_size < WS_END) { fprintf(stderr, "kernel_launch: workspace too small: %zu < %zu\n", ws_size, (size_t)WS_END); }
  }
  Args a{};
  for (int i = 0; i < 19; ++i) a.in[i] = (const float*)d_in[i];
  a.out = (float*)d_out; a.ws = (unsigned char*)d_ws;
  (void)hipMemsetAsync((unsigned char*)d_ws + WS_BAR, 0, 256, stream);
  void* args[] = {&a};
  hipError_t e = hipLaunchCooperativeKernel((const void*)mega, dim3(grid), dim3(512), args, LDS_BYTES, stream);
  if (e != hipSuccess) fprintf(stderr, "kernel_launch: cooperative launch failed: %s (grid %d)\n", hipGetErrorString(e), grid);
}
```

```cpp
#include <hip/hip_runtime.h>
#include <hip/hip_cooperative_groups.h>
#include <cstdio>
namespace cg = cooperative_groups;
__device__ __forceinline__ int lane_id_v() { int l; asm volatile("v_mbcnt_lo_u32_b32 %0, -1, 0\n\tv_mbcnt_hi_u32_b32 %0, -1, %0" : "=v"(l)); return l; }
#define ltid() ((WV << 6) | lane_id_v())
__device__ __forceinline__ float shx(float v, int m, int lane) { return __int_as_float(__builtin_amdgcn_ds_bpermute((lane ^ m) << 2, __float_as_int(v))); }
namespace pg8 {
#define PG8_LAS __attribute__((address_space(3)))
typedef unsigned short bf16_t;
typedef short bf16x8 __attribute__((ext_vector_type(8)));
typedef float f32x4 __attribute__((ext_vector_type(4)));
typedef unsigned u32x4 __attribute__((ext_vector_type(4)));
constexpr int BM = 256, BK = 64, HALF = 128, HTB = HALF * BK * 2  , STAGE_BYTES = 8 * HTB, NXCD = 8, WGM = 8;

__host__ __device__ __forceinline__ int lds_byte(int r, int c) { const int st = (r >> 4) * 2 + (c >> 5), rr = r & 15, cc = c & 31, ob = rr * 64 + cc * 2; return st * 1024 + (ob ^ (((ob >> 9) & 1) << 5)); }
__host__ __device__ __forceinline__ void stage_rc(int b, int& R, int& C) { const int st = b / 1024, sb = b % 1024, swz = sb ^ (((sb >> 9) & 1) << 5); R = (st >> 1) * 16 + swz / 64; C = (st & 1) * 32 + (swz % 64) / 2; }
__host__ __device__ __forceinline__ int perm32(int rho) { const int n = rho >> 4, i = rho & 15; return 8 * (i >> 2) + 4 * n + (i & 3); }

struct Unit { int pm, pn; };
struct Gemm { const bf16_t* A; const bf16_t* Bt; int M, N, K, lda; };

struct StaticOrder {
    int nM, nN, nwg, G, c;
    __host__ __device__ void init(int M, int N, int G_, int c_) { nM = M / BM; nN = N / BM; nwg = nM * nN; G = G_; c = c_; }
    __host__ __device__ bool next(int i, Unit& u) const {
        const long L = (long)i * G + c; if (L >= nwg) return false;
        int wgid = (int)L; { const int q = nwg / NXCD, r = nwg % NXCD, xcd = wgid % NXCD, off = wgid / NXCD; wgid = (xcd < r ? xcd * (q + 1) : r * (q + 1) + (xcd - r) * q) + off; }
        const int nig = WGM * nN, gid = wgid / nig, fm = gid * WGM, gsz = (nM - fm) < WGM ? (nM - fm) : WGM;
        u.pm = fm + ((wgid % nig) % gsz); u.pn = (wgid % nig) / gsz; return true;
    }
    __device__ __forceinline__ void a_ready(const Unit&) const {}
    __device__ __forceinline__ void done(const Unit&) const {}
};
__device__ __forceinline__ unsigned cvt_pk_bf16(float lo, float hi) { unsigned r; asm volatile("v_cvt_pk_bf16_f32 %0, %1, %2" : "=v"(r) : "v"(lo), "v"(hi)); return r; }
template <class Epi, class Sched, bool STAMP = false>
__device__ __forceinline__ void gemm_phase(const int WV, PG8_LAS unsigned char* lds, const Gemm g, const Sched& S, const Epi& E, unsigned long long* stamps) {
    const int tid = ltid(); const int wid = __builtin_amdgcn_readfirstlane(tid >> 6), lane = tid & 63, wr = wid >> 2, wc = wid & 3, fr = lane & 15, fq = lane >> 4;
    const int K = g.K, nt = K / BK;
    int ts_lo = 0, ts_hi = 0, nts = 0; const unsigned long long rt_entry = STAMP ? (unsigned long long)wall_clock64() : 0ull;
#define PG8_STAMP() do { if (STAMP && wid == 0 && nts < 64) { const unsigned long long _c = (unsigned long long)clock64(); \
        ts_lo = (lane == nts) ? (int)(unsigned)_c : ts_lo; ts_hi = (lane == nts) ? (int)(unsigned)(_c >> 32) : ts_hi; ++nts; } } while (0)
    PG8_STAMP();
    unsigned voffA[2], voffB[2];
#pragma unroll
    for (int i = 0; i < 2; ++i) { int R, C; stage_rc(tid * 16 + i * 8192, R, C); const int Rb = Epi::PERM ? ((R & ~31) + perm32(R & 31)) : R;
        voffA[i] = (unsigned)(R * g.lda + C) * 2u; voffB[i] = (unsigned)(Rb * K + C) * 2u; }
    const size_t kstep = (size_t)(BK * 2);
    const size_t hstep = (size_t)HALF * K * 2;
    const size_t tstep = 2 * hstep; const size_t hstepA = (size_t)HALF * g.lda * 2; const size_t tstepA = 2 * hstepA;
    const unsigned ldsw = (unsigned)wid * 1024u;
    const int aoff = lds_byte(wr * 64 + fr, fq * 8), boff = lds_byte(wc * 32 + fr, fq * 8);
#define PG8_SA(b, h) (((b) * 2 + (h)) * HTB)
#define PG8_SB(b, h) ((4 + (b) * 2 + (h)) * HTB)
#define PG8_STAGE(bufoff, gbase, voff) do { _Pragma("unroll") for (int _i = 0; _i < 2; ++_i) \
        __builtin_amdgcn_global_load_lds((const unsigned*)((const char*)(gbase) + (voff)[_i]), (PG8_LAS unsigned*)(lds + (bufoff) + ldsw + _i * 8192), 16, 0, 0); } while (0)
#define PG8_LDA(dst, b, h) do { _Pragma("unroll") for (int m = 0; m < 4; ++m) _Pragma("unroll") for (int k = 0; k < 2; ++k) dst[m][k] = *(const PG8_LAS bf16x8*)(lds + PG8_SA(b, h) + aoff + m * 2048 + k * 1024); } while (0)
#define PG8_LDB(dst, b, h) do { _Pragma("unroll") for (int n = 0; n < 2; ++n) _Pragma("unroll") for (int k = 0; k < 2; ++k) dst[n][k] = *(const PG8_LAS bf16x8*)(lds + PG8_SB(b, h) + boff + n * 2048 + k * 1024); } while (0)
#define PG8_MMA(ai, bj, At, Bt) do { __builtin_amdgcn_s_setprio(1); _Pragma("unroll") for (int m = 0; m < 4; ++m) _Pragma("unroll") for (int n = 0; n < 2; ++n) _Pragma("unroll") for (int k = 0; k < 2; ++k) \
        acc[ai][bj][m][n] = __builtin_amdgcn_mfma_f32_16x16x32_bf16(Bt[n][k], At[m][k], acc[ai][bj][m][n], 0, 0, 0); __builtin_amdgcn_s_setprio(0); } while (0)
#define PG8_WAIT_V(n) asm volatile("s_waitcnt vmcnt(" #n ")" ::: "memory")
#define PG8_WAIT_L(n) asm volatile("s_waitcnt lgkmcnt(" #n ")" ::: "memory")
#define PG8_BAR __builtin_amdgcn_s_barrier()
#define PG8_SCHED __builtin_amdgcn_sched_barrier(0)
    Unit cur, nxt; int ui = 0;
    if (!S.next(0, cur)) return;
    f32x4 acc[2][2][4][2];
#pragma unroll
    for (int a = 0; a < 2; ++a)
#pragma unroll
        for (int b = 0; b < 2; ++b)
#pragma unroll
            for (int m = 0; m < 4; ++m)
#pragma unroll
                for (int n = 0; n < 2; ++n) acc[a][b][m][n] = (f32x4){0.f, 0.f, 0.f, 0.f};
    bf16x8 At[4][2], B0[2][2], B1[2][2];
    const char* cA = (const char*)g.A + (size_t)cur.pm * tstepA; const char* cB = (const char*)g.Bt + (size_t)cur.pn * tstep;
    S.a_ready(cur);
    PG8_STAGE(PG8_SB(0, 0), cB, voffB); PG8_STAGE(PG8_SA(0, 0), cA, voffA); PG8_STAGE(PG8_SB(0, 1), cB + hstep, voffB); PG8_STAGE(PG8_SA(0, 1), cA + hstepA, voffA);
    if (wr == 1) PG8_BAR;
    PG8_WAIT_V(4); PG8_BAR;
    PG8_STAGE(PG8_SB(1, 0), cB + kstep, voffB); PG8_STAGE(PG8_SA(1, 0), cA + kstep, voffA); PG8_STAGE(PG8_SB(1, 1), cB + hstep + kstep, voffB);
    PG8_WAIT_V(6); PG8_BAR;
    PG8_STAMP();
    for (;;) {
        const bool has_next = S.next(ui + 1, nxt);
        const char* nA = has_next ? (const char*)g.A + (size_t)nxt.pm * tstepA : cA; const char* nB = has_next ? (const char*)g.Bt + (size_t)nxt.pn * tstep : cB;
        for (int t = 0; t < nt; t += 2) {
            const bool last = (t == nt - 2);
            const char* a1 = cA + (size_t)(t + 1) * kstep;
            const char* a2 = last ? nA : cA + (size_t)(t + 2) * kstep; const char* b2 = last ? nB : cB + (size_t)(t + 2) * kstep;
            const char* a3 = a2 + kstep; const char* b3 = b2 + kstep;
            if (last && has_next) S.a_ready(nxt);
            PG8_LDB(B0, 0, 0); PG8_SCHED; PG8_LDA(At, 0, 0); PG8_STAGE(PG8_SA(1, 1), a1 + hstepA, voffA);
            PG8_WAIT_L(8); PG8_BAR; PG8_WAIT_L(0); PG8_MMA(0, 0, At, B0); PG8_BAR; PG8_SCHED;
            PG8_LDB(B1, 0, 1); PG8_STAGE(PG8_SB(0, 0), b2, voffB);
            PG8_BAR; PG8_WAIT_L(0); PG8_MMA(0, 1, At, B1); PG8_BAR;
            PG8_LDA(At, 0, 1); PG8_STAGE(PG8_SA(0, 0), a2, voffA);
            PG8_BAR; PG8_WAIT_L(0); PG8_MMA(1, 0, At, B0); PG8_BAR; PG8_SCHED;
            PG8_STAGE(PG8_SB(0, 1), b2 + hstep, voffB);
            PG8_WAIT_V(6); PG8_BAR; PG8_MMA(1, 1, At, B1); PG8_BAR;
            PG8_LDB(B0, 1, 0); PG8_SCHED; PG8_LDA(At, 1, 0); PG8_STAGE(PG8_SA(0, 1), a2 + hstepA, voffA);
            PG8_WAIT_L(8); PG8_BAR; PG8_WAIT_L(0); PG8_MMA(0, 0, At, B0); PG8_BAR; PG8_SCHED;
            PG8_LDB(B1, 1, 1); PG8_STAGE(PG8_SB(1, 0), b3, voffB);
            PG8_BAR; PG8_WAIT_L(0); PG8_MMA(0, 1, At, B1); PG8_BAR;
            PG8_LDA(At, 1, 1); PG8_STAGE(PG8_SA(1, 0), a3, voffA);
            PG8_BAR; PG8_WAIT_L(0); PG8_MMA(1, 0, At, B0); PG8_BAR; PG8_SCHED;
            PG8_STAGE(PG8_SB(1, 1), b3 + hstep, voffB);
            PG8_WAIT_V(6); PG8_BAR; PG8_MMA(1, 1, At, B1); PG8_BAR;
        }
        PG8_STAMP();
        if constexpr (!Epi::AFTER_DRAIN) { E(acc, cur, wr, wc, fr, fq); S.done(cur); }
        PG8_STAMP();
        if (!has_next) break;
#pragma unroll
        for (int a = 0; a < 2; ++a)
#pragma unroll
            for (int b = 0; b < 2; ++b)
#pragma unroll
                for (int m = 0; m < 4; ++m)
#pragma unroll
                    for (int n = 0; n < 2; ++n) acc[a][b][m][n] = (f32x4){0.f, 0.f, 0.f, 0.f};
        cur = nxt; cA = nA; cB = nB; ++ui;
    }
    PG8_WAIT_V(0);
    if (wr == 0) PG8_BAR;
    PG8_BAR;
    if constexpr (Epi::AFTER_DRAIN) { E.fused(acc, cur, wr, wc, fr, fq, lds, wid, lane); S.done(cur); }
    PG8_STAMP();
    if (STAMP && wid == 0) { stamps[lane] = lane < nts ? (((unsigned long long)(unsigned)ts_hi << 32) | (unsigned)ts_lo) : 0ull;
        if (lane == 62) stamps[62] = rt_entry; if (lane == 63) stamps[63] = (unsigned long long)wall_clock64(); }
#undef PG8_STAMP
#undef PG8_SA
#undef PG8_SB
#undef PG8_STAGE
#undef PG8_LDA
#undef PG8_LDB
#undef PG8_MMA
#undef PG8_WAIT_V
#undef PG8_WAIT_L
#undef PG8_BAR
#undef PG8_SCHED
}
}
using pg8::bf16_t; using pg8::bf16x8; using pg8::f32x4; using pg8::u32x4; using pg8::cvt_pk_bf16;
typedef float f32x16 __attribute__((ext_vector_type(16)));
typedef short s16x4 __attribute__((ext_vector_type(4)));
typedef unsigned u32x2 __attribute__((ext_vector_type(2)));
#define DI __device__ __forceinline__
#define LAS __attribute__((address_space(3)))
#define MFMA32(a, b, c) __builtin_amdgcn_mfma_f32_32x32x16_bf16((a), (b), (c), 0, 0, 0)

constexpr int L_ = 16384, LC_ = 256, MT_ = 16640, D_ = 1024, DFF_ = 2816, DEPTH_ = 4;
constexpr int NWIN_ = 5888, NPB_ = 2816, NGB_ = 3072;
constexpr int C_FA = 0, C_FB = 256, C_RQ = 512, C_RK = 704, C_RV = 896, C_RG = 1280, C_DQ = 1664, C_DK = 2048, C_DV = 2432;
constexpr int LDS_BYTES = 147456;
constexpr float EPS_ = 1e-6f;

constexpr size_t al256(size_t x) { return (x + 255) & ~(size_t)255; }
constexpr size_t WS_W13 = 0;
constexpr size_t WS_W2  = WS_W13 + (size_t)4 * 2 * 5632 * 1024 * 2;
constexpr size_t WS_WIN = WS_W2 + (size_t)4 * 2 * 1024 * 2816 * 2;
constexpr size_t WS_WBF = WS_WIN + (size_t)4 * 5888 * 1024 * 2;
constexpr size_t WS_WBR = WS_WBF + (size_t)4 * 1024 * 256 * 2;
constexpr size_t WS_WBD = WS_WBR + (size_t)4 * 1024 * 384 * 2;
constexpr size_t WS_WO  = WS_WBD + (size_t)4 * 1024 * 384 * 2;
constexpr size_t WS_X   = WS_WO + (size_t)4 * 1024 * 1024 * 2;
constexpr size_t WS_H   = WS_X + (size_t)MT_ * 1024 * 4;
constexpr size_t WS_BR  = WS_H + (size_t)MT_ * 1024 * 2;
constexpr size_t WS_AL  = WS_BR + (size_t)MT_ * 1024 * 2;
constexpr size_t WS_U   = WS_AL;
constexpr size_t WS_PB  = WS_AL;
constexpr size_t WS_GB  = WS_AL + (size_t)MT_ * 2816 * 2;
constexpr size_t WS_V   = WS_GB + (size_t)MT_ * 3072 * 2;
constexpr size_t WS_T   = WS_V + (size_t)128 * 128 * 2 * 256 * 2;
constexpr size_t WS_S   = WS_T + (size_t)130 * 6 * 2 * 2048 * 4;
constexpr size_t WS_MXC = WS_S + (size_t)130 * 6 * 2 * 2048 * 4;
constexpr size_t WS_MOD = WS_MXC + (size_t)256 * 1024 * 4;
constexpr size_t WS_TRET = WS_MOD + (size_t)2 * 4 * 9216 * 4;
constexpr size_t WS_TROW = WS_TRET + (size_t)16384 * 16 * 2 * 4;
constexpr size_t WS_TCOL = WS_TROW + (size_t)256 * 8 * 2 * 4;
constexpr size_t WS_SCAL = WS_TCOL + (size_t)64 * 8 * 2 * 4;
constexpr size_t WS_BAR = WS_SCAL + 4 * 64 * 4;
constexpr size_t WS_END = WS_BAR + 256;

__device__ __forceinline__ int lbid() { int t = blockIdx.x; asm volatile("" : "+s"(t)); return t; }
__device__ __forceinline__ int lnb() { int t = gridDim.x; asm volatile("" : "+s"(t)); return t; }
struct Args { const float* in[19]; float* out; unsigned char* ws; };
typedef const Args __attribute__((address_space(4)))* KArgs;
__device__ __forceinline__ KArgs kargs() { KArgs p = (KArgs)__builtin_amdgcn_kernarg_segment_ptr(); asm volatile("" : "+s"(p)); return p; }

DI float bf2f(unsigned v) { return __uint_as_float(v << 16); }
DI bf16_t f2bf(float x) { return (bf16_t)(cvt_pk_bf16(x, 0.f) & 0xffffu); }
DI int crow(int reg, int h) { return (reg & 3) + 8 * (reg >> 2) + 4 * h; }
DI bf16x8 pack_step(const f32x16& x, int s) {
  u32x4 p;
  asm volatile("v_cvt_pk_bf16_f32 %0, %4, %5\n\tv_cvt_pk_bf16_f32 %1, %6, %7\n\tv_cvt_pk_bf16_f32 %2, %8, %9\n\tv_cvt_pk_bf16_f32 %3, %10, %11\n\ts_nop 1"
               : "=&v"(p[0]), "=&v"(p[1]), "=&v"(p[2]), "=&v"(p[3])
               : "v"(x[8 * s]), "v"(x[8 * s + 1]), "v"(x[8 * s + 2]), "v"(x[8 * s + 3]), "v"(x[8 * s + 4]), "v"(x[8 * s + 5]), "v"(x[8 * s + 6]), "v"(x[8 * s + 7]));
  return __builtin_bit_cast(bf16x8, p);
}
DI float silu_f(float a) { return a * __builtin_amdgcn_rcpf(1.0f + __expf(-a)); }
DI float sigmoid_f(float a) { return __builtin_amdgcn_rcpf(1.0f + __expf(-a)); }
DI float wave_sum(float v) {
  const int lane = lane_id_v();
#pragma unroll
  for (int o = 32; o > 0; o >>= 1) v += shx(v, o, lane);
  return v;
}
DI void sincos_acc(float xf, float& s, float& c) {
  const double x = (double)xf;
  const double k = rint(x * 0.63661977236758134308);
  double r = fma(-k, 1.57079632679489655800e+00, x); r = fma(-k, 6.12323399573676603587e-17, r);
  const double r2 = r * r;
  double sp = -1.0 / 39916800.0; sp = fma(sp, r2, 1.0 / 362880.0); sp = fma(sp, r2, -1.0 / 5040.0); sp = fma(sp, r2, 1.0 / 120.0); sp = fma(sp, r2, -1.0 / 6.0); sp = fma(sp * r2, r, r);
  double cp = 1.0 / 479001600.0; cp = fma(cp, r2, -1.0 / 3628800.0); cp = fma(cp, r2, 1.0 / 40320.0); cp = fma(cp, r2, -1.0 / 720.0); cp = fma(cp, r2, 1.0 / 24.0); cp = fma(cp, r2, -0.5); cp = fma(cp, r2, 1.0);
  const int q = ((int)(long long)k) & 3;
  const double sv = (q == 0) ? sp : (q == 1) ? cp : (q == 2) ? -sp : -cp;
  const double cv = (q == 0) ? cp : (q == 1) ? -sp : (q == 2) ? -cp : sp;
  s = (float)sv; c = (float)cv;
}
__constant__ float INV16[16] = {1.0f, 0.5623413324356079f, 0.3162277638912201f, 0.17782793939113617f, 0.10000000149011612f, 0.05623413249850273f, 0.03162277489900589f, 0.017782794311642647f,
                             0.009999999776482582f, 0.005623413249850273f, 0.003162277629598975f, 0.0017782794311642647f, 0.0010000000474974513f, 0.000562341301701963f, 0.0003162277571391314f, 0.00017782794020604342f};
struct ConvJob { const float* src; const float* src2; bf16_t* dst; int N, K, ld, kind; };
DI ConvJob conv_job(KArgs a, int j) {
  const int l = j / 9, kd = j % 9; ConvJob J; J.src2 = nullptr; J.kind = 0;
  unsigned char* ws = a->ws;
  switch (kd) {
    case 0: case 1: { const int f = kd; J.src = a->in[7] + (size_t)(l * 2 + f) * 1024 * 2816; J.src2 = a->in[8] + (size_t)(l * 2 + f) * 1024 * 2816; J.dst = (bf16_t*)(ws + WS_W13) + (size_t)(l * 2 + f) * 5632 * 1024; J.N = 5632; J.K = 1024; J.ld = 2816; J.kind = 1; break; }
    case 2: case 3: { const int f = kd - 2; J.src = a->in[9] + (size_t)(l * 2 + f) * 2816 * 1024; J.dst = (bf16_t*)(ws + WS_W2) + (size_t)(l * 2 + f) * 1024 * 2816; J.N = 1024; J.K = 2816; J.ld = 1024; break; }
    case 4: { J.src = a->in[10] + (size_t)l * 1024 * 5632; J.dst = (bf16_t*)(ws + WS_WIN) + (size_t)l * 5888 * 1024; J.N = 5888; J.K = 1024; J.ld = 5632; J.kind = 2; break; }
    case 5: { J.src = a->in[14] + (size_t)l * 256 * 1024; J.dst = (bf16_t*)(ws + WS_WBF) + (size_t)l * 1024 * 256; J.N = 1024; J.K = 256; J.ld = 1024; break; }
    case 6: { J.src = a->in[15] + (size_t)l * 384 * 1024; J.dst = (bf16_t*)(ws + WS_WBR) + (size_t)l * 1024 * 384; J.N = 1024; J.K = 384; J.ld = 1024; break; }
    case 7: { J.src = a->in[16] + (size_t)l * 384 * 1024; J.dst = (bf16_t*)(ws + WS_WBD) + (size_t)l * 1024 * 384; J.N = 1024; J.K = 384; J.ld = 1024; break; }
    default: { J.src = a->in[17] + (size_t)l * 1024 * 1024; J.dst = (bf16_t*)(ws + WS_WO) + (size_t)l * 1024 * 1024; J.N = 1024; J.K = 1024; J.ld = 1024; break; }
  }
  return J;
}
DI int axial_perm(int s) { return s < 8 ? s : (s < 16 ? s + 8 : (s < 24 ? s - 8 : s)); }

DI void prologue(int WV, KArgs a, unsigned char* smem) {
  const int tid = ltid(), nb = lnb(), bid = lbid();
  float* t = (float*)smem;
  float* tr = t + 64 * 65;
  {
    constexpr int tiles_per_layer = 1408 * 2 + 704 * 2 + 1472 + 64 + 96 + 96 + 256;
    const int nn = tid & 63, kq = tid >> 6;
#pragma unroll 1
    for (int g = bid; g < 4 * tiles_per_layer; g += nb) {
      const int l = g / tiles_per_layer; int rem = g % tiles_per_layer; int kd;
      if (rem < 1408) kd = 0; else if (rem < 2816) { kd = 1; rem -= 1408; } else if (rem < 3520) { kd = 2; rem -= 2816; } else if (rem < 4224) { kd = 3; rem -= 3520; }
      else if (rem < 5696) { kd = 4; rem -= 4224; } else if (rem < 5760) { kd = 5; rem -= 5696; } else if (rem < 5856) { kd = 6; rem -= 5760; } else if (rem < 5952) { kd = 7; rem -= 5856; } else { kd = 8; rem -= 5952; }
      const ConvJob J = conv_job(a, l * 9 + kd);
      const int nkt = J.K / 64; const int n0 = (rem / nkt) * 64, k0 = (rem % nkt) * 64;
      const bool fold = (J.kind == 2) && (n0 < 512);
      const float* sp = J.src; int col = n0 + nn;
      if (J.kind == 1) { const int n = n0 + nn, gi = n >> 5, s = n & 31; sp = (s < 16) ? J.src : J.src2; col = 16 * gi + (s & 15); }
      else if (J.kind == 2) {
        const int n = n0 + nn;
        if (fold) col = (n0 & 192) + nn;
        else { col = n - 256; if (n >= C_DQ && n < C_DV) { const int s = n & 31; col = (n - 256 - s) + axial_perm(s); } }
      }
      const float* cp = sp + (size_t)(k0 + kq) * J.ld + col;
      float lv[8];
#pragma unroll
      for (int i = 0; i < 8; ++i) lv[i] = cp[(size_t)(8 * i) * J.ld];
#pragma unroll
      for (int i = 0; i < 8; ++i) t[nn * 65 + kq + 8 * i] = lv[i];
      if (fold && tid < 64) { const float ang = (float)tid * (1.0f / 32.0f); tr[tid] = (n0 >= 256) ? sinpif(ang) : cospif(ang); }
      __syncthreads();
      if (!fold) {
#pragma unroll
        for (int i = 0; i < 4; ++i) {
          const int e = tid + i * 512, n2 = e >> 5, kp = (e & 31) * 2;
          *(unsigned*)(J.dst + (size_t)(n0 + n2) * J.K + k0 + kp) = cvt_pk_bf16(t[n2 * 65 + kp], t[n2 * 65 + kp + 1]);
        }
      } else {
#pragma unroll 1
        for (int i = 0; i < 8; ++i) {
          const int m = kq + 8 * i, kk = nn;
          float acc = 0.f;
#pragma unroll 8
          for (int c = 0; c < 64; ++c) acc += t[c * 65 + kk] * tr[(m * c) & 63];
          J.dst[(size_t)(n0 + m) * J.K + k0 + kk] = f2bf(acc);
        }
      }
      __syncthreads();
    }
  }
  {
    float* sc = (float*)smem; float* scc = sc + 1024; float* red = scc + 1024;
    __syncthreads();
    for (int i = tid; i < 1024; i += 512) { sc[i] = silu_f(a->in[1][i]); scc[i] = silu_f(a->in[3][i]); }
    __syncthreads();
    float* MOD = (float*)(a->ws + WS_MOD);
    for (int it = bid; it < 4 * 72; it += nb) {
      const int l = it / 72, cb = it % 72;
      const int cgp = tid & 31, ks = tid >> 5;
      const float* wp = a->in[4] + ((size_t)l * 1024 + ks * 64) * 9216 + cb * 128 + cgp * 4;
      f32x4 am = {0.f, 0.f, 0.f, 0.f}, ac = {0.f, 0.f, 0.f, 0.f};
#pragma unroll 8
      for (int k = 0; k < 64; ++k) { const f32x4 w = *(const f32x4*)(wp + (size_t)k * 9216); am += w * sc[ks * 64 + k]; ac += w * scc[ks * 64 + k]; }
#pragma unroll
      for (int j = 0; j < 4; ++j) { red[(ks * 128 + cgp * 4 + j) * 2] = am[j]; red[(ks * 128 + cgp * 4 + j) * 2 + 1] = ac[j]; }
      __syncthreads();
      if (tid < 256) {
        const int col = tid >> 1, which = tid & 1; float s = 0.f;
#pragma unroll
        for (int q = 0; q < 16; ++q) s += red[(q * 128 + col) * 2 + which];
        const int gc = cb * 128 + col;
        MOD[(size_t)(which * 4 + l) * 9216 + gc] = s + a->in[5][(size_t)l * 9216 + gc];
      }
      __syncthreads();
    }
  }
  {
    float* TRET = (float*)(a->ws + WS_TRET); float* TROW = (float*)(a->ws + WS_TROW); float* TCOL = (float*)(a->ws + WS_TCOL);
    const int gt = bid * 512 + tid, gn = nb * 512;
    for (int e = gt; e < 16384 * 16; e += gn) { const int p = e >> 4, i = e & 15; float s, c; sincos_acc((float)p * INV16[i], s, c); TRET[2 * e] = c; TRET[2 * e + 1] = s; }
    for (int e = gt; e < 256 * 8; e += gn) { const int p = e >> 3, i = e & 7; float s, c; sincos_acc((float)p * INV16[2 * i], s, c); TROW[2 * e] = c; TROW[2 * e + 1] = s; }
    for (int e = gt; e < 64 * 8; e += gn) { const int p = e >> 3, i = e & 7; float s, c; sincos_acc((float)p * INV16[2 * i], s, c); TCOL[2 * e] = c; TCOL[2 * e + 1] = s; }
    if (bid == 0 && tid < 4) {
      const int l = tid; float* S = (float*)(a->ws + WS_SCAL) + l * 64;
      const float* lv = a->in[12] + l * 128; float d01 = 0.f, d23 = 0.f;
      for (int i = 0; i < 32; ++i) { d01 += lv[i] * lv[32 + i]; d23 += lv[64 + i] * lv[96 + i]; }
      const float lam_init = 0.8f - 0.6f * expf(-0.3f * (float)l);
      S[0] = expf(d01) - expf(d23) + lam_init; S[1] = lam_init;
      for (int i = 0; i < 12; ++i) { const float x = a->in[11][l * 12 + i]; S[4 + i] = -log1pf(expf(-x)); }
      for (int i = 0; i < 12; ++i) ((unsigned*)S)[16 + i] = 0u;
    }
  }
}
DI void norm_phase(int WV, KArgs a, int l, int which, bool first) {
  const int tid = ltid(), lane = tid & 63, wave = tid >> 6;
  const float* g = a->in[6] + (size_t)(l * 3 + which) * 1024;
  const float* mod = (const float*)(a->ws + WS_MOD) + (size_t)l * 9216;
  const float* modc = (const float*)(a->ws + WS_MOD) + (size_t)(4 + l) * 9216;
  float* X = (float*)(a->ws + WS_X); bf16_t* H = (bf16_t*)(a->ws + WS_H);
  const int stride = lnb() * 8;
  for (int r = lbid() * 8 + wave; r < MT_; r += 2 * stride) {
    const int r2 = r + stride; const bool has2 = r2 < MT_; const int rb = has2 ? r2 : r;
    const float* srcA = first ? (r < L_ ? a->in[0] + (size_t)r * 1024 : a->in[2] + (size_t)(r - L_) * 1024) : X + (size_t)r * 1024;
    const float* srcB = first ? (rb < L_ ? a->in[0] + (size_t)rb * 1024 : a->in[2] + (size_t)(rb - L_) * 1024) : X + (size_t)rb * 1024;
    f32x4 va[4], vb[4]; float sa = 0.f, sb = 0.f;
#pragma unroll
    for (int i = 0; i < 4; ++i) { va[i] = *(const f32x4*)(srcA + i * 256 + lane * 4); vb[i] = *(const f32x4*)(srcB + i * 256 + lane * 4); }
#pragma unroll
    for (int i = 0; i < 4; ++i) { sa += va[i][0] * va[i][0] + va[i][1] * va[i][1] + va[i][2] * va[i][2] + va[i][3] * va[i][3]; sb += vb[i][0] * vb[i][0] + vb[i][1] * vb[i][1] + vb[i][2] * vb[i][2] + vb[i][3] * vb[i][3]; }
    sa = wave_sum(sa); sb = wave_sum(sb);
    const float rsa = rsqrtf(sa * (1.0f / 1024.0f) + EPS_), rsb = rsqrtf(sb * (1.0f / 1024.0f) + EPS_);
#pragma unroll
    for (int q = 0; q < 2; ++q) {
      if (q == 1 && !has2) break;
      const int rr = q ? r2 : r; const float rstd = q ? rsb : rsa;
      const float* mm = (rr < L_) ? mod : modc;
#pragma unroll
      for (int i = 0; i < 4; ++i) {
        const int c = i * 256 + lane * 4;
        const f32x4 v = q ? vb[i] : va[i];
        const f32x4 gg = *(const f32x4*)(g + c), sh = *(const f32x4*)(mm + (which * 3) * 1024 + c), sc = *(const f32x4*)(mm + (which * 3 + 1) * 1024 + c);
        f32x4 y;
#pragma unroll
        for (int j = 0; j < 4; ++j) y[j] = v[j] * rstd * gg[j] * (1.0f + sc[j]) + sh[j];
        u32x2 w; w.x = cvt_pk_bf16(y[0], y[1]); w.y = cvt_pk_bf16(y[2], y[3]);
        *(u32x2*)(H + (size_t)rr * 1024 + c) = w;
        if (first) *(f32x4*)(X + (size_t)rr * 1024 + c) = v;
      }
    }
  }
}
DI void final_norm(int WV, KArgs a) {
  const int tid = ltid(), lane = tid & 63, wave = tid >> 6;
  const float* g = a->in[18]; const float* X = (const float*)(a->ws + WS_X);
  for (int r = lbid() * 8 + wave; r < L_; r += lnb() * 8) {
    f32x4 v[4]; float ss = 0.f;
#pragma unroll
    for (int i = 0; i < 4; ++i) { v[i] = *(const f32x4*)(X + (size_t)r * 1024 + i * 256 + lane * 4); ss += v[i][0] * v[i][0] + v[i][1] * v[i][1] + v[i][2] * v[i][2] + v[i][3] * v[i][3]; }
    ss = wave_sum(ss);
    const float rstd = rsqrtf(ss * (1.0f / 1024.0f) + EPS_);
#pragma unroll
    for (int i = 0; i < 4; ++i) { const int c = i * 256 + lane * 4; const f32x4 gg = *(const f32x4*)(g + c); f32x4 y; for (int j = 0; j < 4; ++j) y[j] = v[i][j] * rstd * gg[j]; *(f32x4*)(a->out + (size_t)r * 1024 + c) = y; }
  }
}

using pg8::Unit; using pg8::HALF; using pg8::BM;
struct EpiSwiglu {
  static constexpr bool PERM = false, AFTER_DRAIN = false;
  bf16_t* U;
  DI void operator()(const f32x4 (&acc)[2][2][4][2], const Unit& u, int wr, int wc, int fr_, int fq_) const {
    const int ln_ = lane_id_v(), fr = ln_ & 15, fq = ln_ >> 4;
#pragma unroll
    for (int ai = 0; ai < 2; ++ai)
#pragma unroll
      for (int m = 0; m < 4; ++m) {
        const int r = u.pm * BM + ai * HALF + wr * 64 + m * 16 + fr;
#pragma unroll
        for (int bj = 0; bj < 2; ++bj) {
          const int gi = u.pn * 8 + bj * 4 + wc;
          const f32x4 x = acc[ai][bj][m][0], y = acc[ai][bj][m][1];
          u32x2 w; w.x = cvt_pk_bf16(silu_f(x[0]) * y[0], silu_f(x[1]) * y[1]); w.y = cvt_pk_bf16(silu_f(x[2]) * y[2], silu_f(x[3]) * y[3]);
          *(u32x2*)(U + (size_t)r * DFF_ + gi * 16 + fq * 4) = w;
        }
        __builtin_amdgcn_sched_barrier(0);
      }
  }
};
struct EpiResid {
  static constexpr bool PERM = false, AFTER_DRAIN = false;
  float* X; const float* gate; float scale;
  DI void operator()(const f32x4 (&acc)[2][2][4][2], const Unit& u, int wr, int wc, int fr_, int fq_) const {
    const int ln_ = lane_id_v(), fr = ln_ & 15, fq = ln_ >> 4;
#pragma unroll
    for (int bj = 0; bj < 2; ++bj)
#pragma unroll
      for (int n = 0; n < 2; ++n) {
        const int c = u.pn * BM + bj * HALF + wc * 32 + n * 16 + fq * 4;
        const f32x4 gv = *(const f32x4*)(gate + c) * scale;
#pragma unroll
        for (int ai = 0; ai < 2; ++ai)
#pragma unroll
          for (int m = 0; m < 4; ++m) {
            const int r = u.pm * BM + ai * HALF + wr * 64 + m * 16 + fr;
            float* p = X + (size_t)r * 1024 + c;
            *(f32x4*)p = *(const f32x4*)p + gv * acc[ai][bj][m][n];
          }
      }
  }
};
template <int STEP> struct EpiMerge {
  static constexpr bool PERM = false, AFTER_DRAIN = false;
  float* MX; const bf16_t* G; bf16_t* Hout;
  DI void operator()(const f32x4 (&acc)[2][2][4][2], const Unit& u, int wr, int wc, int fr_, int fq_) const {
    const int ln_ = lane_id_v(), fr = ln_ & 15, fq = ln_ >> 4;
#pragma unroll
    for (int ai = 0; ai < 2; ++ai)
#pragma unroll
      for (int bj = 0; bj < 2; ++bj)
#pragma unroll
        for (int n = 0; n < 2; ++n) {
          const int c = u.pn * BM + bj * HALF + wc * 32 + n * 16 + fq * 4;
          const int r0 = u.pm * BM + ai * HALF + wr * 64 + fr;
          u32x2 gw[4]; f32x4 old[4];
#pragma unroll
          for (int m = 0; m < 4; ++m) {
            gw[m] = *(const u32x2*)(G + (size_t)(r0 + m * 16) * NGB_ + c);
            if (STEP > 0) old[m] = *(const f32x4*)(MX + (size_t)(r0 + m * 16) * 1024 + c);
          }
#pragma unroll
          for (int m = 0; m < 4; ++m) {
            f32x4 gv; gv[0] = bf2f(gw[m].x & 0xffffu); gv[1] = bf2f(gw[m].x >> 16); gv[2] = bf2f(gw[m].y & 0xffffu); gv[3] = bf2f(gw[m].y >> 16);
            f32x4 v = gv * acc[ai][bj][m][n];
            if (STEP > 0) v += old[m];
            if (STEP < 2) *(f32x4*)(MX + (size_t)(r0 + m * 16) * 1024 + c) = v;
            else { u32x2 w; w.x = cvt_pk_bf16(v[0], v[1]); w.y = cvt_pk_bf16(v[2], v[3]); *(u32x2*)(Hout + (size_t)(r0 + m * 16) * 1024 + c) = w; }
          }
          __builtin_amdgcn_sched_barrier(0);
        }
  }
};
struct EpiWin {
  static constexpr bool PERM = false, AFTER_DRAIN = false;
  bf16_t* PB; bf16_t* GB; const float* TRET; const float* TROW; const float* TCOL; unsigned* kmax;
  DI void operator()(const f32x4 (&acc)[2][2][4][2], const Unit& u, int wr, int wc, int fr_, int fq_) const {
    const int ln_ = lane_id_v(), fr = ln_ & 15, fq = ln_ >> 4;
#pragma unroll
    for (int bj = 0; bj < 2; ++bj) {
      const int cb = u.pn * BM + bj * HALF + wc * 32;
      float kmx = 0.f;
#pragma unroll
      for (int ai = 0; ai < 2; ++ai)
#pragma unroll
        for (int m = 0; m < 4; ++m) {
          const int r = u.pm * BM + ai * HALF + wr * 64 + m * 16 + fr;
          f32x4 x0 = acc[ai][bj][m][0], x1 = acc[ai][bj][m][1];
          if (cb >= NPB_) {
#pragma unroll
            for (int j = 0; j < 4; ++j) { x0[j] = sigmoid_f(x0[j]); x1[j] = sigmoid_f(x1[j]); }
            u32x2 w0, w1; w0.x = cvt_pk_bf16(x0[0], x0[1]); w0.y = cvt_pk_bf16(x0[2], x0[3]); w1.x = cvt_pk_bf16(x1[0], x1[1]); w1.y = cvt_pk_bf16(x1[2], x1[3]);
            bf16_t* p = GB + (size_t)r * NGB_ + (cb - NPB_) + fq * 4;
            *(u32x2*)p = w0; *(u32x2*)(p + 16) = w1;
            __builtin_amdgcn_sched_barrier(0);
            continue;
          }
          if (cb >= C_RQ && cb < C_RV) {
            if (r < L_) {
              const f32x4* tp = (const f32x4*)(TRET + ((size_t)r * 16 + fq * 4) * 2);
              const f32x4 t0 = tp[0], t1 = tp[1];
              const float cs[4] = {t0[0], t0[2], t1[0], t1[2]}, sn[4] = {t0[1], t0[3], t1[1], t1[3]};
#pragma unroll
              for (int j = 0; j < 4; ++j) { const float a_ = x0[j], b_ = x1[j]; x0[j] = a_ * cs[j] - b_ * sn[j]; x1[j] = a_ * sn[j] + b_ * cs[j]; }
            }
            if (cb >= C_RK) { x0 *= 0.17677669529663687f; x1 *= 0.17677669529663687f; }
          } else if (cb >= C_RG && cb < C_DQ) {
#pragma unroll
            for (int j = 0; j < 4; ++j) { x0[j] = silu_f(x0[j]); x1[j] = silu_f(x1[j]); }
          } else if (cb >= C_DQ && cb < C_DV) {
            if (r < L_) {
              const float* tb = (fq < 2) ? (TROW + ((size_t)(r >> 6) * 8 + fq * 4) * 2) : (TCOL + ((size_t)(r & 63) * 8 + (fq - 2) * 4) * 2);
              const f32x4 t0 = ((const f32x4*)tb)[0], t1 = ((const f32x4*)tb)[1];
              const float cs[4] = {t0[0], t0[2], t1[0], t1[2]}, sn[4] = {t0[1], t0[3], t1[1], t1[3]};
#pragma unroll
              for (int j = 0; j < 4; ++j) { const float a_ = x0[j], b_ = x1[j]; x0[j] = a_ * cs[j] - b_ * sn[j]; x1[j] = a_ * sn[j] + b_ * cs[j]; }
            }
            if (cb < C_DK) { x0 *= 0.25503486f; x1 *= 0.25503486f; }
            else { float ss = 0.f;
#pragma unroll
              for (int j = 0; j < 4; ++j) ss += x0[j] * x0[j] + x1[j] * x1[j];
              ss += shx(ss, 16, lane_id_v()); ss += shx(ss, 32, lane_id_v()); kmx = fmaxf(kmx, ss); }
          }
          u32x2 w0, w1; w0.x = cvt_pk_bf16(x0[0], x0[1]); w0.y = cvt_pk_bf16(x0[2], x0[3]); w1.x = cvt_pk_bf16(x1[0], x1[1]); w1.y = cvt_pk_bf16(x1[2], x1[3]);
          bf16_t* p = PB + (size_t)r * NPB_ + cb + fq * 4;
          *(u32x2*)p = w0; *(u32x2*)(p + 16) = w1;
          __builtin_amdgcn_sched_barrier(0);
        }
      if (cb >= C_DK && cb < C_DV) {
#pragma unroll
        for (int o = 1; o < 16; o <<= 1) kmx = fmaxf(kmx, shx(kmx, o, lane_id_v()));
        if (lane_id_v() == 0) atomicMax(kmax + ((cb - C_DK) >> 5), __float_as_uint(kmx));
      }
    }
  }
};
template <class F> DI void ctx_gemm32(int WV, const bf16_t* A, int lda, const bf16_t* Bt, int K, int N, unsigned char* smem, F epi) {
  const int tid = ltid(), lane = tid & 63, wave = tid >> 6, r31 = lane & 31, h = lane >> 5;
  float* red = (float*)smem;
  const int ntn = N / 32, ntiles = 8 * ntn, kper = K / 8;
  for (int tile = lbid(); tile < ntiles; tile += lnb()) {
    const int tm = tile / ntn, tn = tile % ntn;
    f32x16 acc; for (int i = 0; i < 16; ++i) acc[i] = 0.f;
    const bf16_t* ap = A + (size_t)(tm * 32 + r31) * lda + wave * kper + 8 * h;
    const bf16_t* bp = Bt + (size_t)(tn * 32 + r31) * K + wave * kper + 8 * h;
    int kk = 0;
    for (; kk + 64 <= kper; kk += 64) {
      bf16x8 av[4], bv[4];
#pragma unroll
      for (int q = 0; q < 4; ++q) { av[q] = *(const bf16x8*)(ap + kk + 16 * q); bv[q] = *(const bf16x8*)(bp + kk + 16 * q); }
#pragma unroll
      for (int q = 0; q < 4; ++q) acc = MFMA32(av[q], bv[q], acc);
    }
    for (; kk < kper; kk += 16) { const bf16x8 av = *(const bf16x8*)(ap + kk), bv = *(const bf16x8*)(bp + kk); acc = MFMA32(av, bv, acc); }
#pragma unroll
    for (int i = 0; i < 16; ++i) red[(wave * 16 + i) * 64 + lane] = acc[i];
    __syncthreads();
#pragma unroll
    for (int q = 0; q < 2; ++q) {
      const int o = tid + q * 512, i = o >> 6, ln = o & 63; float s = 0.f;
#pragma unroll
      for (int w = 0; w < 8; ++w) s += red[(w * 16 + i) * 64 + ln];
      epi(tm * 32 + crow(i, ln >> 5), tn * 32 + (ln & 31), s);
    }
    __syncthreads();
  }
}

constexpr int FR_LD = 136;
DI void fourier_tables(int WV, unsigned char* smem) {
  bf16_t* Cw = (bf16_t*)smem; bf16_t* Sw = Cw + 128 * FR_LD;
  for (int e = ltid(); e < 128 * 128; e += 512) { const int a_ = e >> 7, b_ = e & 127; const float x = (float)((a_ * b_) & 127) * (1.0f / 64.0f); Cw[a_ * FR_LD + b_] = f2bf(cospif(x)); Sw[a_ * FR_LD + b_] = f2bf(sinpif(x)); }
}
DI void fourier_load(int WV, const bf16_t* src, size_t rs, size_t po, unsigned char* smem) {
  bf16_t* dA = (bf16_t*)smem + 2 * 128 * FR_LD;
#pragma unroll
  for (int i = 0; i < 4; ++i) {
    const int id = ltid() + 512 * i, seg = id & 7, part = (id >> 3) & 1, row = id >> 4;
    const bf16x8 v = *(const bf16x8*)(src + (size_t)row * rs + (size_t)part * po + seg * 8);
    bf16_t* d = dA + part * 64 * FR_LD + (seg * 8) * FR_LD + row;
#pragma unroll
    for (int e = 0; e < 8; ++e) d[e * FR_LD] = (bf16_t)v[e];
  }
}
DI void fourier_stage1(int WV, KArgs a, unsigned char* smem) {
  const int tid = ltid(), lane = tid & 63, wave = tid >> 6, r31 = lane & 31, h = lane >> 5, rb = wave & 3, cbk = wave >> 2;
  const bf16_t* PB = (const bf16_t*)(a->ws + WS_PB); bf16_t* V = (bf16_t*)(a->ws + WS_V);
  const bf16_t* Cw = (const bf16_t*)smem; const bf16_t* Sw = Cw + 128 * FR_LD; const bf16_t* dA = Sw + 128 * FR_LD; const bf16_t* dB = dA + 64 * FR_LD;
  for (int it = lbid(); it < 512; it += lnb()) {
    const int t2 = it >> 2, c0 = (it & 3) * 64;
    __syncthreads();
    fourier_load(WV, PB + (size_t)t2 * NPB_ + C_FA + c0, (size_t)128 * NPB_, (size_t)(C_FB - C_FA), smem);
    __syncthreads();
    f32x16 R, nI; for (int i = 0; i < 16; ++i) { R[i] = 0.f; nI[i] = 0.f; }
#pragma unroll
    for (int s = 0; s < 8; ++s) {
      const bf16x8 cw = *(const bf16x8*)(Cw + (32 * rb + r31) * FR_LD + 16 * s + 8 * h), sw = *(const bf16x8*)(Sw + (32 * rb + r31) * FR_LD + 16 * s + 8 * h);
      const bf16x8 af = *(const bf16x8*)(dA + (32 * cbk + r31) * FR_LD + 16 * s + 8 * h), bfv = *(const bf16x8*)(dB + (32 * cbk + r31) * FR_LD + 16 * s + 8 * h);
      bf16x8 nb; for (int e = 0; e < 8; ++e) nb[e] = (short)(bfv[e] ^ (short)0x8000);
      R = MFMA32(cw, af, R); R = MFMA32(sw, nb, R); nI = MFMA32(sw, af, nI); nI = MFMA32(cw, bfv, nI);
    }
    const int col = c0 + 32 * cbk + r31;
#pragma unroll
    for (int i = 0; i < 16; ++i) {
      const int k1 = 32 * rb + crow(i, h);
      const float x = (float)(k1 * t2) * (1.0f / 8192.0f); const float ct = cospif(x), st = sinpif(x);
      const float vre = R[i] * ct - nI[i] * st, vim = -nI[i] * ct - R[i] * st;
      bf16_t* vp = V + ((size_t)(k1 * 128 + t2) * 2) * 256 + col;
      vp[0] = f2bf(vre); vp[256] = f2bf(vim);
    }
  }
}
DI void fourier_stage2(int WV, KArgs a, unsigned char* smem) {
  const int tid = ltid(), lane = tid & 63, wave = tid >> 6, r31 = lane & 31, h = lane >> 5, rb = wave & 3, cbk = wave >> 2;
  const bf16_t* V = (const bf16_t*)(a->ws + WS_V); bf16_t* BR = (bf16_t*)(a->ws + WS_BR);
  const bf16_t* Cw = (const bf16_t*)smem; const bf16_t* Sw = Cw + 128 * FR_LD; const bf16_t* dA = Sw + 128 * FR_LD; const bf16_t* dB = dA + 64 * FR_LD;
  for (int it = lbid(); it < 512; it += lnb()) {
    const int k1 = it >> 2, c0 = (it & 3) * 64;
    __syncthreads();
    fourier_load(WV, V + (size_t)k1 * 128 * 512 + c0, (size_t)512, (size_t)256, smem);
    __syncthreads();
    f32x16 Y; for (int i = 0; i < 16; ++i) Y[i] = 0.f;
#pragma unroll
    for (int s = 0; s < 8; ++s) {
      const bf16x8 cw = *(const bf16x8*)(Cw + (32 * rb + r31) * FR_LD + 16 * s + 8 * h), sw = *(const bf16x8*)(Sw + (32 * rb + r31) * FR_LD + 16 * s + 8 * h);
      const bf16x8 vr = *(const bf16x8*)(dA + (32 * cbk + r31) * FR_LD + 16 * s + 8 * h), vi = *(const bf16x8*)(dB + (32 * cbk + r31) * FR_LD + 16 * s + 8 * h);
      Y = MFMA32(cw, vr, Y); Y = MFMA32(sw, vi, Y);
    }
    const int col = c0 + 32 * cbk + r31;
#pragma unroll
    for (int i = 0; i < 16; ++i) { const int k2 = 32 * rb + crow(i, h); BR[(size_t)(k1 + 128 * k2) * 1024 + col] = f2bf(Y[i] * (1.0f / 1024.0f)); }
  }
}
DI void fourier_ctx(int WV, KArgs a, unsigned char* smem) {
  const int tid = ltid();
  const bf16_t* PB = (const bf16_t*)(a->ws + WS_PB) + (size_t)L_ * NPB_; bf16_t* BR = (bf16_t*)(a->ws + WS_BR) + (size_t)L_ * 1024;
  float* ct = (float*)smem; float* st = ct + 256; float* part = st + 256;
  __syncthreads();
  if (tid < 256) { const float x = (float)tid * (1.0f / 128.0f); ct[tid] = cospif(x); st[tid] = sinpif(x); }
  __syncthreads();
  for (int k = lbid(); k < 256; k += lnb()) {
    const int col = tid & 255, half = tid >> 8;
    float acc = 0.f;
#pragma unroll 8
    for (int t = half * 128; t < half * 128 + 128; ++t) {
      const int idx = (k * t) & 255;
      acc += ct[idx] * bf2f(PB[(size_t)t * NPB_ + C_FA + col]) - st[idx] * bf2f(PB[(size_t)t * NPB_ + C_FB + col]);
    }
    if (half == 1) part[col] = acc;
    __syncthreads();
    if (half == 0) BR[(size_t)k * 1024 + col] = f2bf((acc + part[col]) * (1.0f / 128.0f));
    __syncthreads();
  }
}
DI int chunk_row0(int ci) { return ci < 128 ? ci * 128 : L_ + (ci - 128) * 128; }
DI void ret_states(int WV, KArgs a, int l, unsigned char* smem) {
  const int tid = ltid();
  const bf16_t* PB = (const bf16_t*)(a->ws + WS_PB); float* T = (float*)(a->ws + WS_T);
  const float* S = (const float*)(a->ws + WS_SCAL) + l * 64;
  float* kL = (float*)smem; float* vL = kL + 128 * 33; float* wf = vL + 128 * 64; float* wb = wf + 128;
  for (int it = lbid(); it < 130 * 6; it += lnb()) {
    const int ci = it / 6, hh = it % 6, r0 = chunk_row0(ci);
    __syncthreads();
    { const int row = tid >> 2, seg = tid & 3; const bf16x8 v = *(const bf16x8*)(PB + (size_t)(r0 + row) * NPB_ + C_RK + hh * 32 + seg * 8);
#pragma unroll
      for (int e = 0; e < 8; ++e) kL[row * 33 + seg * 8 + e] = bf2f((unsigned)(unsigned short)v[e]); }
#pragma unroll
    for (int q = 0; q < 2; ++q) { const int id = tid + 512 * q, row = id >> 3, seg = id & 7; const bf16x8 v = *(const bf16x8*)(PB + (size_t)(r0 + row) * NPB_ + C_RV + hh * 64 + seg * 8);
#pragma unroll
      for (int e = 0; e < 8; ++e) vL[row * 64 + seg * 8 + e] = bf2f((unsigned)(unsigned short)v[e]); }
    if (tid < 128) { wf[tid] = expf(S[4 + hh] * (float)(127 - tid)); wb[tid] = expf(S[10 + hh] * (float)tid); }
    __syncthreads();
    const int d = tid >> 4, v4 = (tid & 15) * 4;
    f32x4 af = {0.f, 0.f, 0.f, 0.f}, ab = {0.f, 0.f, 0.f, 0.f};
#pragma unroll 4
    for (int j = 0; j < 128; ++j) { const float kd = kL[j * 33 + d]; const f32x4 vv = *(const f32x4*)(vL + j * 64 + v4); af += vv * (kd * wf[j]); ab += vv * (kd * wb[j]); }
    float* tp = T + ((size_t)(ci * 6 + hh) * 2) * 2048 + d * 64 + v4;
    *(f32x4*)tp = af; *(f32x4*)(tp + 2048) = ab;
  }
}
DI void ret_scan(int WV, KArgs a, int l) {
  const int gt = lbid() * 512 + ltid();
  if (gt >= 6 * 2 * 2048) return;
  const int idx = gt & 2047, dir = (gt >> 11) & 1, hh = gt >> 12;
  const float* T = (const float*)(a->ws + WS_T); float* S = (float*)(a->ws + WS_S);
  const float* SC = (const float*)(a->ws + WS_SCAL) + l * 64;
  const float dec = expf(SC[4 + dir * 6 + hh] * 128.0f);
  const size_t base = (size_t)(hh * 2 + dir) * 2048 + idx; const size_t cs = (size_t)6 * 2 * 2048;
  const float tc0 = T[base + 128 * cs], tc1 = T[base + 129 * cs];
  if (dir == 0) {
    float s = tc0 * dec + tc1; S[base + 128 * cs] = 0.f; S[base + 129 * cs] = tc0;
#pragma unroll 8
    for (int i = 0; i < 128; ++i) { S[base + i * cs] = s; s = s * dec + T[base + i * cs]; }
  } else {
    float s = tc0 + dec * tc1; S[base + 129 * cs] = 0.f; S[base + 128 * cs] = tc1;
#pragma unroll 8
    for (int i = 127; i >= 0; --i) { S[base + i * cs] = s; s = s * dec + T[base + i * cs]; }
  }
}
DI void ret_out(int WV, KArgs a, int l, unsigned char* smem) {
  const int tid = ltid(), lane = tid & 63, wave = tid >> 6, r31 = lane & 31, h = lane >> 5, jb = wave & 3, vh = wave >> 2;
  const bf16_t* PB = (const bf16_t*)(a->ws + WS_PB); bf16_t* BR = (bf16_t*)(a->ws + WS_BR); const float* Sg = (const float*)(a->ws + WS_S);
  const float* SC = (const float*)(a->ws + WS_SCAL) + l * 64;
  bf16_t* Kl = (bf16_t*)smem;
  bf16_t* Vt = Kl + 128 * 40;
  bf16_t* SfT = Vt + 64 * 136;
  bf16_t* SbT = SfT + 64 * 40;
  float* pwf = (float*)(SbT + 64 * 40);
  float* pwb = pwf + 128;
  float* ssq = pwb + 128;
  for (int it = lbid(); it < 130 * 6; it += lnb()) {
    const int ci = it / 6, hh = it % 6, r0 = chunk_row0(ci);
    const float lgf = SC[4 + hh], lgb = SC[10 + hh];
    __syncthreads();
    { const int row = tid >> 2, seg = tid & 3; *(bf16x8*)(Kl + row * 40 + seg * 8) = *(const bf16x8*)(PB + (size_t)(r0 + row) * NPB_ + C_RK + hh * 32 + seg * 8); }
#pragma unroll
    for (int q = 0; q < 2; ++q) { const int id = tid + 512 * q, row = id >> 3, seg = id & 7; const bf16x8 v = *(const bf16x8*)(PB + (size_t)(r0 + row) * NPB_ + C_RV + hh * 64 + seg * 8);
#pragma unroll
      for (int e = 0; e < 8; ++e) Vt[(seg * 8 + e) * 136 + row] = (bf16_t)v[e]; }
#pragma unroll
    for (int q = 0; q < 8; ++q) { const int e = tid + 512 * q, dir = e >> 11, idx = e & 2047, d = idx >> 6, v = idx & 63;
      const float sv = Sg[((size_t)(ci * 6 + hh) * 2 + dir) * 2048 + idx]; (dir ? SbT : SfT)[v * 40 + d] = f2bf(sv); }
    if (tid < 128) { pwf[tid] = expf(lgf * (float)tid); pwb[tid] = expf(lgb * (float)tid); }
    const int qrow = r0 + 32 * jb + r31, j = 32 * jb + r31;
    bf16x8 qf[2];
#pragma unroll
    for (int s = 0; s < 2; ++s) qf[s] = *(const bf16x8*)(PB + (size_t)qrow * NPB_ + C_RQ + hh * 32 + 16 * s + 8 * h);
    __syncthreads();
    f32x16 O; for (int i = 0; i < 16; ++i) O[i] = 0.f;
#pragma unroll
    for (int kb = 0; kb < 4; ++kb) {
      f32x16 St; for (int i = 0; i < 16; ++i) St[i] = 0.f;
#pragma unroll
      for (int s = 0; s < 2; ++s) { const bf16x8 kf = *(const bf16x8*)(Kl + (32 * kb + r31) * 40 + 16 * s + 8 * h); St = MFMA32(kf, qf[s], St); }
#pragma unroll
      for (int i = 0; i < 16; ++i) { const int jp = 32 * kb + crow(i, h); const int dl = j - jp; const float dv = dl > 0 ? pwf[dl] : (dl < 0 ? pwb[-dl] : 2.0f); St[i] *= dv; }
#pragma unroll
      for (int s = 0; s < 2; ++s) {
        const bf16x8 pb = pack_step(St, s);
        const bf16_t* vp = Vt + (32 * vh + r31) * 136 + 32 * kb + 16 * s + 4 * h;
        const s16x4 lo = *(const s16x4*)vp, hi = *(const s16x4*)(vp + 8);
        const bf16x8 vf = __builtin_shufflevector(lo, hi, 0, 1, 2, 3, 4, 5, 6, 7);
        O = MFMA32(vf, pb, O);
      }
    }
    f32x16 Of, Ob; for (int i = 0; i < 16; ++i) { Of[i] = 0.f; Ob[i] = 0.f; }
#pragma unroll
    for (int s = 0; s < 2; ++s) {
      const bf16x8 sf = *(const bf16x8*)(SfT + (32 * vh + r31) * 40 + 16 * s + 8 * h), sb = *(const bf16x8*)(SbT + (32 * vh + r31) * 40 + 16 * s + 8 * h);
      Of = MFMA32(sf, qf[s], Of); Ob = MFMA32(sb, qf[s], Ob);
    }
    const float qdf = expf(lgf * (float)(j + 1)), qdb = expf(lgb * (float)(128 - j));
    float ss = 0.f;
#pragma unroll
    for (int i = 0; i < 16; ++i) { O[i] = O[i] + Of[i] * qdf + Ob[i] * qdb; ss += O[i] * O[i]; }
    ss += shx(ss, 32, lane_id_v());
    if (h == 0) ssq[vh * 128 + j] = ss;
    __syncthreads();
    const float rstd = rsqrtf((ssq[j] + ssq[128 + j]) * (1.0f / 64.0f) + EPS_);
#pragma unroll
    for (int g4 = 0; g4 < 4; ++g4) {
      const int v0 = 32 * vh + 8 * g4 + 4 * h;
      const u32x2 gw = *(const u32x2*)(PB + (size_t)qrow * NPB_ + C_RG + hh * 64 + v0);
      const float g0 = bf2f(gw.x & 0xffffu), g1 = bf2f(gw.x >> 16), g2 = bf2f(gw.y & 0xffffu), g3 = bf2f(gw.y >> 16);
      u32x2 w; w.x = cvt_pk_bf16(O[4 * g4] * rstd * g0, O[4 * g4 + 1] * rstd * g1); w.y = cvt_pk_bf16(O[4 * g4 + 2] * rstd * g2, O[4 * g4 + 3] * rstd * g3);
      *(u32x2*)(BR + (size_t)qrow * 1024 + 256 + hh * 64 + v0) = w;
    }
  }
}
constexpr int AT_LD = 72;
typedef __bf16 bf16x2_t __attribute__((ext_vector_type(2)));
typedef float f32x2_t __attribute__((ext_vector_type(2)));
DI unsigned cvt2(float a, float b) { f32x2_t v = {a, b}; return __builtin_bit_cast(unsigned, __builtin_convertvector(v, bf16x2_t)); }
template <int VAR> DI void attn_phase(int WV, KArgs a, int l, bool with_ctx, unsigned char* smem) {
  const int tid = ltid(), lane = tid & 63, wave = tid >> 6, r31 = lane & 31, h = lane >> 5, qsub = wave & 3, kh = wave >> 2;
  const bf16_t* PB = (const bf16_t*)(a->ws + WS_PB); bf16_t* BR = (bf16_t*)(a->ws + (VAR == 0 ? WS_BR : WS_H));
  const float* SC = (const float*)(a->ws + WS_SCAL) + l * 64;
  const float lam = SC[0], lam_init = SC[1];
  bf16_t* Ks = (bf16_t*)smem;
  bf16_t* Vt = Ks + 2 * 64 * AT_LD;
  float* cmb = (float*)(Vt + 2 * 64 * AT_LD);
  const int nitems = 6 * 128 + (with_ctx ? 12 : 0);
  const int skey = tid >> 3, sseg = tid & 7;
  for (int it = lbid(); it < nitems; it += lnb()) {
    int head, q0, krow0, nt;
    if (it < 768) { head = (it >> 8) * 2 + (it & 1); q0 = ((it & 255) >> 1) * 128; krow0 = 0; nt = MT_ / 64; }
    else { const int e = it - 768; head = e >> 1; q0 = L_ + (e & 1) * 128; krow0 = L_; nt = LC_ / 64; }
    const int qrow = q0 + 32 * qsub + r31;
    bf16x8 qf[2][2];
#pragma unroll
    for (int mp = 0; mp < 2; ++mp)
#pragma unroll
      for (int s = 0; s < 2; ++s) qf[mp][s] = *(const bf16x8*)(PB + (size_t)qrow * NPB_ + C_DQ + head * 64 + mp * 32 + 16 * s + 8 * h);
    float negm = 0.f;
#pragma unroll
    for (int mp = 0; mp < 2; ++mp) {
      float ss = 0.f;
#pragma unroll
      for (int s = 0; s < 2; ++s)
#pragma unroll
        for (int e = 0; e < 8; ++e) { const float x = bf2f((unsigned)(unsigned short)qf[mp][s][e]); ss += x * x; }
      ss += shx(ss, 32, lane_id_v());
      const float kmx = __uint_as_float(((const unsigned*)SC)[16 + head * 2 + mp]);
      negm = fminf(negm, -sqrtf(ss * kmx) * 1.01f);
    }
    f32x16 NM; for (int i = 0; i < 16; ++i) NM[i] = negm;
    f32x16 O1[2], O2[2]; for (int i = 0; i < 16; ++i) { O1[0][i] = 0.f; O1[1][i] = 0.f; O2[0][i] = 0.f; O2[1][i] = 0.f; }
    f32x4 LA = {0.f, 0.f, 0.f, 0.f}, LB = {0.f, 0.f, 0.f, 0.f};
    bf16x8 osel; { const bool on = ((lane & 15) == 0 && ((lane >> 4) & 1) == 0) || ((lane & 15) == 1 && ((lane >> 4) & 1) == 1);
      for (int e = 0; e < 8; ++e) osel[e] = on ? (short)0x3F80 : (short)0; }
#define MFMA16(a_, b_, c_) __builtin_amdgcn_mfma_f32_16x16x32_bf16((a_), (b_), (c_), 0, 0, 0)
    const bf16_t* kg = PB + (size_t)(krow0 + skey) * NPB_ + C_DK + head * 64 + sseg * 8;
    const bf16_t* vg = PB + (size_t)(krow0 + skey) * NPB_ + C_DV + head * 64 + sseg * 8;
    const int vslot = ((skey & ~12) | ((skey & 4) << 1) | ((skey & 8) >> 1)) ^ (sseg << 3);
    __syncthreads();
    bf16x8 kA = *(const bf16x8*)kg, vA = *(const bf16x8*)vg;
    bf16x8 kB = *(const bf16x8*)(kg + (size_t)64 * NPB_), vB = *(const bf16x8*)(vg + (size_t)64 * NPB_);
    { *(bf16x8*)(Ks + skey * AT_LD + sseg * 8) = kA;
#pragma unroll
      for (int e = 0; e < 8; ++e) Vt[(sseg * 8 + e) * AT_LD + vslot] = (bf16_t)vA[e]; }
    __syncthreads();
    for (int t = 0; t < nt; ++t) {
      const int buf = t & 1;
      const bf16_t* ks = Ks + buf * 64 * AT_LD + (32 * kh + r31) * AT_LD + 8 * h;
      const bf16_t* vt = Vt + buf * 64 * AT_LD + r31 * AT_LD;
      const bf16x8 k00 = *(const bf16x8*)(ks), k01 = *(const bf16x8*)(ks + 16), k10 = *(const bf16x8*)(ks + 32), k11 = *(const bf16x8*)(ks + 48);
      bf16x8 vf[2][2];
#pragma unroll
      for (int s = 0; s < 2; ++s)
#pragma unroll
        for (int mt = 0; mt < 2; ++mt) vf[mt][s] = *(const bf16x8*)(vt + mt * 32 * AT_LD + (((4 * kh + 2 * s + h) ^ ((4 * mt + (r31 >> 3)) & 7)) << 3));
      f32x16 S1 = MFMA32(k00, qf[0][0], NM); f32x16 S2 = MFMA32(k10, qf[1][0], NM); S1 = MFMA32(k01, qf[0][1], S1); S2 = MFMA32(k11, qf[1][1], S2);
      bf16x8 p1[2], p2[2];
      { u32x4 w0, w1;
#pragma unroll
        for (int i = 0; i < 4; ++i) { w0[i] = cvt2(VAR == 1 ? S1[2 * i] * 0.001f : __builtin_amdgcn_exp2f(S1[2 * i]), VAR == 1 ? S1[2 * i + 1] * 0.001f : __builtin_amdgcn_exp2f(S1[2 * i + 1]));
                                       w1[i] = cvt2(VAR == 1 ? S1[8 + 2 * i] * 0.001f : __builtin_amdgcn_exp2f(S1[8 + 2 * i]), VAR == 1 ? S1[9 + 2 * i] * 0.001f : __builtin_amdgcn_exp2f(S1[9 + 2 * i])); }
        p1[0] = __builtin_bit_cast(bf16x8, w0); p1[1] = __builtin_bit_cast(bf16x8, w1); }
      O1[0] = MFMA32(vf[0][0], p1[0], O1[0]); O1[1] = MFMA32(vf[1][0], p1[0], O1[1]); LA = MFMA16(osel, p1[0], LA);
      O1[0] = MFMA32(vf[0][1], p1[1], O1[0]); O1[1] = MFMA32(vf[1][1], p1[1], O1[1]); LA = MFMA16(osel, p1[1], LA);
      { u32x4 w0, w1;
#pragma unroll
        for (int i = 0; i < 4; ++i) { w0[i] = cvt2(VAR == 1 ? S2[2 * i] * 0.001f : __builtin_amdgcn_exp2f(S2[2 * i]), VAR == 1 ? S2[2 * i + 1] * 0.001f : __builtin_amdgcn_exp2f(S2[2 * i + 1]));
                                       w1[i] = cvt2(VAR == 1 ? S2[8 + 2 * i] * 0.001f : __builtin_amdgcn_exp2f(S2[8 + 2 * i]), VAR == 1 ? S2[9 + 2 * i] * 0.001f : __builtin_amdgcn_exp2f(S2[9 + 2 * i])); }
        p2[0] = __builtin_bit_cast(bf16x8, w0); p2[1] = __builtin_bit_cast(bf16x8, w1); }
      if (VAR != 5) {
      O2[0] = MFMA32(vf[0][0], p2[0], O2[0]); O2[1] = MFMA32(vf[1][0], p2[0], O2[1]); LB = MFMA16(osel, p2[0], LB);
      O2[0] = MFMA32(vf[0][1], p2[1], O2[0]); O2[1] = MFMA32(vf[1][1], p2[1], O2[1]); LB = MFMA16(osel, p2[1], LB); }
      __builtin_amdgcn_sched_group_barrier(0x100, 8, 0);
      __builtin_amdgcn_sched_group_barrier(0x8, 4, 0);
      __builtin_amdgcn_sched_group_barrier(0x402, 24, 0);
#pragma unroll
      for (int i = 0; i < 6; ++i) { __builtin_amdgcn_sched_group_barrier(0x8, 1, 0); __builtin_amdgcn_sched_group_barrier(0x402, 4, 0); }
      { const int nb_ = buf ^ 1;
        *(bf16x8*)(Ks + nb_ * 64 * AT_LD + skey * AT_LD + sseg * 8) = kB;
#pragma unroll
        for (int e = 0; e < 8; ++e) Vt[nb_ * 64 * AT_LD + (sseg * 8 + e) * AT_LD + vslot] = (bf16_t)vB[e];
        const int tl_ = (t + 2 < nt) ? t + 2 : nt - 1;
        kB = *(const bf16x8*)(kg + (size_t)tl_ * 64 * NPB_); vB = *(const bf16x8*)(vg + (size_t)tl_ * 64 * NPB_); }
#pragma unroll
      for (int i = 0; i < 5; ++i) { __builtin_amdgcn_sched_group_barrier(0x8, 1, 0); __builtin_amdgcn_sched_group_barrier(0x200, 2, 0); }
      __builtin_amdgcn_sched_group_barrier(0x8, 1, 0); __builtin_amdgcn_sched_group_barrier(0x20, 2, 0);
      __syncthreads();
    }
    float* cw = cmb + (size_t)(qsub * 64 + lane) * 66;
    const int sl_ = ((lane & 15) << 2);
    const float a0_ = __int_as_float(__builtin_amdgcn_ds_bpermute(sl_, __float_as_int(LA[0]))), a1_ = __int_as_float(__builtin_amdgcn_ds_bpermute(sl_, __float_as_int(LA[1])));
    const float b0_ = __int_as_float(__builtin_amdgcn_ds_bpermute(sl_, __float_as_int(LB[0]))), b1_ = __int_as_float(__builtin_amdgcn_ds_bpermute(sl_, __float_as_int(LB[1])));
    const float lq1 = (r31 >> 4) ? a1_ : a0_, lq2 = (r31 >> 4) ? b1_ : b0_;
    if (kh == 1) {
#pragma unroll
      for (int i = 0; i < 16; ++i) { cw[i] = O1[0][i]; cw[16 + i] = O1[1][i]; cw[32 + i] = O2[0][i]; cw[48 + i] = O2[1][i]; }
      cw[64] = lq1; cw[65] = lq2;
    }
    __syncthreads();
    if (kh == 0) {
#pragma unroll
      for (int i = 0; i < 16; ++i) { O1[0][i] += cw[i]; O1[1][i] += cw[16 + i]; O2[0][i] += cw[32 + i]; O2[1][i] += cw[48 + i]; }
      const float l1 = lq1 + cw[64], l2 = lq2 + cw[65];
      const float i1 = 1.0f / l1, i2 = lam / l2;
      float ss = 0.f;
#pragma unroll
      for (int mt = 0; mt < 2; ++mt)
#pragma unroll
        for (int i = 0; i < 16; ++i) { const float o = O1[mt][i] * i1 - O2[mt][i] * i2; O1[mt][i] = o; ss += o * o; }
      ss += shx(ss, 32, lane_id_v());
      const float sc = rsqrtf(ss * (1.0f / 64.0f) + EPS_) * (1.0f - lam_init);
      const float* sw = a->in[13] + l * 64;
#pragma unroll
      for (int mt = 0; mt < 2; ++mt)
#pragma unroll
        for (int g4 = 0; g4 < 4; ++g4) {
          const int v0 = 32 * mt + 8 * g4 + 4 * h;
          const f32x4 wv = *(const f32x4*)(sw + v0);
          u32x2 w; w.x = cvt_pk_bf16(O1[mt][4 * g4] * sc * wv[0], O1[mt][4 * g4 + 1] * sc * wv[1]); w.y = cvt_pk_bf16(O1[mt][4 * g4 + 2] * sc * wv[2], O1[mt][4 * g4 + 3] * sc * wv[3]);
          *(u32x2*)(BR + (size_t)qrow * 1024 + 640 + head * 64 + v0) = w;
        }
    }
  }
}
template <class Epi> DI void run_gemm(int WV, LAS unsigned char* lds, const bf16_t* A, int lda, const bf16_t* Bt, int M, int N, int K, const Epi& E) {
  pg8::Gemm g; g.A = A; g.Bt = Bt; g.M = M; g.N = N; g.K = K; g.lda = lda;
  pg8::StaticOrder S; S.init(M, N, lnb(), lbid());
  pg8::gemm_phase<Epi, pg8::StaticOrder, false>(WV, lds, g, S, E, nullptr);
}
struct CtxMerge0 { float* MXC; const bf16_t* G; DI void operator()(int r, int c, float v) const { MXC[r * 1024 + c] = bf2f(G[(size_t)r * NGB_ + c]) * v; } };
struct CtxMerge1 { float* MXC; const bf16_t* G; DI void operator()(int r, int c, float v) const { MXC[r * 1024 + c] += bf2f(G[(size_t)r * NGB_ + c]) * v; } };
struct CtxMerge2 { const float* MXC; const bf16_t* G; bf16_t* Hc; DI void operator()(int r, int c, float v) const { Hc[r * 1024 + c] = f2bf(MXC[r * 1024 + c] + bf2f(G[(size_t)r * NGB_ + c]) * v); } };
struct CtxResid { float* Xc; const float* gate; float scale; DI void operator()(int r, int c, float v) const { Xc[r * 1024 + c] += scale * gate[c] * v; } };

DI void phase_win(int WV, int l, unsigned char* smem) {
  KArgs a = kargs(); unsigned char* ws = a->ws;
  EpiWin E; E.PB = (bf16_t*)(ws + WS_PB); E.GB = (bf16_t*)(ws + WS_GB); E.TRET = (const float*)(ws + WS_TRET); E.TROW = (const float*)(ws + WS_TROW); E.TCOL = (const float*)(ws + WS_TCOL);
  E.kmax = (unsigned*)(ws + WS_SCAL) + l * 64 + 16;
  run_gemm(WV, (LAS unsigned char*)smem, (const bf16_t*)(ws + WS_H), 1024, (const bf16_t*)(ws + WS_WIN) + (size_t)l * 5888 * 1024, MT_, NWIN_, 1024, E);
}
DI void phase_merge(int WV, int l, unsigned char* smem) {
  LAS unsigned char* lds = (LAS unsigned char*)smem;
  { KArgs a = kargs(); unsigned char* ws = a->ws; EpiMerge<0> E; E.MX = a->out; E.G = (const bf16_t*)(ws + WS_GB); E.Hout = (bf16_t*)(ws + WS_H);
    run_gemm(WV, lds, (const bf16_t*)(ws + WS_BR), 1024, (const bf16_t*)(ws + WS_WBF) + (size_t)l * 1024 * 256, L_, 1024, 256, E); }
  { KArgs a = kargs(); unsigned char* ws = a->ws; EpiMerge<1> E; E.MX = a->out; E.G = (const bf16_t*)(ws + WS_GB) + 1024; E.Hout = (bf16_t*)(ws + WS_H);
    run_gemm(WV, lds, (const bf16_t*)(ws + WS_BR) + 256, 1024, (const bf16_t*)(ws + WS_WBR) + (size_t)l * 1024 * 384, L_, 1024, 384, E); }
  { KArgs a = kargs(); unsigned char* ws = a->ws; EpiMerge<2> E; E.MX = a->out; E.G = (const bf16_t*)(ws + WS_GB) + 2048; E.Hout = (bf16_t*)(ws + WS_H);
    run_gemm(WV, lds, (const bf16_t*)(ws + WS_BR) + 640, 1024, (const bf16_t*)(ws + WS_WBD) + (size_t)l * 1024 * 384, L_, 1024, 384, E); }
  { KArgs a = kargs(); unsigned char* ws = a->ws;
    const bf16_t* BRc = (const bf16_t*)(ws + WS_BR) + (size_t)L_ * 1024; const bf16_t* GBc = (const bf16_t*)(ws + WS_GB) + (size_t)L_ * NGB_;
    CtxMerge0 e0; e0.MXC = (float*)(ws + WS_MXC); e0.G = GBc;
    ctx_gemm32(WV, BRc, 1024, (const bf16_t*)(ws + WS_WBF) + (size_t)l * 1024 * 256, 256, 1024, smem, e0);
    CtxMerge1 e1; e1.MXC = (float*)(ws + WS_MXC); e1.G = GBc + 1024;
    ctx_gemm32(WV, BRc + 256, 1024, (const bf16_t*)(ws + WS_WBR) + (size_t)l * 1024 * 384, 384, 1024, smem, e1);
    CtxMerge2 e2; e2.MXC = (const float*)(ws + WS_MXC); e2.G = GBc + 2048; e2.Hc = (bf16_t*)(ws + WS_H) + (size_t)L_ * 1024;
    ctx_gemm32(WV, BRc + 640, 1024, (const bf16_t*)(ws + WS_WBD) + (size_t)l * 1024 * 384, 384, 1024, smem, e2); }
}
DI void phase_wo(int WV, int l, unsigned char* smem) {
  { KArgs a = kargs(); unsigned char* ws = a->ws; EpiResid E; E.X = (float*)(ws + WS_X); E.gate = (const float*)(ws + WS_MOD) + (size_t)l * 9216 + 5 * 1024; E.scale = 1.0f;
    run_gemm(WV, (LAS unsigned char*)smem, (const bf16_t*)(ws + WS_H), 1024, (const bf16_t*)(ws + WS_WO) + (size_t)l * 1024 * 1024, L_, 1024, 1024, E); }
  { KArgs a = kargs(); unsigned char* ws = a->ws; CtxResid e; e.Xc = (float*)(ws + WS_X) + (size_t)L_ * 1024; e.gate = (const float*)(ws + WS_MOD) + (size_t)(4 + l) * 9216 + 5 * 1024; e.scale = 1.0f;
    ctx_gemm32(WV, (const bf16_t*)(ws + WS_H) + (size_t)L_ * 1024, 1024, (const bf16_t*)(ws + WS_WO) + (size_t)l * 1024 * 1024, 1024, 1024, smem, e); }
}
DI void phase_g1(int WV, int l, int f, unsigned char* smem) {
  KArgs a = kargs(); unsigned char* ws = a->ws; EpiSwiglu E; E.U = (bf16_t*)(ws + WS_U);
  run_gemm(WV, (LAS unsigned char*)smem, (const bf16_t*)(ws + WS_H), 1024, (const bf16_t*)(ws + WS_W13) + (size_t)(l * 2 + f) * 5632 * 1024, MT_, 5632, 1024, E);
}
DI void phase_g2(int WV, int l, int f, unsigned char* smem) {
  const int gi = f == 0 ? 2 : 8;
  { KArgs a = kargs(); unsigned char* ws = a->ws; EpiResid E; E.X = (float*)(ws + WS_X); E.gate = (const float*)(ws + WS_MOD) + (size_t)l * 9216 + gi * 1024; E.scale = 0.5f;
    run_gemm(WV, (LAS unsigned char*)smem, (const bf16_t*)(ws + WS_U), 2816, (const bf16_t*)(ws + WS_W2) + (size_t)(l * 2 + f) * 1024 * 2816, L_, 1024, 2816, E); }
  { KArgs a = kargs(); unsigned char* ws = a->ws; CtxResid e; e.Xc = (float*)(ws + WS_X) + (size_t)L_ * 1024; e.gate = (const float*)(ws + WS_MOD) + (size_t)(4 + l) * 9216 + gi * 1024; e.scale = 0.5f;
    ctx_gemm32(WV, (const bf16_t*)(ws + WS_U) + (size_t)L_ * 2816, 2816, (const bf16_t*)(ws + WS_W2) + (size_t)(l * 2 + f) * 1024 * 2816, 2816, 1024, smem, e); }
}

DI void grid_bar(int WV, unsigned& gen) {
  asm volatile("s_waitcnt vmcnt(0)" ::: "memory");
  __syncthreads();
  gen += 1;
  if (ltid() == 0) {
    unsigned* cnt = (unsigned*)(kargs()->ws + WS_BAR);
    __builtin_amdgcn_fence(__ATOMIC_RELEASE, "agent");
    asm volatile("s_waitcnt vmcnt(0)" ::: "memory");
    __hip_atomic_fetch_add(cnt, 1u, __ATOMIC_RELAXED, __HIP_MEMORY_SCOPE_AGENT);
    const unsigned target = gen * (unsigned)lnb();
    while (__hip_atomic_load(cnt, __ATOMIC_RELAXED, __HIP_MEMORY_SCOPE_AGENT) < target) __builtin_amdgcn_s_sleep(2);
    __builtin_amdgcn_fence(__ATOMIC_ACQUIRE, "agent");
    asm volatile("s_waitcnt vmcnt(0)" ::: "memory");
  }
  __syncthreads();
}

__global__ void __launch_bounds__(512, 2) mega(Args a_unused) {
  extern __shared__ __attribute__((aligned(16))) unsigned char smem[];
  cg::grid_group grid = cg::this_grid();
  const int WV = __builtin_amdgcn_readfirstlane((int)(threadIdx.x >> 6));
#ifndef NO_PRO
  prologue(WV, kargs(), smem);
#ifdef PROBE_PRO
  __syncthreads(); prologue(WV, kargs(), smem);
#endif
#endif
  grid.sync();
  unsigned gen = 0;
#pragma unroll 1
  for (int l = 0; l < DEPTH_; ++l) {
#pragma unroll 1
    for (int f = 0; f < 2; ++f) {
      if (f == 1) {
        norm_phase(WV, kargs(), l, 1, false);
        grid_bar(WV, gen);
        phase_win(WV, l, smem);
#ifdef PROBE_WIN
        phase_win(WV, l, smem);
#endif
        grid_bar(WV, gen);
#ifndef NO_MIXA
        fourier_tables(WV, smem); __syncthreads(); fourier_stage1(WV, kargs(), smem); fourier_ctx(WV, kargs(), smem); __syncthreads(); ret_states(WV, kargs(), l, smem);
#ifdef PROBE_MIXA
        __syncthreads();
        fourier_tables(WV, smem); __syncthreads(); fourier_stage1(WV, kargs(), smem); fourier_ctx(WV, kargs(), smem); __syncthreads(); ret_states(WV, kargs(), l, smem);
#endif
#endif
        grid_bar(WV, gen);
#ifndef NO_MIXB
        ret_scan(WV, kargs(), l); __syncthreads(); fourier_tables(WV, smem); __syncthreads(); fourier_stage2(WV, kargs(), smem);
#ifdef PROBE_MIXB
        __syncthreads();
        ret_scan(WV, kargs(), l); __syncthreads(); fourier_tables(WV, smem); __syncthreads(); fourier_stage2(WV, kargs(), smem);
#endif
#endif
        grid_bar(WV, gen);
#ifndef NO_RETOUT
        ret_out(WV, kargs(), l, smem); __syncthreads();
#ifdef PROBE_RET
        ret_out(WV, kargs(), l, smem); __syncthreads();
#endif
#endif
#ifndef NO_ATTN
        attn_phase<0>(WV, kargs(), l, l < DEPTH_ - 1, smem);
#ifdef PROBE_ATTN
        __syncthreads(); attn_phase<PROBE_ATTN>(WV, kargs(), l, l < DEPTH_ - 1, smem);
#endif
#endif
        grid_bar(WV, gen);
        phase_merge(WV, l, smem);
#ifdef PROBE_MERGE
        phase_merge(WV, l, smem);
#endif
        grid_bar(WV, gen);
        phase_wo(WV, l, smem);
        grid_bar(WV, gen);
      }
      norm_phase(WV, kargs(), l, f == 0 ? 0 : 2, l == 0 && f == 0);
      grid_bar(WV, gen);
      phase_g1(WV, l, f, smem);
#ifdef PROBE_G1
      phase_g1(WV, l, f, smem);
#endif
      grid_bar(WV, gen);
      phase_g2(WV, l, f, smem);
      grid_bar(WV, gen);
    }
  }
  final_norm(WV, kargs());
}

extern "C" void kernel_launch(void* const* d_in, const int* in_sizes, int n_in, void* d_out, int out_size, void* d_ws, size_t ws_size, hipStream_t stream) {
  static int grid = 0;
  if (grid == 0) {
    int dev = 0, cus = 0, per_cu = 0;
    (void)hipGetDevice(&dev); (void)hipDeviceGetAttribute(&cus, hipDeviceAttributeMultiprocessorCount, dev);
    if (hipFuncSetAttribute((const void*)mega, hipFuncAttributeMaxDynamicSharedMemorySize, LDS_BYTES) != hipSuccess) fprintf(stderr, "kernel_launch: hipFuncSetAttribute failed\n");
    if (hipOccupancyMaxActiveBlocksPerMultiprocessor(&per_cu, (const void*)mega, 512, LDS_BYTES) != hipSuccess || per_cu < 1) fprintf(stderr, "kernel_launch: occupancy query says %d blocks per CU\n", per_cu);
    (void)hipGetLastError();
    grid = cus > 0 ? cus : 256;
    if (ws_size < WS_END) { fprintf(stderr, "kernel_launch: workspace too small: %zu < %zu\n", ws_size, (size_t)WS_END); }
  }
  Args a{};
  for (int i = 0; i < 19; ++i) a.in[i] = (const float*)d_in[i];
  a.out = (float*)d_out; a.ws = (unsigned char*)d_ws;
  (void)hipMemsetAsync((unsigned char*)d_ws + WS_BAR, 0, 256, stream);
  void* args[] = {&a};
  hipError_t e = hipLaunchCooperativeKernel((const void*)mega, dim3(grid), dim3(512), args, LDS_BYTES, stream);
  if (e != hipSuccess) fprintf(stderr, "kernel_launch: cooperative launch failed: %s (grid %d)\n", hipGetErrorString(e), grid);
}
```

```cpp
#include <hip/hip_runtime.h>
#include <hip/hip_cooperative_groups.h>
#include <cstdio>
namespace cg = cooperative_groups;
__device__ __forceinline__ int lane_id_v() { int l; asm volatile("v_mbcnt_lo_u32_b32 %0, -1, 0\n\tv_mbcnt_hi_u32_b32 %0, -1, %0" : "=v"(l)); return l; }
#define ltid() ((WV << 6) | lane_id_v())
__device__ __forceinline__ float shx(float v, int m, int lane) { return __int_as_float(__builtin_amdgcn_ds_bpermute((lane ^ m) << 2, __float_as_int(v))); }
namespace pg8 {
#define PG8_LAS __attribute__((address_space(3)))
typedef unsigned short bf16_t;
typedef short bf16x8 __attribute__((ext_vector_type(8)));
typedef float f32x4 __attribute__((ext_vector_type(4)));
typedef unsigned u32x4 __attribute__((ext_vector_type(4)));
constexpr int BM = 256, BK = 64, HALF = 128, HTB = HALF * BK * 2  , STAGE_BYTES = 8 * HTB, NXCD = 8, WGM = 8;

__host__ __device__ __forceinline__ int lds_byte(int r, int c) { const int st = (r >> 4) * 2 + (c >> 5), rr = r & 15, cc = c & 31, ob = rr * 64 + cc * 2; return st * 1024 + (ob ^ (((ob >> 9) & 1) << 5)); }
__host__ __device__ __forceinline__ void stage_rc(int b, int& R, int& C) { const int st = b / 1024, sb = b % 1024, swz = sb ^ (((sb >> 9) & 1) << 5); R = (st >> 1) * 16 + swz / 64; C = (st & 1) * 32 + (swz % 64) / 2; }
__host__ __device__ __forceinline__ int perm32(int rho) { const int n = rho >> 4, i = rho & 15; return 8 * (i >> 2) + 4 * n + (i & 3); }

struct Unit { int pm, pn; };
struct Gemm { const bf16_t* A; const bf16_t* Bt; int M, N, K, lda; };

struct StaticOrder {
    int nM, nN, nwg, G, c;
    __host__ __device__ void init(int M, int N, int G_, int c_) { nM = M / BM; nN = N / BM; nwg = nM * nN; G = G_; c = c_; }
    __host__ __device__ bool next(int i, Unit& u) const {
        const long L = (long)i * G + c; if (L >= nwg) return false;
        int wgid = (int)L; { const int q = nwg / NXCD, r = nwg % NXCD, xcd = wgid % NXCD, off = wgid / NXCD; wgid = (xcd < r ? xcd * (q + 1) : r * (q + 1) + (xcd - r) * q) + off; }
        const int nig = WGM * nN, gid = wgid / nig, fm = gid * WGM, gsz = (nM - fm) < WGM ? (nM - fm) : WGM;
        u.pm = fm + ((wgid % nig) % gsz); u.pn = (wgid % nig) / gsz; return true;
    }
    __device__ __forceinline__ void a_ready(const Unit&) const {}
    __device__ __forceinline__ void done(const Unit&) const {}
};
__device__ __forceinline__ unsigned cvt_pk_bf16(float lo, float hi) { unsigned r; asm volatile("v_cvt_pk_bf16_f32 %0, %1, %2" : "=v"(r) : "v"(lo), "v"(hi)); return r; }
template <class Epi, class Sched, bool STAMP = false>
__device__ __forceinline__ void gemm_phase(const int WV, PG8_LAS unsigned char* lds, const Gemm g, const Sched& S, const Epi& E, unsigned long long* stamps) {
    const int tid = ltid(); const int wid = __builtin_amdgcn_readfirstlane(tid >> 6), lane = tid & 63, wr = wid >> 2, wc = wid & 3, fr = lane & 15, fq = lane >> 4;
    const int K = g.K, nt = K / BK;
    int ts_lo = 0, ts_hi = 0, nts = 0; const unsigned long long rt_entry = STAMP ? (unsigned long long)wall_clock64() : 0ull;
#define PG8_STAMP() do { if (STAMP && wid == 0 && nts < 64) { const unsigned long long _c = (unsigned long long)clock64(); \
        ts_lo = (lane == nts) ? (int)(unsigned)_c : ts_lo; ts_hi = (lane == nts) ? (int)(unsigned)(_c >> 32) : ts_hi; ++nts; } } while (0)
    PG8_STAMP();
    unsigned voffA[2], voffB[2];
#pragma unroll
    for (int i = 0; i < 2; ++i) { int R, C; stage_rc(tid * 16 + i * 8192, R, C); const int Rb = Epi::PERM ? ((R & ~31) + perm32(R & 31)) : R;
        voffA[i] = (unsigned)(R * g.lda + C) * 2u; voffB[i] = (unsigned)(Rb * K + C) * 2u; }
    const size_t kstep = (size_t)(BK * 2);
    const size_t hstep = (size_t)HALF * K * 2;
    const size_t tstep = 2 * hstep; const size_t hstepA = (size_t)HALF * g.lda * 2; const size_t tstepA = 2 * hstepA;
    const unsigned ldsw = (unsigned)wid * 1024u;
    const int aoff = lds_byte(wr * 64 + fr, fq * 8), boff = lds_byte(wc * 32 + fr, fq * 8);
#define PG8_SA(b, h) (((b) * 2 + (h)) * HTB)
#define PG8_SB(b, h) ((4 + (b) * 2 + (h)) * HTB)
#define PG8_STAGE(bufoff, gbase, voff) do { _Pragma("unroll") for (int _i = 0; _i < 2; ++_i) \
        __builtin_amdgcn_global_load_lds((const unsigned*)((const char*)(gbase) + (voff)[_i]), (PG8_LAS unsigned*)(lds + (bufoff) + ldsw + _i * 8192), 16, 0, 0); } while (0)
#define PG8_LDA(dst, b, h) do { _Pragma("unroll") for (int m = 0; m < 4; ++m) _Pragma("unroll") for (int k = 0; k < 2; ++k) dst[m][k] = *(const PG8_LAS bf16x8*)(lds + PG8_SA(b, h) + aoff + m * 2048 + k * 1024); } while (0)
#define PG8_LDB(dst, b, h) do { _Pragma("unroll") for (int n = 0; n < 2; ++n) _Pragma("unroll") for (int k = 0; k < 2; ++k) dst[n][k] = *(const PG8_LAS bf16x8*)(lds + PG8_SB(b, h) + boff + n * 2048 + k * 1024); } while (0)
#define PG8_MMA(ai, bj, At, Bt) do { __builtin_amdgcn_s_setprio(1); _Pragma("unroll") for (int m = 0; m < 4; ++m) _Pragma("unroll") for (int n = 0; n < 2; ++n) _Pragma("unroll") for (int k = 0; k < 2; ++k) \
        acc[ai][bj][m][n] = __builtin_amdgcn_mfma_f32_16x16x32_bf16(Bt[n][k], At[m][k], acc[ai][bj][m][n], 0, 0, 0); __builtin_amdgcn_s_setprio(0); } while (0)
#define PG8_WAIT_V(n) asm volatile("s_waitcnt vmcnt(" #n ")" ::: "memory")
#define PG8_WAIT_L(n) asm volatile("s_waitcnt lgkmcnt(" #n ")" ::: "memory")
#define PG8_BAR __builtin_amdgcn_s_barrier()
#define PG8_SCHED __builtin_amdgcn_sched_barrier(0)
    Unit cur, nxt; int ui = 0;
    if (!S.next(0, cur)) return;
    f32x4 acc[2][2][4][2];
#pragma unroll
    for (int a = 0; a < 2; ++a)
#pragma unroll
        for (int b = 0; b < 2; ++b)
#pragma unroll
            for (int m = 0; m < 4; ++m)
#pragma unroll
                for (int n = 0; n < 2; ++n) acc[a][b][m][n] = (f32x4){0.f, 0.f, 0.f, 0.f};
    bf16x8 At[4][2], B0[2][2], B1[2][2];
    const char* cA = (const char*)g.A + (size_t)cur.pm * tstepA; const char* cB = (const char*)g.Bt + (size_t)cur.pn * tstep;
    S.a_ready(cur);
    PG8_STAGE(PG8_SB(0, 0), cB, voffB); PG8_STAGE(PG8_SA(0, 0), cA, voffA); PG8_STAGE(PG8_SB(0, 1), cB + hstep, voffB); PG8_STAGE(PG8_SA(0, 1), cA + hstepA, voffA);
    if (wr == 1) PG8_BAR;
    PG8_WAIT_V(4); PG8_BAR;
    PG8_STAGE(PG8_SB(1, 0), cB + kstep, voffB); PG8_STAGE(PG8_SA(1, 0), cA + kstep, voffA); PG8_STAGE(PG8_SB(1, 1), cB + hstep + kstep, voffB);
    PG8_WAIT_V(6); PG8_BAR;
    PG8_STAMP();
    for (;;) {
        const bool has_next = S.next(ui + 1, nxt);
        const char* nA = has_next ? (const char*)g.A + (size_t)nxt.pm * tstepA : cA; const char* nB = has_next ? (const char*)g.Bt + (size_t)nxt.pn * tstep : cB;
        for (int t = 0; t < nt; t += 2) {
            const bool last = (t == nt - 2);
            const char* a1 = cA + (size_t)(t + 1) * kstep;
            const char* a2 = last ? nA : cA + (size_t)(t + 2) * kstep; const char* b2 = last ? nB : cB + (size_t)(t + 2) * kstep;
            const char* a3 = a2 + kstep; const char* b3 = b2 + kstep;
            if (last && has_next) S.a_ready(nxt);
            PG8_LDB(B0, 0, 0); PG8_SCHED; PG8_LDA(At, 0, 0); PG8_STAGE(PG8_SA(1, 1), a1 + hstepA, voffA);
            PG8_WAIT_L(8); PG8_BAR; PG8_WAIT_L(0); PG8_MMA(0, 0, At, B0); PG8_BAR; PG8_SCHED;
            PG8_LDB(B1, 0, 1); PG8_STAGE(PG8_SB(0, 0), b2, voffB);
            PG8_BAR; PG8_WAIT_L(0); PG8_MMA(0, 1, At, B1); PG8_BAR;
            PG8_LDA(At, 0, 1); PG8_STAGE(PG8_SA(0, 0), a2, voffA);
            PG8_BAR; PG8_WAIT_L(0); PG8_MMA(1, 0, At, B0); PG8_BAR; PG8_SCHED;
            PG8_STAGE(PG8_SB(0, 1), b2 + hstep, voffB);
            PG8_WAIT_V(6); PG8_BAR; PG8_MMA(1, 1, At, B1); PG8_BAR;
            PG8_LDB(B0, 1, 0); PG8_SCHED; PG8_LDA(At, 1, 0); PG8_STAGE(PG8_SA(0, 1), a2 + hstepA, voffA);
            PG8_WAIT_L(8); PG8_BAR; PG8_WAIT_L(0); PG8_MMA(0, 0, At, B0); PG8_BAR; PG8_SCHED;
            PG8_LDB(B1, 1, 1); PG8_STAGE(PG8_SB(1, 0), b3, voffB);
            PG8_BAR; PG8_WAIT_L(0); PG8_MMA(0, 1, At, B1); PG8_BAR;
            PG8_LDA(At, 1, 1); PG8_STAGE(PG8_SA(1, 0), a3, voffA);
            PG8_BAR; PG8_WAIT_L(0); PG8_MMA(1, 0, At, B0); PG8_BAR; PG8_SCHED;
            PG8_STAGE(PG8_SB(1, 1), b3 + hstep, voffB);
            PG8_WAIT_V(6); PG8_BAR; PG8_MMA(1, 1, At, B1); PG8_BAR;
        }
        PG8_STAMP();
        if constexpr (!Epi::AFTER_DRAIN) { E(acc, cur, wr, wc, fr, fq); S.done(cur); }
        PG8_STAMP();
        if (!has_next) break;
#pragma unroll
        for (int a = 0; a < 2; ++a)
#pragma unroll
            for (int b = 0; b < 2; ++b)
#pragma unroll
                for (int m = 0; m < 4; ++m)
#pragma unroll
                    for (int n = 0; n < 2; ++n) acc[a][b][m][n] = (f32x4){0.f, 0.f, 0.f, 0.f};
        cur = nxt; cA = nA; cB = nB; ++ui;
    }
    PG8_WAIT_V(0);
    if (wr == 0) PG8_BAR;
    PG8_BAR;
    if constexpr (Epi::AFTER_DRAIN) { E.fused(acc, cur, wr, wc, fr, fq, lds, wid, lane); S.done(cur); }
    PG8_STAMP();
    if (STAMP && wid == 0) { stamps[lane] = lane < nts ? (((unsigned long long)(unsigned)ts_hi << 32) | (unsigned)ts_lo) : 0ull;
        if (lane == 62) stamps[62] = rt_entry; if (lane == 63) stamps[63] = (unsigned long long)wall_clock64(); }
#undef PG8_STAMP
#undef PG8_SA
#undef PG8_SB
#undef PG8_STAGE
#undef PG8_LDA
#undef PG8_LDB
#undef PG8_MMA
#undef PG8_WAIT_V
#undef PG8_WAIT_L
#undef PG8_BAR
#undef PG8_SCHED
}
}
using pg8::bf16_t; using pg8::bf16x8; using pg8::f32x4; using pg8::u32x4; using pg8::cvt_pk_bf16;
typedef float f32x16 __attribute__((ext_vector_type(16)));
typedef short s16x4 __attribute__((ext_vector_type(4)));
typedef unsigned u32x2 __attribute__((ext_vector_type(2)));
#define DI __device__ __forceinline__
#define LAS __attribute__((address_space(3)))
#define MFMA32(a, b, c) __builtin_amdgcn_mfma_f32_32x32x16_bf16((a), (b), (c), 0, 0, 0)

constexpr int L_ = 16384, LC_ = 256, MT_ = 16640, D_ = 1024, DFF_ = 2816, DEPTH_ = 4;
constexpr int NWIN_ = 5888, NPB_ = 2816, NGB_ = 3072;
constexpr int C_FA = 0, C_FB = 256, C_RQ = 512, C_RK = 704, C_RV = 896, C_RG = 1280, C_DQ = 1664, C_DK = 2048, C_DV = 2432;
constexpr int LDS_BYTES = 147456;
constexpr float EPS_ = 1e-6f;

constexpr size_t al256(size_t x) { return (x + 255) & ~(size_t)255; }
constexpr size_t WS_W13 = 0;
constexpr size_t WS_W2  = WS_W13 + (size_t)4 * 2 * 5632 * 1024 * 2;
constexpr size_t WS_WIN = WS_W2 + (size_t)4 * 2 * 1024 * 2816 * 2;
constexpr size_t WS_WBF = WS_WIN + (size_t)4 * 5888 * 1024 * 2;
constexpr size_t WS_WBR = WS_WBF + (size_t)4 * 1024 * 256 * 2;
constexpr size_t WS_WBD = WS_WBR + (size_t)4 * 1024 * 384 * 2;
constexpr size_t WS_WO  = WS_WBD + (size_t)4 * 1024 * 384 * 2;
constexpr size_t WS_X   = WS_WO + (size_t)4 * 1024 * 1024 * 2;
constexpr size_t WS_H   = WS_X + (size_t)MT_ * 1024 * 4;
constexpr size_t WS_BR  = WS_H + (size_t)MT_ * 1024 * 2;
constexpr size_t WS_AL  = WS_BR + (size_t)MT_ * 1024 * 2;
constexpr size_t WS_U   = WS_AL;
constexpr size_t WS_PB  = WS_AL;
constexpr size_t WS_GB  = WS_AL + (size_t)MT_ * 2816 * 2;
constexpr size_t WS_V   = WS_GB + (size_t)MT_ * 3072 * 2;
constexpr size_t WS_T   = WS_V + (size_t)128 * 128 * 2 * 256 * 2;
constexpr size_t WS_S   = WS_T + (size_t)130 * 6 * 2 * 2048 * 4;
constexpr size_t WS_MXC = WS_S + (size_t)130 * 6 * 2 * 2048 * 4;
constexpr size_t WS_MOD = WS_MXC + (size_t)256 * 1024 * 4;
constexpr size_t WS_TRET = WS_MOD + (size_t)2 * 4 * 9216 * 4;
constexpr size_t WS_TROW = WS_TRET + (size_t)16384 * 16 * 2 * 4;
constexpr size_t WS_TCOL = WS_TROW + (size_t)256 * 8 * 2 * 4;
constexpr size_t WS_SCAL = WS_TCOL + (size_t)64 * 8 * 2 * 4;
constexpr size_t WS_BAR = WS_SCAL + 4 * 64 * 4;
constexpr size_t WS_END = WS_BAR + 8192;

__device__ __forceinline__ int lbid() { int t = blockIdx.x; asm volatile("" : "+s"(t)); return t; }
__device__ __forceinline__ int lnb() { int t = gridDim.x; asm volatile("" : "+s"(t)); return t; }
struct Args { const float* in[19]; float* out; unsigned char* ws; };
typedef const Args __attribute__((address_space(4)))* KArgs;
__device__ __forceinline__ KArgs kargs() { KArgs p = (KArgs)__builtin_amdgcn_kernarg_segment_ptr(); asm volatile("" : "+s"(p)); return p; }

DI float bf2f(unsigned v) { return __uint_as_float(v << 16); }
DI bf16_t f2bf(float x) { return (bf16_t)(cvt_pk_bf16(x, 0.f) & 0xffffu); }
DI int crow(int reg, int h) { return (reg & 3) + 8 * (reg >> 2) + 4 * h; }
DI bf16x8 pack_step(const f32x16& x, int s) {
  u32x4 p;
  asm volatile("v_cvt_pk_bf16_f32 %0, %4, %5\n\tv_cvt_pk_bf16_f32 %1, %6, %7\n\tv_cvt_pk_bf16_f32 %2, %8, %9\n\tv_cvt_pk_bf16_f32 %3, %10, %11\n\ts_nop 1"
               : "=&v"(p[0]), "=&v"(p[1]), "=&v"(p[2]), "=&v"(p[3])
               : "v"(x[8 * s]), "v"(x[8 * s + 1]), "v"(x[8 * s + 2]), "v"(x[8 * s + 3]), "v"(x[8 * s + 4]), "v"(x[8 * s + 5]), "v"(x[8 * s + 6]), "v"(x[8 * s + 7]));
  return __builtin_bit_cast(bf16x8, p);
}
DI float silu_f(float a) { return a * __builtin_amdgcn_rcpf(1.0f + __expf(-a)); }
DI float sigmoid_f(float a) { return __builtin_amdgcn_rcpf(1.0f + __expf(-a)); }
DI float wave_sum(float v) {
  const int lane = lane_id_v();
#pragma unroll
  for (int o = 32; o > 0; o >>= 1) v += shx(v, o, lane);
  return v;
}
DI void sincos_acc(float xf, float& s, float& c) {
  const double x = (double)xf;
  const double k = rint(x * 0.63661977236758134308);
  double r = fma(-k, 1.57079632679489655800e+00, x); r = fma(-k, 6.12323399573676603587e-17, r);
  const double r2 = r * r;
  double sp = -1.0 / 39916800.0; sp = fma(sp, r2, 1.0 / 362880.0); sp = fma(sp, r2, -1.0 / 5040.0); sp = fma(sp, r2, 1.0 / 120.0); sp = fma(sp, r2, -1.0 / 6.0); sp = fma(sp * r2, r, r);
  double cp = 1.0 / 479001600.0; cp = fma(cp, r2, -1.0 / 3628800.0); cp = fma(cp, r2, 1.0 / 40320.0); cp = fma(cp, r2, -1.0 / 720.0); cp = fma(cp, r2, 1.0 / 24.0); cp = fma(cp, r2, -0.5); cp = fma(cp, r2, 1.0);
  const int q = ((int)(long long)k) & 3;
  const double sv = (q == 0) ? sp : (q == 1) ? cp : (q == 2) ? -sp : -cp;
  const double cv = (q == 0) ? cp : (q == 1) ? -sp : (q == 2) ? -cp : sp;
  s = (float)sv; c = (float)cv;
}
__constant__ float INV16[16] = {1.0f, 0.5623413324356079f, 0.3162277638912201f, 0.17782793939113617f, 0.10000000149011612f, 0.05623413249850273f, 0.03162277489900589f, 0.017782794311642647f,
                             0.009999999776482582f, 0.005623413249850273f, 0.003162277629598975f, 0.0017782794311642647f, 0.0010000000474974513f, 0.000562341301701963f, 0.0003162277571391314f, 0.00017782794020604342f};
struct ConvJob { const float* src; const float* src2; bf16_t* dst; int N, K, ld, kind; };
DI ConvJob conv_job(KArgs a, int j) {
  const int l = j / 9, kd = j % 9; ConvJob J; J.src2 = nullptr; J.kind = 0;
  unsigned char* ws = a->ws;
  switch (kd) {
    case 0: case 1: { const int f = kd; J.src = a->in[7] + (size_t)(l * 2 + f) * 1024 * 2816; J.src2 = a->in[8] + (size_t)(l * 2 + f) * 1024 * 2816; J.dst = (bf16_t*)(ws + WS_W13) + (size_t)(l * 2 + f) * 5632 * 1024; J.N = 5632; J.K = 1024; J.ld = 2816; J.kind = 1; break; }
    case 2: case 3: { const int f = kd - 2; J.src = a->in[9] + (size_t)(l * 2 + f) * 2816 * 1024; J.dst = (bf16_t*)(ws + WS_W2) + (size_t)(l * 2 + f) * 1024 * 2816; J.N = 1024; J.K = 2816; J.ld = 1024; break; }
    case 4: { J.src = a->in[10] + (size_t)l * 1024 * 5632; J.dst = (bf16_t*)(ws + WS_WIN) + (size_t)l * 5888 * 1024; J.N = 5888; J.K = 1024; J.ld = 5632; J.kind = 2; break; }
    case 5: { J.src = a->in[14] + (size_t)l * 256 * 1024; J.dst = (bf16_t*)(ws + WS_WBF) + (size_t)l * 1024 * 256; J.N = 1024; J.K = 256; J.ld = 1024; break; }
    case 6: { J.src = a->in[15] + (size_t)l * 384 * 1024; J.dst = (bf16_t*)(ws + WS_WBR) + (size_t)l * 1024 * 384; J.N = 1024; J.K = 384; J.ld = 1024; break; }
    case 7: { J.src = a->in[16] + (size_t)l * 384 * 1024; J.dst = (bf16_t*)(ws + WS_WBD) + (size_t)l * 1024 * 384; J.N = 1024; J.K = 384; J.ld = 1024; break; }
    default: { J.src = a->in[17] + (size_t)l * 1024 * 1024; J.dst = (bf16_t*)(ws + WS_WO) + (size_t)l * 1024 * 1024; J.N = 1024; J.K = 1024; J.ld = 1024; break; }
  }
  return J;
}
DI int axial_perm(int s) { return s < 8 ? s : (s < 16 ? s + 8 : (s < 24 ? s - 8 : s)); }

DI void prologue(int WV, KArgs a, unsigned char* smem) {
  const int tid = ltid(), nb = lnb(), bid = lbid();
  float* t = (float*)smem;
  float* tr = t + 64 * 65;
  {
    constexpr int tiles_per_layer = 1408 * 2 + 704 * 2 + 1472 + 64 + 96 + 96 + 256;
    const int nn = tid & 63, kq = tid >> 6;
#pragma unroll 1
    for (int g = bid; g < 4 * tiles_per_layer; g += nb) {
      const int l = g / tiles_per_layer; int rem = g % tiles_per_layer; int kd;
      if (rem < 1408) kd = 0; else if (rem < 2816) { kd = 1; rem -= 1408; } else if (rem < 3520) { kd = 2; rem -= 2816; } else if (rem < 4224) { kd = 3; rem -= 3520; }
      else if (rem < 5696) { kd = 4; rem -= 4224; } else if (rem < 5760) { kd = 5; rem -= 5696; } else if (rem < 5856) { kd = 6; rem -= 5760; } else if (rem < 5952) { kd = 7; rem -= 5856; } else { kd = 8; rem -= 5952; }
      const ConvJob J = conv_job(a, l * 9 + kd);
      const int nkt = J.K / 64; const int n0 = (rem / nkt) * 64, k0 = (rem % nkt) * 64;
      const bool fold = (J.kind == 2) && (n0 < 512);
      const float* sp = J.src; int col = n0 + nn;
      if (J.kind == 1) { const int n = n0 + nn, gi = n >> 5, s = n & 31; sp = (s < 16) ? J.src : J.src2; col = 16 * gi + (s & 15); }
      else if (J.kind == 2) {
        const int n = n0 + nn;
        if (fold) col = (n0 & 192) + nn;
        else { col = n - 256; if (n >= C_DQ && n < C_DV) { const int s = n & 31; col = (n - 256 - s) + axial_perm(s); } }
      }
      const float* cp = sp + (size_t)(k0 + kq) * J.ld + col;
      float lv[8];
#pragma unroll
      for (int i = 0; i < 8; ++i) lv[i] = cp[(size_t)(8 * i) * J.ld];
#pragma unroll
      for (int i = 0; i < 8; ++i) t[nn * 65 + kq + 8 * i] = lv[i];
      if (fold && tid < 64) { const float ang = (float)tid * (1.0f / 32.0f); tr[tid] = (n0 >= 256) ? sinpif(ang) : cospif(ang); }
      __syncthreads();
      if (!fold) {
#pragma unroll
        for (int i = 0; i < 4; ++i) {
          const int e = tid + i * 512, n2 = e >> 5, kp = (e & 31) * 2;
          *(unsigned*)(J.dst + (size_t)(n0 + n2) * J.K + k0 + kp) = cvt_pk_bf16(t[n2 * 65 + kp], t[n2 * 65 + kp + 1]);
        }
      } else {
#pragma unroll 1
        for (int i = 0; i < 8; ++i) {
          const int m = kq + 8 * i, kk = nn;
          float acc = 0.f;
#pragma unroll 8
          for (int c = 0; c < 64; ++c) acc += t[c * 65 + kk] * tr[(m * c) & 63];
          J.dst[(size_t)(n0 + m) * J.K + k0 + kk] = f2bf(acc);
        }
      }
      __syncthreads();
    }
  }
  {
    float* sc = (float*)smem; float* scc = sc + 1024; float* red = scc + 1024;
    __syncthreads();
    for (int i = tid; i < 1024; i += 512) { sc[i] = silu_f(a->in[1][i]); scc[i] = silu_f(a->in[3][i]); }
    __syncthreads();
    float* MOD = (float*)(a->ws + WS_MOD);
    for (int it = bid; it < 4 * 72; it += nb) {
      const int l = it / 72, cb = it % 72;
      const int cgp = tid & 31, ks = tid >> 5;
      const float* wp = a->in[4] + ((size_t)l * 1024 + ks * 64) * 9216 + cb * 128 + cgp * 4;
      f32x4 am = {0.f, 0.f, 0.f, 0.f}, ac = {0.f, 0.f, 0.f, 0.f};
#pragma unroll 8
      for (int k = 0; k < 64; ++k) { const f32x4 w = *(const f32x4*)(wp + (size_t)k * 9216); am += w * sc[ks * 64 + k]; ac += w * scc[ks * 64 + k]; }
#pragma unroll
      for (int j = 0; j < 4; ++j) { red[(ks * 128 + cgp * 4 + j) * 2] = am[j]; red[(ks * 128 + cgp * 4 + j) * 2 + 1] = ac[j]; }
      __syncthreads();
      if (tid < 256) {
        const int col = tid >> 1, which = tid & 1; float s = 0.f;
#pragma unroll
        for (int q = 0; q < 16; ++q) s += red[(q * 128 + col) * 2 + which];
        const int gc = cb * 128 + col;
        MOD[(size_t)(which * 4 + l) * 9216 + gc] = s + a->in[5][(size_t)l * 9216 + gc];
      }
      __syncthreads();
    }
  }
  {
    float* TRET = (float*)(a->ws + WS_TRET); float* TROW = (float*)(a->ws + WS_TROW); float* TCOL = (float*)(a->ws + WS_TCOL);
    const int gt = bid * 512 + tid, gn = nb * 512;
    for (int e = gt; e < 16384 * 16; e += gn) { const int p = e >> 4, i = e & 15; float s, c; sincos_acc((float)p * INV16[i], s, c); TRET[2 * e] = c; TRET[2 * e + 1] = s; }
    for (int e = gt; e < 256 * 8; e += gn) { const int p = e >> 3, i = e & 7; float s, c; sincos_acc((float)p * INV16[2 * i], s, c); TROW[2 * e] = c; TROW[2 * e + 1] = s; }
    for (int e = gt; e < 64 * 8; e += gn) { const int p = e >> 3, i = e & 7; float s, c; sincos_acc((float)p * INV16[2 * i], s, c); TCOL[2 * e] = c; TCOL[2 * e + 1] = s; }
    if (bid == 0 && tid < 4) {
      const int l = tid; float* S = (float*)(a->ws + WS_SCAL) + l * 64;
      const float* lv = a->in[12] + l * 128; float d01 = 0.f, d23 = 0.f;
      for (int i = 0; i < 32; ++i) { d01 += lv[i] * lv[32 + i]; d23 += lv[64 + i] * lv[96 + i]; }
      const float lam_init = 0.8f - 0.6f * expf(-0.3f * (float)l);
      S[0] = expf(d01) - expf(d23) + lam_init; S[1] = lam_init;
      for (int i = 0; i < 12; ++i) { const float x = a->in[11][l * 12 + i]; S[4 + i] = -log1pf(expf(-x)); }
      for (int i = 0; i < 12; ++i) ((unsigned*)S)[16 + i] = 0u;
    }
  }
}
DI void norm_phase(int WV, KArgs a, int l, int which, bool first) {
  const int tid = ltid(), lane = tid & 63, wave = tid >> 6;
  const float* g = a->in[6] + (size_t)(l * 3 + which) * 1024;
  const float* mod = (const float*)(a->ws + WS_MOD) + (size_t)l * 9216;
  const float* modc = (const float*)(a->ws + WS_MOD) + (size_t)(4 + l) * 9216;
  float* X = (float*)(a->ws + WS_X); bf16_t* H = (bf16_t*)(a->ws + WS_H);
  const int stride = lnb() * 8;
  for (int r = lbid() * 8 + wave; r < MT_; r += 2 * stride) {
    const int r2 = r + stride; const bool has2 = r2 < MT_; const int rb = has2 ? r2 : r;
    const float* srcA = first ? (r < L_ ? a->in[0] + (size_t)r * 1024 : a->in[2] + (size_t)(r - L_) * 1024) : X + (size_t)r * 1024;
    const float* srcB = first ? (rb < L_ ? a->in[0] + (size_t)rb * 1024 : a->in[2] + (size_t)(rb - L_) * 1024) : X + (size_t)rb * 1024;
    f32x4 va[4], vb[4]; float sa = 0.f, sb = 0.f;
#pragma unroll
    for (int i = 0; i < 4; ++i) { va[i] = *(const f32x4*)(srcA + i * 256 + lane * 4); vb[i] = *(const f32x4*)(srcB + i * 256 + lane * 4); }
#pragma unroll
    for (int i = 0; i < 4; ++i) { sa += va[i][0] * va[i][0] + va[i][1] * va[i][1] + va[i][2] * va[i][2] + va[i][3] * va[i][3]; sb += vb[i][0] * vb[i][0] + vb[i][1] * vb[i][1] + vb[i][2] * vb[i][2] + vb[i][3] * vb[i][3]; }
    sa = wave_sum(sa); sb = wave_sum(sb);
    const float rsa = rsqrtf(sa * (1.0f / 1024.0f) + EPS_), rsb = rsqrtf(sb * (1.0f / 1024.0f) + EPS_);
#pragma unroll
    for (int q = 0; q < 2; ++q) {
      if (q == 1 && !has2) break;
      const int rr = q ? r2 : r; const float rstd = q ? rsb : rsa;
      const float* mm = (rr < L_) ? mod : modc;
#pragma unroll
      for (int i = 0; i < 4; ++i) {
        const int c = i * 256 + lane * 4;
        const f32x4 v = q ? vb[i] : va[i];
        const f32x4 gg = *(const f32x4*)(g + c), sh = *(const f32x4*)(mm + (which * 3) * 1024 + c), sc = *(const f32x4*)(mm + (which * 3 + 1) * 1024 + c);
        f32x4 y;
#pragma unroll
        for (int j = 0; j < 4; ++j) y[j] = v[j] * rstd * gg[j] * (1.0f + sc[j]) + sh[j];
        u32x2 w; w.x = cvt_pk_bf16(y[0], y[1]); w.y = cvt_pk_bf16(y[2], y[3]);
        *(u32x2*)(H + (size_t)rr * 1024 + c) = w;
        if (first) *(f32x4*)(X + (size_t)rr * 1024 + c) = v;
      }
    }
  }
}
DI void final_norm(int WV, KArgs a) {
  const int tid = ltid(), lane = tid & 63, wave = tid >> 6;
  const float* g = a->in[18]; const float* X = (const float*)(a->ws + WS_X);
  for (int r = lbid() * 8 + wave; r < L_; r += lnb() * 8) {
    f32x4 v[4]; float ss = 0.f;
#pragma unroll
    for (int i = 0; i < 4; ++i) { v[i] = *(const f32x4*)(X + (size_t)r * 1024 + i * 256 + lane * 4); ss += v[i][0] * v[i][0] + v[i][1] * v[i][1] + v[i][2] * v[i][2] + v[i][3] * v[i][3]; }
    ss = wave_sum(ss);
    const float rstd = rsqrtf(ss * (1.0f / 1024.0f) + EPS_);
#pragma unroll
    for (int i = 0; i < 4; ++i) { const int c = i * 256 + lane * 4; const f32x4 gg = *(const f32x4*)(g + c); f32x4 y; for (int j = 0; j < 4; ++j) y[j] = v[i][j] * rstd * gg[j]; *(f32x4*)(a->out + (size_t)r * 1024 + c) = y; }
  }
}

using pg8::Unit; using pg8::HALF; using pg8::BM;
struct EpiSwiglu {
  static constexpr bool PERM = false, AFTER_DRAIN = false;
  bf16_t* U;
  DI void operator()(const f32x4 (&acc)[2][2][4][2], const Unit& u, int wr, int wc, int fr_, int fq_) const {
    const int ln_ = lane_id_v(), fr = ln_ & 15, fq = ln_ >> 4;
#pragma unroll
    for (int ai = 0; ai < 2; ++ai)
#pragma unroll
      for (int m = 0; m < 4; ++m) {
        const int r = u.pm * BM + ai * HALF + wr * 64 + m * 16 + fr;
#pragma unroll
        for (int bj = 0; bj < 2; ++bj) {
          const int gi = u.pn * 8 + bj * 4 + wc;
          const f32x4 x = acc[ai][bj][m][0], y = acc[ai][bj][m][1];
          u32x2 w; w.x = cvt_pk_bf16(silu_f(x[0]) * y[0], silu_f(x[1]) * y[1]); w.y = cvt_pk_bf16(silu_f(x[2]) * y[2], silu_f(x[3]) * y[3]);
          *(u32x2*)(U + (size_t)r * DFF_ + gi * 16 + fq * 4) = w;
        }
        __builtin_amdgcn_sched_barrier(0);
      }
  }
};
struct EpiResid {
  static constexpr bool PERM = false, AFTER_DRAIN = false;
  float* X; const float* gate; float scale;
  DI void operator()(const f32x4 (&acc)[2][2][4][2], const Unit& u, int wr, int wc, int fr_, int fq_) const {
    const int ln_ = lane_id_v(), fr = ln_ & 15, fq = ln_ >> 4;
#pragma unroll
    for (int bj = 0; bj < 2; ++bj)
#pragma unroll
      for (int n = 0; n < 2; ++n) {
        const int c = u.pn * BM + bj * HALF + wc * 32 + n * 16 + fq * 4;
        const f32x4 gv = *(const f32x4*)(gate + c) * scale;
#pragma unroll
        for (int ai = 0; ai < 2; ++ai)
#pragma unroll
          for (int m = 0; m < 4; ++m) {
            const int r = u.pm * BM + ai * HALF + wr * 64 + m * 16 + fr;
            float* p = X + (size_t)r * 1024 + c;
            *(f32x4*)p = *(const f32x4*)p + gv * acc[ai][bj][m][n];
          }
      }
  }
};
template <int STEP> struct EpiMerge {
  static constexpr bool PERM = false, AFTER_DRAIN = false;
  float* MX; const bf16_t* G; bf16_t* Hout;
  DI void operator()(const f32x4 (&acc)[2][2][4][2], const Unit& u, int wr, int wc, int fr_, int fq_) const {
    const int ln_ = lane_id_v(), fr = ln_ & 15, fq = ln_ >> 4;
#pragma unroll
    for (int ai = 0; ai < 2; ++ai)
#pragma unroll
      for (int bj = 0; bj < 2; ++bj)
#pragma unroll
        for (int n = 0; n < 2; ++n) {
          const int c = u.pn * BM + bj * HALF + wc * 32 + n * 16 + fq * 4;
          const int r0 = u.pm * BM + ai * HALF + wr * 64 + fr;
          u32x2 gw[4]; f32x4 old[4];
#pragma unroll
          for (int m = 0; m < 4; ++m) {
            gw[m] = *(const u32x2*)(G + (size_t)(r0 + m * 16) * NGB_ + c);
            if (STEP > 0) old[m] = *(const f32x4*)(MX + (size_t)(r0 + m * 16) * 1024 + c);
          }
#pragma unroll
          for (int m = 0; m < 4; ++m) {
            f32x4 gv; gv[0] = bf2f(gw[m].x & 0xffffu); gv[1] = bf2f(gw[m].x >> 16); gv[2] = bf2f(gw[m].y & 0xffffu); gv[3] = bf2f(gw[m].y >> 16);
            f32x4 v = gv * acc[ai][bj][m][n];
            if (STEP > 0) v += old[m];
            if (STEP < 2) *(f32x4*)(MX + (size_t)(r0 + m * 16) * 1024 + c) = v;
            else { u32x2 w; w.x = cvt_pk_bf16(v[0], v[1]); w.y = cvt_pk_bf16(v[2], v[3]); *(u32x2*)(Hout + (size_t)(r0 + m * 16) * 1024 + c) = w; }
          }
          __builtin_amdgcn_sched_barrier(0);
        }
  }
};
struct EpiWin {
  static constexpr bool PERM = false, AFTER_DRAIN = false;
  bf16_t* PB; bf16_t* GB; const float* TRET; const float* TROW; const float* TCOL; unsigned* kmax;
  DI void operator()(const f32x4 (&acc)[2][2][4][2], const Unit& u, int wr, int wc, int fr_, int fq_) const {
    const int ln_ = lane_id_v(), fr = ln_ & 15, fq = ln_ >> 4;
#pragma unroll
    for (int bj = 0; bj < 2; ++bj) {
      const int cb = u.pn * BM + bj * HALF + wc * 32;
      float kmx = 0.f;
#pragma unroll
      for (int ai = 0; ai < 2; ++ai)
#pragma unroll
        for (int m = 0; m < 4; ++m) {
          const int r = u.pm * BM + ai * HALF + wr * 64 + m * 16 + fr;
          f32x4 x0 = acc[ai][bj][m][0], x1 = acc[ai][bj][m][1];
          if (cb >= NPB_) {
#pragma unroll
            for (int j = 0; j < 4; ++j) { x0[j] = sigmoid_f(x0[j]); x1[j] = sigmoid_f(x1[j]); }
            u32x2 w0, w1; w0.x = cvt_pk_bf16(x0[0], x0[1]); w0.y = cvt_pk_bf16(x0[2], x0[3]); w1.x = cvt_pk_bf16(x1[0], x1[1]); w1.y = cvt_pk_bf16(x1[2], x1[3]);
            bf16_t* p = GB + (size_t)r * NGB_ + (cb - NPB_) + fq * 4;
            *(u32x2*)p = w0; *(u32x2*)(p + 16) = w1;
            __builtin_amdgcn_sched_barrier(0);
            continue;
          }
          if (cb >= C_RQ && cb < C_RV) {
            if (r < L_) {
              const f32x4* tp = (const f32x4*)(TRET + ((size_t)r * 16 + fq * 4) * 2);
              const f32x4 t0 = tp[0], t1 = tp[1];
              const float cs[4] = {t0[0], t0[2], t1[0], t1[2]}, sn[4] = {t0[1], t0[3], t1[1], t1[3]};
#pragma unroll
              for (int j = 0; j < 4; ++j) { const float a_ = x0[j], b_ = x1[j]; x0[j] = a_ * cs[j] - b_ * sn[j]; x1[j] = a_ * sn[j] + b_ * cs[j]; }
            }
            if (cb >= C_RK) { x0 *= 0.17677669529663687f; x1 *= 0.17677669529663687f; }
          } else if (cb >= C_RG && cb < C_DQ) {
#pragma unroll
            for (int j = 0; j < 4; ++j) { x0[j] = silu_f(x0[j]); x1[j] = silu_f(x1[j]); }
          } else if (cb >= C_DQ && cb < C_DV) {
            if (r < L_) {
              const float* tb = (fq < 2) ? (TROW + ((size_t)(r >> 6) * 8 + fq * 4) * 2) : (TCOL + ((size_t)(r & 63) * 8 + (fq - 2) * 4) * 2);
              const f32x4 t0 = ((const f32x4*)tb)[0], t1 = ((const f32x4*)tb)[1];
              const float cs[4] = {t0[0], t0[2], t1[0], t1[2]}, sn[4] = {t0[1], t0[3], t1[1], t1[3]};
#pragma unroll
              for (int j = 0; j < 4; ++j) { const float a_ = x0[j], b_ = x1[j]; x0[j] = a_ * cs[j] - b_ * sn[j]; x1[j] = a_ * sn[j] + b_ * cs[j]; }
            }
            if (cb < C_DK) { x0 *= 0.25503486f; x1 *= 0.25503486f; }
            else { float ss = 0.f;
#pragma unroll
              for (int j = 0; j < 4; ++j) ss += x0[j] * x0[j] + x1[j] * x1[j];
              ss += shx(ss, 16, lane_id_v()); ss += shx(ss, 32, lane_id_v()); kmx = fmaxf(kmx, ss); }
          }
          u32x2 w0, w1; w0.x = cvt_pk_bf16(x0[0], x0[1]); w0.y = cvt_pk_bf16(x0[2], x0[3]); w1.x = cvt_pk_bf16(x1[0], x1[1]); w1.y = cvt_pk_bf16(x1[2], x1[3]);
          bf16_t* p = PB + (size_t)r * NPB_ + cb + fq * 4;
          *(u32x2*)p = w0; *(u32x2*)(p + 16) = w1;
          __builtin_amdgcn_sched_barrier(0);
        }
      if (cb >= C_DK && cb < C_DV) {
#pragma unroll
        for (int o = 1; o < 16; o <<= 1) kmx = fmaxf(kmx, shx(kmx, o, lane_id_v()));
        if (lane_id_v() == 0) atomicMax(kmax + ((cb - C_DK) >> 5), __float_as_uint(kmx));
      }
    }
  }
};
template <class F> DI void ctx_gemm32(int WV, const bf16_t* A, int lda, const bf16_t* Bt, int K, int N, unsigned char* smem, F epi) {
  const int tid = ltid(), lane = tid & 63, wave = tid >> 6, r31 = lane & 31, h = lane >> 5;
  float* red = (float*)smem;
  const int ntn = N / 32, ntiles = 8 * ntn, kper = K / 8;
  for (int tile = lbid(); tile < ntiles; tile += lnb()) {
    const int tm = tile / ntn, tn = tile % ntn;
    f32x16 acc; for (int i = 0; i < 16; ++i) acc[i] = 0.f;
    const bf16_t* ap = A + (size_t)(tm * 32 + r31) * lda + wave * kper + 8 * h;
    const bf16_t* bp = Bt + (size_t)(tn * 32 + r31) * K + wave * kper + 8 * h;
    int kk = 0;
    for (; kk + 64 <= kper; kk += 64) {
      bf16x8 av[4], bv[4];
#pragma unroll
      for (int q = 0; q < 4; ++q) { av[q] = *(const bf16x8*)(ap + kk + 16 * q); bv[q] = *(const bf16x8*)(bp + kk + 16 * q); }
#pragma unroll
      for (int q = 0; q < 4; ++q) acc = MFMA32(av[q], bv[q], acc);
    }
    for (; kk < kper; kk += 16) { const bf16x8 av = *(const bf16x8*)(ap + kk), bv = *(const bf16x8*)(bp + kk); acc = MFMA32(av, bv, acc); }
#pragma unroll
    for (int i = 0; i < 16; ++i) red[(wave * 16 + i) * 64 + lane] = acc[i];
    __syncthreads();
#pragma unroll
    for (int q = 0; q < 2; ++q) {
      const int o = tid + q * 512, i = o >> 6, ln = o & 63; float s = 0.f;
#pragma unroll
      for (int w = 0; w < 8; ++w) s += red[(w * 16 + i) * 64 + ln];
      epi(tm * 32 + crow(i, ln >> 5), tn * 32 + (ln & 31), s);
    }
    __syncthreads();
  }
}

constexpr int FR_LD = 136;
DI void fourier_tables(int WV, unsigned char* smem) {
  bf16_t* Cw = (bf16_t*)smem; bf16_t* Sw = Cw + 128 * FR_LD;
  for (int e = ltid(); e < 128 * 128; e += 512) { const int a_ = e >> 7, b_ = e & 127; const float x = (float)((a_ * b_) & 127) * (1.0f / 64.0f); Cw[a_ * FR_LD + b_] = f2bf(cospif(x)); Sw[a_ * FR_LD + b_] = f2bf(sinpif(x)); }
}
DI void fourier_load(int WV, const bf16_t* src, size_t rs, size_t po, unsigned char* smem) {
  bf16_t* dA = (bf16_t*)smem + 2 * 128 * FR_LD;
#pragma unroll
  for (int i = 0; i < 4; ++i) {
    const int id = ltid() + 512 * i, seg = id & 7, part = (id >> 3) & 1, row = id >> 4;
    const bf16x8 v = *(const bf16x8*)(src + (size_t)row * rs + (size_t)part * po + seg * 8);
    bf16_t* d = dA + part * 64 * FR_LD + (seg * 8) * FR_LD + row;
#pragma unroll
    for (int e = 0; e < 8; ++e) d[e * FR_LD] = (bf16_t)v[e];
  }
}
DI void fourier_stage1(int WV, KArgs a, unsigned char* smem) {
  const int tid = ltid(), lane = tid & 63, wave = tid >> 6, r31 = lane & 31, h = lane >> 5, rb = wave & 3, cbk = wave >> 2;
  const bf16_t* PB = (const bf16_t*)(a->ws + WS_PB); bf16_t* V = (bf16_t*)(a->ws + WS_V);
  const bf16_t* Cw = (const bf16_t*)smem; const bf16_t* Sw = Cw + 128 * FR_LD; const bf16_t* dA = Sw + 128 * FR_LD; const bf16_t* dB = dA + 64 * FR_LD;
  for (int it = lbid(); it < 512; it += lnb()) {
    const int t2 = it >> 2, c0 = (it & 3) * 64;
    __syncthreads();
    fourier_load(WV, PB + (size_t)t2 * NPB_ + C_FA + c0, (size_t)128 * NPB_, (size_t)(C_FB - C_FA), smem);
    __syncthreads();
    f32x16 R, nI; for (int i = 0; i < 16; ++i) { R[i] = 0.f; nI[i] = 0.f; }
#pragma unroll
    for (int s = 0; s < 8; ++s) {
      const bf16x8 cw = *(const bf16x8*)(Cw + (32 * rb + r31) * FR_LD + 16 * s + 8 * h), sw = *(const bf16x8*)(Sw + (32 * rb + r31) * FR_LD + 16 * s + 8 * h);
      const bf16x8 af = *(const bf16x8*)(dA + (32 * cbk + r31) * FR_LD + 16 * s + 8 * h), bfv = *(const bf16x8*)(dB + (32 * cbk + r31) * FR_LD + 16 * s + 8 * h);
      bf16x8 nb; for (int e = 0; e < 8; ++e) nb[e] = (short)(bfv[e] ^ (short)0x8000);
      R = MFMA32(cw, af, R); R = MFMA32(sw, nb, R); nI = MFMA32(sw, af, nI); nI = MFMA32(cw, bfv, nI);
    }
    const int col = c0 + 32 * cbk + r31;
#pragma unroll
    for (int i = 0; i < 16; ++i) {
      const int k1 = 32 * rb + crow(i, h);
      const float x = (float)(k1 * t2) * (1.0f / 8192.0f); const float ct = cospif(x), st = sinpif(x);
      const float vre = R[i] * ct - nI[i] * st, vim = -nI[i] * ct - R[i] * st;
      bf16_t* vp = V + ((size_t)(k1 * 128 + t2) * 2) * 256 + col;
      vp[0] = f2bf(vre); vp[256] = f2bf(vim);
    }
  }
}
DI void fourier_stage2(int WV, KArgs a, unsigned char* smem) {
  const int tid = ltid(), lane = tid & 63, wave = tid >> 6, r31 = lane & 31, h = lane >> 5, rb = wave & 3, cbk = wave >> 2;
  const bf16_t* V = (const bf16_t*)(a->ws + WS_V); bf16_t* BR = (bf16_t*)(a->ws + WS_BR);
  const bf16_t* Cw = (const bf16_t*)smem; const bf16_t* Sw = Cw + 128 * FR_LD; const bf16_t* dA = Sw + 128 * FR_LD; const bf16_t* dB = dA + 64 * FR_LD;
  for (int it = lbid(); it < 512; it += lnb()) {
    const int k1 = it >> 2, c0 = (it & 3) * 64;
    __syncthreads();
    fourier_load(WV, V + (size_t)k1 * 128 * 512 + c0, (size_t)512, (size_t)256, smem);
    __syncthreads();
    f32x16 Y; for (int i = 0; i < 16; ++i) Y[i] = 0.f;
#pragma unroll
    for (int s = 0; s < 8; ++s) {
      const bf16x8 cw = *(const bf16x8*)(Cw + (32 * rb + r31) * FR_LD + 16 * s + 8 * h), sw = *(const bf16x8*)(Sw + (32 * rb + r31) * FR_LD + 16 * s + 8 * h);
      const bf16x8 vr = *(const bf16x8*)(dA + (32 * cbk + r31) * FR_LD + 16 * s + 8 * h), vi = *(const bf16x8*)(dB + (32 * cbk + r31) * FR_LD + 16 * s + 8 * h);
      Y = MFMA32(cw, vr, Y); Y = MFMA32(sw, vi, Y);
    }
    const int col = c0 + 32 * cbk + r31;
#pragma unroll
    for (int i = 0; i < 16; ++i) { const int k2 = 32 * rb + crow(i, h); BR[(size_t)(k1 + 128 * k2) * 1024 + col] = f2bf(Y[i] * (1.0f / 1024.0f)); }
  }
}
DI void fourier_ctx(int WV, KArgs a, unsigned char* smem) {
  const int tid = ltid();
  const bf16_t* PB = (const bf16_t*)(a->ws + WS_PB) + (size_t)L_ * NPB_; bf16_t* BR = (bf16_t*)(a->ws + WS_BR) + (size_t)L_ * 1024;
  float* ct = (float*)smem; float* st = ct + 256; float* part = st + 256;
  __syncthreads();
  if (tid < 256) { const float x = (float)tid * (1.0f / 128.0f); ct[tid] = cospif(x); st[tid] = sinpif(x); }
  __syncthreads();
  for (int k = lbid(); k < 256; k += lnb()) {
    const int col = tid & 255, half = tid >> 8;
    float acc = 0.f;
#pragma unroll 8
    for (int t = half * 128; t < half * 128 + 128; ++t) {
      const int idx = (k * t) & 255;
      acc += ct[idx] * bf2f(PB[(size_t)t * NPB_ + C_FA + col]) - st[idx] * bf2f(PB[(size_t)t * NPB_ + C_FB + col]);
    }
    if (half == 1) part[col] = acc;
    __syncthreads();
    if (half == 0) BR[(size_t)k * 1024 + col] = f2bf((acc + part[col]) * (1.0f / 128.0f));
    __syncthreads();
  }
}
DI int chunk_row0(int ci) { return ci < 128 ? ci * 128 : L_ + (ci - 128) * 128; }
DI void ret_states(int WV, KArgs a, int l, unsigned char* smem) {
  const int tid = ltid();
  const bf16_t* PB = (const bf16_t*)(a->ws + WS_PB); float* T = (float*)(a->ws + WS_T);
  const float* S = (const float*)(a->ws + WS_SCAL) + l * 64;
  float* kL = (float*)smem; float* vL = kL + 128 * 33; float* wf = vL + 128 * 64; float* wb = wf + 128;
  for (int it = lbid(); it < 130 * 6; it += lnb()) {
    const int ci = it / 6, hh = it % 6, r0 = chunk_row0(ci);
    __syncthreads();
    { const int row = tid >> 2, seg = tid & 3; const bf16x8 v = *(const bf16x8*)(PB + (size_t)(r0 + row) * NPB_ + C_RK + hh * 32 + seg * 8);
#pragma unroll
      for (int e = 0; e < 8; ++e) kL[row * 33 + seg * 8 + e] = bf2f((unsigned)(unsigned short)v[e]); }
#pragma unroll
    for (int q = 0; q < 2; ++q) { const int id = tid + 512 * q, row = id >> 3, seg = id & 7; const bf16x8 v = *(const bf16x8*)(PB + (size_t)(r0 + row) * NPB_ + C_RV + hh * 64 + seg * 8);
#pragma unroll
      for (int e = 0; e < 8; ++e) vL[row * 64 + seg * 8 + e] = bf2f((unsigned)(unsigned short)v[e]); }
    if (tid < 128) { wf[tid] = expf(S[4 + hh] * (float)(127 - tid)); wb[tid] = expf(S[10 + hh] * (float)tid); }
    __syncthreads();
    const int d = tid >> 4, v4 = (tid & 15) * 4;
    f32x4 af = {0.f, 0.f, 0.f, 0.f}, ab = {0.f, 0.f, 0.f, 0.f};
#pragma unroll 4
    for (int j = 0; j < 128; ++j) { const float kd = kL[j * 33 + d]; const f32x4 vv = *(const f32x4*)(vL + j * 64 + v4); af += vv * (kd * wf[j]); ab += vv * (kd * wb[j]); }
    float* tp = T + ((size_t)(ci * 6 + hh) * 2) * 2048 + d * 64 + v4;
    *(f32x4*)tp = af; *(f32x4*)(tp + 2048) = ab;
  }
}
DI void ret_scan(int WV, KArgs a, int l) {
  const int gt = lbid() * 512 + ltid();
  if (gt >= 6 * 2 * 2048) return;
  const int idx = gt & 2047, dir = (gt >> 11) & 1, hh = gt >> 12;
  const float* T = (const float*)(a->ws + WS_T); float* S = (float*)(a->ws + WS_S);
  const float* SC = (const float*)(a->ws + WS_SCAL) + l * 64;
  const float dec = expf(SC[4 + dir * 6 + hh] * 128.0f);
  const size_t base = (size_t)(hh * 2 + dir) * 2048 + idx; const size_t cs = (size_t)6 * 2 * 2048;
  const float tc0 = T[base + 128 * cs], tc1 = T[base + 129 * cs];
  if (dir == 0) {
    float s = tc0 * dec + tc1; S[base + 128 * cs] = 0.f; S[base + 129 * cs] = tc0;
#pragma unroll 8
    for (int i = 0; i < 128; ++i) { S[base + i * cs] = s; s = s * dec + T[base + i * cs]; }
  } else {
    float s = tc0 + dec * tc1; S[base + 129 * cs] = 0.f; S[base + 128 * cs] = tc1;
#pragma unroll 8
    for (int i = 127; i >= 0; --i) { S[base + i * cs] = s; s = s * dec + T[base + i * cs]; }
  }
}
DI void ret_out(int WV, KArgs a, int l, unsigned char* smem) {
  const int tid = ltid(), lane = tid & 63, wave = tid >> 6, r31 = lane & 31, h = lane >> 5, jb = wave & 3, vh = wave >> 2;
  const bf16_t* PB = (const bf16_t*)(a->ws + WS_PB); bf16_t* BR = (bf16_t*)(a->ws + WS_BR); const float* Sg = (const float*)(a->ws + WS_S);
  const float* SC = (const float*)(a->ws + WS_SCAL) + l * 64;
  bf16_t* Kl = (bf16_t*)smem;
  bf16_t* Vt = Kl + 128 * 40;
  bf16_t* SfT = Vt + 64 * 136;
  bf16_t* SbT = SfT + 64 * 40;
  float* pwf = (float*)(SbT + 64 * 40);
  float* pwb = pwf + 128;
  float* ssq = pwb + 128;
  for (int it = lbid(); it < 130 * 6; it += lnb()) {
    const int ci = it / 6, hh = it % 6, r0 = chunk_row0(ci);
    const float lgf = SC[4 + hh], lgb = SC[10 + hh];
    __syncthreads();
    { const int row = tid >> 2, seg = tid & 3; *(bf16x8*)(Kl + row * 40 + seg * 8) = *(const bf16x8*)(PB + (size_t)(r0 + row) * NPB_ + C_RK + hh * 32 + seg * 8); }
#pragma unroll
    for (int q = 0; q < 2; ++q) { const int id = tid + 512 * q, row = id >> 3, seg = id & 7; const bf16x8 v = *(const bf16x8*)(PB + (size_t)(r0 + row) * NPB_ + C_RV + hh * 64 + seg * 8);
#pragma unroll
      for (int e = 0; e < 8; ++e) Vt[(seg * 8 + e) * 136 + row] = (bf16_t)v[e]; }
#pragma unroll
    for (int q = 0; q < 8; ++q) { const int e = tid + 512 * q, dir = e >> 11, idx = e & 2047, d = idx >> 6, v = idx & 63;
      const float sv = Sg[((size_t)(ci * 6 + hh) * 2 + dir) * 2048 + idx]; (dir ? SbT : SfT)[v * 40 + d] = f2bf(sv); }
    if (tid < 128) { pwf[tid] = expf(lgf * (float)tid); pwb[tid] = expf(lgb * (float)tid); }
    const int qrow = r0 + 32 * jb + r31, j = 32 * jb + r31;
    bf16x8 qf[2];
#pragma unroll
    for (int s = 0; s < 2; ++s) qf[s] = *(const bf16x8*)(PB + (size_t)qrow * NPB_ + C_RQ + hh * 32 + 16 * s + 8 * h);
    __syncthreads();
    f32x16 O; for (int i = 0; i < 16; ++i) O[i] = 0.f;
#pragma unroll
    for (int kb = 0; kb < 4; ++kb) {
      f32x16 St; for (int i = 0; i < 16; ++i) St[i] = 0.f;
#pragma unroll
      for (int s = 0; s < 2; ++s) { const bf16x8 kf = *(const bf16x8*)(Kl + (32 * kb + r31) * 40 + 16 * s + 8 * h); St = MFMA32(kf, qf[s], St); }
#pragma unroll
      for (int i = 0; i < 16; ++i) { const int jp = 32 * kb + crow(i, h); const int dl = j - jp; const float dv = dl > 0 ? pwf[dl] : (dl < 0 ? pwb[-dl] : 2.0f); St[i] *= dv; }
#pragma unroll
      for (int s = 0; s < 2; ++s) {
        const bf16x8 pb = pack_step(St, s);
        const bf16_t* vp = Vt + (32 * vh + r31) * 136 + 32 * kb + 16 * s + 4 * h;
        const s16x4 lo = *(const s16x4*)vp, hi = *(const s16x4*)(vp + 8);
        const bf16x8 vf = __builtin_shufflevector(lo, hi, 0, 1, 2, 3, 4, 5, 6, 7);
        O = MFMA32(vf, pb, O);
      }
    }
    f32x16 Of, Ob; for (int i = 0; i < 16; ++i) { Of[i] = 0.f; Ob[i] = 0.f; }
#pragma unroll
    for (int s = 0; s < 2; ++s) {
      const bf16x8 sf = *(const bf16x8*)(SfT + (32 * vh + r31) * 40 + 16 * s + 8 * h), sb = *(const bf16x8*)(SbT + (32 * vh + r31) * 40 + 16 * s + 8 * h);
      Of = MFMA32(sf, qf[s], Of); Ob = MFMA32(sb, qf[s], Ob);
    }
    const float qdf = expf(lgf * (float)(j + 1)), qdb = expf(lgb * (float)(128 - j));
    float ss = 0.f;
#pragma unroll
    for (int i = 0; i < 16; ++i) { O[i] = O[i] + Of[i] * qdf + Ob[i] * qdb; ss += O[i] * O[i]; }
    ss += shx(ss, 32, lane_id_v());
    if (h == 0) ssq[vh * 128 + j] = ss;
    __syncthreads();
    const float rstd = rsqrtf((ssq[j] + ssq[128 + j]) * (1.0f / 64.0f) + EPS_);
#pragma unroll
    for (int g4 = 0; g4 < 4; ++g4) {
      const int v0 = 32 * vh + 8 * g4 + 4 * h;
      const u32x2 gw = *(const u32x2*)(PB + (size_t)qrow * NPB_ + C_RG + hh * 64 + v0);
      const float g0 = bf2f(gw.x & 0xffffu), g1 = bf2f(gw.x >> 16), g2 = bf2f(gw.y & 0xffffu), g3 = bf2f(gw.y >> 16);
      u32x2 w; w.x = cvt_pk_bf16(O[4 * g4] * rstd * g0, O[4 * g4 + 1] * rstd * g1); w.y = cvt_pk_bf16(O[4 * g4 + 2] * rstd * g2, O[4 * g4 + 3] * rstd * g3);
      *(u32x2*)(BR + (size_t)qrow * 1024 + 256 + hh * 64 + v0) = w;
    }
  }
}
constexpr int AT_LD = 72;
typedef __bf16 bf16x2_t __attribute__((ext_vector_type(2)));
typedef float f32x2_t __attribute__((ext_vector_type(2)));
DI unsigned cvt2(float a, float b) { f32x2_t v = {a, b}; return __builtin_bit_cast(unsigned, __builtin_convertvector(v, bf16x2_t)); }
template <int VAR> DI void attn_phase(int WV, KArgs a, int l, bool with_ctx, unsigned char* smem) {
  const int tid = ltid(), lane = tid & 63, wave = tid >> 6, r31 = lane & 31, h = lane >> 5, qsub = wave & 3, kh = wave >> 2;
  const bf16_t* PB = (const bf16_t*)(a->ws + WS_PB); bf16_t* BR = (bf16_t*)(a->ws + (VAR == 0 ? WS_BR : WS_H));
  const float* SC = (const float*)(a->ws + WS_SCAL) + l * 64;
  const float lam = SC[0], lam_init = SC[1];
  bf16_t* Ks = (bf16_t*)smem;
  bf16_t* Vt = Ks + 2 * 64 * AT_LD;
  float* cmb = (float*)(Vt + 2 * 64 * AT_LD);
  const int nitems = 6 * 128 + (with_ctx ? 12 : 0);
  const int skey = tid >> 3, sseg = tid & 7;
  for (int it = lbid(); it < nitems; it += lnb()) {
    int head, q0, krow0, nt;
    if (it < 768) { head = (it >> 8) * 2 + (it & 1); q0 = ((it & 255) >> 1) * 128; krow0 = 0; nt = MT_ / 64; }
    else { const int e = it - 768; head = e >> 1; q0 = L_ + (e & 1) * 128; krow0 = L_; nt = LC_ / 64; }
    const int qrow = q0 + 32 * qsub + r31;
    bf16x8 qf[2][2];
#pragma unroll
    for (int mp = 0; mp < 2; ++mp)
#pragma unroll
      for (int s = 0; s < 2; ++s) qf[mp][s] = *(const bf16x8*)(PB + (size_t)qrow * NPB_ + C_DQ + head * 64 + mp * 32 + 16 * s + 8 * h);
    float negm = 0.f;
#pragma unroll
    for (int mp = 0; mp < 2; ++mp) {
      float ss = 0.f;
#pragma unroll
      for (int s = 0; s < 2; ++s)
#pragma unroll
        for (int e = 0; e < 8; ++e) { const float x = bf2f((unsigned)(unsigned short)qf[mp][s][e]); ss += x * x; }
      ss += shx(ss, 32, lane_id_v());
      const float kmx = __uint_as_float(((const unsigned*)SC)[16 + head * 2 + mp]);
      negm = fminf(negm, -sqrtf(ss * kmx) * 1.01f);
    }
    f32x16 NM; for (int i = 0; i < 16; ++i) NM[i] = negm;
    f32x16 O1[2], O2[2]; for (int i = 0; i < 16; ++i) { O1[0][i] = 0.f; O1[1][i] = 0.f; O2[0][i] = 0.f; O2[1][i] = 0.f; }
    f32x4 LA = {0.f, 0.f, 0.f, 0.f}, LB = {0.f, 0.f, 0.f, 0.f};
    bf16x8 osel; { const bool on = ((lane & 15) == 0 && ((lane >> 4) & 1) == 0) || ((lane & 15) == 1 && ((lane >> 4) & 1) == 1);
      for (int e = 0; e < 8; ++e) osel[e] = on ? (short)0x3F80 : (short)0; }
#define MFMA16(a_, b_, c_) __builtin_amdgcn_mfma_f32_16x16x32_bf16((a_), (b_), (c_), 0, 0, 0)
    const bf16_t* kg = PB + (size_t)(krow0 + skey) * NPB_ + C_DK + head * 64 + sseg * 8;
    const bf16_t* vg = PB + (size_t)(krow0 + skey) * NPB_ + C_DV + head * 64 + sseg * 8;
    const int vslot = ((skey & ~12) | ((skey & 4) << 1) | ((skey & 8) >> 1)) ^ (sseg << 3);
    __syncthreads();
    bf16x8 kA = *(const bf16x8*)kg, vA = *(const bf16x8*)vg;
    bf16x8 kB = *(const bf16x8*)(kg + (size_t)64 * NPB_), vB = *(const bf16x8*)(vg + (size_t)64 * NPB_);
    { *(bf16x8*)(Ks + skey * AT_LD + sseg * 8) = kA;
#pragma unroll
      for (int e = 0; e < 8; ++e) Vt[(sseg * 8 + e) * AT_LD + vslot] = (bf16_t)vA[e]; }
    __syncthreads();
    for (int t = 0; t < nt; ++t) {
      const int buf = t & 1;
      const bf16_t* ks = Ks + buf * 64 * AT_LD + (32 * kh + r31) * AT_LD + 8 * h;
      const bf16_t* vt = Vt + buf * 64 * AT_LD + r31 * AT_LD;
      const bf16x8 k00 = *(const bf16x8*)(ks), k01 = *(const bf16x8*)(ks + 16), k10 = *(const bf16x8*)(ks + 32), k11 = *(const bf16x8*)(ks + 48);
      bf16x8 vf[2][2];
#pragma unroll
      for (int s = 0; s < 2; ++s)
#pragma unroll
        for (int mt = 0; mt < 2; ++mt) vf[mt][s] = *(const bf16x8*)(vt + mt * 32 * AT_LD + (((4 * kh + 2 * s + h) ^ ((4 * mt + (r31 >> 3)) & 7)) << 3));
      f32x16 S1 = MFMA32(k00, qf[0][0], NM); f32x16 S2 = MFMA32(k10, qf[1][0], NM); S1 = MFMA32(k01, qf[0][1], S1); S2 = MFMA32(k11, qf[1][1], S2);
      bf16x8 p1[2], p2[2];
      { u32x4 w0, w1;
#pragma unroll
        for (int i = 0; i < 4; ++i) { w0[i] = cvt2(VAR == 1 ? S1[2 * i] * 0.001f : __builtin_amdgcn_exp2f(S1[2 * i]), VAR == 1 ? S1[2 * i + 1] * 0.001f : __builtin_amdgcn_exp2f(S1[2 * i + 1]));
                                       w1[i] = cvt2(VAR == 1 ? S1[8 + 2 * i] * 0.001f : __builtin_amdgcn_exp2f(S1[8 + 2 * i]), VAR == 1 ? S1[9 + 2 * i] * 0.001f : __builtin_amdgcn_exp2f(S1[9 + 2 * i])); }
        p1[0] = __builtin_bit_cast(bf16x8, w0); p1[1] = __builtin_bit_cast(bf16x8, w1); }
      O1[0] = MFMA32(vf[0][0], p1[0], O1[0]); O1[1] = MFMA32(vf[1][0], p1[0], O1[1]); LA = MFMA16(osel, p1[0], LA);
      O1[0] = MFMA32(vf[0][1], p1[1], O1[0]); O1[1] = MFMA32(vf[1][1], p1[1], O1[1]); LA = MFMA16(osel, p1[1], LA);
      { u32x4 w0, w1;
#pragma unroll
        for (int i = 0; i < 4; ++i) { w0[i] = cvt2(VAR == 1 ? S2[2 * i] * 0.001f : __builtin_amdgcn_exp2f(S2[2 * i]), VAR == 1 ? S2[2 * i + 1] * 0.001f : __builtin_amdgcn_exp2f(S2[2 * i + 1]));
                                       w1[i] = cvt2(VAR == 1 ? S2[8 + 2 * i] * 0.001f : __builtin_amdgcn_exp2f(S2[8 + 2 * i]), VAR == 1 ? S2[9 + 2 * i] * 0.001f : __builtin_amdgcn_exp2f(S2[9 + 2 * i])); }
        p2[0] = __builtin_bit_cast(bf16x8, w0); p2[1] = __builtin_bit_cast(bf16x8, w1); }
      if (VAR != 5) {
      O2[0] = MFMA32(vf[0][0], p2[0], O2[0]); O2[1] = MFMA32(vf[1][0], p2[0], O2[1]); LB = MFMA16(osel, p2[0], LB);
      O2[0] = MFMA32(vf[0][1], p2[1], O2[0]); O2[1] = MFMA32(vf[1][1], p2[1], O2[1]); LB = MFMA16(osel, p2[1], LB); }
      __builtin_amdgcn_sched_group_barrier(0x100, 8, 0);
      __builtin_amdgcn_sched_group_barrier(0x8, 4, 0);
      __builtin_amdgcn_sched_group_barrier(0x402, 24, 0);
#pragma unroll
      for (int i = 0; i < 6; ++i) { __builtin_amdgcn_sched_group_barrier(0x8, 1, 0); __builtin_amdgcn_sched_group_barrier(0x402, 4, 0); }
      { const int nb_ = buf ^ 1;
        *(bf16x8*)(Ks + nb_ * 64 * AT_LD + skey * AT_LD + sseg * 8) = kB;
#pragma unroll
        for (int e = 0; e < 8; ++e) Vt[nb_ * 64 * AT_LD + (sseg * 8 + e) * AT_LD + vslot] = (bf16_t)vB[e];
        const int tl_ = (t + 2 < nt) ? t + 2 : nt - 1;
        kB = *(const bf16x8*)(kg + (size_t)tl_ * 64 * NPB_); vB = *(const bf16x8*)(vg + (size_t)tl_ * 64 * NPB_); }
#pragma unroll
      for (int i = 0; i < 5; ++i) { __builtin_amdgcn_sched_group_barrier(0x8, 1, 0); __builtin_amdgcn_sched_group_barrier(0x200, 2, 0); }
      __builtin_amdgcn_sched_group_barrier(0x8, 1, 0); __builtin_amdgcn_sched_group_barrier(0x20, 2, 0);
      __syncthreads();
    }
    float* cw = cmb + (size_t)(qsub * 64 + lane) * 66;
    const int sl_ = ((lane & 15) << 2);
    const float a0_ = __int_as_float(__builtin_amdgcn_ds_bpermute(sl_, __float_as_int(LA[0]))), a1_ = __int_as_float(__builtin_amdgcn_ds_bpermute(sl_, __float_as_int(LA[1])));
    const float b0_ = __int_as_float(__builtin_amdgcn_ds_bpermute(sl_, __float_as_int(LB[0]))), b1_ = __int_as_float(__builtin_amdgcn_ds_bpermute(sl_, __float_as_int(LB[1])));
    const float lq1 = (r31 >> 4) ? a1_ : a0_, lq2 = (r31 >> 4) ? b1_ : b0_;
    if (kh == 1) {
#pragma unroll
      for (int i = 0; i < 16; ++i) { cw[i] = O1[0][i]; cw[16 + i] = O1[1][i]; cw[32 + i] = O2[0][i]; cw[48 + i] = O2[1][i]; }
      cw[64] = lq1; cw[65] = lq2;
    }
    __syncthreads();
    if (kh == 0) {
#pragma unroll
      for (int i = 0; i < 16; ++i) { O1[0][i] += cw[i]; O1[1][i] += cw[16 + i]; O2[0][i] += cw[32 + i]; O2[1][i] += cw[48 + i]; }
      const float l1 = lq1 + cw[64], l2 = lq2 + cw[65];
      const float i1 = 1.0f / l1, i2 = lam / l2;
      float ss = 0.f;
#pragma unroll
      for (int mt = 0; mt < 2; ++mt)
#pragma unroll
        for (int i = 0; i < 16; ++i) { const float o = O1[mt][i] * i1 - O2[mt][i] * i2; O1[mt][i] = o; ss += o * o; }
      ss += shx(ss, 32, lane_id_v());
      const float sc = rsqrtf(ss * (1.0f / 64.0f) + EPS_) * (1.0f - lam_init);
      const float* sw = a->in[13] + l * 64;
#pragma unroll
      for (int mt = 0; mt < 2; ++mt)
#pragma unroll
        for (int g4 = 0; g4 < 4; ++g4) {
          const int v0 = 32 * mt + 8 * g4 + 4 * h;
          const f32x4 wv = *(const f32x4*)(sw + v0);
          u32x2 w; w.x = cvt_pk_bf16(O1[mt][4 * g4] * sc * wv[0], O1[mt][4 * g4 + 1] * sc * wv[1]); w.y = cvt_pk_bf16(O1[mt][4 * g4 + 2] * sc * wv[2], O1[mt][4 * g4 + 3] * sc * wv[3]);
          *(u32x2*)(BR + (size_t)qrow * 1024 + 640 + head * 64 + v0) = w;
        }
    }
  }
}
template <class Epi> DI void run_gemm(int WV, LAS unsigned char* lds, const bf16_t* A, int lda, const bf16_t* Bt, int M, int N, int K, const Epi& E) {
  pg8::Gemm g; g.A = A; g.Bt = Bt; g.M = M; g.N = N; g.K = K; g.lda = lda;
  pg8::StaticOrder S; S.init(M, N, lnb(), lbid());
  pg8::gemm_phase<Epi, pg8::StaticOrder, false>(WV, lds, g, S, E, nullptr);
}
struct CtxMerge0 { float* MXC; const bf16_t* G; DI void operator()(int r, int c, float v) const { MXC[r * 1024 + c] = bf2f(G[(size_t)r * NGB_ + c]) * v; } };
struct CtxMerge1 { float* MXC; const bf16_t* G; DI void operator()(int r, int c, float v) const { MXC[r * 1024 + c] += bf2f(G[(size_t)r * NGB_ + c]) * v; } };
struct CtxMerge2 { const float* MXC; const bf16_t* G; bf16_t* Hc; DI void operator()(int r, int c, float v) const { Hc[r * 1024 + c] = f2bf(MXC[r * 1024 + c] + bf2f(G[(size_t)r * NGB_ + c]) * v); } };
struct CtxResid { float* Xc; const float* gate; float scale; DI void operator()(int r, int c, float v) const { Xc[r * 1024 + c] += scale * gate[c] * v; } };

DI void phase_win(int WV, int l, unsigned char* smem) {
  KArgs a = kargs(); unsigned char* ws = a->ws;
  EpiWin E; E.PB = (bf16_t*)(ws + WS_PB); E.GB = (bf16_t*)(ws + WS_GB); E.TRET = (const float*)(ws + WS_TRET); E.TROW = (const float*)(ws + WS_TROW); E.TCOL = (const float*)(ws + WS_TCOL);
  E.kmax = (unsigned*)(ws + WS_SCAL) + l * 64 + 16;
  run_gemm(WV, (LAS unsigned char*)smem, (const bf16_t*)(ws + WS_H), 1024, (const bf16_t*)(ws + WS_WIN) + (size_t)l * 5888 * 1024, MT_, NWIN_, 1024, E);
}
DI void phase_merge(int WV, int l, unsigned char* smem) {
  LAS unsigned char* lds = (LAS unsigned char*)smem;
  { KArgs a = kargs(); unsigned char* ws = a->ws; EpiMerge<0> E; E.MX = a->out; E.G = (const bf16_t*)(ws + WS_GB); E.Hout = (bf16_t*)(ws + WS_H);
    run_gemm(WV, lds, (const bf16_t*)(ws + WS_BR), 1024, (const bf16_t*)(ws + WS_WBF) + (size_t)l * 1024 * 256, L_, 1024, 256, E); }
  { KArgs a = kargs(); unsigned char* ws = a->ws; EpiMerge<1> E; E.MX = a->out; E.G = (const bf16_t*)(ws + WS_GB) + 1024; E.Hout = (bf16_t*)(ws + WS_H);
    run_gemm(WV, lds, (const bf16_t*)(ws + WS_BR) + 256, 1024, (const bf16_t*)(ws + WS_WBR) + (size_t)l * 1024 * 384, L_, 1024, 384, E); }
  { KArgs a = kargs(); unsigned char* ws = a->ws; EpiMerge<2> E; E.MX = a->out; E.G = (const bf16_t*)(ws + WS_GB) + 2048; E.Hout = (bf16_t*)(ws + WS_H);
    run_gemm(WV, lds, (const bf16_t*)(ws + WS_BR) + 640, 1024, (const bf16_t*)(ws + WS_WBD) + (size_t)l * 1024 * 384, L_, 1024, 384, E); }
  { KArgs a = kargs(); unsigned char* ws = a->ws;
    const bf16_t* BRc = (const bf16_t*)(ws + WS_BR) + (size_t)L_ * 1024; const bf16_t* GBc = (const bf16_t*)(ws + WS_GB) + (size_t)L_ * NGB_;
    CtxMerge0 e0; e0.MXC = (float*)(ws + WS_MXC); e0.G = GBc;
    ctx_gemm32(WV, BRc, 1024, (const bf16_t*)(ws + WS_WBF) + (size_t)l * 1024 * 256, 256, 1024, smem, e0);
    CtxMerge1 e1; e1.MXC = (float*)(ws + WS_MXC); e1.G = GBc + 1024;
    ctx_gemm32(WV, BRc + 256, 1024, (const bf16_t*)(ws + WS_WBR) + (size_t)l * 1024 * 384, 384, 1024, smem, e1);
    CtxMerge2 e2; e2.MXC = (const float*)(ws + WS_MXC); e2.G = GBc + 2048; e2.Hc = (bf16_t*)(ws + WS_H) + (size_t)L_ * 1024;
    ctx_gemm32(WV, BRc + 640, 1024, (const bf16_t*)(ws + WS_WBD) + (size_t)l * 1024 * 384, 384, 1024, smem, e2); }
}
DI void phase_wo(int WV, int l, unsigned char* smem) {
  { KArgs a = kargs(); unsigned char* ws = a->ws; EpiResid E; E.X = (float*)(ws + WS_X); E.gate = (const float*)(ws + WS_MOD) + (size_t)l * 9216 + 5 * 1024; E.scale = 1.0f;
    run_gemm(WV, (LAS unsigned char*)smem, (const bf16_t*)(ws + WS_H), 1024, (const bf16_t*)(ws + WS_WO) + (size_t)l * 1024 * 1024, L_, 1024, 1024, E); }
  { KArgs a = kargs(); unsigned char* ws = a->ws; CtxResid e; e.Xc = (float*)(ws + WS_X) + (size_t)L_ * 1024; e.gate = (const float*)(ws + WS_MOD) + (size_t)(4 + l) * 9216 + 5 * 1024; e.scale = 1.0f;
    ctx_gemm32(WV, (const bf16_t*)(ws + WS_H) + (size_t)L_ * 1024, 1024, (const bf16_t*)(ws + WS_WO) + (size_t)l * 1024 * 1024, 1024, 1024, smem, e); }
}
DI void phase_g1(int WV, int l, int f, unsigned char* smem) {
  KArgs a = kargs(); unsigned char* ws = a->ws; EpiSwiglu E; E.U = (bf16_t*)(ws + WS_U);
  run_gemm(WV, (LAS unsigned char*)smem, (const bf16_t*)(ws + WS_H), 1024, (const bf16_t*)(ws + WS_W13) + (size_t)(l * 2 + f) * 5632 * 1024, MT_, 5632, 1024, E);
}
DI void phase_g2(int WV, int l, int f, unsigned char* smem) {
  const int gi = f == 0 ? 2 : 8;
  { KArgs a = kargs(); unsigned char* ws = a->ws; EpiResid E; E.X = (float*)(ws + WS_X); E.gate = (const float*)(ws + WS_MOD) + (size_t)l * 9216 + gi * 1024; E.scale = 0.5f;
    run_gemm(WV, (LAS unsigned char*)smem, (const bf16_t*)(ws + WS_U), 2816, (const bf16_t*)(ws + WS_W2) + (size_t)(l * 2 + f) * 1024 * 2816, L_, 1024, 2816, E); }
  { KArgs a = kargs(); unsigned char* ws = a->ws; CtxResid e; e.Xc = (float*)(ws + WS_X) + (size_t)L_ * 1024; e.gate = (const float*)(ws + WS_MOD) + (size_t)(4 + l) * 9216 + gi * 1024; e.scale = 0.5f;
    ctx_gemm32(WV, (const bf16_t*)(ws + WS_U) + (size_t)L_ * 2816, 2816, (const bf16_t*)(ws + WS_W2) + (size_t)(l * 2 + f) * 1024 * 2816, 2816, 1024, smem, e); }
}

DI unsigned xcc_id() { return (unsigned)__builtin_amdgcn_s_getreg((3 << 11) | 20) & 0xFu; }
DI void grid_bar(int WV, unsigned& gen, unsigned xcc, unsigned nloc, unsigned nx) {
  asm volatile("s_waitcnt vmcnt(0)" ::: "memory");
  __syncthreads();
  gen += 1;
  if (ltid() == 0) {
    unsigned* bar = (unsigned*)(kargs()->ws + WS_BAR);
    const unsigned old = __hip_atomic_fetch_add(bar + 320 + 16 * xcc, 1u, __ATOMIC_RELAXED, __HIP_MEMORY_SCOPE_AGENT);
    if (old + 1u == gen * nloc) {
      __builtin_amdgcn_fence(__ATOMIC_RELEASE, "agent");
      asm volatile("s_waitcnt vmcnt(0)" ::: "memory");
      __hip_atomic_fetch_add(bar + 640, 1u, __ATOMIC_RELAXED, __HIP_MEMORY_SCOPE_AGENT);
    }
    const unsigned target = gen * nx;
    while (__hip_atomic_load(bar + 640, __ATOMIC_RELAXED, __HIP_MEMORY_SCOPE_AGENT) < target) __builtin_amdgcn_s_sleep(1);
    __builtin_amdgcn_fence(__ATOMIC_ACQUIRE, "agent");
    asm volatile("s_waitcnt vmcnt(0)" ::: "memory");
  }
  __syncthreads();
}

__global__ void __launch_bounds__(512, 2) mega(Args a_unused) {
  extern __shared__ __attribute__((aligned(16))) unsigned char smem[];
  cg::grid_group grid = cg::this_grid();
  const int WV = __builtin_amdgcn_readfirstlane((int)(threadIdx.x >> 6));
  const unsigned xcc = xcc_id();
  if (threadIdx.x == 0) __hip_atomic_fetch_add((unsigned*)(kargs()->ws + WS_BAR) + 16 + 16 * xcc, 1u, __ATOMIC_RELAXED, __HIP_MEMORY_SCOPE_AGENT);
#ifndef NO_PRO
  prologue(WV, kargs(), smem);
#ifdef PROBE_PRO
  __syncthreads(); prologue(WV, kargs(), smem);
#endif
#endif
  grid.sync();
  unsigned gen = 0, nloc = 1, nx = 0;
  { const unsigned* cen = (const unsigned*)(kargs()->ws + WS_BAR) + 16;
    for (int j = 0; j < 16; ++j) { const unsigned cj = __hip_atomic_load(cen + 16 * j, __ATOMIC_RELAXED, __HIP_MEMORY_SCOPE_AGENT); nx += cj ? 1u : 0u; if ((unsigned)j == xcc) nloc = cj; }
    nloc = __builtin_amdgcn_readfirstlane(nloc); nx = __builtin_amdgcn_readfirstlane(nx); }
#pragma unroll 1
  for (int l = 0; l < DEPTH_; ++l) {
#pragma unroll 1
    for (int f = 0; f < 2; ++f) {
      if (f == 1) {
        norm_phase(WV, kargs(), l, 1, false);
        grid_bar(WV, gen, xcc, nloc, nx);
        phase_win(WV, l, smem);
#ifdef PROBE_WIN
        phase_win(WV, l, smem);
#endif
        grid_bar(WV, gen, xcc, nloc, nx);
#ifndef NO_MIXA
        fourier_tables(WV, smem); __syncthreads(); fourier_stage1(WV, kargs(), smem); fourier_ctx(WV, kargs(), smem); __syncthreads(); ret_states(WV, kargs(), l, smem);
#ifdef PROBE_MIXA
        __syncthreads();
        fourier_tables(WV, smem); __syncthreads(); fourier_stage1(WV, kargs(), smem); fourier_ctx(WV, kargs(), smem); __syncthreads(); ret_states(WV, kargs(), l, smem);
#endif
#endif
        grid_bar(WV, gen, xcc, nloc, nx);
#ifndef NO_MIXB
        ret_scan(WV, kargs(), l); __syncthreads(); fourier_tables(WV, smem); __syncthreads(); fourier_stage2(WV, kargs(), smem);
#ifdef PROBE_MIXB
        __syncthreads();
        ret_scan(WV, kargs(), l); __syncthreads(); fourier_tables(WV, smem); __syncthreads(); fourier_stage2(WV, kargs(), smem);
#endif
#endif
        grid_bar(WV, gen, xcc, nloc, nx);
#ifndef NO_RETOUT
        ret_out(WV, kargs(), l, smem); __syncthreads();
#ifdef PROBE_RET
        ret_out(WV, kargs(), l, smem); __syncthreads();
#endif
#endif
#ifndef NO_ATTN
        attn_phase<0>(WV, kargs(), l, l < DEPTH_ - 1, smem);
#ifdef PROBE_ATTN
        __syncthreads(); attn_phase<PROBE_ATTN>(WV, kargs(), l, l < DEPTH_ - 1, smem);
#endif
#endif
        grid_bar(WV, gen, xcc, nloc, nx);
        phase_merge(WV, l, smem);
#ifdef PROBE_MERGE
        phase_merge(WV, l, smem);
#endif
        grid_bar(WV, gen, xcc, nloc, nx);
        phase_wo(WV, l, smem);
        grid_bar(WV, gen, xcc, nloc, nx);
      }
      norm_phase(WV, kargs(), l, f == 0 ? 0 : 2, l == 0 && f == 0);
      grid_bar(WV, gen, xcc, nloc, nx);
      phase_g1(WV, l, f, smem);
#ifdef PROBE_G1
      phase_g1(WV, l, f, smem);
#endif
      grid_bar(WV, gen, xcc, nloc, nx);
      phase_g2(WV, l, f, smem);
      grid_bar(WV, gen, xcc, nloc, nx);
    }
  }
  final_norm(WV, kargs());
}

extern "C" void kernel_launch(void* const* d_in, const int* in_sizes, int n_in, void* d_out, int out_size, void* d_ws, size_t ws_size, hipStream_t stream) {
  static int grid = 0;
  if (grid == 0) {
    int dev = 0, cus = 0, per_cu = 0;
    (void)hipGetDevice(&dev); (void)hipDeviceGetAttribute(&cus, hipDeviceAttributeMultiprocessorCount, dev);
    if (hipFuncSetAttribute((const void*)mega, hipFuncAttributeMaxDynamicSharedMemorySize, LDS_BYTES) != hipSuccess) fprintf(stderr, "kernel_launch: hipFuncSetAttribute failed\n");
    if (hipOccupancyMaxActiveBlocksPerMultiprocessor(&per_cu, (const void*)mega, 512, LDS_BYTES) != hipSuccess || per_cu < 1) fprintf(stderr, "kernel_launch: occupancy query says %d blocks per CU\n", per_cu);
    (void)hipGetLastError();
    grid = cus > 0 ? cus : 256;
    if (ws_size < WS_END) { fprintf(stderr, "kernel_launch: workspace too small: %zu < %zu\n", ws_size, (size_t)WS_END); }
  }
  Args a{};
  for (int i = 0; i < 19; ++i) a.in[i] = (const float*)d_in[i];
  a.out = (float*)d_out; a.ws = (unsigned char*)d_ws;
  (void)hipMemsetAsync((unsigned char*)d_ws + WS_BAR, 0, 8192, stream);
  void* args[] = {&a};
  hipError_t e = hipLaunchCooperativeKernel((const void*)mega, dim3(grid), dim3(512), args, LDS_BYTES, stream);
  if (e != hipSuccess) fprintf(stderr, "kernel_launch: cooperative launch failed: %s (grid %d)\n", hipGetErrorString(e), grid);
}
```

```cpp
#include <hip/hip_runtime.h>
#include <hip/hip_cooperative_groups.h>
#include <cstdio>
namespace cg = cooperative_groups;
__device__ __forceinline__ int lane_id_v() { int l; asm volatile("v_mbcnt_lo_u32_b32 %0, -1, 0\n\tv_mbcnt_hi_u32_b32 %0, -1, %0" : "=v"(l)); return l; }
#define ltid() ((WV << 6) | lane_id_v())
__device__ __forceinline__ float shx(float v, int m, int lane) { return __int_as_float(__builtin_amdgcn_ds_bpermute((lane ^ m) << 2, __float_as_int(v))); }
namespace pg8 {
#define PG8_LAS __attribute__((address_space(3)))
typedef unsigned short bf16_t;
typedef short bf16x8 __attribute__((ext_vector_type(8)));
typedef float f32x4 __attribute__((ext_vector_type(4)));
typedef unsigned u32x4 __attribute__((ext_vector_type(4)));
constexpr int BM = 256, BK = 64, HALF = 128, HTB = HALF * BK * 2  , STAGE_BYTES = 8 * HTB, NXCD = 8, WGM = 8;

__host__ __device__ __forceinline__ int lds_byte(int r, int c) { const int st = (r >> 4) * 2 + (c >> 5), rr = r & 15, cc = c & 31, ob = rr * 64 + cc * 2; return st * 1024 + (ob ^ (((ob >> 9) & 1) << 5)); }
__host__ __device__ __forceinline__ void stage_rc(int b, int& R, int& C) { const int st = b / 1024, sb = b % 1024, swz = sb ^ (((sb >> 9) & 1) << 5); R = (st >> 1) * 16 + swz / 64; C = (st & 1) * 32 + (swz % 64) / 2; }
__host__ __device__ __forceinline__ int perm32(int rho) { const int n = rho >> 4, i = rho & 15; return 8 * (i >> 2) + 4 * n + (i & 3); }

struct Unit { int pm, pn; };
struct Gemm { const bf16_t* A; const bf16_t* Bt; int M, N, K, lda; };

struct StaticOrder {
    int nM, nN, nwg, G, c;
    __host__ __device__ void init(int M, int N, int G_, int c_) { nM = M / BM; nN = N / BM; nwg = nM * nN; G = G_; c = c_; }
    __host__ __device__ bool next(int i, Unit& u) const {
        const long L = (long)i * G + c; if (L >= nwg) return false;
        int wgid = (int)L; { const int q = nwg / NXCD, r = nwg % NXCD, xcd = wgid % NXCD, off = wgid / NXCD; wgid = (xcd < r ? xcd * (q + 1) : r * (q + 1) + (xcd - r) * q) + off; }
        const int nig = WGM * nN, gid = wgid / nig, fm = gid * WGM, gsz = (nM - fm) < WGM ? (nM - fm) : WGM;
        u.pm = fm + ((wgid % nig) % gsz); u.pn = (wgid % nig) / gsz; return true;
    }
    __device__ __forceinline__ void a_ready(const Unit&) const {}
    __device__ __forceinline__ void done(const Unit&) const {}
};
__device__ __forceinline__ unsigned cvt_pk_bf16(float lo, float hi) { unsigned r; asm volatile("v_cvt_pk_bf16_f32 %0, %1, %2" : "=v"(r) : "v"(lo), "v"(hi)); return r; }
template <class Epi, class Sched, bool STAMP = false>
__device__ __forceinline__ void gemm_phase(const int WV, PG8_LAS unsigned char* lds, const Gemm g, const Sched& S, const Epi& E, unsigned long long* stamps) {
    const int tid = ltid(); const int wid = __builtin_amdgcn_readfirstlane(tid >> 6), lane = tid & 63, wr = wid >> 2, wc = wid & 3, fr = lane & 15, fq = lane >> 4;
    const int K = g.K, nt = K / BK;
    int ts_lo = 0, ts_hi = 0, nts = 0; const unsigned long long rt_entry = STAMP ? (unsigned long long)wall_clock64() : 0ull;
#define PG8_STAMP() do { if (STAMP && wid == 0 && nts < 64) { const unsigned long long _c = (unsigned long long)clock64(); \
        ts_lo = (lane == nts) ? (int)(unsigned)_c : ts_lo; ts_hi = (lane == nts) ? (int)(unsigned)(_c >> 32) : ts_hi; ++nts; } } while (0)
    PG8_STAMP();
    unsigned voffA[2], voffB[2];
#pragma unroll
    for (int i = 0; i < 2; ++i) { int R, C; stage_rc(tid * 16 + i * 8192, R, C); const int Rb = Epi::PERM ? ((R & ~31) + perm32(R & 31)) : R;
        voffA[i] = (unsigned)(R * g.lda + C) * 2u; voffB[i] = (unsigned)(Rb * K + C) * 2u; }
    const size_t kstep = (size_t)(BK * 2);
    const size_t hstep = (size_t)HALF * K * 2;
    const size_t tstep = 2 * hstep; const size_t hstepA = (size_t)HALF * g.lda * 2; const size_t tstepA = 2 * hstepA;
    const unsigned ldsw = (unsigned)wid * 1024u;
    const int aoff = lds_byte(wr * 64 + fr, fq * 8), boff = lds_byte(wc * 32 + fr, fq * 8);
#define PG8_SA(b, h) (((b) * 2 + (h)) * HTB)
#define PG8_SB(b, h) ((4 + (b) * 2 + (h)) * HTB)
#define PG8_STAGE(bufoff, gbase, voff) do { _Pragma("unroll") for (int _i = 0; _i < 2; ++_i) \
        __builtin_amdgcn_global_load_lds((const unsigned*)((const char*)(gbase) + (voff)[_i]), (PG8_LAS unsigned*)(lds + (bufoff) + ldsw + _i * 8192), 16, 0, 0); } while (0)
#define PG8_LDA(dst, b, h) do { _Pragma("unroll") for (int m = 0; m < 4; ++m) _Pragma("unroll") for (int k = 0; k < 2; ++k) dst[m][k] = *(const PG8_LAS bf16x8*)(lds + PG8_SA(b, h) + aoff + m * 2048 + k * 1024); } while (0)
#define PG8_LDB(dst, b, h) do { _Pragma("unroll") for (int n = 0; n < 2; ++n) _Pragma("unroll") for (int k = 0; k < 2; ++k) dst[n][k] = *(const PG8_LAS bf16x8*)(lds + PG8_SB(b, h) + boff + n * 2048 + k * 1024); } while (0)
#define PG8_MMA(ai, bj, At, Bt) do { __builtin_amdgcn_s_setprio(1); _Pragma("unroll") for (int m = 0; m < 4; ++m) _Pragma("unroll") for (int n = 0; n < 2; ++n) _Pragma("unroll") for (int k = 0; k < 2; ++k) \
        acc[ai][bj][m][n] = __builtin_amdgcn_mfma_f32_16x16x32_bf16(Bt[n][k], At[m][k], acc[ai][bj][m][n], 0, 0, 0); __builtin_amdgcn_s_setprio(0); } while (0)
#define PG8_WAIT_V(n) asm volatile("s_waitcnt vmcnt(" #n ")" ::: "memory")
#define PG8_WAIT_L(n) asm volatile("s_waitcnt lgkmcnt(" #n ")" ::: "memory")
#define PG8_BAR __builtin_amdgcn_s_barrier()
#define PG8_SCHED __builtin_amdgcn_sched_barrier(0)
    Unit cur, nxt; int ui = 0;
    if (!S.next(0, cur)) return;
    f32x4 acc[2][2][4][2];
#pragma unroll
    for (int a = 0; a < 2; ++a)
#pragma unroll
        for (int b = 0; b < 2; ++b)
#pragma unroll
            for (int m = 0; m < 4; ++m)
#pragma unroll
                for (int n = 0; n < 2; ++n) acc[a][b][m][n] = (f32x4){0.f, 0.f, 0.f, 0.f};
    bf16x8 At[4][2], B0[2][2], B1[2][2];
    const char* cA = (const char*)g.A + (size_t)cur.pm * tstepA; const char* cB = (const char*)g.Bt + (size_t)cur.pn * tstep;
    S.a_ready(cur);
    PG8_STAGE(PG8_SB(0, 0), cB, voffB); PG8_STAGE(PG8_SA(0, 0), cA, voffA); PG8_STAGE(PG8_SB(0, 1), cB + hstep, voffB); PG8_STAGE(PG8_SA(0, 1), cA + hstepA, voffA);
    if (wr == 1) PG8_BAR;
    PG8_WAIT_V(4); PG8_BAR;
    PG8_STAGE(PG8_SB(1, 0), cB + kstep, voffB); PG8_STAGE(PG8_SA(1, 0), cA + kstep, voffA); PG8_STAGE(PG8_SB(1, 1), cB + hstep + kstep, voffB);
    PG8_WAIT_V(6); PG8_BAR;
    PG8_STAMP();
    for (;;) {
        const bool has_next = S.next(ui + 1, nxt);
        const char* nA = has_next ? (const char*)g.A + (size_t)nxt.pm * tstepA : cA; const char* nB = has_next ? (const char*)g.Bt + (size_t)nxt.pn * tstep : cB;
        for (int t = 0; t < nt; t += 2) {
            const bool last = (t == nt - 2);
            const char* a1 = cA + (size_t)(t + 1) * kstep;
            const char* a2 = last ? nA : cA + (size_t)(t + 2) * kstep; const char* b2 = last ? nB : cB + (size_t)(t + 2) * kstep;
            const char* a3 = a2 + kstep; const char* b3 = b2 + kstep;
            if (last && has_next) S.a_ready(nxt);
            PG8_LDB(B0, 0, 0); PG8_SCHED; PG8_LDA(At, 0, 0); PG8_STAGE(PG8_SA(1, 1), a1 + hstepA, voffA);
            PG8_WAIT_L(8); PG8_BAR; PG8_WAIT_L(0); PG8_MMA(0, 0, At, B0); PG8_BAR; PG8_SCHED;
            PG8_LDB(B1, 0, 1); PG8_STAGE(PG8_SB(0, 0), b2, voffB);
            PG8_BAR; PG8_WAIT_L(0); PG8_MMA(0, 1, At, B1); PG8_BAR;
            PG8_LDA(At, 0, 1); PG8_STAGE(PG8_SA(0, 0), a2, voffA);
            PG8_BAR; PG8_WAIT_L(0); PG8_MMA(1, 0, At, B0); PG8_BAR; PG8_SCHED;
            PG8_STAGE(PG8_SB(0, 1), b2 + hstep, voffB);
            PG8_WAIT_V(6); PG8_BAR; PG8_MMA(1, 1, At, B1); PG8_BAR;
            PG8_LDB(B0, 1, 0); PG8_SCHED; PG8_LDA(At, 1, 0); PG8_STAGE(PG8_SA(0, 1), a2 + hstepA, voffA);
            PG8_WAIT_L(8); PG8_BAR; PG8_WAIT_L(0); PG8_MMA(0, 0, At, B0); PG8_BAR; PG8_SCHED;
            PG8_LDB(B1, 1, 1); PG8_STAGE(PG8_SB(1, 0), b3, voffB);
            PG8_BAR; PG8_WAIT_L(0); PG8_MMA(0, 1, At, B1); PG8_BAR;
            PG8_LDA(At, 1, 1); PG8_STAGE(PG8_SA(1, 0), a3, voffA);
            PG8_BAR; PG8_WAIT_L(0); PG8_MMA(1, 0, At, B0); PG8_BAR; PG8_SCHED;
            PG8_STAGE(PG8_SB(1, 1), b3 + hstep, voffB);
            PG8_WAIT_V(6); PG8_BAR; PG8_MMA(1, 1, At, B1); PG8_BAR;
        }
        PG8_STAMP();
        if constexpr (!Epi::AFTER_DRAIN) { E(acc, cur, wr, wc, fr, fq); S.done(cur); }
        PG8_STAMP();
        if (!has_next) break;
#pragma unroll
        for (int a = 0; a < 2; ++a)
#pragma unroll
            for (int b = 0; b < 2; ++b)
#pragma unroll
                for (int m = 0; m < 4; ++m)
#pragma unroll
                    for (int n = 0; n < 2; ++n) acc[a][b][m][n] = (f32x4){0.f, 0.f, 0.f, 0.f};
        cur = nxt; cA = nA; cB = nB; ++ui;
    }
    PG8_WAIT_V(0);
    if (wr == 0) PG8_BAR;
    PG8_BAR;
    if constexpr (Epi::AFTER_DRAIN) { E.fused(acc, cur, wr, wc, fr, fq, lds, wid, lane); S.done(cur); }
    PG8_STAMP();
    if (STAMP && wid == 0) { stamps[lane] = lane < nts ? (((unsigned long long)(unsigned)ts_hi << 32) | (unsigned)ts_lo) : 0ull;
        if (lane == 62) stamps[62] = rt_entry; if (lane == 63) stamps[63] = (unsigned long long)wall_clock64(); }
#undef PG8_STAMP
#undef PG8_SA
#undef PG8_SB
#undef PG8_STAGE
#undef PG8_LDA
#undef PG8_LDB
#undef PG8_MMA
#undef PG8_WAIT_V
#undef PG8_WAIT_L
#undef PG8_BAR
#undef PG8_SCHED
}
}
using pg8::bf16_t; using pg8::bf16x8; using pg8::f32x4; using pg8::u32x4; using pg8::cvt_pk_bf16;
typedef float f32x16 __attribute__((ext_vector_type(16)));
typedef short s16x4 __attribute__((ext_vector_type(4)));
typedef unsigned u32x2 __attribute__((ext_vector_type(2)));
#define DI __device__ __forceinline__
#define LAS __attribute__((address_space(3)))
#define MFMA32(a, b, c) __builtin_amdgcn_mfma_f32_32x32x16_bf16((a), (b), (c), 0, 0, 0)

constexpr int L_ = 16384, LC_ = 256, MT_ = 16640, D_ = 1024, DFF_ = 2816, DEPTH_ = 4;
constexpr int NWIN_ = 5888, NPB_ = 2816, NGB_ = 3072;
constexpr int C_FA = 0, C_FB = 256, C_RQ = 512, C_RK = 704, C_RV = 896, C_RG = 1280, C_DQ = 1664, C_DK = 2048, C_DV = 2432;
constexpr int LDS_BYTES = 147456;
constexpr float EPS_ = 1e-6f;

constexpr size_t al256(size_t x) { return (x + 255) & ~(size_t)255; }
constexpr size_t WS_W13 = 0;
constexpr size_t WS_W2  = WS_W13 + (size_t)4 * 2 * 5632 * 1024 * 2;
constexpr size_t WS_WIN = WS_W2 + (size_t)4 * 2 * 1024 * 2816 * 2;
constexpr size_t WS_WBF = WS_WIN + (size_t)4 * 5888 * 1024 * 2;
constexpr size_t WS_WBR = WS_WBF + (size_t)4 * 1024 * 256 * 2;
constexpr size_t WS_WBD = WS_WBR + (size_t)4 * 1024 * 384 * 2;
constexpr size_t WS_WO  = WS_WBD + (size_t)4 * 1024 * 384 * 2;
constexpr size_t WS_X   = WS_WO + (size_t)4 * 1024 * 1024 * 2;
constexpr size_t WS_H   = WS_X + (size_t)MT_ * 1024 * 4;
constexpr size_t WS_BR  = WS_H + (size_t)MT_ * 1024 * 2;
constexpr size_t WS_AL  = WS_BR + (size_t)MT_ * 1024 * 2;
constexpr size_t WS_U   = WS_AL;
constexpr size_t WS_PB  = WS_AL;
constexpr size_t WS_GB  = WS_AL + (size_t)MT_ * 2816 * 2;
constexpr size_t WS_V   = WS_GB + (size_t)MT_ * 3072 * 2;
constexpr size_t WS_T   = WS_V + (size_t)128 * 128 * 2 * 256 * 2;
constexpr size_t WS_S   = WS_T + (size_t)130 * 6 * 2 * 2048 * 4;
constexpr size_t WS_MXC = WS_S + (size_t)130 * 6 * 2 * 2048 * 4;
constexpr size_t WS_MOD = WS_MXC + (size_t)256 * 1024 * 4;
constexpr size_t WS_TRET = WS_MOD + (size_t)2 * 4 * 9216 * 4;
constexpr size_t WS_TROW = WS_TRET + (size_t)16384 * 16 * 2 * 4;
constexpr size_t WS_TCOL = WS_TROW + (size_t)256 * 8 * 2 * 4;
constexpr size_t WS_SCAL = WS_TCOL + (size_t)64 * 8 * 2 * 4;
constexpr size_t WS_BAR = WS_SCAL + 4 * 64 * 4;
constexpr size_t WS_END = WS_BAR + 8192;

__device__ __forceinline__ int lbid() { int t = blockIdx.x; asm volatile("" : "+s"(t)); return t; }
__device__ __forceinline__ int lnb() { int t = gridDim.x; asm volatile("" : "+s"(t)); return t; }
struct Args { const float* in[19]; float* out; unsigned char* ws; };
typedef const Args __attribute__((address_space(4)))* KArgs;
__device__ __forceinline__ KArgs kargs() { KArgs p = (KArgs)__builtin_amdgcn_kernarg_segment_ptr(); asm volatile("" : "+s"(p)); return p; }

DI float bf2f(unsigned v) { return __uint_as_float(v << 16); }
DI bf16_t f2bf(float x) { return (bf16_t)(cvt_pk_bf16(x, 0.f) & 0xffffu); }
DI int crow(int reg, int h) { return (reg & 3) + 8 * (reg >> 2) + 4 * h; }
DI bf16x8 pack_step(const f32x16& x, int s) {
  u32x4 p;
  asm volatile("v_cvt_pk_bf16_f32 %0, %4, %5\n\tv_cvt_pk_bf16_f32 %1, %6, %7\n\tv_cvt_pk_bf16_f32 %2, %8, %9\n\tv_cvt_pk_bf16_f32 %3, %10, %11\n\ts_nop 1"
               : "=&v"(p[0]), "=&v"(p[1]), "=&v"(p[2]), "=&v"(p[3])
               : "v"(x[8 * s]), "v"(x[8 * s + 1]), "v"(x[8 * s + 2]), "v"(x[8 * s + 3]), "v"(x[8 * s + 4]), "v"(x[8 * s + 5]), "v"(x[8 * s + 6]), "v"(x[8 * s + 7]));
  return __builtin_bit_cast(bf16x8, p);
}
DI float silu_f(float a) { return a * __builtin_amdgcn_rcpf(1.0f + __expf(-a)); }
DI float sigmoid_f(float a) { return __builtin_amdgcn_rcpf(1.0f + __expf(-a)); }
DI float wave_sum(float v) {
  const int lane = lane_id_v();
#pragma unroll
  for (int o = 32; o > 0; o >>= 1) v += shx(v, o, lane);
  return v;
}
DI void sincos_acc(float xf, float& s, float& c) {
  const double x = (double)xf;
  const double k = rint(x * 0.63661977236758134308);
  double r = fma(-k, 1.57079632679489655800e+00, x); r = fma(-k, 6.12323399573676603587e-17, r);
  const double r2 = r * r;
  double sp = -1.0 / 39916800.0; sp = fma(sp, r2, 1.0 / 362880.0); sp = fma(sp, r2, -1.0 / 5040.0); sp = fma(sp, r2, 1.0 / 120.0); sp = fma(sp, r2, -1.0 / 6.0); sp = fma(sp * r2, r, r);
  double cp = 1.0 / 479001600.0; cp = fma(cp, r2, -1.0 / 3628800.0); cp = fma(cp, r2, 1.0 / 40320.0); cp = fma(cp, r2, -1.0 / 720.0); cp = fma(cp, r2, 1.0 / 24.0); cp = fma(cp, r2, -0.5); cp = fma(cp, r2, 1.0);
  const int q = ((int)(long long)k) & 3;
  const double sv = (q == 0) ? sp : (q == 1) ? cp : (q == 2) ? -sp : -cp;
  const double cv = (q == 0) ? cp : (q == 1) ? -sp : (q == 2) ? -cp : sp;
  s = (float)sv; c = (float)cv;
}
__constant__ float INV16[16] = {1.0f, 0.5623413324356079f, 0.3162277638912201f, 0.17782793939113617f, 0.10000000149011612f, 0.05623413249850273f, 0.03162277489900589f, 0.017782794311642647f,
                             0.009999999776482582f, 0.005623413249850273f, 0.003162277629598975f, 0.0017782794311642647f, 0.0010000000474974513f, 0.000562341301701963f, 0.0003162277571391314f, 0.00017782794020604342f};
struct ConvJob { const float* src; const float* src2; bf16_t* dst; int N, K, ld, kind; };
DI ConvJob conv_job(KArgs a, int j) {
  const int l = j / 9, kd = j % 9; ConvJob J; J.src2 = nullptr; J.kind = 0;
  unsigned char* ws = a->ws;
  switch (kd) {
    case 0: case 1: { const int f = kd; J.src = a->in[7] + (size_t)(l * 2 + f) * 1024 * 2816; J.src2 = a->in[8] + (size_t)(l * 2 + f) * 1024 * 2816; J.dst = (bf16_t*)(ws + WS_W13) + (size_t)(l * 2 + f) * 5632 * 1024; J.N = 5632; J.K = 1024; J.ld = 2816; J.kind = 1; break; }
    case 2: case 3: { const int f = kd - 2; J.src = a->in[9] + (size_t)(l * 2 + f) * 2816 * 1024; J.dst = (bf16_t*)(ws + WS_W2) + (size_t)(l * 2 + f) * 1024 * 2816; J.N = 1024; J.K = 2816; J.ld = 1024; break; }
    case 4: { J.src = a->in[10] + (size_t)l * 1024 * 5632; J.dst = (bf16_t*)(ws + WS_WIN) + (size_t)l * 5888 * 1024; J.N = 5888; J.K = 1024; J.ld = 5632; J.kind = 2; break; }
    case 5: { J.src = a->in[14] + (size_t)l * 256 * 1024; J.dst = (bf16_t*)(ws + WS_WBF) + (size_t)l * 1024 * 256; J.N = 1024; J.K = 256; J.ld = 1024; break; }
    case 6: { J.src = a->in[15] + (size_t)l * 384 * 1024; J.dst = (bf16_t*)(ws + WS_WBR) + (size_t)l * 1024 * 384; J.N = 1024; J.K = 384; J.ld = 1024; break; }
    case 7: { J.src = a->in[16] + (size_t)l * 384 * 1024; J.dst = (bf16_t*)(ws + WS_WBD) + (size_t)l * 1024 * 384; J.N = 1024; J.K = 384; J.ld = 1024; break; }
    default: { J.src = a->in[17] + (size_t)l * 1024 * 1024; J.dst = (bf16_t*)(ws + WS_WO) + (size_t)l * 1024 * 1024; J.N = 1024; J.K = 1024; J.ld = 1024; break; }
  }
  return J;
}
DI int axial_perm(int s) { return s < 8 ? s : (s < 16 ? s + 8 : (s < 24 ? s - 8 : s)); }

DI void prologue(int WV, KArgs a, unsigned char* smem) {
  const int tid = ltid(), nb = lnb(), bid = lbid();
  float* t = (float*)smem;
  float* tr = t + 64 * 65;
  {
    constexpr int tiles_per_layer = 1408 * 2 + 704 * 2 + 1472 + 64 + 96 + 96 + 256;
    const int nn = tid & 63, kq = tid >> 6;
#pragma unroll 1
    for (int g = bid; g < 4 * tiles_per_layer; g += nb) {
      const int l = g / tiles_per_layer; int rem = g % tiles_per_layer; int kd;
      if (rem < 1408) kd = 0; else if (rem < 2816) { kd = 1; rem -= 1408; } else if (rem < 3520) { kd = 2; rem -= 2816; } else if (rem < 4224) { kd = 3; rem -= 3520; }
      else if (rem < 5696) { kd = 4; rem -= 4224; } else if (rem < 5760) { kd = 5; rem -= 5696; } else if (rem < 5856) { kd = 6; rem -= 5760; } else if (rem < 5952) { kd = 7; rem -= 5856; } else { kd = 8; rem -= 5952; }
      const ConvJob J = conv_job(a, l * 9 + kd);
      const int nkt = J.K / 64; const int n0 = (rem / nkt) * 64, k0 = (rem % nkt) * 64;
      const bool fold = (J.kind == 2) && (n0 < 512);
      const float* sp = J.src; int col = n0 + nn;
      if (J.kind == 1) { const int n = n0 + nn, gi = n >> 5, s = n & 31; sp = (s < 16) ? J.src : J.src2; col = 16 * gi + (s & 15); }
      else if (J.kind == 2) {
        const int n = n0 + nn;
        if (fold) col = (n0 & 192) + nn;
        else { col = n - 256; if (n >= C_DQ && n < C_DV) { const int s = n & 31; col = (n - 256 - s) + axial_perm(s); } }
      }
      const float* cp = sp + (size_t)(k0 + kq) * J.ld + col;
      float lv[8];
#pragma unroll
      for (int i = 0; i < 8; ++i) lv[i] = cp[(size_t)(8 * i) * J.ld];
#pragma unroll
      for (int i = 0; i < 8; ++i) t[nn * 65 + kq + 8 * i] = lv[i];
      if (fold && tid < 64) { const float ang = (float)tid * (1.0f / 32.0f); tr[tid] = (n0 >= 256) ? sinpif(ang) : cospif(ang); }
      __syncthreads();
      if (!fold) {
#pragma unroll
        for (int i = 0; i < 4; ++i) {
          const int e = tid + i * 512, n2 = e >> 5, kp = (e & 31) * 2;
          *(unsigned*)(J.dst + (size_t)(n0 + n2) * J.K + k0 + kp) = cvt_pk_bf16(t[n2 * 65 + kp], t[n2 * 65 + kp + 1]);
        }
      } else {
#pragma unroll 1
        for (int i = 0; i < 8; ++i) {
          const int m = kq + 8 * i, kk = nn;
          float acc = 0.f;
#pragma unroll 8
          for (int c = 0; c < 64; ++c) acc += t[c * 65 + kk] * tr[(m * c) & 63];
          J.dst[(size_t)(n0 + m) * J.K + k0 + kk] = f2bf(acc);
        }
      }
      __syncthreads();
    }
  }
  {
    float* sc = (float*)smem; float* scc = sc + 1024; float* red = scc + 1024;
    __syncthreads();
    for (int i = tid; i < 1024; i += 512) { sc[i] = silu_f(a->in[1][i]); scc[i] = silu_f(a->in[3][i]); }
    __syncthreads();
    float* MOD = (float*)(a->ws + WS_MOD);
    for (int it = bid; it < 4 * 72; it += nb) {
      const int l = it / 72, cb = it % 72;
      const int cgp = tid & 31, ks = tid >> 5;
      const float* wp = a->in[4] + ((size_t)l * 1024 + ks * 64) * 9216 + cb * 128 + cgp * 4;
      f32x4 am = {0.f, 0.f, 0.f, 0.f}, ac = {0.f, 0.f, 0.f, 0.f};
#pragma unroll 8
      for (int k = 0; k < 64; ++k) { const f32x4 w = *(const f32x4*)(wp + (size_t)k * 9216); am += w * sc[ks * 64 + k]; ac += w * scc[ks * 64 + k]; }
#pragma unroll
      for (int j = 0; j < 4; ++j) { red[(ks * 128 + cgp * 4 + j) * 2] = am[j]; red[(ks * 128 + cgp * 4 + j) * 2 + 1] = ac[j]; }
      __syncthreads();
      if (tid < 256) {
        const int col = tid >> 1, which = tid & 1; float s = 0.f;
#pragma unroll
        for (int q = 0; q < 16; ++q) s += red[(q * 128 + col) * 2 + which];
        const int gc = cb * 128 + col;
        MOD[(size_t)(which * 4 + l) * 9216 + gc] = s + a->in[5][(size_t)l * 9216 + gc];
      }
      __syncthreads();
    }
  }
  {
    float* TRET = (float*)(a->ws + WS_TRET); float* TROW = (float*)(a->ws + WS_TROW); float* TCOL = (float*)(a->ws + WS_TCOL);
    const int gt = bid * 512 + tid, gn = nb * 512;
    for (int e = gt; e < 16384 * 16; e += gn) { const int p = e >> 4, i = e & 15; float s, c; sincos_acc((float)p * INV16[i], s, c); TRET[2 * e] = c; TRET[2 * e + 1] = s; }
    for (int e = gt; e < 256 * 8; e += gn) { const int p = e >> 3, i = e & 7; float s, c; sincos_acc((float)p * INV16[2 * i], s, c); TROW[2 * e] = c; TROW[2 * e + 1] = s; }
    for (int e = gt; e < 64 * 8; e += gn) { const int p = e >> 3, i = e & 7; float s, c; sincos_acc((float)p * INV16[2 * i], s, c); TCOL[2 * e] = c; TCOL[2 * e + 1] = s; }
    if (bid == 0 && tid < 4) {
      const int l = tid; float* S = (float*)(a->ws + WS_SCAL) + l * 64;
      const float* lv = a->in[12] + l * 128; float d01 = 0.f, d23 = 0.f;
      for (int i = 0; i < 32; ++i) { d01 += lv[i] * lv[32 + i]; d23 += lv[64 + i] * lv[96 + i]; }
      const float lam_init = 0.8f - 0.6f * expf(-0.3f * (float)l);
      S[0] = expf(d01) - expf(d23) + lam_init; S[1] = lam_init;
      for (int i = 0; i < 12; ++i) { const float x = a->in[11][l * 12 + i]; S[4 + i] = -log1pf(expf(-x)); }
      for (int i = 0; i < 12; ++i) ((unsigned*)S)[16 + i] = 0u;
    }
  }
}
DI void norm_phase(int WV, KArgs a, int l, int which, bool first) {
  const int tid = ltid(), lane = tid & 63, wave = tid >> 6;
  const float* g = a->in[6] + (size_t)(l * 3 + which) * 1024;
  const float* mod = (const float*)(a->ws + WS_MOD) + (size_t)l * 9216;
  const float* modc = (const float*)(a->ws + WS_MOD) + (size_t)(4 + l) * 9216;
  float* X = (float*)(a->ws + WS_X); bf16_t* H = (bf16_t*)(a->ws + WS_H);
  const int stride = lnb() * 8;
  for (int r = lbid() * 8 + wave; r < MT_; r += 2 * stride) {
    const int r2 = r + stride; const bool has2 = r2 < MT_; const int rb = has2 ? r2 : r;
    const float* srcA = first ? (r < L_ ? a->in[0] + (size_t)r * 1024 : a->in[2] + (size_t)(r - L_) * 1024) : X + (size_t)r * 1024;
    const float* srcB = first ? (rb < L_ ? a->in[0] + (size_t)rb * 1024 : a->in[2] + (size_t)(rb - L_) * 1024) : X + (size_t)rb * 1024;
    f32x4 va[4], vb[4]; float sa = 0.f, sb = 0.f;
#pragma unroll
    for (int i = 0; i < 4; ++i) { va[i] = *(const f32x4*)(srcA + i * 256 + lane * 4); vb[i] = *(const f32x4*)(srcB + i * 256 + lane * 4); }
#pragma unroll
    for (int i = 0; i < 4; ++i) { sa += va[i][0] * va[i][0] + va[i][1] * va[i][1] + va[i][2] * va[i][2] + va[i][3] * va[i][3]; sb += vb[i][0] * vb[i][0] + vb[i][1] * vb[i][1] + vb[i][2] * vb[i][2] + vb[i][3] * vb[i][3]; }
    sa = wave_sum(sa); sb = wave_sum(sb);
    const float rsa = rsqrtf(sa * (1.0f / 1024.0f) + EPS_), rsb = rsqrtf(sb * (1.0f / 1024.0f) + EPS_);
#pragma unroll
    for (int q = 0; q < 2; ++q) {
      if (q == 1 && !has2) break;
      const int rr = q ? r2 : r; const float rstd = q ? rsb : rsa;
      const float* mm = (rr < L_) ? mod : modc;
#pragma unroll
      for (int i = 0; i < 4; ++i) {
        const int c = i * 256 + lane * 4;
        const f32x4 v = q ? vb[i] : va[i];
        const f32x4 gg = *(const f32x4*)(g + c), sh = *(const f32x4*)(mm + (which * 3) * 1024 + c), sc = *(const f32x4*)(mm + (which * 3 + 1) * 1024 + c);
        f32x4 y;
#pragma unroll
        for (int j = 0; j < 4; ++j) y[j] = v[j] * rstd * gg[j] * (1.0f + sc[j]) + sh[j];
        u32x2 w; w.x = cvt_pk_bf16(y[0], y[1]); w.y = cvt_pk_bf16(y[2], y[3]);
        *(u32x2*)(H + (size_t)rr * 1024 + c) = w;
        if (first) *(f32x4*)(X + (size_t)rr * 1024 + c) = v;
      }
    }
  }
}
DI void final_norm(int WV, KArgs a) {
  const int tid = ltid(), lane = tid & 63, wave = tid >> 6;
  const float* g = a->in[18]; const float* X = (const float*)(a->ws + WS_X);
  for (int r = lbid() * 8 + wave; r < L_; r += lnb() * 8) {
    f32x4 v[4]; float ss = 0.f;
#pragma unroll
    for (int i = 0; i < 4; ++i) { v[i] = *(const f32x4*)(X + (size_t)r * 1024 + i * 256 + lane * 4); ss += v[i][0] * v[i][0] + v[i][1] * v[i][1] + v[i][2] * v[i][2] + v[i][3] * v[i][3]; }
    ss = wave_sum(ss);
    const float rstd = rsqrtf(ss * (1.0f / 1024.0f) + EPS_);
#pragma unroll
    for (int i = 0; i < 4; ++i) { const int c = i * 256 + lane * 4; const f32x4 gg = *(const f32x4*)(g + c); f32x4 y; for (int j = 0; j < 4; ++j) y[j] = v[i][j] * rstd * gg[j]; *(f32x4*)(a->out + (size_t)r * 1024 + c) = y; }
  }
}

using pg8::Unit; using pg8::HALF; using pg8::BM;
struct EpiSwiglu {
  static constexpr bool PERM = false, AFTER_DRAIN = false;
  bf16_t* U;
  DI void operator()(const f32x4 (&acc)[2][2][4][2], const Unit& u, int wr, int wc, int fr_, int fq_) const {
    const int ln_ = lane_id_v(), fr = ln_ & 15, fq = ln_ >> 4;
#pragma unroll
    for (int ai = 0; ai < 2; ++ai)
#pragma unroll
      for (int m = 0; m < 4; ++m) {
        const int r = u.pm * BM + ai * HALF + wr * 64 + m * 16 + fr;
#pragma unroll
        for (int bj = 0; bj < 2; ++bj) {
          const int gi = u.pn * 8 + bj * 4 + wc;
          const f32x4 x = acc[ai][bj][m][0], y = acc[ai][bj][m][1];
          u32x2 w; w.x = cvt_pk_bf16(silu_f(x[0]) * y[0], silu_f(x[1]) * y[1]); w.y = cvt_pk_bf16(silu_f(x[2]) * y[2], silu_f(x[3]) * y[3]);
          *(u32x2*)(U + (size_t)r * DFF_ + gi * 16 + fq * 4) = w;
        }
        __builtin_amdgcn_sched_barrier(0);
      }
  }
};
struct EpiResid {
  static constexpr bool PERM = false, AFTER_DRAIN = false;
  float* X; const float* gate; float scale;
  DI void operator()(const f32x4 (&acc)[2][2][4][2], const Unit& u, int wr, int wc, int fr_, int fq_) const {
    const int ln_ = lane_id_v(), fr = ln_ & 15, fq = ln_ >> 4;
#pragma unroll
    for (int bj = 0; bj < 2; ++bj)
#pragma unroll
      for (int n = 0; n < 2; ++n) {
        const int c = u.pn * BM + bj * HALF + wc * 32 + n * 16 + fq * 4;
        const f32x4 gv = *(const f32x4*)(gate + c) * scale;
#pragma unroll
        for (int ai = 0; ai < 2; ++ai)
#pragma unroll
          for (int m = 0; m < 4; ++m) {
            const int r = u.pm * BM + ai * HALF + wr * 64 + m * 16 + fr;
            float* p = X + (size_t)r * 1024 + c;
            *(f32x4*)p = *(const f32x4*)p + gv * acc[ai][bj][m][n];
          }
      }
  }
};
template <int STEP> struct EpiMerge {
  static constexpr bool PERM = false, AFTER_DRAIN = false;
  bf16_t* MX; const bf16_t* G; bf16_t* Hout;
  DI void operator()(const f32x4 (&acc)[2][2][4][2], const Unit& u, int wr, int wc, int fr_, int fq_) const {
    const int ln_ = lane_id_v(), fr = ln_ & 15, fq = ln_ >> 4;
#pragma unroll
    for (int ai = 0; ai < 2; ++ai)
#pragma unroll
      for (int bj = 0; bj < 2; ++bj)
#pragma unroll
        for (int n = 0; n < 2; ++n) {
          const int c = u.pn * BM + bj * HALF + wc * 32 + n * 16 + fq * 4;
          const int r0 = u.pm * BM + ai * HALF + wr * 64 + fr;
          u32x2 gw[4], old[4];
#pragma unroll
          for (int m = 0; m < 4; ++m) {
            gw[m] = *(const u32x2*)(G + (size_t)(r0 + m * 16) * NGB_ + c);
            if (STEP > 0) old[m] = *(const u32x2*)(MX + (size_t)(r0 + m * 16) * 1024 + c);
          }
#pragma unroll
          for (int m = 0; m < 4; ++m) {
            f32x4 gv; gv[0] = bf2f(gw[m].x & 0xffffu); gv[1] = bf2f(gw[m].x >> 16); gv[2] = bf2f(gw[m].y & 0xffffu); gv[3] = bf2f(gw[m].y >> 16);
            f32x4 v = gv * acc[ai][bj][m][n];
            if (STEP > 0) { v[0] += bf2f(old[m].x & 0xffffu); v[1] += bf2f(old[m].x >> 16); v[2] += bf2f(old[m].y & 0xffffu); v[3] += bf2f(old[m].y >> 16); }
            u32x2 w; w.x = cvt_pk_bf16(v[0], v[1]); w.y = cvt_pk_bf16(v[2], v[3]);
            if (STEP < 2) *(u32x2*)(MX + (size_t)(r0 + m * 16) * 1024 + c) = w;
            else *(u32x2*)(Hout + (size_t)(r0 + m * 16) * 1024 + c) = w;
          }
          __builtin_amdgcn_sched_barrier(0);
        }
  }
};
struct EpiWin {
  static constexpr bool PERM = false, AFTER_DRAIN = false;
  bf16_t* PB; bf16_t* GB; const float* TRET; const float* TROW; const float* TCOL; unsigned* kmax;
  DI void operator()(const f32x4 (&acc)[2][2][4][2], const Unit& u, int wr, int wc, int fr_, int fq_) const {
    const int ln_ = lane_id_v(), fr = ln_ & 15, fq = ln_ >> 4;
#pragma unroll
    for (int bj = 0; bj < 2; ++bj) {
      const int cb = u.pn * BM + bj * HALF + wc * 32;
      float kmx = 0.f;
#pragma unroll
      for (int ai = 0; ai < 2; ++ai)
#pragma unroll
        for (int m = 0; m < 4; ++m) {
          const int r = u.pm * BM + ai * HALF + wr * 64 + m * 16 + fr;
          f32x4 x0 = acc[ai][bj][m][0], x1 = acc[ai][bj][m][1];
          if (cb >= NPB_) {
#pragma unroll
            for (int j = 0; j < 4; ++j) { x0[j] = sigmoid_f(x0[j]); x1[j] = sigmoid_f(x1[j]); }
            u32x2 w0, w1; w0.x = cvt_pk_bf16(x0[0], x0[1]); w0.y = cvt_pk_bf16(x0[2], x0[3]); w1.x = cvt_pk_bf16(x1[0], x1[1]); w1.y = cvt_pk_bf16(x1[2], x1[3]);
            bf16_t* p = GB + (size_t)r * NGB_ + (cb - NPB_) + fq * 4;
            *(u32x2*)p = w0; *(u32x2*)(p + 16) = w1;
            __builtin_amdgcn_sched_barrier(0);
            continue;
          }
          if (cb >= C_RQ && cb < C_RV) {
            if (r < L_) {
              const f32x4* tp = (const f32x4*)(TRET + ((size_t)r * 16 + fq * 4) * 2);
              const f32x4 t0 = tp[0], t1 = tp[1];
              const float cs[4] = {t0[0], t0[2], t1[0], t1[2]}, sn[4] = {t0[1], t0[3], t1[1], t1[3]};
#pragma unroll
              for (int j = 0; j < 4; ++j) { const float a_ = x0[j], b_ = x1[j]; x0[j] = a_ * cs[j] - b_ * sn[j]; x1[j] = a_ * sn[j] + b_ * cs[j]; }
            }
            if (cb >= C_RK) { x0 *= 0.17677669529663687f; x1 *= 0.17677669529663687f; }
          } else if (cb >= C_RG && cb < C_DQ) {
#pragma unroll
            for (int j = 0; j < 4; ++j) { x0[j] = silu_f(x0[j]); x1[j] = silu_f(x1[j]); }
          } else if (cb >= C_DQ && cb < C_DV) {
            if (r < L_) {
              const float* tb = (fq < 2) ? (TROW + ((size_t)(r >> 6) * 8 + fq * 4) * 2) : (TCOL + ((size_t)(r & 63) * 8 + (fq - 2) * 4) * 2);
              const f32x4 t0 = ((const f32x4*)tb)[0], t1 = ((const f32x4*)tb)[1];
              const float cs[4] = {t0[0], t0[2], t1[0], t1[2]}, sn[4] = {t0[1], t0[3], t1[1], t1[3]};
#pragma unroll
              for (int j = 0; j < 4; ++j) { const float a_ = x0[j], b_ = x1[j]; x0[j] = a_ * cs[j] - b_ * sn[j]; x1[j] = a_ * sn[j] + b_ * cs[j]; }
            }
            if (cb < C_DK) { x0 *= 0.25503486f; x1 *= 0.25503486f; }
            else { float ss = 0.f;
#pragma unroll
              for (int j = 0; j < 4; ++j) ss += x0[j] * x0[j] + x1[j] * x1[j];
              ss += shx(ss, 16, lane_id_v()); ss += shx(ss, 32, lane_id_v()); kmx = fmaxf(kmx, ss); }
          }
          u32x2 w0, w1; w0.x = cvt_pk_bf16(x0[0], x0[1]); w0.y = cvt_pk_bf16(x0[2], x0[3]); w1.x = cvt_pk_bf16(x1[0], x1[1]); w1.y = cvt_pk_bf16(x1[2], x1[3]);
          bf16_t* p = PB + (size_t)r * NPB_ + cb + fq * 4;
          *(u32x2*)p = w0; *(u32x2*)(p + 16) = w1;
          __builtin_amdgcn_sched_barrier(0);
        }
      if (cb >= C_DK && cb < C_DV) {
#pragma unroll
        for (int o = 1; o < 16; o <<= 1) kmx = fmaxf(kmx, shx(kmx, o, lane_id_v()));
        if (lane_id_v() == 0) atomicMax(kmax + ((cb - C_DK) >> 5), __float_as_uint(kmx));
      }
    }
  }
};
template <class F> DI void ctx_gemm32(int WV, const bf16_t* A, int lda, const bf16_t* Bt, int K, int N, unsigned char* smem, F epi) {
  const int tid = ltid(), lane = tid & 63, wave = tid >> 6, r31 = lane & 31, h = lane >> 5;
  float* red = (float*)smem;
  const int ntn = N / 32, ntiles = 8 * ntn, kper = K / 8;
  for (int tile = lbid(); tile < ntiles; tile += lnb()) {
    const int tm = tile / ntn, tn = tile % ntn;
    f32x16 acc; for (int i = 0; i < 16; ++i) acc[i] = 0.f;
    const bf16_t* ap = A + (size_t)(tm * 32 + r31) * lda + wave * kper + 8 * h;
    const bf16_t* bp = Bt + (size_t)(tn * 32 + r31) * K + wave * kper + 8 * h;
    int kk = 0;
    for (; kk + 64 <= kper; kk += 64) {
      bf16x8 av[4], bv[4];
#pragma unroll
      for (int q = 0; q < 4; ++q) { av[q] = *(const bf16x8*)(ap + kk + 16 * q); bv[q] = *(const bf16x8*)(bp + kk + 16 * q); }
#pragma unroll
      for (int q = 0; q < 4; ++q) acc = MFMA32(av[q], bv[q], acc);
    }
    for (; kk < kper; kk += 16) { const bf16x8 av = *(const bf16x8*)(ap + kk), bv = *(const bf16x8*)(bp + kk); acc = MFMA32(av, bv, acc); }
#pragma unroll
    for (int i = 0; i < 16; ++i) red[(wave * 16 + i) * 64 + lane] = acc[i];
    __syncthreads();
#pragma unroll
    for (int q = 0; q < 2; ++q) {
      const int o = tid + q * 512, i = o >> 6, ln = o & 63; float s = 0.f;
#pragma unroll
      for (int w = 0; w < 8; ++w) s += red[(w * 16 + i) * 64 + ln];
      epi(tm * 32 + crow(i, ln >> 5), tn * 32 + (ln & 31), s);
    }
    __syncthreads();
  }
}

constexpr int FR_LD = 136;
DI void fourier_tables(int WV, unsigned char* smem) {
  bf16_t* Cw = (bf16_t*)smem; bf16_t* Sw = Cw + 128 * FR_LD;
  for (int e = ltid(); e < 128 * 128; e += 512) { const int a_ = e >> 7, b_ = e & 127; const float x = (float)((a_ * b_) & 127) * (1.0f / 64.0f); Cw[a_ * FR_LD + b_] = f2bf(cospif(x)); Sw[a_ * FR_LD + b_] = f2bf(sinpif(x)); }
}
DI void fourier_load(int WV, const bf16_t* src, size_t rs, size_t po, unsigned char* smem) {
  bf16_t* dA = (bf16_t*)smem + 2 * 128 * FR_LD;
#pragma unroll
  for (int i = 0; i < 4; ++i) {
    const int id = ltid() + 512 * i, seg = id & 7, part = (id >> 3) & 1, row = id >> 4;
    const bf16x8 v = *(const bf16x8*)(src + (size_t)row * rs + (size_t)part * po + seg * 8);
    bf16_t* d = dA + part * 64 * FR_LD + (seg * 8) * FR_LD + (row ^ (seg << 3));
#pragma unroll
    for (int e = 0; e < 8; ++e) d[e * FR_LD] = (bf16_t)v[e];
  }
}
DI void fourier_stage1(int WV, KArgs a, unsigned char* smem) {
  const int tid = ltid(), lane = tid & 63, wave = tid >> 6, r31 = lane & 31, h = lane >> 5, rb = wave & 3, cbk = wave >> 2;
  const bf16_t* PB = (const bf16_t*)(a->ws + WS_PB); bf16_t* V = (bf16_t*)(a->ws + WS_V);
  const bf16_t* Cw = (const bf16_t*)smem; const bf16_t* Sw = Cw + 128 * FR_LD; const bf16_t* dA = Sw + 128 * FR_LD; const bf16_t* dB = dA + 64 * FR_LD;
  for (int it = lbid(); it < 512; it += lnb()) {
    const int t2 = it >> 2, c0 = (it & 3) * 64;
    __syncthreads();
    fourier_load(WV, PB + (size_t)t2 * NPB_ + C_FA + c0, (size_t)128 * NPB_, (size_t)(C_FB - C_FA), smem);
    __syncthreads();
    f32x16 R, nI; for (int i = 0; i < 16; ++i) { R[i] = 0.f; nI[i] = 0.f; }
#pragma unroll
    for (int s = 0; s < 8; ++s) {
      const bf16x8 cw = *(const bf16x8*)(Cw + (32 * rb + r31) * FR_LD + 16 * s + 8 * h), sw = *(const bf16x8*)(Sw + (32 * rb + r31) * FR_LD + 16 * s + 8 * h);
      const int so_ = (16 * s + 8 * h) ^ (((4 * cbk + (r31 >> 3)) & 7) << 3);
      const bf16x8 af = *(const bf16x8*)(dA + (32 * cbk + r31) * FR_LD + so_), bfv = *(const bf16x8*)(dB + (32 * cbk + r31) * FR_LD + so_);
      bf16x8 nb; for (int e = 0; e < 8; ++e) nb[e] = (short)(bfv[e] ^ (short)0x8000);
      R = MFMA32(cw, af, R); R = MFMA32(sw, nb, R); nI = MFMA32(sw, af, nI); nI = MFMA32(cw, bfv, nI);
    }
    const int col = c0 + 32 * cbk + r31;
#pragma unroll
    for (int i = 0; i < 16; ++i) {
      const int k1 = 32 * rb + crow(i, h);
      const float x = (float)(k1 * t2) * (1.0f / 8192.0f); const float ct = cospif(x), st = sinpif(x);
      const float vre = R[i] * ct - nI[i] * st, vim = -nI[i] * ct - R[i] * st;
      bf16_t* vp = V + ((size_t)(k1 * 128 + t2) * 2) * 256 + col;
      vp[0] = f2bf(vre); vp[256] = f2bf(vim);
    }
  }
}
DI void fourier_stage2(int WV, KArgs a, unsigned char* smem) {
  const int tid = ltid(), lane = tid & 63, wave = tid >> 6, r31 = lane & 31, h = lane >> 5, rb = wave & 3, cbk = wave >> 2;
  const bf16_t* V = (const bf16_t*)(a->ws + WS_V); bf16_t* BR = (bf16_t*)(a->ws + WS_BR);
  const bf16_t* Cw = (const bf16_t*)smem; const bf16_t* Sw = Cw + 128 * FR_LD; const bf16_t* dA = Sw + 128 * FR_LD; const bf16_t* dB = dA + 64 * FR_LD;
  for (int it = lbid(); it < 512; it += lnb()) {
    const int k1 = it >> 2, c0 = (it & 3) * 64;
    __syncthreads();
    fourier_load(WV, V + (size_t)k1 * 128 * 512 + c0, (size_t)512, (size_t)256, smem);
    __syncthreads();
    f32x16 Y; for (int i = 0; i < 16; ++i) Y[i] = 0.f;
#pragma unroll
    for (int s = 0; s < 8; ++s) {
      const bf16x8 cw = *(const bf16x8*)(Cw + (32 * rb + r31) * FR_LD + 16 * s + 8 * h), sw = *(const bf16x8*)(Sw + (32 * rb + r31) * FR_LD + 16 * s + 8 * h);
      const int so_ = (16 * s + 8 * h) ^ (((4 * cbk + (r31 >> 3)) & 7) << 3);
      const bf16x8 vr = *(const bf16x8*)(dA + (32 * cbk + r31) * FR_LD + so_), vi = *(const bf16x8*)(dB + (32 * cbk + r31) * FR_LD + so_);
      Y = MFMA32(cw, vr, Y); Y = MFMA32(sw, vi, Y);
    }
    const int col = c0 + 32 * cbk + r31;
#pragma unroll
    for (int i = 0; i < 16; ++i) { const int k2 = 32 * rb + crow(i, h); BR[(size_t)(k1 + 128 * k2) * 1024 + col] = f2bf(Y[i] * (1.0f / 1024.0f)); }
  }
}
DI void fourier_ctx(int WV, KArgs a, unsigned char* smem) {
  const int tid = ltid();
  const bf16_t* PB = (const bf16_t*)(a->ws + WS_PB) + (size_t)L_ * NPB_; bf16_t* BR = (bf16_t*)(a->ws + WS_BR) + (size_t)L_ * 1024;
  float* ct = (float*)smem; float* st = ct + 256; float* part = st + 256;
  __syncthreads();
  if (tid < 256) { const float x = (float)tid * (1.0f / 128.0f); ct[tid] = cospif(x); st[tid] = sinpif(x); }
  __syncthreads();
  for (int k = lbid(); k < 256; k += lnb()) {
    const int col = tid & 255, half = tid >> 8;
    float acc = 0.f;
#pragma unroll 8
    for (int t = half * 128; t < half * 128 + 128; ++t) {
      const int idx = (k * t) & 255;
      acc += ct[idx] * bf2f(PB[(size_t)t * NPB_ + C_FA + col]) - st[idx] * bf2f(PB[(size_t)t * NPB_ + C_FB + col]);
    }
    if (half == 1) part[col] = acc;
    __syncthreads();
    if (half == 0) BR[(size_t)k * 1024 + col] = f2bf((acc + part[col]) * (1.0f / 128.0f));
    __syncthreads();
  }
}
DI int chunk_row0(int ci) { return ci < 128 ? ci * 128 : L_ + (ci - 128) * 128; }
DI void ret_states(int WV, KArgs a, int l, unsigned char* smem) {
  const int tid = ltid();
  const bf16_t* PB = (const bf16_t*)(a->ws + WS_PB); float* T = (float*)(a->ws + WS_T);
  const float* S = (const float*)(a->ws + WS_SCAL) + l * 64;
  float* kL = (float*)smem; float* vL = kL + 128 * 33; float* wf = vL + 128 * 64; float* wb = wf + 128;
  for (int it = lbid(); it < 130 * 6; it += lnb()) {
    const int ci = it / 6, hh = it % 6, r0 = chunk_row0(ci);
    __syncthreads();
    { const int row = tid >> 2, seg = tid & 3; const bf16x8 v = *(const bf16x8*)(PB + (size_t)(r0 + row) * NPB_ + C_RK + hh * 32 + seg * 8);
#pragma unroll
      for (int e = 0; e < 8; ++e) kL[row * 33 + seg * 8 + e] = bf2f((unsigned)(unsigned short)v[e]); }
#pragma unroll
    for (int q = 0; q < 2; ++q) { const int id = tid + 512 * q, row = id >> 3, seg = id & 7; const bf16x8 v = *(const bf16x8*)(PB + (size_t)(r0 + row) * NPB_ + C_RV + hh * 64 + seg * 8);
#pragma unroll
      for (int e = 0; e < 8; ++e) vL[row * 64 + seg * 8 + e] = bf2f((unsigned)(unsigned short)v[e]); }
    if (tid < 128) { wf[tid] = expf(S[4 + hh] * (float)(127 - tid)); wb[tid] = expf(S[10 + hh] * (float)tid); }
    __syncthreads();
    const int d = tid >> 4, v4 = (tid & 15) * 4;
    f32x4 af = {0.f, 0.f, 0.f, 0.f}, ab = {0.f, 0.f, 0.f, 0.f};
#pragma unroll 4
    for (int j = 0; j < 128; ++j) { const float kd = kL[j * 33 + d]; const f32x4 vv = *(const f32x4*)(vL + j * 64 + v4); af += vv * (kd * wf[j]); ab += vv * (kd * wb[j]); }
    float* tp = T + ((size_t)(ci * 6 + hh) * 2) * 2048 + d * 64 + v4;
    *(f32x4*)tp = af; *(f32x4*)(tp + 2048) = ab;
  }
}
DI void ret_scan(int WV, KArgs a, int l) {
  const int gt = lbid() * 512 + ltid();
  if (gt >= 6 * 2 * 2048) return;
  const int idx = gt & 2047, dir = (gt >> 11) & 1, hh = gt >> 12;
  const float* T = (const float*)(a->ws + WS_T); float* S = (float*)(a->ws + WS_S);
  const float* SC = (const float*)(a->ws + WS_SCAL) + l * 64;
  const float dec = expf(SC[4 + dir * 6 + hh] * 128.0f);
  const size_t base = (size_t)(hh * 2 + dir) * 2048 + idx; const size_t cs = (size_t)6 * 2 * 2048;
  const float tc0 = T[base + 128 * cs], tc1 = T[base + 129 * cs];
  if (dir == 0) {
    float s = tc0 * dec + tc1; S[base + 128 * cs] = 0.f; S[base + 129 * cs] = tc0;
#pragma unroll 8
    for (int i = 0; i < 128; ++i) { S[base + i * cs] = s; s = s * dec + T[base + i * cs]; }
  } else {
    float s = tc0 + dec * tc1; S[base + 129 * cs] = 0.f; S[base + 128 * cs] = tc1;
#pragma unroll 8
    for (int i = 127; i >= 0; --i) { S[base + i * cs] = s; s = s * dec + T[base + i * cs]; }
  }
}
DI void ret_out(int WV, KArgs a, int l, unsigned char* smem) {
  const int tid = ltid(), lane = tid & 63, wave = tid >> 6, r31 = lane & 31, h = lane >> 5, jb = wave & 3, vh = wave >> 2;
  const bf16_t* PB = (const bf16_t*)(a->ws + WS_PB); bf16_t* BR = (bf16_t*)(a->ws + WS_BR); const float* Sg = (const float*)(a->ws + WS_S);
  const float* SC = (const float*)(a->ws + WS_SCAL) + l * 64;
  bf16_t* Kl = (bf16_t*)smem;
  bf16_t* Vt = Kl + 128 * 40;
  bf16_t* SfT = Vt + 64 * 136;
  bf16_t* SbT = SfT + 64 * 40;
  float* pwf = (float*)(SbT + 64 * 40);
  float* pwb = pwf + 128;
  float* ssq = pwb + 128;
  for (int it = lbid(); it < 130 * 6; it += lnb()) {
    const int ci = it / 6, hh = it % 6, r0 = chunk_row0(ci);
    const float lgf = SC[4 + hh], lgb = SC[10 + hh];
    __syncthreads();
    { const int row = tid >> 2, seg = tid & 3; *(bf16x8*)(Kl + row * 40 + seg * 8) = *(const bf16x8*)(PB + (size_t)(r0 + row) * NPB_ + C_RK + hh * 32 + seg * 8); }
#pragma unroll
    for (int q = 0; q < 2; ++q) { const int id = tid + 512 * q, row = id >> 3, seg = id & 7; const bf16x8 v = *(const bf16x8*)(PB + (size_t)(r0 + row) * NPB_ + C_RV + hh * 64 + seg * 8);
#pragma unroll
      for (int e = 0; e < 8; ++e) Vt[(seg * 8 + e) * 136 + (row ^ (seg << 3))] = (bf16_t)v[e]; }
#pragma unroll
    for (int q = 0; q < 8; ++q) { const int e = tid + 512 * q, dir = e >> 11, idx = e & 2047, d = idx >> 6, v = idx & 63;
      const float sv = Sg[((size_t)(ci * 6 + hh) * 2 + dir) * 2048 + idx]; (dir ? SbT : SfT)[v * 40 + d] = f2bf(sv); }
    if (tid < 128) { pwf[tid] = expf(lgf * (float)tid); pwb[tid] = expf(lgb * (float)tid); }
    const int qrow = r0 + 32 * jb + r31, j = 32 * jb + r31;
    bf16x8 qf[2];
#pragma unroll
    for (int s = 0; s < 2; ++s) qf[s] = *(const bf16x8*)(PB + (size_t)qrow * NPB_ + C_RQ + hh * 32 + 16 * s + 8 * h);
    __syncthreads();
    f32x16 O; for (int i = 0; i < 16; ++i) O[i] = 0.f;
#pragma unroll
    for (int kb = 0; kb < 4; ++kb) {
      f32x16 St; for (int i = 0; i < 16; ++i) St[i] = 0.f;
#pragma unroll
      for (int s = 0; s < 2; ++s) { const bf16x8 kf = *(const bf16x8*)(Kl + (32 * kb + r31) * 40 + 16 * s + 8 * h); St = MFMA32(kf, qf[s], St); }
#pragma unroll
      for (int i = 0; i < 16; ++i) { const int jp = 32 * kb + crow(i, h); const int dl = j - jp; const float dv = dl > 0 ? pwf[dl] : (dl < 0 ? pwb[-dl] : 2.0f); St[i] *= dv; }
#pragma unroll
      for (int s = 0; s < 2; ++s) {
        const bf16x8 pb = pack_step(St, s);
        const bf16_t* vrow = Vt + (32 * vh + r31) * 136; const int px_ = ((4 * vh + (r31 >> 3)) & 7) << 3, p0_ = 32 * kb + 16 * s + 4 * h;
        const s16x4 lo = *(const s16x4*)(vrow + (p0_ ^ px_)), hi = *(const s16x4*)(vrow + ((p0_ + 8) ^ px_));
        const bf16x8 vf = __builtin_shufflevector(lo, hi, 0, 1, 2, 3, 4, 5, 6, 7);
        O = MFMA32(vf, pb, O);
      }
    }
    f32x16 Of, Ob; for (int i = 0; i < 16; ++i) { Of[i] = 0.f; Ob[i] = 0.f; }
#pragma unroll
    for (int s = 0; s < 2; ++s) {
      const bf16x8 sf = *(const bf16x8*)(SfT + (32 * vh + r31) * 40 + 16 * s + 8 * h), sb = *(const bf16x8*)(SbT + (32 * vh + r31) * 40 + 16 * s + 8 * h);
      Of = MFMA32(sf, qf[s], Of); Ob = MFMA32(sb, qf[s], Ob);
    }
    const float qdf = expf(lgf * (float)(j + 1)), qdb = expf(lgb * (float)(128 - j));
    float ss = 0.f;
#pragma unroll
    for (int i = 0; i < 16; ++i) { O[i] = O[i] + Of[i] * qdf + Ob[i] * qdb; ss += O[i] * O[i]; }
    ss += shx(ss, 32, lane_id_v());
    if (h == 0) ssq[vh * 128 + j] = ss;
    __syncthreads();
    const float rstd = rsqrtf((ssq[j] + ssq[128 + j]) * (1.0f / 64.0f) + EPS_);
#pragma unroll
    for (int g4 = 0; g4 < 4; ++g4) {
      const int v0 = 32 * vh + 8 * g4 + 4 * h;
      const u32x2 gw = *(const u32x2*)(PB + (size_t)qrow * NPB_ + C_RG + hh * 64 + v0);
      const float g0 = bf2f(gw.x & 0xffffu), g1 = bf2f(gw.x >> 16), g2 = bf2f(gw.y & 0xffffu), g3 = bf2f(gw.y >> 16);
      u32x2 w; w.x = cvt_pk_bf16(O[4 * g4] * rstd * g0, O[4 * g4 + 1] * rstd * g1); w.y = cvt_pk_bf16(O[4 * g4 + 2] * rstd * g2, O[4 * g4 + 3] * rstd * g3);
      *(u32x2*)(BR + (size_t)qrow * 1024 + 256 + hh * 64 + v0) = w;
    }
  }
}
constexpr int AT_LD = 72;
typedef __bf16 bf16x2_t __attribute__((ext_vector_type(2)));
typedef float f32x2_t __attribute__((ext_vector_type(2)));
DI unsigned cvt2(float a, float b) { f32x2_t v = {a, b}; return __builtin_bit_cast(unsigned, __builtin_convertvector(v, bf16x2_t)); }
template <int VAR> DI void attn_phase(int WV, KArgs a, int l, bool with_ctx, unsigned char* smem) {
  const int tid = ltid(), lane = tid & 63, wave = tid >> 6, r31 = lane & 31, h = lane >> 5, qsub = wave & 3, kh = wave >> 2;
  const bf16_t* PB = (const bf16_t*)(a->ws + WS_PB); bf16_t* BR = (bf16_t*)(a->ws + (VAR == 0 ? WS_BR : WS_H));
  const float* SC = (const float*)(a->ws + WS_SCAL) + l * 64;
  const float lam = SC[0], lam_init = SC[1];
  bf16_t* Ks = (bf16_t*)smem;
  bf16_t* Vt = Ks + 2 * 64 * AT_LD;
  float* cmb = (float*)(Vt + 2 * 64 * AT_LD);
  const int nitems = 6 * 128 + (with_ctx ? 12 : 0);
  const int skey = tid >> 3, sseg = tid & 7;
  for (int it = lbid(); it < nitems; it += lnb()) {
    int head, q0, krow0, nt;
    if (it < 768) { head = (it >> 8) * 2 + (it & 1); q0 = ((it & 255) >> 1) * 128; krow0 = 0; nt = MT_ / 64; }
    else { const int e = it - 768; head = e >> 1; q0 = L_ + (e & 1) * 128; krow0 = L_; nt = LC_ / 64; }
    const int qrow = q0 + 32 * qsub + r31;
    bf16x8 qf[2][2];
#pragma unroll
    for (int mp = 0; mp < 2; ++mp)
#pragma unroll
      for (int s = 0; s < 2; ++s) qf[mp][s] = *(const bf16x8*)(PB + (size_t)qrow * NPB_ + C_DQ + head * 64 + mp * 32 + 16 * s + 8 * h);
    float negm = 0.f;
#pragma unroll
    for (int mp = 0; mp < 2; ++mp) {
      float ss = 0.f;
#pragma unroll
      for (int s = 0; s < 2; ++s)
#pragma unroll
        for (int e = 0; e < 8; ++e) { const float x = bf2f((unsigned)(unsigned short)qf[mp][s][e]); ss += x * x; }
      ss += shx(ss, 32, lane_id_v());
      const float kmx = __uint_as_float(((const unsigned*)SC)[16 + head * 2 + mp]);
      negm = fminf(negm, -sqrtf(ss * kmx) * 1.01f);
    }
    f32x16 NM; for (int i = 0; i < 16; ++i) NM[i] = negm;
    f32x16 O1[2], O2[2]; for (int i = 0; i < 16; ++i) { O1[0][i] = 0.f; O1[1][i] = 0.f; O2[0][i] = 0.f; O2[1][i] = 0.f; }
    f32x4 LA = {0.f, 0.f, 0.f, 0.f}, LB = {0.f, 0.f, 0.f, 0.f};
    bf16x8 osel; { const bool on = ((lane & 15) == 0 && ((lane >> 4) & 1) == 0) || ((lane & 15) == 1 && ((lane >> 4) & 1) == 1);
      for (int e = 0; e < 8; ++e) osel[e] = on ? (short)0x3F80 : (short)0; }
#define MFMA16(a_, b_, c_) __builtin_amdgcn_mfma_f32_16x16x32_bf16((a_), (b_), (c_), 0, 0, 0)
    const bf16_t* kg = PB + (size_t)(krow0 + skey) * NPB_ + C_DK + head * 64 + sseg * 8;
    const bf16_t* vg = PB + (size_t)(krow0 + skey) * NPB_ + C_DV + head * 64 + sseg * 8;
    const int vslot = ((skey & ~12) | ((skey & 4) << 1) | ((skey & 8) >> 1)) ^ (sseg << 3);
    __syncthreads();
    bf16x8 kA = *(const bf16x8*)kg, vA = *(const bf16x8*)vg;
    bf16x8 kB = *(const bf16x8*)(kg + (size_t)64 * NPB_), vB = *(const bf16x8*)(vg + (size_t)64 * NPB_);
    { *(bf16x8*)(Ks + skey * AT_LD + sseg * 8) = kA;
#pragma unroll
      for (int e = 0; e < 8; ++e) Vt[(sseg * 8 + e) * AT_LD + vslot] = (bf16_t)vA[e]; }
    __syncthreads();
    for (int t = 0; t < nt; ++t) {
      const int buf = t & 1;
      const bf16_t* ks = Ks + buf * 64 * AT_LD + (32 * kh + r31) * AT_LD + 8 * h;
      const bf16_t* vt = Vt + buf * 64 * AT_LD + r31 * AT_LD;
      const bf16x8 k00 = *(const bf16x8*)(ks), k01 = *(const bf16x8*)(ks + 16), k10 = *(const bf16x8*)(ks + 32), k11 = *(const bf16x8*)(ks + 48);
      bf16x8 vf[2][2];
#pragma unroll
      for (int s = 0; s < 2; ++s)
#pragma unroll
        for (int mt = 0; mt < 2; ++mt) vf[mt][s] = *(const bf16x8*)(vt + mt * 32 * AT_LD + (((4 * kh + 2 * s + h) ^ ((4 * mt + (r31 >> 3)) & 7)) << 3));
      f32x16 S1 = MFMA32(k00, qf[0][0], NM); f32x16 S2 = MFMA32(k10, qf[1][0], NM); S1 = MFMA32(k01, qf[0][1], S1); S2 = MFMA32(k11, qf[1][1], S2);
      bf16x8 p1[2], p2[2];
      { u32x4 w0, w1;
#pragma unroll
        for (int i = 0; i < 4; ++i) { w0[i] = cvt2(VAR == 1 ? S1[2 * i] * 0.001f : __builtin_amdgcn_exp2f(S1[2 * i]), VAR == 1 ? S1[2 * i + 1] * 0.001f : __builtin_amdgcn_exp2f(S1[2 * i + 1]));
                                       w1[i] = cvt2(VAR == 1 ? S1[8 + 2 * i] * 0.001f : __builtin_amdgcn_exp2f(S1[8 + 2 * i]), VAR == 1 ? S1[9 + 2 * i] * 0.001f : __builtin_amdgcn_exp2f(S1[9 + 2 * i])); }
        p1[0] = __builtin_bit_cast(bf16x8, w0); p1[1] = __builtin_bit_cast(bf16x8, w1); }
      O1[0] = MFMA32(vf[0][0], p1[0], O1[0]); O1[1] = MFMA32(vf[1][0], p1[0], O1[1]); LA = MFMA16(osel, p1[0], LA);
      O1[0] = MFMA32(vf[0][1], p1[1], O1[0]); O1[1] = MFMA32(vf[1][1], p1[1], O1[1]); LA = MFMA16(osel, p1[1], LA);
      { u32x4 w0, w1;
#pragma unroll
        for (int i = 0; i < 4; ++i) { w0[i] = cvt2(VAR == 1 ? S2[2 * i] * 0.001f : __builtin_amdgcn_exp2f(S2[2 * i]), VAR == 1 ? S2[2 * i + 1] * 0.001f : __builtin_amdgcn_exp2f(S2[2 * i + 1]));
                                       w1[i] = cvt2(VAR == 1 ? S2[8 + 2 * i] * 0.001f : __builtin_amdgcn_exp2f(S2[8 + 2 * i]), VAR == 1 ? S2[9 + 2 * i] * 0.001f : __builtin_amdgcn_exp2f(S2[9 + 2 * i])); }
        p2[0] = __builtin_bit_cast(bf16x8, w0); p2[1] = __builtin_bit_cast(bf16x8, w1); }
      if (VAR != 5) {
      O2[0] = MFMA32(vf[0][0], p2[0], O2[0]); O2[1] = MFMA32(vf[1][0], p2[0], O2[1]); LB = MFMA16(osel, p2[0], LB);
      O2[0] = MFMA32(vf[0][1], p2[1], O2[0]); O2[1] = MFMA32(vf[1][1], p2[1], O2[1]); LB = MFMA16(osel, p2[1], LB); }
      __builtin_amdgcn_sched_group_barrier(0x100, 8, 0);
      __builtin_amdgcn_sched_group_barrier(0x8, 4, 0);
      __builtin_amdgcn_sched_group_barrier(0x402, 24, 0);
#pragma unroll
      for (int i = 0; i < 6; ++i) { __builtin_amdgcn_sched_group_barrier(0x8, 1, 0); __builtin_amdgcn_sched_group_barrier(0x402, 4, 0); }
      { const int nb_ = buf ^ 1;
        *(bf16x8*)(Ks + nb_ * 64 * AT_LD + skey * AT_LD + sseg * 8) = kB;
#pragma unroll
        for (int e = 0; e < 8; ++e) Vt[nb_ * 64 * AT_LD + (sseg * 8 + e) * AT_LD + vslot] = (bf16_t)vB[e];
        const int tl_ = (t + 2 < nt) ? t + 2 : nt - 1;
        kB = *(const bf16x8*)(kg + (size_t)tl_ * 64 * NPB_); vB = *(const bf16x8*)(vg + (size_t)tl_ * 64 * NPB_); }
#pragma unroll
      for (int i = 0; i < 5; ++i) { __builtin_amdgcn_sched_group_barrier(0x8, 1, 0); __builtin_amdgcn_sched_group_barrier(0x200, 2, 0); }
      __builtin_amdgcn_sched_group_barrier(0x8, 1, 0); __builtin_amdgcn_sched_group_barrier(0x20, 2, 0);
      __syncthreads();
    }
    float* cw = cmb + (size_t)(qsub * 64 + lane) * 66;
    const int sl_ = ((lane & 15) << 2);
    const float a0_ = __int_as_float(__builtin_amdgcn_ds_bpermute(sl_, __float_as_int(LA[0]))), a1_ = __int_as_float(__builtin_amdgcn_ds_bpermute(sl_, __float_as_int(LA[1])));
    const float b0_ = __int_as_float(__builtin_amdgcn_ds_bpermute(sl_, __float_as_int(LB[0]))), b1_ = __int_as_float(__builtin_amdgcn_ds_bpermute(sl_, __float_as_int(LB[1])));
    const float lq1 = (r31 >> 4) ? a1_ : a0_, lq2 = (r31 >> 4) ? b1_ : b0_;
    if (kh == 1) {
#pragma unroll
      for (int i = 0; i < 16; ++i) { cw[i] = O1[0][i]; cw[16 + i] = O1[1][i]; cw[32 + i] = O2[0][i]; cw[48 + i] = O2[1][i]; }
      cw[64] = lq1; cw[65] = lq2;
    }
    __syncthreads();
    if (kh == 0) {
#pragma unroll
      for (int i = 0; i < 16; ++i) { O1[0][i] += cw[i]; O1[1][i] += cw[16 + i]; O2[0][i] += cw[32 + i]; O2[1][i] += cw[48 + i]; }
      const float l1 = lq1 + cw[64], l2 = lq2 + cw[65];
      const float i1 = 1.0f / l1, i2 = lam / l2;
      float ss = 0.f;
#pragma unroll
      for (int mt = 0; mt < 2; ++mt)
#pragma unroll
        for (int i = 0; i < 16; ++i) { const float o = O1[mt][i] * i1 - O2[mt][i] * i2; O1[mt][i] = o; ss += o * o; }
      ss += shx(ss, 32, lane_id_v());
      const float sc = rsqrtf(ss * (1.0f / 64.0f) + EPS_) * (1.0f - lam_init);
      const float* sw = a->in[13] + l * 64;
#pragma unroll
      for (int mt = 0; mt < 2; ++mt)
#pragma unroll
        for (int g4 = 0; g4 < 4; ++g4) {
          const int v0 = 32 * mt + 8 * g4 + 4 * h;
          const f32x4 wv = *(const f32x4*)(sw + v0);
          u32x2 w; w.x = cvt_pk_bf16(O1[mt][4 * g4] * sc * wv[0], O1[mt][4 * g4 + 1] * sc * wv[1]); w.y = cvt_pk_bf16(O1[mt][4 * g4 + 2] * sc * wv[2], O1[mt][4 * g4 + 3] * sc * wv[3]);
          *(u32x2*)(BR + (size_t)qrow * 1024 + 640 + head * 64 + v0) = w;
        }
    }
  }
}
template <class Epi> DI void run_gemm(int WV, LAS unsigned char* lds, const bf16_t* A, int lda, const bf16_t* Bt, int M, int N, int K, const Epi& E) {
  pg8::Gemm g; g.A = A; g.Bt = Bt; g.M = M; g.N = N; g.K = K; g.lda = lda;
  pg8::StaticOrder S; S.init(M, N, lnb(), lbid());
  pg8::gemm_phase<Epi, pg8::StaticOrder, false>(WV, lds, g, S, E, nullptr);
}
struct CtxMerge0 { float* MXC; const bf16_t* G; DI void operator()(int r, int c, float v) const { MXC[r * 1024 + c] = bf2f(G[(size_t)r * NGB_ + c]) * v; } };
struct CtxMerge1 { float* MXC; const bf16_t* G; DI void operator()(int r, int c, float v) const { MXC[r * 1024 + c] += bf2f(G[(size_t)r * NGB_ + c]) * v; } };
struct CtxMerge2 { const float* MXC; const bf16_t* G; bf16_t* Hc; DI void operator()(int r, int c, float v) const { Hc[r * 1024 + c] = f2bf(MXC[r * 1024 + c] + bf2f(G[(size_t)r * NGB_ + c]) * v); } };
struct CtxResid { float* Xc; const float* gate; float scale; DI void operator()(int r, int c, float v) const { Xc[r * 1024 + c] += scale * gate[c] * v; } };

DI void phase_win(int WV, int l, unsigned char* smem) {
  KArgs a = kargs(); unsigned char* ws = a->ws;
  EpiWin E; E.PB = (bf16_t*)(ws + WS_PB); E.GB = (bf16_t*)(ws + WS_GB); E.TRET = (const float*)(ws + WS_TRET); E.TROW = (const float*)(ws + WS_TROW); E.TCOL = (const float*)(ws + WS_TCOL);
  E.kmax = (unsigned*)(ws + WS_SCAL) + l * 64 + 16;
  run_gemm(WV, (LAS unsigned char*)smem, (const bf16_t*)(ws + WS_H), 1024, (const bf16_t*)(ws + WS_WIN) + (size_t)l * 5888 * 1024, MT_, NWIN_, 1024, E);
}
DI void phase_merge(int WV, int l, unsigned char* smem) {
  LAS unsigned char* lds = (LAS unsigned char*)smem;
  { KArgs a = kargs(); unsigned char* ws = a->ws; EpiMerge<0> E; E.MX = (bf16_t*)a->out; E.G = (const bf16_t*)(ws + WS_GB); E.Hout = (bf16_t*)(ws + WS_H);
    run_gemm(WV, lds, (const bf16_t*)(ws + WS_BR), 1024, (const bf16_t*)(ws + WS_WBF) + (size_t)l * 1024 * 256, L_, 1024, 256, E); }
  { KArgs a = kargs(); unsigned char* ws = a->ws; EpiMerge<1> E; E.MX = (bf16_t*)a->out; E.G = (const bf16_t*)(ws + WS_GB) + 1024; E.Hout = (bf16_t*)(ws + WS_H);
    run_gemm(WV, lds, (const bf16_t*)(ws + WS_BR) + 256, 1024, (const bf16_t*)(ws + WS_WBR) + (size_t)l * 1024 * 384, L_, 1024, 384, E); }
  { KArgs a = kargs(); unsigned char* ws = a->ws; EpiMerge<2> E; E.MX = (bf16_t*)a->out; E.G = (const bf16_t*)(ws + WS_GB) + 2048; E.Hout = (bf16_t*)(ws + WS_H);
    run_gemm(WV, lds, (const bf16_t*)(ws + WS_BR) + 640, 1024, (const bf16_t*)(ws + WS_WBD) + (size_t)l * 1024 * 384, L_, 1024, 384, E); }
  { KArgs a = kargs(); unsigned char* ws = a->ws;
    const bf16_t* BRc = (const bf16_t*)(ws + WS_BR) + (size_t)L_ * 1024; const bf16_t* GBc = (const bf16_t*)(ws + WS_GB) + (size_t)L_ * NGB_;
    CtxMerge0 e0; e0.MXC = (float*)(ws + WS_MXC); e0.G = GBc;
    ctx_gemm32(WV, BRc, 1024, (const bf16_t*)(ws + WS_WBF) + (size_t)l * 1024 * 256, 256, 1024, smem, e0);
    CtxMerge1 e1; e1.MXC = (float*)(ws + WS_MXC); e1.G = GBc + 1024;
    ctx_gemm32(WV, BRc + 256, 1024, (const bf16_t*)(ws + WS_WBR) + (size_t)l * 1024 * 384, 384, 1024, smem, e1);
    CtxMerge2 e2; e2.MXC = (const float*)(ws + WS_MXC); e2.G = GBc + 2048; e2.Hc = (bf16_t*)(ws + WS_H) + (size_t)L_ * 1024;
    ctx_gemm32(WV, BRc + 640, 1024, (const bf16_t*)(ws + WS_WBD) + (size_t)l * 1024 * 384, 384, 1024, smem, e2); }
}
DI void phase_wo(int WV, int l, unsigned char* smem) {
  { KArgs a = kargs(); unsigned char* ws = a->ws; EpiResid E; E.X = (float*)(ws + WS_X); E.gate = (const float*)(ws + WS_MOD) + (size_t)l * 9216 + 5 * 1024; E.scale = 1.0f;
    run_gemm(WV, (LAS unsigned char*)smem, (const bf16_t*)(ws + WS_H), 1024, (const bf16_t*)(ws + WS_WO) + (size_t)l * 1024 * 1024, L_, 1024, 1024, E); }
  { KArgs a = kargs(); unsigned char* ws = a->ws; CtxResid e; e.Xc = (float*)(ws + WS_X) + (size_t)L_ * 1024; e.gate = (const float*)(ws + WS_MOD) + (size_t)(4 + l) * 9216 + 5 * 1024; e.scale = 1.0f;
    ctx_gemm32(WV, (const bf16_t*)(ws + WS_H) + (size_t)L_ * 1024, 1024, (const bf16_t*)(ws + WS_WO) + (size_t)l * 1024 * 1024, 1024, 1024, smem, e); }
}
DI void phase_g1(int WV, int l, int f, unsigned char* smem) {
  KArgs a = kargs(); unsigned char* ws = a->ws; EpiSwiglu E; E.U = (bf16_t*)(ws + WS_U);
  run_gemm(WV, (LAS unsigned char*)smem, (const bf16_t*)(ws + WS_H), 1024, (const bf16_t*)(ws + WS_W13) + (size_t)(l * 2 + f) * 5632 * 1024, MT_, 5632, 1024, E);
}
DI void phase_g2(int WV, int l, int f, unsigned char* smem) {
  const int gi = f == 0 ? 2 : 8;
  { KArgs a = kargs(); unsigned char* ws = a->ws; EpiResid E; E.X = (float*)(ws + WS_X); E.gate = (const float*)(ws + WS_MOD) + (size_t)l * 9216 + gi * 1024; E.scale = 0.5f;
    run_gemm(WV, (LAS unsigned char*)smem, (const bf16_t*)(ws + WS_U), 2816, (const bf16_t*)(ws + WS_W2) + (size_t)(l * 2 + f) * 1024 * 2816, L_, 1024, 2816, E); }
  { KArgs a = kargs(); unsigned char* ws = a->ws; CtxResid e; e.Xc = (float*)(ws + WS_X) + (size_t)L_ * 1024; e.gate = (const float*)(ws + WS_MOD) + (size_t)(4 + l) * 9216 + gi * 1024; e.scale = 0.5f;
    ctx_gemm32(WV, (const bf16_t*)(ws + WS_U) + (size_t)L_ * 2816, 2816, (const bf16_t*)(ws + WS_W2) + (size_t)(l * 2 + f) * 1024 * 2816, 2816, 1024, smem, e); }
}

DI unsigned xcc_id() { return (unsigned)__builtin_amdgcn_s_getreg((3 << 11) | 20) & 0xFu; }
DI void grid_bar(int WV, unsigned& gen, unsigned xcc, unsigned nloc, unsigned nx) {
  asm volatile("s_waitcnt vmcnt(0)" ::: "memory");
  __syncthreads();
  gen += 1;
  if (ltid() == 0) {
    unsigned* bar = (unsigned*)(kargs()->ws + WS_BAR);
    const unsigned old = __hip_atomic_fetch_add(bar + 320 + 16 * xcc, 1u, __ATOMIC_RELAXED, __HIP_MEMORY_SCOPE_AGENT);
    if (old + 1u == gen * nloc) {
      __builtin_amdgcn_fence(__ATOMIC_RELEASE, "agent");
      asm volatile("s_waitcnt vmcnt(0)" ::: "memory");
      __hip_atomic_fetch_add(bar + 640, 1u, __ATOMIC_RELAXED, __HIP_MEMORY_SCOPE_AGENT);
    }
    const unsigned target = gen * nx;
    while (__hip_atomic_load(bar + 640, __ATOMIC_RELAXED, __HIP_MEMORY_SCOPE_AGENT) < target) __builtin_amdgcn_s_sleep(1);
    __builtin_amdgcn_fence(__ATOMIC_ACQUIRE, "agent");
    asm volatile("s_waitcnt vmcnt(0)" ::: "memory");
  }
  __syncthreads();
}

__global__ void __launch_bounds__(512, 2) mega(Args a_unused) {
  extern __shared__ __attribute__((aligned(16))) unsigned char smem[];
  cg::grid_group grid = cg::this_grid();
  const int WV = __builtin_amdgcn_readfirstlane((int)(threadIdx.x >> 6));
  const unsigned xcc = xcc_id();
  if (threadIdx.x == 0) __hip_atomic_fetch_add((unsigned*)(kargs()->ws + WS_BAR) + 16 + 16 * xcc, 1u, __ATOMIC_RELAXED, __HIP_MEMORY_SCOPE_AGENT);
#ifndef NO_PRO
  prologue(WV, kargs(), smem);
#ifdef PROBE_PRO
  __syncthreads(); prologue(WV, kargs(), smem);
#endif
#endif
  grid.sync();
  unsigned gen = 0, nloc = 1, nx = 0;
  { const unsigned* cen = (const unsigned*)(kargs()->ws + WS_BAR) + 16;
    for (int j = 0; j < 16; ++j) { const unsigned cj = __hip_atomic_load(cen + 16 * j, __ATOMIC_RELAXED, __HIP_MEMORY_SCOPE_AGENT); nx += cj ? 1u : 0u; if ((unsigned)j == xcc) nloc = cj; }
    nloc = __builtin_amdgcn_readfirstlane(nloc); nx = __builtin_amdgcn_readfirstlane(nx); }
#pragma unroll 1
  for (int l = 0; l < DEPTH_; ++l) {
#pragma unroll 1
    for (int f = 0; f < 2; ++f) {
      if (f == 1) {
        norm_phase(WV, kargs(), l, 1, false);
        grid_bar(WV, gen, xcc, nloc, nx);
        phase_win(WV, l, smem);
#ifdef PROBE_WIN
        phase_win(WV, l, smem);
#endif
        grid_bar(WV, gen, xcc, nloc, nx);
#ifndef NO_MIXA
        fourier_tables(WV, smem); __syncthreads(); fourier_stage1(WV, kargs(), smem); fourier_ctx(WV, kargs(), smem); __syncthreads(); ret_states(WV, kargs(), l, smem);
#ifdef PROBE_MIXA
        __syncthreads();
        fourier_tables(WV, smem); __syncthreads(); fourier_stage1(WV, kargs(), smem); fourier_ctx(WV, kargs(), smem); __syncthreads(); ret_states(WV, kargs(), l, smem);
#endif
#endif
        grid_bar(WV, gen, xcc, nloc, nx);
#ifndef NO_MIXB
        ret_scan(WV, kargs(), l); __syncthreads(); fourier_tables(WV, smem); __syncthreads(); fourier_stage2(WV, kargs(), smem);
#ifdef PROBE_MIXB
        __syncthreads();
        ret_scan(WV, kargs(), l); __syncthreads(); fourier_tables(WV, smem); __syncthreads(); fourier_stage2(WV, kargs(), smem);
#endif
#endif
        grid_bar(WV, gen, xcc, nloc, nx);
#ifndef NO_RETOUT
        ret_out(WV, kargs(), l, smem); __syncthreads();
#ifdef PROBE_RET
        ret_out(WV, kargs(), l, smem); __syncthreads();
#endif
#endif
#ifndef NO_ATTN
        attn_phase<0>(WV, kargs(), l, l < DEPTH_ - 1, smem);
#ifdef PROBE_ATTN
        __syncthreads(); attn_phase<PROBE_ATTN>(WV, kargs(), l, l < DEPTH_ - 1, smem);
#endif
#endif
        grid_bar(WV, gen, xcc, nloc, nx);
        phase_merge(WV, l, smem);
#ifdef PROBE_MERGE
        phase_merge(WV, l, smem);
#endif
        grid_bar(WV, gen, xcc, nloc, nx);
        phase_wo(WV, l, smem);
        grid_bar(WV, gen, xcc, nloc, nx);
      }
      norm_phase(WV, kargs(), l, f == 0 ? 0 : 2, l == 0 && f == 0);
      grid_bar(WV, gen, xcc, nloc, nx);
      phase_g1(WV, l, f, smem);
#ifdef PROBE_G1
      phase_g1(WV, l, f, smem);
#endif
      grid_bar(WV, gen, xcc, nloc, nx);
      phase_g2(WV, l, f, smem);
      grid_bar(WV, gen, xcc, nloc, nx);
    }
  }
  final_norm(WV, kargs());
}

extern "C" void kernel_launch(void* const* d_in, const int* in_sizes, int n_in, void* d_out, int out_size, void* d_ws, size_t ws_size, hipStream_t stream) {
  static int grid = 0;
  if (grid == 0) {
    int dev = 0, cus = 0, per_cu = 0;
    (void)hipGetDevice(&dev); (void)hipDeviceGetAttribute(&cus, hipDeviceAttributeMultiprocessorCount, dev);
    if (hipFuncSetAttribute((const void*)mega, hipFuncAttributeMaxDynamicSharedMemorySize, LDS_BYTES) != hipSuccess) fprintf(stderr, "kernel_launch: hipFuncSetAttribute failed\n");
    if (hipOccupancyMaxActiveBlocksPerMultiprocessor(&per_cu, (const void*)mega, 512, LDS_BYTES) != hipSuccess || per_cu < 1) fprintf(stderr, "kernel_launch: occupancy query says %d blocks per CU\n", per_cu);
    (void)hipGetLastError();
    grid = cus > 0 ? cus : 256;
    if (ws_size < WS_END) { fprintf(stderr, "kernel_launch: workspace too small: %zu < %zu\n", ws_size, (size_t)WS_END); }
  }
  Args a{};
  for (int i = 0; i < 19; ++i) a.in[i] = (const float*)d_in[i];
  a.out = (float*)d_out; a.ws = (unsigned char*)d_ws;
  (void)hipMemsetAsync((unsigned char*)d_ws + WS_BAR, 0, 8192, stream);
  void* args[] = {&a};
  hipError_t e = hipLaunchCooperativeKernel((const void*)mega, dim3(grid), dim3(512), args, LDS_BYTES, stream);
  if (e != hipSuccess) fprintf(stderr, "kernel_launch: cooperative launch failed: %s (grid %d)\n", hipGetErrorString(e), grid);
}
```

```cpp
#define IGLP_ID 2
#include <hip/hip_runtime.h>
#include <hip/hip_cooperative_groups.h>
#include <cstdio>
namespace cg = cooperative_groups;
__device__ __forceinline__ int lane_id_v() { int l; asm volatile("v_mbcnt_lo_u32_b32 %0, -1, 0\n\tv_mbcnt_hi_u32_b32 %0, -1, %0" : "=v"(l)); return l; }
#define ltid() ((WV << 6) | lane_id_v())
__device__ __forceinline__ float shx(float v, int m, int lane) { return __int_as_float(__builtin_amdgcn_ds_bpermute((lane ^ m) << 2, __float_as_int(v))); }
namespace pg8 {
#define PG8_LAS __attribute__((address_space(3)))
typedef unsigned short bf16_t;
typedef short bf16x8 __attribute__((ext_vector_type(8)));
typedef float f32x4 __attribute__((ext_vector_type(4)));
typedef unsigned u32x4 __attribute__((ext_vector_type(4)));
constexpr int BM = 256, BK = 64, HALF = 128, HTB = HALF * BK * 2  , STAGE_BYTES = 8 * HTB, NXCD = 8, WGM = 8;

__host__ __device__ __forceinline__ int lds_byte(int r, int c) { const int st = (r >> 4) * 2 + (c >> 5), rr = r & 15, cc = c & 31, ob = rr * 64 + cc * 2; return st * 1024 + (ob ^ (((ob >> 9) & 1) << 5)); }
__host__ __device__ __forceinline__ void stage_rc(int b, int& R, int& C) { const int st = b / 1024, sb = b % 1024, swz = sb ^ (((sb >> 9) & 1) << 5); R = (st >> 1) * 16 + swz / 64; C = (st & 1) * 32 + (swz % 64) / 2; }
__host__ __device__ __forceinline__ int perm32(int rho) { const int n = rho >> 4, i = rho & 15; return 8 * (i >> 2) + 4 * n + (i & 3); }

struct Unit { int pm, pn; };
struct Gemm { const bf16_t* A; const bf16_t* Bt; int M, N, K, lda; };

struct StaticOrder {
    int nM, nN, nwg, G, c;
    __host__ __device__ void init(int M, int N, int G_, int c_) { nM = M / BM; nN = N / BM; nwg = nM * nN; G = G_; c = c_; }
    __host__ __device__ bool next(int i, Unit& u) const {
        const long L = (long)i * G + c; if (L >= nwg) return false;
        int wgid = (int)L; { const int q = nwg / NXCD, r = nwg % NXCD, xcd = wgid % NXCD, off = wgid / NXCD; wgid = (xcd < r ? xcd * (q + 1) : r * (q + 1) + (xcd - r) * q) + off; }
        const int nig = WGM * nN, gid = wgid / nig, fm = gid * WGM, gsz = (nM - fm) < WGM ? (nM - fm) : WGM;
        u.pm = fm + ((wgid % nig) % gsz); u.pn = (wgid % nig) / gsz; return true;
    }
    __device__ __forceinline__ void a_ready(const Unit&) const {}
    __device__ __forceinline__ void done(const Unit&) const {}
};
__device__ __forceinline__ unsigned cvt_pk_bf16(float lo, float hi) { unsigned r; asm volatile("v_cvt_pk_bf16_f32 %0, %1, %2" : "=v"(r) : "v"(lo), "v"(hi)); return r; }
template <class Epi, class Sched, bool STAMP = false>
__device__ __forceinline__ void gemm_phase(const int WV, PG8_LAS unsigned char* lds, const Gemm g, const Sched& S, const Epi& E, unsigned long long* stamps) {
    const int tid = ltid(); const int wid = __builtin_amdgcn_readfirstlane(tid >> 6), lane = tid & 63, wr = wid >> 2, wc = wid & 3, fr = lane & 15, fq = lane >> 4;
    const int K = g.K, nt = K / BK;
    int ts_lo = 0, ts_hi = 0, nts = 0; const unsigned long long rt_entry = STAMP ? (unsigned long long)wall_clock64() : 0ull;
#define PG8_STAMP() do { if (STAMP && wid == 0 && nts < 64) { const unsigned long long _c = (unsigned long long)clock64(); \
        ts_lo = (lane == nts) ? (int)(unsigned)_c : ts_lo; ts_hi = (lane == nts) ? (int)(unsigned)(_c >> 32) : ts_hi; ++nts; } } while (0)
    PG8_STAMP();
    unsigned voffA[2], voffB[2];
#pragma unroll
    for (int i = 0; i < 2; ++i) { int R, C; stage_rc(tid * 16 + i * 8192, R, C); const int Rb = Epi::PERM ? ((R & ~31) + perm32(R & 31)) : R;
        voffA[i] = (unsigned)(R * g.lda + C) * 2u; voffB[i] = (unsigned)(Rb * K + C) * 2u; }
    const size_t kstep = (size_t)(BK * 2);
    const size_t hstep = (size_t)HALF * K * 2;
    const size_t tstep = 2 * hstep; const size_t hstepA = (size_t)HALF * g.lda * 2; const size_t tstepA = 2 * hstepA;
    const unsigned ldsw = (unsigned)wid * 1024u;
    const int aoff = lds_byte(wr * 64 + fr, fq * 8), boff = lds_byte(wc * 32 + fr, fq * 8);
#define PG8_SA(b, h) (((b) * 2 + (h)) * HTB)
#define PG8_SB(b, h) ((4 + (b) * 2 + (h)) * HTB)
#define PG8_STAGE(bufoff, gbase, voff) do { _Pragma("unroll") for (int _i = 0; _i < 2; ++_i) \
        __builtin_amdgcn_global_load_lds((const unsigned*)((const char*)(gbase) + (voff)[_i]), (PG8_LAS unsigned*)(lds + (bufoff) + ldsw + _i * 8192), 16, 0, 0); } while (0)
#define PG8_LDA(dst, b, h) do { _Pragma("unroll") for (int m = 0; m < 4; ++m) _Pragma("unroll") for (int k = 0; k < 2; ++k) dst[m][k] = *(const PG8_LAS bf16x8*)(lds + PG8_SA(b, h) + aoff + m * 2048 + k * 1024); } while (0)
#define PG8_LDB(dst, b, h) do { _Pragma("unroll") for (int n = 0; n < 2; ++n) _Pragma("unroll") for (int k = 0; k < 2; ++k) dst[n][k] = *(const PG8_LAS bf16x8*)(lds + PG8_SB(b, h) + boff + n * 2048 + k * 1024); } while (0)
#define PG8_MMA(ai, bj, At, Bt) do { __builtin_amdgcn_s_setprio(1); _Pragma("unroll") for (int m = 0; m < 4; ++m) _Pragma("unroll") for (int n = 0; n < 2; ++n) _Pragma("unroll") for (int k = 0; k < 2; ++k) \
        acc[ai][bj][m][n] = __builtin_amdgcn_mfma_f32_16x16x32_bf16(Bt[n][k], At[m][k], acc[ai][bj][m][n], 0, 0, 0); __builtin_amdgcn_s_setprio(0); } while (0)
#define PG8_WAIT_V(n) asm volatile("s_waitcnt vmcnt(" #n ")" ::: "memory")
#define PG8_WAIT_L(n) asm volatile("s_waitcnt lgkmcnt(" #n ")" ::: "memory")
#define PG8_BAR __builtin_amdgcn_s_barrier()
#define PG8_SCHED __builtin_amdgcn_sched_barrier(0)
    Unit cur, nxt; int ui = 0;
    if (!S.next(0, cur)) return;
    f32x4 acc[2][2][4][2];
#pragma unroll
    for (int a = 0; a < 2; ++a)
#pragma unroll
        for (int b = 0; b < 2; ++b)
#pragma unroll
            for (int m = 0; m < 4; ++m)
#pragma unroll
                for (int n = 0; n < 2; ++n) acc[a][b][m][n] = (f32x4){0.f, 0.f, 0.f, 0.f};
    bf16x8 At[4][2], B0[2][2], B1[2][2];
    const char* cA = (const char*)g.A + (size_t)cur.pm * tstepA; const char* cB = (const char*)g.Bt + (size_t)cur.pn * tstep;
    S.a_ready(cur);
    PG8_STAGE(PG8_SB(0, 0), cB, voffB); PG8_STAGE(PG8_SA(0, 0), cA, voffA); PG8_STAGE(PG8_SB(0, 1), cB + hstep, voffB); PG8_STAGE(PG8_SA(0, 1), cA + hstepA, voffA);
    if (wr == 1) PG8_BAR;
    PG8_WAIT_V(4); PG8_BAR;
    PG8_STAGE(PG8_SB(1, 0), cB + kstep, voffB); PG8_STAGE(PG8_SA(1, 0), cA + kstep, voffA); PG8_STAGE(PG8_SB(1, 1), cB + hstep + kstep, voffB);
    PG8_WAIT_V(6); PG8_BAR;
    PG8_STAMP();
    for (;;) {
        const bool has_next = S.next(ui + 1, nxt);
        const char* nA = has_next ? (const char*)g.A + (size_t)nxt.pm * tstepA : cA; const char* nB = has_next ? (const char*)g.Bt + (size_t)nxt.pn * tstep : cB;
        for (int t = 0; t < nt; t += 2) {
            const bool last = (t == nt - 2);
            const char* a1 = cA + (size_t)(t + 1) * kstep;
            const char* a2 = last ? nA : cA + (size_t)(t + 2) * kstep; const char* b2 = last ? nB : cB + (size_t)(t + 2) * kstep;
            const char* a3 = a2 + kstep; const char* b3 = b2 + kstep;
            if (last && has_next) S.a_ready(nxt);
            PG8_LDB(B0, 0, 0); PG8_SCHED; PG8_LDA(At, 0, 0); PG8_STAGE(PG8_SA(1, 1), a1 + hstepA, voffA);
            PG8_WAIT_L(8); PG8_BAR; PG8_WAIT_L(0); PG8_MMA(0, 0, At, B0); PG8_BAR; PG8_SCHED;
            PG8_LDB(B1, 0, 1); PG8_STAGE(PG8_SB(0, 0), b2, voffB);
            PG8_BAR; PG8_WAIT_L(0); PG8_MMA(0, 1, At, B1); PG8_BAR;
            PG8_LDA(At, 0, 1); PG8_STAGE(PG8_SA(0, 0), a2, voffA);
            PG8_BAR; PG8_WAIT_L(0); PG8_MMA(1, 0, At, B0); PG8_BAR; PG8_SCHED;
            PG8_STAGE(PG8_SB(0, 1), b2 + hstep, voffB);
            PG8_WAIT_V(6); PG8_BAR; PG8_MMA(1, 1, At, B1); PG8_BAR;
            PG8_LDB(B0, 1, 0); PG8_SCHED; PG8_LDA(At, 1, 0); PG8_STAGE(PG8_SA(0, 1), a2 + hstepA, voffA);
            PG8_WAIT_L(8); PG8_BAR; PG8_WAIT_L(0); PG8_MMA(0, 0, At, B0); PG8_BAR; PG8_SCHED;
            PG8_LDB(B1, 1, 1); PG8_STAGE(PG8_SB(1, 0), b3, voffB);
            PG8_BAR; PG8_WAIT_L(0); PG8_MMA(0, 1, At, B1); PG8_BAR;
            PG8_LDA(At, 1, 1); PG8_STAGE(PG8_SA(1, 0), a3, voffA);
            PG8_BAR; PG8_WAIT_L(0); PG8_MMA(1, 0, At, B0); PG8_BAR; PG8_SCHED;
            PG8_STAGE(PG8_SB(1, 1), b3 + hstep, voffB);
            PG8_WAIT_V(6); PG8_BAR; PG8_MMA(1, 1, At, B1); PG8_BAR;
        }
        PG8_STAMP();
        if constexpr (!Epi::AFTER_DRAIN) { E(acc, cur, wr, wc, fr, fq); S.done(cur); }
        PG8_STAMP();
        if (!has_next) break;
#pragma unroll
        for (int a = 0; a < 2; ++a)
#pragma unroll
            for (int b = 0; b < 2; ++b)
#pragma unroll
                for (int m = 0; m < 4; ++m)
#pragma unroll
                    for (int n = 0; n < 2; ++n) acc[a][b][m][n] = (f32x4){0.f, 0.f, 0.f, 0.f};
        cur = nxt; cA = nA; cB = nB; ++ui;
    }
    PG8_WAIT_V(0);
    if (wr == 0) PG8_BAR;
    PG8_BAR;
    if constexpr (Epi::AFTER_DRAIN) { E.fused(acc, cur, wr, wc, fr, fq, lds, wid, lane); S.done(cur); }
    PG8_STAMP();
    if (STAMP && wid == 0) { stamps[lane] = lane < nts ? (((unsigned long long)(unsigned)ts_hi << 32) | (unsigned)ts_lo) : 0ull;
        if (lane == 62) stamps[62] = rt_entry; if (lane == 63) stamps[63] = (unsigned long long)wall_clock64(); }
#undef PG8_STAMP
#undef PG8_SA
#undef PG8_SB
#undef PG8_STAGE
#undef PG8_LDA
#undef PG8_LDB
#undef PG8_MMA
#undef PG8_WAIT_V
#undef PG8_WAIT_L
#undef PG8_BAR
#undef PG8_SCHED
}
}
using pg8::bf16_t; using pg8::bf16x8; using pg8::f32x4; using pg8::u32x4; using pg8::cvt_pk_bf16;
typedef float f32x16 __attribute__((ext_vector_type(16)));
typedef short s16x4 __attribute__((ext_vector_type(4)));
typedef unsigned u32x2 __attribute__((ext_vector_type(2)));
#define DI __device__ __forceinline__
#define LAS __attribute__((address_space(3)))
#define MFMA32(a, b, c) __builtin_amdgcn_mfma_f32_32x32x16_bf16((a), (b), (c), 0, 0, 0)

constexpr int L_ = 16384, LC_ = 256, MT_ = 16640, D_ = 1024, DFF_ = 2816, DEPTH_ = 4;
constexpr int NWIN_ = 5888, NPB_ = 2816, NGB_ = 3072;
constexpr int C_FA = 0, C_FB = 256, C_RQ = 512, C_RK = 704, C_RV = 896, C_RG = 1280, C_DQ = 1664, C_DK = 2048, C_DV = 2432;
constexpr int LDS_BYTES = 147456;
constexpr float EPS_ = 1e-6f;

constexpr size_t al256(size_t x) { return (x + 255) & ~(size_t)255; }
constexpr size_t WS_W13 = 0;
constexpr size_t WS_W2  = WS_W13 + (size_t)4 * 2 * 5632 * 1024 * 2;
constexpr size_t WS_WIN = WS_W2 + (size_t)4 * 2 * 1024 * 2816 * 2;
constexpr size_t WS_WBF = WS_WIN + (size_t)4 * 5888 * 1024 * 2;
constexpr size_t WS_WBR = WS_WBF + (size_t)4 * 1024 * 256 * 2;
constexpr size_t WS_WBD = WS_WBR + (size_t)4 * 1024 * 384 * 2;
constexpr size_t WS_WO  = WS_WBD + (size_t)4 * 1024 * 384 * 2;
constexpr size_t WS_X   = WS_WO + (size_t)4 * 1024 * 1024 * 2;
constexpr size_t WS_H   = WS_X + (size_t)MT_ * 1024 * 4;
constexpr size_t WS_BR  = WS_H + (size_t)MT_ * 1024 * 2;
constexpr size_t WS_AL  = WS_BR + (size_t)MT_ * 1024 * 2;
constexpr size_t WS_U   = WS_AL;
constexpr size_t WS_PB  = WS_AL;
constexpr size_t WS_GB  = WS_AL + (size_t)MT_ * 2816 * 2;
constexpr size_t WS_V   = WS_GB + (size_t)MT_ * 3072 * 2;
constexpr size_t WS_T   = WS_V + (size_t)128 * 128 * 2 * 256 * 2;
constexpr size_t WS_S   = WS_T + (size_t)130 * 6 * 2 * 2048 * 4;
constexpr size_t WS_MXC = WS_S + (size_t)130 * 6 * 2 * 2048 * 4;
constexpr size_t WS_MOD = WS_MXC + (size_t)256 * 1024 * 4;
constexpr size_t WS_TRET = WS_MOD + (size_t)2 * 4 * 9216 * 4;
constexpr size_t WS_TROW = WS_TRET + (size_t)16384 * 16 * 2 * 4;
constexpr size_t WS_TCOL = WS_TROW + (size_t)256 * 8 * 2 * 4;
constexpr size_t WS_SCAL = WS_TCOL + (size_t)64 * 8 * 2 * 4;
constexpr size_t WS_BAR = WS_SCAL + 4 * 64 * 4;
constexpr size_t WS_END = WS_BAR + 8192;

__device__ __forceinline__ int lbid() { int t = blockIdx.x; asm volatile("" : "+s"(t)); return t; }
__device__ __forceinline__ int lnb() { int t = gridDim.x; asm volatile("" : "+s"(t)); return t; }
struct Args { const float* in[19]; float* out; unsigned char* ws; };
typedef const Args __attribute__((address_space(4)))* KArgs;
__device__ __forceinline__ KArgs kargs() { KArgs p = (KArgs)__builtin_amdgcn_kernarg_segment_ptr(); asm volatile("" : "+s"(p)); return p; }

DI float bf2f(unsigned v) { return __uint_as_float(v << 16); }
DI bf16_t f2bf(float x) { return (bf16_t)(cvt_pk_bf16(x, 0.f) & 0xffffu); }
DI int crow(int reg, int h) { return (reg & 3) + 8 * (reg >> 2) + 4 * h; }
DI bf16x8 pack_step(const f32x16& x, int s) {
  u32x4 p;
  asm volatile("v_cvt_pk_bf16_f32 %0, %4, %5\n\tv_cvt_pk_bf16_f32 %1, %6, %7\n\tv_cvt_pk_bf16_f32 %2, %8, %9\n\tv_cvt_pk_bf16_f32 %3, %10, %11\n\ts_nop 1"
               : "=&v"(p[0]), "=&v"(p[1]), "=&v"(p[2]), "=&v"(p[3])
               : "v"(x[8 * s]), "v"(x[8 * s + 1]), "v"(x[8 * s + 2]), "v"(x[8 * s + 3]), "v"(x[8 * s + 4]), "v"(x[8 * s + 5]), "v"(x[8 * s + 6]), "v"(x[8 * s + 7]));
  return __builtin_bit_cast(bf16x8, p);
}
DI float silu_f(float a) { return a * __builtin_amdgcn_rcpf(1.0f + __expf(-a)); }
DI float sigmoid_f(float a) { return __builtin_amdgcn_rcpf(1.0f + __expf(-a)); }
DI float wave_sum(float v) {
  const int lane = lane_id_v();
#pragma unroll
  for (int o = 32; o > 0; o >>= 1) v += shx(v, o, lane);
  return v;
}
DI void sincos_acc(float xf, float& s, float& c) {
  const double x = (double)xf;
  const double k = rint(x * 0.63661977236758134308);
  double r = fma(-k, 1.57079632679489655800e+00, x); r = fma(-k, 6.12323399573676603587e-17, r);
  const double r2 = r * r;
  double sp = -1.0 / 39916800.0; sp = fma(sp, r2, 1.0 / 362880.0); sp = fma(sp, r2, -1.0 / 5040.0); sp = fma(sp, r2, 1.0 / 120.0); sp = fma(sp, r2, -1.0 / 6.0); sp = fma(sp * r2, r, r);
  double cp = 1.0 / 479001600.0; cp = fma(cp, r2, -1.0 / 3628800.0); cp = fma(cp, r2, 1.0 / 40320.0); cp = fma(cp, r2, -1.0 / 720.0); cp = fma(cp, r2, 1.0 / 24.0); cp = fma(cp, r2, -0.5); cp = fma(cp, r2, 1.0);
  const int q = ((int)(long long)k) & 3;
  const double sv = (q == 0) ? sp : (q == 1) ? cp : (q == 2) ? -sp : -cp;
  const double cv = (q == 0) ? cp : (q == 1) ? -sp : (q == 2) ? -cp : sp;
  s = (float)sv; c = (float)cv;
}
__constant__ float INV16[16] = {1.0f, 0.5623413324356079f, 0.3162277638912201f, 0.17782793939113617f, 0.10000000149011612f, 0.05623413249850273f, 0.03162277489900589f, 0.017782794311642647f,
                             0.009999999776482582f, 0.005623413249850273f, 0.003162277629598975f, 0.0017782794311642647f, 0.0010000000474974513f, 0.000562341301701963f, 0.0003162277571391314f, 0.00017782794020604342f};
struct ConvJob { const float* src; const float* src2; bf16_t* dst; int N, K, ld, kind; };
DI ConvJob conv_job(KArgs a, int j) {
  const int l = j / 9, kd = j % 9; ConvJob J; J.src2 = nullptr; J.kind = 0;
  unsigned char* ws = a->ws;
  switch (kd) {
    case 0: case 1: { const int f = kd; J.src = a->in[7] + (size_t)(l * 2 + f) * 1024 * 2816; J.src2 = a->in[8] + (size_t)(l * 2 + f) * 1024 * 2816; J.dst = (bf16_t*)(ws + WS_W13) + (size_t)(l * 2 + f) * 5632 * 1024; J.N = 5632; J.K = 1024; J.ld = 2816; J.kind = 1; break; }
    case 2: case 3: { const int f = kd - 2; J.src = a->in[9] + (size_t)(l * 2 + f) * 2816 * 1024; J.dst = (bf16_t*)(ws + WS_W2) + (size_t)(l * 2 + f) * 1024 * 2816; J.N = 1024; J.K = 2816; J.ld = 1024; break; }
    case 4: { J.src = a->in[10] + (size_t)l * 1024 * 5632; J.dst = (bf16_t*)(ws + WS_WIN) + (size_t)l * 5888 * 1024; J.N = 5888; J.K = 1024; J.ld = 5632; J.kind = 2; break; }
    case 5: { J.src = a->in[14] + (size_t)l * 256 * 1024; J.dst = (bf16_t*)(ws + WS_WBF) + (size_t)l * 1024 * 256; J.N = 1024; J.K = 256; J.ld = 1024; break; }
    case 6: { J.src = a->in[15] + (size_t)l * 384 * 1024; J.dst = (bf16_t*)(ws + WS_WBR) + (size_t)l * 1024 * 384; J.N = 1024; J.K = 384; J.ld = 1024; break; }
    case 7: { J.src = a->in[16] + (size_t)l * 384 * 1024; J.dst = (bf16_t*)(ws + WS_WBD) + (size_t)l * 1024 * 384; J.N = 1024; J.K = 384; J.ld = 1024; break; }
    default: { J.src = a->in[17] + (size_t)l * 1024 * 1024; J.dst = (bf16_t*)(ws + WS_WO) + (size_t)l * 1024 * 1024; J.N = 1024; J.K = 1024; J.ld = 1024; break; }
  }
  return J;
}
DI int axial_perm(int s) { return s < 8 ? s : (s < 16 ? s + 8 : (s < 24 ? s - 8 : s)); }

DI void prologue(int WV, KArgs a, unsigned char* smem) {
  const int tid = ltid(), nb = lnb(), bid = lbid();
  float* t = (float*)smem;
  float* tr = t + 64 * 65;
  {
    constexpr int tiles_per_layer = 1408 * 2 + 704 * 2 + 1472 + 64 + 96 + 96 + 256;
    const int nn = tid & 63, kq = tid >> 6;
#pragma unroll 1
    for (int g = bid; g < 4 * tiles_per_layer; g += nb) {
      const int l = g / tiles_per_layer; int rem = g % tiles_per_layer; int kd;
      if (rem < 1408) kd = 0; else if (rem < 2816) { kd = 1; rem -= 1408; } else if (rem < 3520) { kd = 2; rem -= 2816; } else if (rem < 4224) { kd = 3; rem -= 3520; }
      else if (rem < 5696) { kd = 4; rem -= 4224; } else if (rem < 5760) { kd = 5; rem -= 5696; } else if (rem < 5856) { kd = 6; rem -= 5760; } else if (rem < 5952) { kd = 7; rem -= 5856; } else { kd = 8; rem -= 5952; }
      const ConvJob J = conv_job(a, l * 9 + kd);
      const int nkt = J.K / 64; const int n0 = (rem / nkt) * 64, k0 = (rem % nkt) * 64;
      const bool fold = (J.kind == 2) && (n0 < 512);
      const float* sp = J.src; int col = n0 + nn;
      if (J.kind == 1) { const int n = n0 + nn, gi = n >> 5, s = n & 31; sp = (s < 16) ? J.src : J.src2; col = 16 * gi + (s & 15); }
      else if (J.kind == 2) {
        const int n = n0 + nn;
        if (fold) col = (n0 & 192) + nn;
        else { col = n - 256; if (n >= C_DQ && n < C_DV) { const int s = n & 31; col = (n - 256 - s) + axial_perm(s); } }
      }
      const float* cp = sp + (size_t)(k0 + kq) * J.ld + col;
      float lv[8];
#pragma unroll
      for (int i = 0; i < 8; ++i) lv[i] = cp[(size_t)(8 * i) * J.ld];
#pragma unroll
      for (int i = 0; i < 8; ++i) t[nn * 65 + kq + 8 * i] = lv[i];
      if (fold && tid < 64) { const float ang = (float)tid * (1.0f / 32.0f); tr[tid] = (n0 >= 256) ? sinpif(ang) : cospif(ang); }
      __syncthreads();
      if (!fold) {
#pragma unroll
        for (int i = 0; i < 4; ++i) {
          const int e = tid + i * 512, n2 = e >> 5, kp = (e & 31) * 2;
          *(unsigned*)(J.dst + (size_t)(n0 + n2) * J.K + k0 + kp) = cvt_pk_bf16(t[n2 * 65 + kp], t[n2 * 65 + kp + 1]);
        }
      } else {
#pragma unroll 1
        for (int i = 0; i < 8; ++i) {
          const int m = kq + 8 * i, kk = nn;
          float acc = 0.f;
#pragma unroll 8
          for (int c = 0; c < 64; ++c) acc += t[c * 65 + kk] * tr[(m * c) & 63];
          J.dst[(size_t)(n0 + m) * J.K + k0 + kk] = f2bf(acc);
        }
      }
      __syncthreads();
    }
  }
  {
    float* sc = (float*)smem; float* scc = sc + 1024; float* red = scc + 1024;
    __syncthreads();
    for (int i = tid; i < 1024; i += 512) { sc[i] = silu_f(a->in[1][i]); scc[i] = silu_f(a->in[3][i]); }
    __syncthreads();
    float* MOD = (float*)(a->ws + WS_MOD);
    for (int it = bid; it < 4 * 72; it += nb) {
      const int l = it / 72, cb = it % 72;
      const int cgp = tid & 31, ks = tid >> 5;
      const float* wp = a->in[4] + ((size_t)l * 1024 + ks * 64) * 9216 + cb * 128 + cgp * 4;
      f32x4 am = {0.f, 0.f, 0.f, 0.f}, ac = {0.f, 0.f, 0.f, 0.f};
#pragma unroll 8
      for (int k = 0; k < 64; ++k) { const f32x4 w = *(const f32x4*)(wp + (size_t)k * 9216); am += w * sc[ks * 64 + k]; ac += w * scc[ks * 64 + k]; }
#pragma unroll
      for (int j = 0; j < 4; ++j) { red[(ks * 128 + cgp * 4 + j) * 2] = am[j]; red[(ks * 128 + cgp * 4 + j) * 2 + 1] = ac[j]; }
      __syncthreads();
      if (tid < 256) {
        const int col = tid >> 1, which = tid & 1; float s = 0.f;
#pragma unroll
        for (int q = 0; q < 16; ++q) s += red[(q * 128 + col) * 2 + which];
        const int gc = cb * 128 + col;
        MOD[(size_t)(which * 4 + l) * 9216 + gc] = s + a->in[5][(size_t)l * 9216 + gc];
      }
      __syncthreads();
    }
  }
  {
    float* TRET = (float*)(a->ws + WS_TRET); float* TROW = (float*)(a->ws + WS_TROW); float* TCOL = (float*)(a->ws + WS_TCOL);
    const int gt = bid * 512 + tid, gn = nb * 512;
    for (int e = gt; e < 16384 * 16; e += gn) { const int p = e >> 4, i = e & 15; float s, c; sincos_acc((float)p * INV16[i], s, c); TRET[2 * e] = c; TRET[2 * e + 1] = s; }
    for (int e = gt; e < 256 * 8; e += gn) { const int p = e >> 3, i = e & 7; float s, c; sincos_acc((float)p * INV16[2 * i], s, c); TROW[2 * e] = c; TROW[2 * e + 1] = s; }
    for (int e = gt; e < 64 * 8; e += gn) { const int p = e >> 3, i = e & 7; float s, c; sincos_acc((float)p * INV16[2 * i], s, c); TCOL[2 * e] = c; TCOL[2 * e + 1] = s; }
    if (bid == 0 && tid < 4) {
      const int l = tid; float* S = (float*)(a->ws + WS_SCAL) + l * 64;
      const float* lv = a->in[12] + l * 128; float d01 = 0.f, d23 = 0.f;
      for (int i = 0; i < 32; ++i) { d01 += lv[i] * lv[32 + i]; d23 += lv[64 + i] * lv[96 + i]; }
      const float lam_init = 0.8f - 0.6f * expf(-0.3f * (float)l);
      S[0] = expf(d01) - expf(d23) + lam_init; S[1] = lam_init;
      for (int i = 0; i < 12; ++i) { const float x = a->in[11][l * 12 + i]; S[4 + i] = -log1pf(expf(-x)); }
      for (int i = 0; i < 12; ++i) ((unsigned*)S)[16 + i] = 0u;
    }
  }
}
DI void norm_phase(int WV, KArgs a, int l, int which, bool first) {
  const int tid = ltid(), lane = tid & 63, wave = tid >> 6;
  const float* g = a->in[6] + (size_t)(l * 3 + which) * 1024;
  const float* mod = (const float*)(a->ws + WS_MOD) + (size_t)l * 9216;
  const float* modc = (const float*)(a->ws + WS_MOD) + (size_t)(4 + l) * 9216;
  float* X = (float*)(a->ws + WS_X); bf16_t* H = (bf16_t*)(a->ws + WS_H);
  const int stride = lnb() * 8;
  for (int r = lbid() * 8 + wave; r < MT_; r += 2 * stride) {
    const int r2 = r + stride; const bool has2 = r2 < MT_; const int rb = has2 ? r2 : r;
    const float* srcA = first ? (r < L_ ? a->in[0] + (size_t)r * 1024 : a->in[2] + (size_t)(r - L_) * 1024) : X + (size_t)r * 1024;
    const float* srcB = first ? (rb < L_ ? a->in[0] + (size_t)rb * 1024 : a->in[2] + (size_t)(rb - L_) * 1024) : X + (size_t)rb * 1024;
    f32x4 va[4], vb[4]; float sa = 0.f, sb = 0.f;
#pragma unroll
    for (int i = 0; i < 4; ++i) { va[i] = *(const f32x4*)(srcA + i * 256 + lane * 4); vb[i] = *(const f32x4*)(srcB + i * 256 + lane * 4); }
#pragma unroll
    for (int i = 0; i < 4; ++i) { sa += va[i][0] * va[i][0] + va[i][1] * va[i][1] + va[i][2] * va[i][2] + va[i][3] * va[i][3]; sb += vb[i][0] * vb[i][0] + vb[i][1] * vb[i][1] + vb[i][2] * vb[i][2] + vb[i][3] * vb[i][3]; }
    sa = wave_sum(sa); sb = wave_sum(sb);
    const float rsa = rsqrtf(sa * (1.0f / 1024.0f) + EPS_), rsb = rsqrtf(sb * (1.0f / 1024.0f) + EPS_);
#pragma unroll
    for (int q = 0; q < 2; ++q) {
      if (q == 1 && !has2) break;
      const int rr = q ? r2 : r; const float rstd = q ? rsb : rsa;
      const float* mm = (rr < L_) ? mod : modc;
#pragma unroll
      for (int i = 0; i < 4; ++i) {
        const int c = i * 256 + lane * 4;
        const f32x4 v = q ? vb[i] : va[i];
        const f32x4 gg = *(const f32x4*)(g + c), sh = *(const f32x4*)(mm + (which * 3) * 1024 + c), sc = *(const f32x4*)(mm + (which * 3 + 1) * 1024 + c);
        f32x4 y;
#pragma unroll
        for (int j = 0; j < 4; ++j) y[j] = v[j] * rstd * gg[j] * (1.0f + sc[j]) + sh[j];
        u32x2 w; w.x = cvt_pk_bf16(y[0], y[1]); w.y = cvt_pk_bf16(y[2], y[3]);
        *(u32x2*)(H + (size_t)rr * 1024 + c) = w;
        if (first) *(f32x4*)(X + (size_t)rr * 1024 + c) = v;
      }
    }
  }
}
DI void final_norm(int WV, KArgs a) {
  const int tid = ltid(), lane = tid & 63, wave = tid >> 6;
  const float* g = a->in[18]; const float* X = (const float*)(a->ws + WS_X);
  for (int r = lbid() * 8 + wave; r < L_; r += lnb() * 8) {
    f32x4 v[4]; float ss = 0.f;
#pragma unroll
    for (int i = 0; i < 4; ++i) { v[i] = *(const f32x4*)(X + (size_t)r * 1024 + i * 256 + lane * 4); ss += v[i][0] * v[i][0] + v[i][1] * v[i][1] + v[i][2] * v[i][2] + v[i][3] * v[i][3]; }
    ss = wave_sum(ss);
    const float rstd = rsqrtf(ss * (1.0f / 1024.0f) + EPS_);
#pragma unroll
    for (int i = 0; i < 4; ++i) { const int c = i * 256 + lane * 4; const f32x4 gg = *(const f32x4*)(g + c); f32x4 y; for (int j = 0; j < 4; ++j) y[j] = v[i][j] * rstd * gg[j]; *(f32x4*)(a->out + (size_t)r * 1024 + c) = y; }
  }
}

using pg8::Unit; using pg8::HALF; using pg8::BM;
struct EpiSwiglu {
  static constexpr bool PERM = false, AFTER_DRAIN = false;
  bf16_t* U;
  DI void operator()(const f32x4 (&acc)[2][2][4][2], const Unit& u, int wr, int wc, int fr_, int fq_) const {
    const int ln_ = lane_id_v(), fr = ln_ & 15, fq = ln_ >> 4;
#pragma unroll
    for (int ai = 0; ai < 2; ++ai)
#pragma unroll
      for (int m = 0; m < 4; ++m) {
        const int r = u.pm * BM + ai * HALF + wr * 64 + m * 16 + fr;
#pragma unroll
        for (int bj = 0; bj < 2; ++bj) {
          const int gi = u.pn * 8 + bj * 4 + wc;
          const f32x4 x = acc[ai][bj][m][0], y = acc[ai][bj][m][1];
          u32x2 w; w.x = cvt_pk_bf16(silu_f(x[0]) * y[0], silu_f(x[1]) * y[1]); w.y = cvt_pk_bf16(silu_f(x[2]) * y[2], silu_f(x[3]) * y[3]);
          *(u32x2*)(U + (size_t)r * DFF_ + gi * 16 + fq * 4) = w;
        }
        __builtin_amdgcn_sched_barrier(0);
      }
  }
};
struct EpiResid {
  static constexpr bool PERM = false, AFTER_DRAIN = false;
  float* X; const float* gate; float scale;
  DI void operator()(const f32x4 (&acc)[2][2][4][2], const Unit& u, int wr, int wc, int fr_, int fq_) const {
    const int ln_ = lane_id_v(), fr = ln_ & 15, fq = ln_ >> 4;
#pragma unroll
    for (int bj = 0; bj < 2; ++bj)
#pragma unroll
      for (int n = 0; n < 2; ++n) {
        const int c = u.pn * BM + bj * HALF + wc * 32 + n * 16 + fq * 4;
        const f32x4 gv = *(const f32x4*)(gate + c) * scale;
#pragma unroll
        for (int ai = 0; ai < 2; ++ai)
#pragma unroll
          for (int m = 0; m < 4; ++m) {
            const int r = u.pm * BM + ai * HALF + wr * 64 + m * 16 + fr;
            float* p = X + (size_t)r * 1024 + c;
            *(f32x4*)p = *(const f32x4*)p + gv * acc[ai][bj][m][n];
          }
      }
  }
};
template <int STEP> struct EpiMerge {
  static constexpr bool PERM = false, AFTER_DRAIN = false;
  bf16_t* MX; const bf16_t* G; bf16_t* Hout;
  DI void operator()(const f32x4 (&acc)[2][2][4][2], const Unit& u, int wr, int wc, int fr_, int fq_) const {
    const int ln_ = lane_id_v(), fr = ln_ & 15, fq = ln_ >> 4;
#pragma unroll
    for (int ai = 0; ai < 2; ++ai)
#pragma unroll
      for (int bj = 0; bj < 2; ++bj)
#pragma unroll
        for (int n = 0; n < 2; ++n) {
          const int c = u.pn * BM + bj * HALF + wc * 32 + n * 16 + fq * 4;
          const int r0 = u.pm * BM + ai * HALF + wr * 64 + fr;
          u32x2 gw[4], old[4];
#pragma unroll
          for (int m = 0; m < 4; ++m) {
            gw[m] = *(const u32x2*)(G + (size_t)(r0 + m * 16) * NGB_ + c);
            if (STEP > 0) old[m] = *(const u32x2*)(MX + (size_t)(r0 + m * 16) * 1024 + c);
          }
#pragma unroll
          for (int m = 0; m < 4; ++m) {
            f32x4 gv; gv[0] = bf2f(gw[m].x & 0xffffu); gv[1] = bf2f(gw[m].x >> 16); gv[2] = bf2f(gw[m].y & 0xffffu); gv[3] = bf2f(gw[m].y >> 16);
            f32x4 v = gv * acc[ai][bj][m][n];
            if (STEP > 0) { v[0] += bf2f(old[m].x & 0xffffu); v[1] += bf2f(old[m].x >> 16); v[2] += bf2f(old[m].y & 0xffffu); v[3] += bf2f(old[m].y >> 16); }
            u32x2 w; w.x = cvt_pk_bf16(v[0], v[1]); w.y = cvt_pk_bf16(v[2], v[3]);
            if (STEP < 2) *(u32x2*)(MX + (size_t)(r0 + m * 16) * 1024 + c) = w;
            else *(u32x2*)(Hout + (size_t)(r0 + m * 16) * 1024 + c) = w;
          }
          __builtin_amdgcn_sched_barrier(0);
        }
  }
};
struct EpiWin {
  static constexpr bool PERM = false, AFTER_DRAIN = false;
  bf16_t* PB; bf16_t* GB; const float* TRET; const float* TROW; const float* TCOL; unsigned* kmax;
  DI void operator()(const f32x4 (&acc)[2][2][4][2], const Unit& u, int wr, int wc, int fr_, int fq_) const {
    const int ln_ = lane_id_v(), fr = ln_ & 15, fq = ln_ >> 4;
#pragma unroll
    for (int bj = 0; bj < 2; ++bj) {
      const int cb = u.pn * BM + bj * HALF + wc * 32;
      float kmx = 0.f;
#pragma unroll
      for (int ai = 0; ai < 2; ++ai)
#pragma unroll
        for (int m = 0; m < 4; ++m) {
          const int r = u.pm * BM + ai * HALF + wr * 64 + m * 16 + fr;
          f32x4 x0 = acc[ai][bj][m][0], x1 = acc[ai][bj][m][1];
          if (cb >= NPB_) {
#pragma unroll
            for (int j = 0; j < 4; ++j) { x0[j] = sigmoid_f(x0[j]); x1[j] = sigmoid_f(x1[j]); }
            u32x2 w0, w1; w0.x = cvt_pk_bf16(x0[0], x0[1]); w0.y = cvt_pk_bf16(x0[2], x0[3]); w1.x = cvt_pk_bf16(x1[0], x1[1]); w1.y = cvt_pk_bf16(x1[2], x1[3]);
            bf16_t* p = GB + (size_t)r * NGB_ + (cb - NPB_) + fq * 4;
            *(u32x2*)p = w0; *(u32x2*)(p + 16) = w1;
            __builtin_amdgcn_sched_barrier(0);
            continue;
          }
          if (cb >= C_RQ && cb < C_RV) {
            if (r < L_) {
              const f32x4* tp = (const f32x4*)(TRET + ((size_t)r * 16 + fq * 4) * 2);
              const f32x4 t0 = tp[0], t1 = tp[1];
              const float cs[4] = {t0[0], t0[2], t1[0], t1[2]}, sn[4] = {t0[1], t0[3], t1[1], t1[3]};
#pragma unroll
              for (int j = 0; j < 4; ++j) { const float a_ = x0[j], b_ = x1[j]; x0[j] = a_ * cs[j] - b_ * sn[j]; x1[j] = a_ * sn[j] + b_ * cs[j]; }
            }
            if (cb >= C_RK) { x0 *= 0.17677669529663687f; x1 *= 0.17677669529663687f; }
          } else if (cb >= C_RG && cb < C_DQ) {
#pragma unroll
            for (int j = 0; j < 4; ++j) { x0[j] = silu_f(x0[j]); x1[j] = silu_f(x1[j]); }
          } else if (cb >= C_DQ && cb < C_DV) {
            if (r < L_) {
              const float* tb = (fq < 2) ? (TROW + ((size_t)(r >> 6) * 8 + fq * 4) * 2) : (TCOL + ((size_t)(r & 63) * 8 + (fq - 2) * 4) * 2);
              const f32x4 t0 = ((const f32x4*)tb)[0], t1 = ((const f32x4*)tb)[1];
              const float cs[4] = {t0[0], t0[2], t1[0], t1[2]}, sn[4] = {t0[1], t0[3], t1[1], t1[3]};
#pragma unroll
              for (int j = 0; j < 4; ++j) { const float a_ = x0[j], b_ = x1[j]; x0[j] = a_ * cs[j] - b_ * sn[j]; x1[j] = a_ * sn[j] + b_ * cs[j]; }
            }
            if (cb < C_DK) { x0 *= 0.25503486f; x1 *= 0.25503486f; }
            else { float ss = 0.f;
#pragma unroll
              for (int j = 0; j < 4; ++j) ss += x0[j] * x0[j] + x1[j] * x1[j];
              ss += shx(ss, 16, lane_id_v()); ss += shx(ss, 32, lane_id_v()); kmx = fmaxf(kmx, ss); }
          }
          u32x2 w0, w1; w0.x = cvt_pk_bf16(x0[0], x0[1]); w0.y = cvt_pk_bf16(x0[2], x0[3]); w1.x = cvt_pk_bf16(x1[0], x1[1]); w1.y = cvt_pk_bf16(x1[2], x1[3]);
          bf16_t* p = PB + (size_t)r * NPB_ + cb + fq * 4;
          *(u32x2*)p = w0; *(u32x2*)(p + 16) = w1;
          __builtin_amdgcn_sched_barrier(0);
        }
      if (cb >= C_DK && cb < C_DV) {
#pragma unroll
        for (int o = 1; o < 16; o <<= 1) kmx = fmaxf(kmx, shx(kmx, o, lane_id_v()));
        if (lane_id_v() == 0) atomicMax(kmax + ((cb - C_DK) >> 5), __float_as_uint(kmx));
      }
    }
  }
};
template <class F> DI void ctx_gemm32(int WV, const bf16_t* A, int lda, const bf16_t* Bt, int K, int N, unsigned char* smem, F epi) {
  const int tid = ltid(), lane = tid & 63, wave = tid >> 6, r31 = lane & 31, h = lane >> 5;
  float* red = (float*)smem;
  const int ntn = N / 32, ntiles = 8 * ntn, kper = K / 8;
  for (int tile = lbid(); tile < ntiles; tile += lnb()) {
    const int tm = tile / ntn, tn = tile % ntn;
    f32x16 acc; for (int i = 0; i < 16; ++i) acc[i] = 0.f;
    const bf16_t* ap = A + (size_t)(tm * 32 + r31) * lda + wave * kper + 8 * h;
    const bf16_t* bp = Bt + (size_t)(tn * 32 + r31) * K + wave * kper + 8 * h;
    int kk = 0;
    for (; kk + 64 <= kper; kk += 64) {
      bf16x8 av[4], bv[4];
#pragma unroll
      for (int q = 0; q < 4; ++q) { av[q] = *(const bf16x8*)(ap + kk + 16 * q); bv[q] = *(const bf16x8*)(bp + kk + 16 * q); }
#pragma unroll
      for (int q = 0; q < 4; ++q) acc = MFMA32(av[q], bv[q], acc);
    }
    for (; kk < kper; kk += 16) { const bf16x8 av = *(const bf16x8*)(ap + kk), bv = *(const bf16x8*)(bp + kk); acc = MFMA32(av, bv, acc); }
#pragma unroll
    for (int i = 0; i < 16; ++i) red[(wave * 16 + i) * 64 + lane] = acc[i];
    __syncthreads();
#pragma unroll
    for (int q = 0; q < 2; ++q) {
      const int o = tid + q * 512, i = o >> 6, ln = o & 63; float s = 0.f;
#pragma unroll
      for (int w = 0; w < 8; ++w) s += red[(w * 16 + i) * 64 + ln];
      epi(tm * 32 + crow(i, ln >> 5), tn * 32 + (ln & 31), s);
    }
    __syncthreads();
  }
}

constexpr int FR_LD = 136;
DI void fourier_tables(int WV, unsigned char* smem) {
  bf16_t* Cw = (bf16_t*)smem; bf16_t* Sw = Cw + 128 * FR_LD;
  for (int e = ltid(); e < 128 * 128; e += 512) { const int a_ = e >> 7, b_ = e & 127; const float x = (float)((a_ * b_) & 127) * (1.0f / 64.0f); Cw[a_ * FR_LD + b_] = f2bf(cospif(x)); Sw[a_ * FR_LD + b_] = f2bf(sinpif(x)); }
}
DI void fourier_load(int WV, const bf16_t* src, size_t rs, size_t po, unsigned char* smem) {
  bf16_t* dA = (bf16_t*)smem + 2 * 128 * FR_LD;
#pragma unroll
  for (int i = 0; i < 4; ++i) {
    const int id = ltid() + 512 * i, seg = id & 7, part = (id >> 3) & 1, row = id >> 4;
    const bf16x8 v = *(const bf16x8*)(src + (size_t)row * rs + (size_t)part * po + seg * 8);
    bf16_t* d = dA + part * 64 * FR_LD + (seg * 8) * FR_LD + (row ^ (seg << 3));
#pragma unroll
    for (int e = 0; e < 8; ++e) d[e * FR_LD] = (bf16_t)v[e];
  }
}
DI void fourier_stage1(int WV, KArgs a, unsigned char* smem) {
  const int tid = ltid(), lane = tid & 63, wave = tid >> 6, r31 = lane & 31, h = lane >> 5, rb = wave & 3, cbk = wave >> 2;
  const bf16_t* PB = (const bf16_t*)(a->ws + WS_PB); bf16_t* V = (bf16_t*)(a->ws + WS_V);
  const bf16_t* Cw = (const bf16_t*)smem; const bf16_t* Sw = Cw + 128 * FR_LD; const bf16_t* dA = Sw + 128 * FR_LD; const bf16_t* dB = dA + 64 * FR_LD;
  for (int it = lbid(); it < 512; it += lnb()) {
    const int t2 = it >> 2, c0 = (it & 3) * 64;
    __syncthreads();
    fourier_load(WV, PB + (size_t)t2 * NPB_ + C_FA + c0, (size_t)128 * NPB_, (size_t)(C_FB - C_FA), smem);
    __syncthreads();
    f32x16 R, nI; for (int i = 0; i < 16; ++i) { R[i] = 0.f; nI[i] = 0.f; }
#pragma unroll
    for (int s = 0; s < 8; ++s) {
      const bf16x8 cw = *(const bf16x8*)(Cw + (32 * rb + r31) * FR_LD + 16 * s + 8 * h), sw = *(const bf16x8*)(Sw + (32 * rb + r31) * FR_LD + 16 * s + 8 * h);
      const int so_ = (16 * s + 8 * h) ^ (((4 * cbk + (r31 >> 3)) & 7) << 3);
      const bf16x8 af = *(const bf16x8*)(dA + (32 * cbk + r31) * FR_LD + so_), bfv = *(const bf16x8*)(dB + (32 * cbk + r31) * FR_LD + so_);
      bf16x8 nb; for (int e = 0; e < 8; ++e) nb[e] = (short)(bfv[e] ^ (short)0x8000);
      R = MFMA32(cw, af, R); R = MFMA32(sw, nb, R); nI = MFMA32(sw, af, nI); nI = MFMA32(cw, bfv, nI);
    }
    const int col = c0 + 32 * cbk + r31;
#pragma unroll
    for (int i = 0; i < 16; ++i) {
      const int k1 = 32 * rb + crow(i, h);
      const float x = (float)(k1 * t2) * (1.0f / 8192.0f); const float ct = cospif(x), st = sinpif(x);
      const float vre = R[i] * ct - nI[i] * st, vim = -nI[i] * ct - R[i] * st;
      bf16_t* vp = V + ((size_t)(k1 * 128 + t2) * 2) * 256 + col;
      vp[0] = f2bf(vre); vp[256] = f2bf(vim);
    }
  }
}
DI void fourier_stage2(int WV, KArgs a, unsigned char* smem) {
  const int tid = ltid(), lane = tid & 63, wave = tid >> 6, r31 = lane & 31, h = lane >> 5, rb = wave & 3, cbk = wave >> 2;
  const bf16_t* V = (const bf16_t*)(a->ws + WS_V); bf16_t* BR = (bf16_t*)(a->ws + WS_BR);
  const bf16_t* Cw = (const bf16_t*)smem; const bf16_t* Sw = Cw + 128 * FR_LD; const bf16_t* dA = Sw + 128 * FR_LD; const bf16_t* dB = dA + 64 * FR_LD;
  for (int it = lbid(); it < 512; it += lnb()) {
    const int k1 = it >> 2, c0 = (it & 3) * 64;
    __syncthreads();
    fourier_load(WV, V + (size_t)k1 * 128 * 512 + c0, (size_t)512, (size_t)256, smem);
    __syncthreads();
    f32x16 Y; for (int i = 0; i < 16; ++i) Y[i] = 0.f;
#pragma unroll
    for (int s = 0; s < 8; ++s) {
      const bf16x8 cw = *(const bf16x8*)(Cw + (32 * rb + r31) * FR_LD + 16 * s + 8 * h), sw = *(const bf16x8*)(Sw + (32 * rb + r31) * FR_LD + 16 * s + 8 * h);
      const int so_ = (16 * s + 8 * h) ^ (((4 * cbk + (r31 >> 3)) & 7) << 3);
      const bf16x8 vr = *(const bf16x8*)(dA + (32 * cbk + r31) * FR_LD + so_), vi = *(const bf16x8*)(dB + (32 * cbk + r31) * FR_LD + so_);
      Y = MFMA32(cw, vr, Y); Y = MFMA32(sw, vi, Y);
    }
    const int col = c0 + 32 * cbk + r31;
#pragma unroll
    for (int i = 0; i < 16; ++i) { const int k2 = 32 * rb + crow(i, h); BR[(size_t)(k1 + 128 * k2) * 1024 + col] = f2bf(Y[i] * (1.0f / 1024.0f)); }
  }
}
DI void fourier_ctx(int WV, KArgs a, unsigned char* smem) {
  const int tid = ltid();
  const bf16_t* PB = (const bf16_t*)(a->ws + WS_PB) + (size_t)L_ * NPB_; bf16_t* BR = (bf16_t*)(a->ws + WS_BR) + (size_t)L_ * 1024;
  float* ct = (float*)smem; float* st = ct + 256; float* part = st + 256;
  __syncthreads();
  if (tid < 256) { const float x = (float)tid * (1.0f / 128.0f); ct[tid] = cospif(x); st[tid] = sinpif(x); }
  __syncthreads();
  for (int k = lbid(); k < 256; k += lnb()) {
    const int col = tid & 255, half = tid >> 8;
    float acc = 0.f;
#pragma unroll 8
    for (int t = half * 128; t < half * 128 + 128; ++t) {
      const int idx = (k * t) & 255;
      acc += ct[idx] * bf2f(PB[(size_t)t * NPB_ + C_FA + col]) - st[idx] * bf2f(PB[(size_t)t * NPB_ + C_FB + col]);
    }
    if (half == 1) part[col] = acc;
    __syncthreads();
    if (half == 0) BR[(size_t)k * 1024 + col] = f2bf((acc + part[col]) * (1.0f / 128.0f));
    __syncthreads();
  }
}
DI int chunk_row0(int ci) { return ci < 128 ? ci * 128 : L_ + (ci - 128) * 128; }
DI void ret_states(int WV, KArgs a, int l, unsigned char* smem) {
  const int tid = ltid();
  const bf16_t* PB = (const bf16_t*)(a->ws + WS_PB); float* T = (float*)(a->ws + WS_T);
  const float* S = (const float*)(a->ws + WS_SCAL) + l * 64;
  float* kL = (float*)smem; float* vL = kL + 128 * 33; float* wf = vL + 128 * 64; float* wb = wf + 128;
  for (int it = lbid(); it < 130 * 6; it += lnb()) {
    const int ci = it / 6, hh = it % 6, r0 = chunk_row0(ci);
    __syncthreads();
    { const int row = tid >> 2, seg = tid & 3; const bf16x8 v = *(const bf16x8*)(PB + (size_t)(r0 + row) * NPB_ + C_RK + hh * 32 + seg * 8);
#pragma unroll
      for (int e = 0; e < 8; ++e) kL[row * 33 + seg * 8 + e] = bf2f((unsigned)(unsigned short)v[e]); }
#pragma unroll
    for (int q = 0; q < 2; ++q) { const int id = tid + 512 * q, row = id >> 3, seg = id & 7; const bf16x8 v = *(const bf16x8*)(PB + (size_t)(r0 + row) * NPB_ + C_RV + hh * 64 + seg * 8);
#pragma unroll
      for (int e = 0; e < 8; ++e) vL[row * 64 + seg * 8 + e] = bf2f((unsigned)(unsigned short)v[e]); }
    if (tid < 128) { wf[tid] = expf(S[4 + hh] * (float)(127 - tid)); wb[tid] = expf(S[10 + hh] * (float)tid); }
    __syncthreads();
    const int d = tid >> 4, v4 = (tid & 15) * 4;
    f32x4 af = {0.f, 0.f, 0.f, 0.f}, ab = {0.f, 0.f, 0.f, 0.f};
#pragma unroll 4
    for (int j = 0; j < 128; ++j) { const float kd = kL[j * 33 + d]; const f32x4 vv = *(const f32x4*)(vL + j * 64 + v4); af += vv * (kd * wf[j]); ab += vv * (kd * wb[j]); }
    float* tp = T + ((size_t)(ci * 6 + hh) * 2) * 2048 + d * 64 + v4;
    *(f32x4*)tp = af; *(f32x4*)(tp + 2048) = ab;
  }
}
DI void ret_scan(int WV, KArgs a, int l) {
  const int gt = lbid() * 512 + ltid();
  if (gt >= 6 * 2 * 2048) return;
  const int idx = gt & 2047, dir = (gt >> 11) & 1, hh = gt >> 12;
  const float* T = (const float*)(a->ws + WS_T); float* S = (float*)(a->ws + WS_S);
  const float* SC = (const float*)(a->ws + WS_SCAL) + l * 64;
  const float dec = expf(SC[4 + dir * 6 + hh] * 128.0f);
  const size_t base = (size_t)(hh * 2 + dir) * 2048 + idx; const size_t cs = (size_t)6 * 2 * 2048;
  const float tc0 = T[base + 128 * cs], tc1 = T[base + 129 * cs];
  if (dir == 0) {
    float s = tc0 * dec + tc1; S[base + 128 * cs] = 0.f; S[base + 129 * cs] = tc0;
#pragma unroll 8
    for (int i = 0; i < 128; ++i) { S[base + i * cs] = s; s = s * dec + T[base + i * cs]; }
  } else {
    float s = tc0 + dec * tc1; S[base + 129 * cs] = 0.f; S[base + 128 * cs] = tc1;
#pragma unroll 8
    for (int i = 127; i >= 0; --i) { S[base + i * cs] = s; s = s * dec + T[base + i * cs]; }
  }
}
DI void ret_out(int WV, KArgs a, int l, unsigned char* smem) {
  const int tid = ltid(), lane = tid & 63, wave = tid >> 6, r31 = lane & 31, h = lane >> 5, jb = wave & 3, vh = wave >> 2;
  const bf16_t* PB = (const bf16_t*)(a->ws + WS_PB); bf16_t* BR = (bf16_t*)(a->ws + WS_BR); const float* Sg = (const float*)(a->ws + WS_S);
  const float* SC = (const float*)(a->ws + WS_SCAL) + l * 64;
  bf16_t* Kl = (bf16_t*)smem;
  bf16_t* Vt = Kl + 128 * 40;
  bf16_t* SfT = Vt + 64 * 136;
  bf16_t* SbT = SfT + 64 * 40;
  float* pwf = (float*)(SbT + 64 * 40);
  float* pwb = pwf + 128;
  float* ssq = pwb + 128;
  for (int it = lbid(); it < 130 * 6; it += lnb()) {
    const int ci = it / 6, hh = it % 6, r0 = chunk_row0(ci);
    const float lgf = SC[4 + hh], lgb = SC[10 + hh];
    __syncthreads();
    { const int row = tid >> 2, seg = tid & 3; *(bf16x8*)(Kl + row * 40 + seg * 8) = *(const bf16x8*)(PB + (size_t)(r0 + row) * NPB_ + C_RK + hh * 32 + seg * 8); }
#pragma unroll
    for (int q = 0; q < 2; ++q) { const int id = tid + 512 * q, row = id >> 3, seg = id & 7; const bf16x8 v = *(const bf16x8*)(PB + (size_t)(r0 + row) * NPB_ + C_RV + hh * 64 + seg * 8);
#pragma unroll
      for (int e = 0; e < 8; ++e) Vt[(seg * 8 + e) * 136 + (row ^ (seg << 3))] = (bf16_t)v[e]; }
#pragma unroll
    for (int q = 0; q < 8; ++q) { const int e = tid + 512 * q, dir = e >> 11, idx = e & 2047, d = idx >> 6, v = idx & 63;
      const float sv = Sg[((size_t)(ci * 6 + hh) * 2 + dir) * 2048 + idx]; (dir ? SbT : SfT)[v * 40 + d] = f2bf(sv); }
    if (tid < 128) { pwf[tid] = expf(lgf * (float)tid); pwb[tid] = expf(lgb * (float)tid); }
    const int qrow = r0 + 32 * jb + r31, j = 32 * jb + r31;
    bf16x8 qf[2];
#pragma unroll
    for (int s = 0; s < 2; ++s) qf[s] = *(const bf16x8*)(PB + (size_t)qrow * NPB_ + C_RQ + hh * 32 + 16 * s + 8 * h);
    __syncthreads();
    f32x16 O; for (int i = 0; i < 16; ++i) O[i] = 0.f;
#pragma unroll
    for (int kb = 0; kb < 4; ++kb) {
      f32x16 St; for (int i = 0; i < 16; ++i) St[i] = 0.f;
#pragma unroll
      for (int s = 0; s < 2; ++s) { const bf16x8 kf = *(const bf16x8*)(Kl + (32 * kb + r31) * 40 + 16 * s + 8 * h); St = MFMA32(kf, qf[s], St); }
#pragma unroll
      for (int i = 0; i < 16; ++i) { const int jp = 32 * kb + crow(i, h); const int dl = j - jp; const float dv = dl > 0 ? pwf[dl] : (dl < 0 ? pwb[-dl] : 2.0f); St[i] *= dv; }
#pragma unroll
      for (int s = 0; s < 2; ++s) {
        const bf16x8 pb = pack_step(St, s);
        const bf16_t* vrow = Vt + (32 * vh + r31) * 136; const int px_ = ((4 * vh + (r31 >> 3)) & 7) << 3, p0_ = 32 * kb + 16 * s + 4 * h;
        const s16x4 lo = *(const s16x4*)(vrow + (p0_ ^ px_)), hi = *(const s16x4*)(vrow + ((p0_ + 8) ^ px_));
        const bf16x8 vf = __builtin_shufflevector(lo, hi, 0, 1, 2, 3, 4, 5, 6, 7);
        O = MFMA32(vf, pb, O);
      }
    }
    f32x16 Of, Ob; for (int i = 0; i < 16; ++i) { Of[i] = 0.f; Ob[i] = 0.f; }
#pragma unroll
    for (int s = 0; s < 2; ++s) {
      const bf16x8 sf = *(const bf16x8*)(SfT + (32 * vh + r31) * 40 + 16 * s + 8 * h), sb = *(const bf16x8*)(SbT + (32 * vh + r31) * 40 + 16 * s + 8 * h);
      Of = MFMA32(sf, qf[s], Of); Ob = MFMA32(sb, qf[s], Ob);
    }
    const float qdf = expf(lgf * (float)(j + 1)), qdb = expf(lgb * (float)(128 - j));
    float ss = 0.f;
#pragma unroll
    for (int i = 0; i < 16; ++i) { O[i] = O[i] + Of[i] * qdf + Ob[i] * qdb; ss += O[i] * O[i]; }
    ss += shx(ss, 32, lane_id_v());
    if (h == 0) ssq[vh * 128 + j] = ss;
    __syncthreads();
    const float rstd = rsqrtf((ssq[j] + ssq[128 + j]) * (1.0f / 64.0f) + EPS_);
#pragma unroll
    for (int g4 = 0; g4 < 4; ++g4) {
      const int v0 = 32 * vh + 8 * g4 + 4 * h;
      const u32x2 gw = *(const u32x2*)(PB + (size_t)qrow * NPB_ + C_RG + hh * 64 + v0);
      const float g0 = bf2f(gw.x & 0xffffu), g1 = bf2f(gw.x >> 16), g2 = bf2f(gw.y & 0xffffu), g3 = bf2f(gw.y >> 16);
      u32x2 w; w.x = cvt_pk_bf16(O[4 * g4] * rstd * g0, O[4 * g4 + 1] * rstd * g1); w.y = cvt_pk_bf16(O[4 * g4 + 2] * rstd * g2, O[4 * g4 + 3] * rstd * g3);
      *(u32x2*)(BR + (size_t)qrow * 1024 + 256 + hh * 64 + v0) = w;
    }
  }
}
constexpr int AT_LD = 72;
typedef __bf16 bf16x2_t __attribute__((ext_vector_type(2)));
typedef float f32x2_t __attribute__((ext_vector_type(2)));
DI unsigned cvt2(float a, float b) { f32x2_t v = {a, b}; return __builtin_bit_cast(unsigned, __builtin_convertvector(v, bf16x2_t)); }
template <int VAR> DI void attn_phase(int WV, KArgs a, int l, bool with_ctx, unsigned char* smem) {
  const int tid = ltid(), lane = tid & 63, wave = tid >> 6, r31 = lane & 31, h = lane >> 5, qsub = wave & 3, kh = wave >> 2;
  const bf16_t* PB = (const bf16_t*)(a->ws + WS_PB); bf16_t* BR = (bf16_t*)(a->ws + (VAR == 0 ? WS_BR : WS_H));
  const float* SC = (const float*)(a->ws + WS_SCAL) + l * 64;
  const float lam = SC[0], lam_init = SC[1];
  bf16_t* Ks = (bf16_t*)smem;
  bf16_t* Vt = Ks + 2 * 64 * AT_LD;
  float* cmb = (float*)(Vt + 2 * 64 * AT_LD);
  const int nitems = 6 * 128 + (with_ctx ? 12 : 0);
  const int skey = tid >> 3, sseg = tid & 7;
  for (int it = lbid(); it < nitems; it += lnb()) {
    int head, q0, krow0, nt;
    if (it < 768) { head = (it >> 8) * 2 + (it & 1); q0 = ((it & 255) >> 1) * 128; krow0 = 0; nt = MT_ / 64; }
    else { const int e = it - 768; head = e >> 1; q0 = L_ + (e & 1) * 128; krow0 = L_; nt = LC_ / 64; }
    const int qrow = q0 + 32 * qsub + r31;
    bf16x8 qf[2][2];
#pragma unroll
    for (int mp = 0; mp < 2; ++mp)
#pragma unroll
      for (int s = 0; s < 2; ++s) qf[mp][s] = *(const bf16x8*)(PB + (size_t)qrow * NPB_ + C_DQ + head * 64 + mp * 32 + 16 * s + 8 * h);
    float negm = 0.f;
#pragma unroll
    for (int mp = 0; mp < 2; ++mp) {
      float ss = 0.f;
#pragma unroll
      for (int s = 0; s < 2; ++s)
#pragma unroll
        for (int e = 0; e < 8; ++e) { const float x = bf2f((unsigned)(unsigned short)qf[mp][s][e]); ss += x * x; }
      ss += shx(ss, 32, lane_id_v());
      const float kmx = __uint_as_float(((const unsigned*)SC)[16 + head * 2 + mp]);
      negm = fminf(negm, -sqrtf(ss * kmx) * 1.01f);
    }
    f32x16 NM; for (int i = 0; i < 16; ++i) NM[i] = negm;
    f32x16 O1[2], O2[2]; for (int i = 0; i < 16; ++i) { O1[0][i] = 0.f; O1[1][i] = 0.f; O2[0][i] = 0.f; O2[1][i] = 0.f; }
    f32x4 LA = {0.f, 0.f, 0.f, 0.f}, LB = {0.f, 0.f, 0.f, 0.f};
    bf16x8 osel; { const bool on = ((lane & 15) == 0 && ((lane >> 4) & 1) == 0) || ((lane & 15) == 1 && ((lane >> 4) & 1) == 1);
      for (int e = 0; e < 8; ++e) osel[e] = on ? (short)0x3F80 : (short)0; }
#define MFMA16(a_, b_, c_) __builtin_amdgcn_mfma_f32_16x16x32_bf16((a_), (b_), (c_), 0, 0, 0)
    const bf16_t* kg = PB + (size_t)(krow0 + skey) * NPB_ + C_DK + head * 64 + sseg * 8;
    const bf16_t* vg = PB + (size_t)(krow0 + skey) * NPB_ + C_DV + head * 64 + sseg * 8;
    const int vslot = ((skey & ~12) | ((skey & 4) << 1) | ((skey & 8) >> 1)) ^ (sseg << 3);
    __syncthreads();
    bf16x8 kA = *(const bf16x8*)kg, vA = *(const bf16x8*)vg;
    bf16x8 kB = *(const bf16x8*)(kg + (size_t)64 * NPB_), vB = *(const bf16x8*)(vg + (size_t)64 * NPB_);
    { *(bf16x8*)(Ks + skey * AT_LD + sseg * 8) = kA;
#pragma unroll
      for (int e = 0; e < 8; ++e) Vt[(sseg * 8 + e) * AT_LD + vslot] = (bf16_t)vA[e]; }
    __syncthreads();
    for (int t = 0; t < nt; ++t) {
      const int buf = t & 1;
      const bf16_t* ks = Ks + buf * 64 * AT_LD + (32 * kh + r31) * AT_LD + 8 * h;
      const bf16_t* vt = Vt + buf * 64 * AT_LD + r31 * AT_LD;
      const bf16x8 k00 = *(const bf16x8*)(ks), k01 = *(const bf16x8*)(ks + 16), k10 = *(const bf16x8*)(ks + 32), k11 = *(const bf16x8*)(ks + 48);
      bf16x8 vf[2][2];
#pragma unroll
      for (int s = 0; s < 2; ++s)
#pragma unroll
        for (int mt = 0; mt < 2; ++mt) vf[mt][s] = *(const bf16x8*)(vt + mt * 32 * AT_LD + (((4 * kh + 2 * s + h) ^ ((4 * mt + (r31 >> 3)) & 7)) << 3));
      f32x16 S1 = MFMA32(k00, qf[0][0], NM); f32x16 S2 = MFMA32(k10, qf[1][0], NM); S1 = MFMA32(k01, qf[0][1], S1); S2 = MFMA32(k11, qf[1][1], S2);
      bf16x8 p1[2], p2[2];
      { u32x4 w0, w1;
#pragma unroll
        for (int i = 0; i < 4; ++i) { w0[i] = cvt2(VAR == 1 ? S1[2 * i] * 0.001f : __builtin_amdgcn_exp2f(S1[2 * i]), VAR == 1 ? S1[2 * i + 1] * 0.001f : __builtin_amdgcn_exp2f(S1[2 * i + 1]));
                                       w1[i] = cvt2(VAR == 1 ? S1[8 + 2 * i] * 0.001f : __builtin_amdgcn_exp2f(S1[8 + 2 * i]), VAR == 1 ? S1[9 + 2 * i] * 0.001f : __builtin_amdgcn_exp2f(S1[9 + 2 * i])); }
        p1[0] = __builtin_bit_cast(bf16x8, w0); p1[1] = __builtin_bit_cast(bf16x8, w1); }
      O1[0] = MFMA32(vf[0][0], p1[0], O1[0]); O1[1] = MFMA32(vf[1][0], p1[0], O1[1]); LA = MFMA16(osel, p1[0], LA);
      O1[0] = MFMA32(vf[0][1], p1[1], O1[0]); O1[1] = MFMA32(vf[1][1], p1[1], O1[1]); LA = MFMA16(osel, p1[1], LA);
      { u32x4 w0, w1;
#pragma unroll
        for (int i = 0; i < 4; ++i) { w0[i] = cvt2(VAR == 1 ? S2[2 * i] * 0.001f : __builtin_amdgcn_exp2f(S2[2 * i]), VAR == 1 ? S2[2 * i + 1] * 0.001f : __builtin_amdgcn_exp2f(S2[2 * i + 1]));
                                       w1[i] = cvt2(VAR == 1 ? S2[8 + 2 * i] * 0.001f : __builtin_amdgcn_exp2f(S2[8 + 2 * i]), VAR == 1 ? S2[9 + 2 * i] * 0.001f : __builtin_amdgcn_exp2f(S2[9 + 2 * i])); }
        p2[0] = __builtin_bit_cast(bf16x8, w0); p2[1] = __builtin_bit_cast(bf16x8, w1); }
      if (VAR != 5) {
      O2[0] = MFMA32(vf[0][0], p2[0], O2[0]); O2[1] = MFMA32(vf[1][0], p2[0], O2[1]); LB = MFMA16(osel, p2[0], LB);
      O2[0] = MFMA32(vf[0][1], p2[1], O2[0]); O2[1] = MFMA32(vf[1][1], p2[1], O2[1]); LB = MFMA16(osel, p2[1], LB); }
      __builtin_amdgcn_iglp_opt(IGLP_ID);
      { const int nb_ = buf ^ 1;
        *(bf16x8*)(Ks + nb_ * 64 * AT_LD + skey * AT_LD + sseg * 8) = kB;
#pragma unroll
        for (int e = 0; e < 8; ++e) Vt[nb_ * 64 * AT_LD + (sseg * 8 + e) * AT_LD + vslot] = (bf16_t)vB[e];
        const int tl_ = (t + 2 < nt) ? t + 2 : nt - 1;
        kB = *(const bf16x8*)(kg + (size_t)tl_ * 64 * NPB_); vB = *(const bf16x8*)(vg + (size_t)tl_ * 64 * NPB_); }
      __syncthreads();
    }
    float* cw = cmb + (size_t)(qsub * 64 + lane) * 66;
    const int sl_ = ((lane & 15) << 2);
    const float a0_ = __int_as_float(__builtin_amdgcn_ds_bpermute(sl_, __float_as_int(LA[0]))), a1_ = __int_as_float(__builtin_amdgcn_ds_bpermute(sl_, __float_as_int(LA[1])));
    const float b0_ = __int_as_float(__builtin_amdgcn_ds_bpermute(sl_, __float_as_int(LB[0]))), b1_ = __int_as_float(__builtin_amdgcn_ds_bpermute(sl_, __float_as_int(LB[1])));
    const float lq1 = (r31 >> 4) ? a1_ : a0_, lq2 = (r31 >> 4) ? b1_ : b0_;
    if (kh == 1) {
#pragma unroll
      for (int i = 0; i < 16; ++i) { cw[i] = O1[0][i]; cw[16 + i] = O1[1][i]; cw[32 + i] = O2[0][i]; cw[48 + i] = O2[1][i]; }
      cw[64] = lq1; cw[65] = lq2;
    }
    __syncthreads();
    if (kh == 0) {
#pragma unroll
      for (int i = 0; i < 16; ++i) { O1[0][i] += cw[i]; O1[1][i] += cw[16 + i]; O2[0][i] += cw[32 + i]; O2[1][i] += cw[48 + i]; }
      const float l1 = lq1 + cw[64], l2 = lq2 + cw[65];
      const float i1 = 1.0f / l1, i2 = lam / l2;
      float ss = 0.f;
#pragma unroll
      for (int mt = 0; mt < 2; ++mt)
#pragma unroll
        for (int i = 0; i < 16; ++i) { const float o = O1[mt][i] * i1 - O2[mt][i] * i2; O1[mt][i] = o; ss += o * o; }
      ss += shx(ss, 32, lane_id_v());
      const float sc = rsqrtf(ss * (1.0f / 64.0f) + EPS_) * (1.0f - lam_init);
      const float* sw = a->in[13] + l * 64;
#pragma unroll
      for (int mt = 0; mt < 2; ++mt)
#pragma unroll
        for (int g4 = 0; g4 < 4; ++g4) {
          const int v0 = 32 * mt + 8 * g4 + 4 * h;
          const f32x4 wv = *(const f32x4*)(sw + v0);
          u32x2 w; w.x = cvt_pk_bf16(O1[mt][4 * g4] * sc * wv[0], O1[mt][4 * g4 + 1] * sc * wv[1]); w.y = cvt_pk_bf16(O1[mt][4 * g4 + 2] * sc * wv[2], O1[mt][4 * g4 + 3] * sc * wv[3]);
          *(u32x2*)(BR + (size_t)qrow * 1024 + 640 + head * 64 + v0) = w;
        }
    }
  }
}
template <class Epi> DI void run_gemm(int WV, LAS unsigned char* lds, const bf16_t* A, int lda, const bf16_t* Bt, int M, int N, int K, const Epi& E) {
  pg8::Gemm g; g.A = A; g.Bt = Bt; g.M = M; g.N = N; g.K = K; g.lda = lda;
  pg8::StaticOrder S; S.init(M, N, lnb(), lbid());
  pg8::gemm_phase<Epi, pg8::StaticOrder, false>(WV, lds, g, S, E, nullptr);
}
struct CtxMerge0 { float* MXC; const bf16_t* G; DI void operator()(int r, int c, float v) const { MXC[r * 1024 + c] = bf2f(G[(size_t)r * NGB_ + c]) * v; } };
struct CtxMerge1 { float* MXC; const bf16_t* G; DI void operator()(int r, int c, float v) const { MXC[r * 1024 + c] += bf2f(G[(size_t)r * NGB_ + c]) * v; } };
struct CtxMerge2 { const float* MXC; const bf16_t* G; bf16_t* Hc; DI void operator()(int r, int c, float v) const { Hc[r * 1024 + c] = f2bf(MXC[r * 1024 + c] + bf2f(G[(size_t)r * NGB_ + c]) * v); } };
struct CtxResid { float* Xc; const float* gate; float scale; DI void operator()(int r, int c, float v) const { Xc[r * 1024 + c] += scale * gate[c] * v; } };

DI void phase_win(int WV, int l, unsigned char* smem) {
  KArgs a = kargs(); unsigned char* ws = a->ws;
  EpiWin E; E.PB = (bf16_t*)(ws + WS_PB); E.GB = (bf16_t*)(ws + WS_GB); E.TRET = (const float*)(ws + WS_TRET); E.TROW = (const float*)(ws + WS_TROW); E.TCOL = (const float*)(ws + WS_TCOL);
  E.kmax = (unsigned*)(ws + WS_SCAL) + l * 64 + 16;
  run_gemm(WV, (LAS unsigned char*)smem, (const bf16_t*)(ws + WS_H), 1024, (const bf16_t*)(ws + WS_WIN) + (size_t)l * 5888 * 1024, MT_, NWIN_, 1024, E);
}
DI void phase_merge(int WV, int l, unsigned char* smem) {
  LAS unsigned char* lds = (LAS unsigned char*)smem;
  { KArgs a = kargs(); unsigned char* ws = a->ws; EpiMerge<0> E; E.MX = (bf16_t*)a->out; E.G = (const bf16_t*)(ws + WS_GB); E.Hout = (bf16_t*)(ws + WS_H);
    run_gemm(WV, lds, (const bf16_t*)(ws + WS_BR), 1024, (const bf16_t*)(ws + WS_WBF) + (size_t)l * 1024 * 256, L_, 1024, 256, E); }
  { KArgs a = kargs(); unsigned char* ws = a->ws; EpiMerge<1> E; E.MX = (bf16_t*)a->out; E.G = (const bf16_t*)(ws + WS_GB) + 1024; E.Hout = (bf16_t*)(ws + WS_H);
    run_gemm(WV, lds, (const bf16_t*)(ws + WS_BR) + 256, 1024, (const bf16_t*)(ws + WS_WBR) + (size_t)l * 1024 * 384, L_, 1024, 384, E); }
  { KArgs a = kargs(); unsigned char* ws = a->ws; EpiMerge<2> E; E.MX = (bf16_t*)a->out; E.G = (const bf16_t*)(ws + WS_GB) + 2048; E.Hout = (bf16_t*)(ws + WS_H);
    run_gemm(WV, lds, (const bf16_t*)(ws + WS_BR) + 640, 1024, (const bf16_t*)(ws + WS_WBD) + (size_t)l * 1024 * 384, L_, 1024, 384, E); }
  { KArgs a = kargs(); unsigned char* ws = a->ws;
    const bf16_t* BRc = (const bf16_t*)(ws + WS_BR) + (size_t)L_ * 1024; const bf16_t* GBc = (const bf16_t*)(ws + WS_GB) + (size_t)L_ * NGB_;
    CtxMerge0 e0; e0.MXC = (float*)(ws + WS_MXC); e0.G = GBc;
    ctx_gemm32(WV, BRc, 1024, (const bf16_t*)(ws + WS_WBF) + (size_t)l * 1024 * 256, 256, 1024, smem, e0);
    CtxMerge1 e1; e1.MXC = (float*)(ws + WS_MXC); e1.G = GBc + 1024;
    ctx_gemm32(WV, BRc + 256, 1024, (const bf16_t*)(ws + WS_WBR) + (size_t)l * 1024 * 384, 384, 1024, smem, e1);
    CtxMerge2 e2; e2.MXC = (const float*)(ws + WS_MXC); e2.G = GBc + 2048; e2.Hc = (bf16_t*)(ws + WS_H) + (size_t)L_ * 1024;
    ctx_gemm32(WV, BRc + 640, 1024, (const bf16_t*)(ws + WS_WBD) + (size_t)l * 1024 * 384, 384, 1024, smem, e2); }
}
DI void phase_wo(int WV, int l, unsigned char* smem) {
  { KArgs a = kargs(); unsigned char* ws = a->ws; EpiResid E; E.X = (float*)(ws + WS_X); E.gate = (const float*)(ws + WS_MOD) + (size_t)l * 9216 + 5 * 1024; E.scale = 1.0f;
    run_gemm(WV, (LAS unsigned char*)smem, (const bf16_t*)(ws + WS_H), 1024, (const bf16_t*)(ws + WS_WO) + (size_t)l * 1024 * 1024, L_, 1024, 1024, E); }
  { KArgs a = kargs(); unsigned char* ws = a->ws; CtxResid e; e.Xc = (float*)(ws + WS_X) + (size_t)L_ * 1024; e.gate = (const float*)(ws + WS_MOD) + (size_t)(4 + l) * 9216 + 5 * 1024; e.scale = 1.0f;
    ctx_gemm32(WV, (const bf16_t*)(ws + WS_H) + (size_t)L_ * 1024, 1024, (const bf16_t*)(ws + WS_WO) + (size_t)l * 1024 * 1024, 1024, 1024, smem, e); }
}
DI void phase_g1(int WV, int l, int f, unsigned char* smem) {
  KArgs a = kargs(); unsigned char* ws = a->ws; EpiSwiglu E; E.U = (bf16_t*)(ws + WS_U);
  run_gemm(WV, (LAS unsigned char*)smem, (const bf16_t*)(ws + WS_H), 1024, (const bf16_t*)(ws + WS_W13) + (size_t)(l * 2 + f) * 5632 * 1024, MT_, 5632, 1024, E);
}
DI void phase_g2(int WV, int l, int f, unsigned char* smem) {
  const int gi = f == 0 ? 2 : 8;
  { KArgs a = kargs(); unsigned char* ws = a->ws; EpiResid E; E.X = (float*)(ws + WS_X); E.gate = (const float*)(ws + WS_MOD) + (size_t)l * 9216 + gi * 1024; E.scale = 0.5f;
    run_gemm(WV, (LAS unsigned char*)smem, (const bf16_t*)(ws + WS_U), 2816, (const bf16_t*)(ws + WS_W2) + (size_t)(l * 2 + f) * 1024 * 2816, L_, 1024, 2816, E); }
  { KArgs a = kargs(); unsigned char* ws = a->ws; CtxResid e; e.Xc = (float*)(ws + WS_X) + (size_t)L_ * 1024; e.gate = (const float*)(ws + WS_MOD) + (size_t)(4 + l) * 9216 + gi * 1024; e.scale = 0.5f;
    ctx_gemm32(WV, (const bf16_t*)(ws + WS_U) + (size_t)L_ * 2816, 2816, (const bf16_t*)(ws + WS_W2) + (size_t)(l * 2 + f) * 1024 * 2816, 2816, 1024, smem, e); }
}

DI unsigned xcc_id() { return (unsigned)__builtin_amdgcn_s_getreg((3 << 11) | 20) & 0xFu; }
DI void grid_bar(int WV, unsigned& gen, unsigned xcc, unsigned nloc, unsigned nx) {
  asm volatile("s_waitcnt vmcnt(0)" ::: "memory");
  __syncthreads();
  gen += 1;
  if (ltid() == 0) {
    unsigned* bar = (unsigned*)(kargs()->ws + WS_BAR);
    const unsigned old = __hip_atomic_fetch_add(bar + 320 + 16 * xcc, 1u, __ATOMIC_RELAXED, __HIP_MEMORY_SCOPE_AGENT);
    if (old + 1u == gen * nloc) {
      __builtin_amdgcn_fence(__ATOMIC_RELEASE, "agent");
      asm volatile("s_waitcnt vmcnt(0)" ::: "memory");
      __hip_atomic_fetch_add(bar + 640, 1u, __ATOMIC_RELAXED, __HIP_MEMORY_SCOPE_AGENT);
    }
    const unsigned target = gen * nx;
    while (__hip_atomic_load(bar + 640, __ATOMIC_RELAXED, __HIP_MEMORY_SCOPE_AGENT) < target) __builtin_amdgcn_s_sleep(1);
    __builtin_amdgcn_fence(__ATOMIC_ACQUIRE, "agent");
    asm volatile("s_waitcnt vmcnt(0)" ::: "memory");
  }
  __syncthreads();
}

__global__ void __launch_bounds__(512, 2) mega(Args a_unused) {
  extern __shared__ __attribute__((aligned(16))) unsigned char smem[];
  cg::grid_group grid = cg::this_grid();
  const int WV = __builtin_amdgcn_readfirstlane((int)(threadIdx.x >> 6));
  const unsigned xcc = xcc_id();
  if (threadIdx.x == 0) __hip_atomic_fetch_add((unsigned*)(kargs()->ws + WS_BAR) + 16 + 16 * xcc, 1u, __ATOMIC_RELAXED, __HIP_MEMORY_SCOPE_AGENT);
#ifndef NO_PRO
  prologue(WV, kargs(), smem);
#ifdef PROBE_PRO
  __syncthreads(); prologue(WV, kargs(), smem);
#endif
#endif
  grid.sync();
  unsigned gen = 0, nloc = 1, nx = 0;
  { const unsigned* cen = (const unsigned*)(kargs()->ws + WS_BAR) + 16;
    for (int j = 0; j < 16; ++j) { const unsigned cj = __hip_atomic_load(cen + 16 * j, __ATOMIC_RELAXED, __HIP_MEMORY_SCOPE_AGENT); nx += cj ? 1u : 0u; if ((unsigned)j == xcc) nloc = cj; }
    nloc = __builtin_amdgcn_readfirstlane(nloc); nx = __builtin_amdgcn_readfirstlane(nx); }
#pragma unroll 1
  for (int l = 0; l < DEPTH_; ++l) {
#pragma unroll 1
    for (int f = 0; f < 2; ++f) {
      if (f == 1) {
        norm_phase(WV, kargs(), l, 1, false);
        grid_bar(WV, gen, xcc, nloc, nx);
        phase_win(WV, l, smem);
#ifdef PROBE_WIN
        phase_win(WV, l, smem);
#endif
        grid_bar(WV, gen, xcc, nloc, nx);
#ifndef NO_MIXA
        fourier_tables(WV, smem); __syncthreads(); fourier_stage1(WV, kargs(), smem); fourier_ctx(WV, kargs(), smem); __syncthreads(); ret_states(WV, kargs(), l, smem);
#ifdef PROBE_MIXA
        __syncthreads();
        fourier_tables(WV, smem); __syncthreads(); fourier_stage1(WV, kargs(), smem); fourier_ctx(WV, kargs(), smem); __syncthreads(); ret_states(WV, kargs(), l, smem);
#endif
#endif
        grid_bar(WV, gen, xcc, nloc, nx);
#ifndef NO_MIXB
        ret_scan(WV, kargs(), l); __syncthreads(); fourier_tables(WV, smem); __syncthreads(); fourier_stage2(WV, kargs(), smem);
#ifdef PROBE_MIXB
        __syncthreads();
        ret_scan(WV, kargs(), l); __syncthreads(); fourier_tables(WV, smem); __syncthreads(); fourier_stage2(WV, kargs(), smem);
#endif
#endif
        grid_bar(WV, gen, xcc, nloc, nx);
#ifndef NO_RETOUT
        ret_out(WV, kargs(), l, smem); __syncthreads();
#ifdef PROBE_RET
        ret_out(WV, kargs(), l, smem); __syncthreads();
#endif
#endif
#ifndef NO_ATTN
        attn_phase<0>(WV, kargs(), l, l < DEPTH_ - 1, smem);
#ifdef PROBE_ATTN
        __syncthreads(); attn_phase<PROBE_ATTN>(WV, kargs(), l, l < DEPTH_ - 1, smem);
#endif
#endif
        grid_bar(WV, gen, xcc, nloc, nx);
        phase_merge(WV, l, smem);
#ifdef PROBE_MERGE
        phase_merge(WV, l, smem);
#endif
        grid_bar(WV, gen, xcc, nloc, nx);
        phase_wo(WV, l, smem);
        grid_bar(WV, gen, xcc, nloc, nx);
      }
      norm_phase(WV, kargs(), l, f == 0 ? 0 : 2, l == 0 && f == 0);
      grid_bar(WV, gen, xcc, nloc, nx);
      phase_g1(WV, l, f, smem);
#ifdef PROBE_G1
      phase_g1(WV, l, f, smem);
#endif
      grid_bar(WV, gen, xcc, nloc, nx);
      phase_g2(WV, l, f, smem);
      grid_bar(WV, gen, xcc, nloc, nx);
    }
  }
  final_norm(WV, kargs());
}

extern "C" void kernel_launch(void* const* d_in, const int* in_sizes, int n_in, void* d_out, int out_size, void* d_ws, size_t ws_size, hipStream_t stream) {
  static int grid = 0;
  if (grid == 0) {
    int dev = 0, cus = 0, per_cu = 0;
    (void)hipGetDevice(&dev); (void)hipDeviceGetAttribute(&cus, hipDeviceAttributeMultiprocessorCount, dev);
    if (hipFuncSetAttribute((const void*)mega, hipFuncAttributeMaxDynamicSharedMemorySize, LDS_BYTES) != hipSuccess) fprintf(stderr, "kernel_launch: hipFuncSetAttribute failed\n");
    if (hipOccupancyMaxActiveBlocksPerMultiprocessor(&per_cu, (const void*)mega, 512, LDS_BYTES) != hipSuccess || per_cu < 1) fprintf(stderr, "kernel_launch: occupancy query says %d blocks per CU\n", per_cu);
    (void)hipGetLastError();
    grid = cus > 0 ? cus : 256;
    if (ws_size < WS_END) { fprintf(stderr, "kernel_launch: workspace too small: %zu < %zu\n", ws_size, (size_t)WS_END); }
  }
  Args a{};
  for (int i = 0; i < 19; ++i) a.in[i] = (const float*)d_in[i];
  a.out = (float*)d_out; a.ws = (unsigned char*)d_ws;
  (void)hipMemsetAsync((unsigned char*)d_ws + WS_BAR, 0, 8192, stream);
  void* args[] = {&a};
  hipError_t e = hipLaunchCooperativeKernel((const void*)mega, dim3(grid), dim3(512), args, LDS_BYTES, stream);
  if (e != hipSuccess) fprintf(stderr, "kernel_launch: cooperative launch failed: %s (grid %d)\n", hipGetErrorString(e), grid);
}
```

```cpp
#include <hip/hip_runtime.h>
#include <hip/hip_cooperative_groups.h>
#include <cstdio>
namespace cg = cooperative_groups;
__device__ __forceinline__ int lane_id_v() { int l; asm volatile("v_mbcnt_lo_u32_b32 %0, -1, 0\n\tv_mbcnt_hi_u32_b32 %0, -1, %0" : "=v"(l)); return l; }
#define ltid() ((WV << 6) | lane_id_v())
__device__ __forceinline__ float shx(float v, int m, int lane) { return __int_as_float(__builtin_amdgcn_ds_bpermute((lane ^ m) << 2, __float_as_int(v))); }
namespace pg8 {
#define PG8_LAS __attribute__((address_space(3)))
typedef unsigned short bf16_t;
typedef short bf16x8 __attribute__((ext_vector_type(8)));
typedef float f32x4 __attribute__((ext_vector_type(4)));
typedef unsigned u32x4 __attribute__((ext_vector_type(4)));
constexpr int BM = 256, BK = 64, HALF = 128, HTB = HALF * BK * 2  , STAGE_BYTES = 8 * HTB, NXCD = 8, WGM = 8;

__host__ __device__ __forceinline__ int lds_byte(int r, int c) { const int st = (r >> 4) * 2 + (c >> 5), rr = r & 15, cc = c & 31, ob = rr * 64 + cc * 2; return st * 1024 + (ob ^ (((ob >> 9) & 1) << 5)); }
__host__ __device__ __forceinline__ void stage_rc(int b, int& R, int& C) { const int st = b / 1024, sb = b % 1024, swz = sb ^ (((sb >> 9) & 1) << 5); R = (st >> 1) * 16 + swz / 64; C = (st & 1) * 32 + (swz % 64) / 2; }
__host__ __device__ __forceinline__ int perm32(int rho) { const int n = rho >> 4, i = rho & 15; return 8 * (i >> 2) + 4 * n + (i & 3); }

struct Unit { int pm, pn; };
struct Gemm { const bf16_t* A; const bf16_t* Bt; int M, N, K, lda; };

struct StaticOrder {
    int nM, nN, nwg, G, c;
    __host__ __device__ void init(int M, int N, int G_, int c_) { nM = M / BM; nN = N / BM; nwg = nM * nN; G = G_; c = c_; }
    __host__ __device__ bool next(int i, Unit& u) const {
        const long L = (long)i * G + c; if (L >= nwg) return false;
        int wgid = (int)L; { const int q = nwg / NXCD, r = nwg % NXCD, xcd = wgid % NXCD, off = wgid / NXCD; wgid = (xcd < r ? xcd * (q + 1) : r * (q + 1) + (xcd - r) * q) + off; }
        const int nig = WGM * nN, gid = wgid / nig, fm = gid * WGM, gsz = (nM - fm) < WGM ? (nM - fm) : WGM;
        u.pm = fm + ((wgid % nig) % gsz); u.pn = (wgid % nig) / gsz; return true;
    }
    __device__ __forceinline__ void a_ready(const Unit&) const {}
    __device__ __forceinline__ void done(const Unit&) const {}
};
__device__ __forceinline__ unsigned cvt_pk_bf16(float lo, float hi) { unsigned r; asm volatile("v_cvt_pk_bf16_f32 %0, %1, %2" : "=v"(r) : "v"(lo), "v"(hi)); return r; }
template <class Epi, class Sched, bool STAMP = false>
__device__ __forceinline__ void gemm_phase(const int WV, PG8_LAS unsigned char* lds, const Gemm g, const Sched& S, const Epi& E, unsigned long long* stamps) {
    const int tid = ltid(); const int wid = __builtin_amdgcn_readfirstlane(tid >> 6), lane = tid & 63, wr = wid >> 2, wc = wid & 3, fr = lane & 15, fq = lane >> 4;
    const int K = g.K, nt = K / BK;
    int ts_lo = 0, ts_hi = 0, nts = 0; const unsigned long long rt_entry = STAMP ? (unsigned long long)wall_clock64() : 0ull;
#define PG8_STAMP() do { if (STAMP && wid == 0 && nts < 64) { const unsigned long long _c = (unsigned long long)clock64(); \
        ts_lo = (lane == nts) ? (int)(unsigned)_c : ts_lo; ts_hi = (lane == nts) ? (int)(unsigned)(_c >> 32) : ts_hi; ++nts; } } while (0)
    PG8_STAMP();
    unsigned voffA[2], voffB[2];
#pragma unroll
    for (int i = 0; i < 2; ++i) { int R, C; stage_rc(tid * 16 + i * 8192, R, C); const int Rb = Epi::PERM ? ((R & ~31) + perm32(R & 31)) : R;
        voffA[i] = (unsigned)(R * g.lda + C) * 2u; voffB[i] = (unsigned)(Rb * K + C) * 2u; }
    const size_t kstep = (size_t)(BK * 2);
    const size_t hstep = (size_t)HALF * K * 2;
    const size_t tstep = 2 * hstep; const size_t hstepA = (size_t)HALF * g.lda * 2; const size_t tstepA = 2 * hstepA;
    const unsigned ldsw = (unsigned)wid * 1024u;
    const int aoff = lds_byte(wr * 64 + fr, fq * 8), boff = lds_byte(wc * 32 + fr, fq * 8);
#define PG8_SA(b, h) (((b) * 2 + (h)) * HTB)
#define PG8_SB(b, h) ((4 + (b) * 2 + (h)) * HTB)
#define PG8_STAGE(bufoff, gbase, voff) do { _Pragma("unroll") for (int _i = 0; _i < 2; ++_i) \
        __builtin_amdgcn_global_load_lds((const unsigned*)((const char*)(gbase) + (voff)[_i]), (PG8_LAS unsigned*)(lds + (bufoff) + ldsw + _i * 8192), 16, 0, 0); } while (0)
#define PG8_LDA(dst, b, h) do { _Pragma("unroll") for (int m = 0; m < 4; ++m) _Pragma("unroll") for (int k = 0; k < 2; ++k) dst[m][k] = *(const PG8_LAS bf16x8*)(lds + PG8_SA(b, h) + aoff + m * 2048 + k * 1024); } while (0)
#define PG8_LDB(dst, b, h) do { _Pragma("unroll") for (int n = 0; n < 2; ++n) _Pragma("unroll") for (int k = 0; k < 2; ++k) dst[n][k] = *(const PG8_LAS bf16x8*)(lds + PG8_SB(b, h) + boff + n * 2048 + k * 1024); } while (0)
#define PG8_MMA(ai, bj, At, Bt) do { __builtin_amdgcn_s_setprio(1); _Pragma("unroll") for (int m = 0; m < 4; ++m) _Pragma("unroll") for (int n = 0; n < 2; ++n) _Pragma("unroll") for (int k = 0; k < 2; ++k) \
        acc[ai][bj][m][n] = __builtin_amdgcn_mfma_f32_16x16x32_bf16(Bt[n][k], At[m][k], acc[ai][bj][m][n], 0, 0, 0); __builtin_amdgcn_s_setprio(0); } while (0)
#define PG8_WAIT_V(n) asm volatile("s_waitcnt vmcnt(" #n ")" ::: "memory")
#define PG8_WAIT_L(n) asm volatile("s_waitcnt lgkmcnt(" #n ")" ::: "memory")
#define PG8_BAR __builtin_amdgcn_s_barrier()
#define PG8_SCHED __builtin_amdgcn_sched_barrier(0)
    Unit cur, nxt; int ui = 0;
    if (!S.next(0, cur)) return;
    f32x4 acc[2][2][4][2];
#pragma unroll
    for (int a = 0; a < 2; ++a)
#pragma unroll
        for (int b = 0; b < 2; ++b)
#pragma unroll
            for (int m = 0; m < 4; ++m)
#pragma unroll
                for (int n = 0; n < 2; ++n) acc[a][b][m][n] = (f32x4){0.f, 0.f, 0.f, 0.f};
    bf16x8 At[4][2], B0[2][2], B1[2][2];
    const char* cA = (const char*)g.A + (size_t)cur.pm * tstepA; const char* cB = (const char*)g.Bt + (size_t)cur.pn * tstep;
    S.a_ready(cur);
    PG8_STAGE(PG8_SB(0, 0), cB, voffB); PG8_STAGE(PG8_SA(0, 0), cA, voffA); PG8_STAGE(PG8_SB(0, 1), cB + hstep, voffB); PG8_STAGE(PG8_SA(0, 1), cA + hstepA, voffA);
    if (wr == 1) PG8_BAR;
    PG8_WAIT_V(4); PG8_BAR;
    PG8_STAGE(PG8_SB(1, 0), cB + kstep, voffB); PG8_STAGE(PG8_SA(1, 0), cA + kstep, voffA); PG8_STAGE(PG8_SB(1, 1), cB + hstep + kstep, voffB);
    PG8_WAIT_V(6); PG8_BAR;
    PG8_STAMP();
    for (;;) {
        const bool has_next = S.next(ui + 1, nxt);
        const char* nA = has_next ? (const char*)g.A + (size_t)nxt.pm * tstepA : cA; const char* nB = has_next ? (const char*)g.Bt + (size_t)nxt.pn * tstep : cB;
        for (int t = 0; t < nt; t += 2) {
            const bool last = (t == nt - 2);
            const char* a1 = cA + (size_t)(t + 1) * kstep;
            const char* a2 = last ? nA : cA + (size_t)(t + 2) * kstep; const char* b2 = last ? nB : cB + (size_t)(t + 2) * kstep;
            const char* a3 = a2 + kstep; const char* b3 = b2 + kstep;
            if (last && has_next) S.a_ready(nxt);
            PG8_LDB(B0, 0, 0); PG8_SCHED; PG8_LDA(At, 0, 0); PG8_STAGE(PG8_SA(1, 1), a1 + hstepA, voffA);
            PG8_WAIT_L(8); PG8_BAR; PG8_WAIT_L(0); PG8_MMA(0, 0, At, B0); PG8_BAR; PG8_SCHED;
            PG8_LDB(B1, 0, 1); PG8_STAGE(PG8_SB(0, 0), b2, voffB);
            PG8_BAR; PG8_WAIT_L(0); PG8_MMA(0, 1, At, B1); PG8_BAR;
            PG8_LDA(At, 0, 1); PG8_STAGE(PG8_SA(0, 0), a2, voffA);
            PG8_BAR; PG8_WAIT_L(0); PG8_MMA(1, 0, At, B0); PG8_BAR; PG8_SCHED;
            PG8_STAGE(PG8_SB(0, 1), b2 + hstep, voffB);
            PG8_WAIT_V(6); PG8_BAR; PG8_MMA(1, 1, At, B1); PG8_BAR;
            PG8_LDB(B0, 1, 0); PG8_SCHED; PG8_LDA(At, 1, 0); PG8_STAGE(PG8_SA(0, 1), a2 + hstepA, voffA);
            PG8_WAIT_L(8); PG8_BAR; PG8_WAIT_L(0); PG8_MMA(0, 0, At, B0); PG8_BAR; PG8_SCHED;
            PG8_LDB(B1, 1, 1); PG8_STAGE(PG8_SB(1, 0), b3, voffB);
            PG8_BAR; PG8_WAIT_L(0); PG8_MMA(0, 1, At, B1); PG8_BAR;
            PG8_LDA(At, 1, 1); PG8_STAGE(PG8_SA(1, 0), a3, voffA);
            PG8_BAR; PG8_WAIT_L(0); PG8_MMA(1, 0, At, B0); PG8_BAR; PG8_SCHED;
            PG8_STAGE(PG8_SB(1, 1), b3 + hstep, voffB);
            PG8_WAIT_V(6); PG8_BAR; PG8_MMA(1, 1, At, B1); PG8_BAR;
        }
        PG8_STAMP();
        if constexpr (!Epi::AFTER_DRAIN) { E(acc, cur, wr, wc, fr, fq); S.done(cur); }
        PG8_STAMP();
        if (!has_next) break;
#pragma unroll
        for (int a = 0; a < 2; ++a)
#pragma unroll
            for (int b = 0; b < 2; ++b)
#pragma unroll
                for (int m = 0; m < 4; ++m)
#pragma unroll
                    for (int n = 0; n < 2; ++n) acc[a][b][m][n] = (f32x4){0.f, 0.f, 0.f, 0.f};
        cur = nxt; cA = nA; cB = nB; ++ui;
    }
    PG8_WAIT_V(0);
    if (wr == 0) PG8_BAR;
    PG8_BAR;
    if constexpr (Epi::AFTER_DRAIN) { E.fused(acc, cur, wr, wc, fr, fq, lds, wid, lane); S.done(cur); }
    PG8_STAMP();
    if (STAMP && wid == 0) { stamps[lane] = lane < nts ? (((unsigned long long)(unsigned)ts_hi << 32) | (unsigned)ts_lo) : 0ull;
        if (lane == 62) stamps[62] = rt_entry; if (lane == 63) stamps[63] = (unsigned long long)wall_clock64(); }
#undef PG8_STAMP
#undef PG8_SA
#undef PG8_SB
#undef PG8_STAGE
#undef PG8_LDA
#undef PG8_LDB
#undef PG8_MMA
#undef PG8_WAIT_V
#undef PG8_WAIT_L
#undef PG8_BAR
#undef PG8_SCHED
}
}
using pg8::bf16_t; using pg8::bf16x8; using pg8::f32x4; using pg8::u32x4; using pg8::cvt_pk_bf16;
typedef float f32x16 __attribute__((ext_vector_type(16)));
typedef short s16x4 __attribute__((ext_vector_type(4)));
typedef unsigned u32x2 __attribute__((ext_vector_type(2)));
#define DI __device__ __forceinline__
#define LAS __attribute__((address_space(3)))
#define MFMA32(a, b, c) __builtin_amdgcn_mfma_f32_32x32x16_bf16((a), (b), (c), 0, 0, 0)

constexpr int L_ = 16384, LC_ = 256, MT_ = 16640, D_ = 1024, DFF_ = 2816, DEPTH_ = 4;
constexpr int NWIN_ = 5888, NPB_ = 2816, NGB_ = 3072;
constexpr int C_FA = 0, C_FB = 256, C_RQ = 512, C_RK = 704, C_RV = 896, C_RG = 1280, C_DQ = 1664, C_DK = 2048, C_DV = 2432;
constexpr int LDS_BYTES = 147456;
constexpr float EPS_ = 1e-6f;

constexpr size_t al256(size_t x) { return (x + 255) & ~(size_t)255; }
constexpr size_t WS_W13 = 0;
constexpr size_t WS_W2  = WS_W13 + (size_t)4 * 2 * 5632 * 1024 * 2;
constexpr size_t WS_WIN = WS_W2 + (size_t)4 * 2 * 1024 * 2816 * 2;
constexpr size_t WS_WBF = WS_WIN + (size_t)4 * 5888 * 1024 * 2;
constexpr size_t WS_WBR = WS_WBF + (size_t)4 * 1024 * 256 * 2;
constexpr size_t WS_WBD = WS_WBR + (size_t)4 * 1024 * 384 * 2;
constexpr size_t WS_WO  = WS_WBD + (size_t)4 * 1024 * 384 * 2;
constexpr size_t WS_X   = WS_WO + (size_t)4 * 1024 * 1024 * 2;
constexpr size_t WS_H   = WS_X + (size_t)MT_ * 1024 * 4;
constexpr size_t WS_BR  = WS_H + (size_t)MT_ * 1024 * 2;
constexpr size_t WS_AL  = WS_BR + (size_t)MT_ * 1024 * 2;
constexpr size_t WS_U   = WS_AL;
constexpr size_t WS_PB  = WS_AL;
constexpr size_t WS_GB  = WS_AL + (size_t)MT_ * 2816 * 2;
constexpr size_t WS_V   = WS_GB + (size_t)MT_ * 3072 * 2;
constexpr size_t WS_T   = WS_V + (size_t)128 * 128 * 2 * 256 * 2;
constexpr size_t WS_S   = WS_T + (size_t)130 * 6 * 2 * 2048 * 4;
constexpr size_t WS_MXC = WS_S + (size_t)130 * 6 * 2 * 2048 * 4;
constexpr size_t WS_MOD = WS_MXC + (size_t)256 * 1024 * 4;
constexpr size_t WS_TRET = WS_MOD + (size_t)2 * 4 * 9216 * 4;
constexpr size_t WS_TROW = WS_TRET + (size_t)16384 * 16 * 2 * 4;
constexpr size_t WS_TCOL = WS_TROW + (size_t)256 * 8 * 2 * 4;
constexpr size_t WS_SCAL = WS_TCOL + (size_t)64 * 8 * 2 * 4;
constexpr size_t WS_BAR = WS_SCAL + 4 * 64 * 4;
constexpr size_t WS_END = WS_BAR + 8192;

__device__ __forceinline__ int lbid() { int t = blockIdx.x; asm volatile("" : "+s"(t)); return t; }
__device__ __forceinline__ int lnb() { int t = gridDim.x; asm volatile("" : "+s"(t)); return t; }
struct Args { const float* in[19]; float* out; unsigned char* ws; };
typedef const Args __attribute__((address_space(4)))* KArgs;
__device__ __forceinline__ KArgs kargs() { KArgs p = (KArgs)__builtin_amdgcn_kernarg_segment_ptr(); asm volatile("" : "+s"(p)); return p; }

DI float bf2f(unsigned v) { return __uint_as_float(v << 16); }
DI bf16_t f2bf(float x) { return (bf16_t)(cvt_pk_bf16(x, 0.f) & 0xffffu); }
DI int crow(int reg, int h) { return (reg & 3) + 8 * (reg >> 2) + 4 * h; }
DI bf16x8 pack_step(const f32x16& x, int s) {
  u32x4 p;
  asm volatile("v_cvt_pk_bf16_f32 %0, %4, %5\n\tv_cvt_pk_bf16_f32 %1, %6, %7\n\tv_cvt_pk_bf16_f32 %2, %8, %9\n\tv_cvt_pk_bf16_f32 %3, %10, %11\n\ts_nop 1"
               : "=&v"(p[0]), "=&v"(p[1]), "=&v"(p[2]), "=&v"(p[3])
               : "v"(x[8 * s]), "v"(x[8 * s + 1]), "v"(x[8 * s + 2]), "v"(x[8 * s + 3]), "v"(x[8 * s + 4]), "v"(x[8 * s + 5]), "v"(x[8 * s + 6]), "v"(x[8 * s + 7]));
  return __builtin_bit_cast(bf16x8, p);
}
DI float silu_f(float a) { return a * __builtin_amdgcn_rcpf(1.0f + __expf(-a)); }
DI float sigmoid_f(float a) { return __builtin_amdgcn_rcpf(1.0f + __expf(-a)); }
DI float wave_sum(float v) {
  const int lane = lane_id_v();
#pragma unroll
  for (int o = 32; o > 0; o >>= 1) v += shx(v, o, lane);
  return v;
}
DI void sincos_acc(float xf, float& s, float& c) {
  const double x = (double)xf;
  const double k = rint(x * 0.63661977236758134308);
  double r = fma(-k, 1.57079632679489655800e+00, x); r = fma(-k, 6.12323399573676603587e-17, r);
  const double r2 = r * r;
  double sp = -1.0 / 39916800.0; sp = fma(sp, r2, 1.0 / 362880.0); sp = fma(sp, r2, -1.0 / 5040.0); sp = fma(sp, r2, 1.0 / 120.0); sp = fma(sp, r2, -1.0 / 6.0); sp = fma(sp * r2, r, r);
  double cp = 1.0 / 479001600.0; cp = fma(cp, r2, -1.0 / 3628800.0); cp = fma(cp, r2, 1.0 / 40320.0); cp = fma(cp, r2, -1.0 / 720.0); cp = fma(cp, r2, 1.0 / 24.0); cp = fma(cp, r2, -0.5); cp = fma(cp, r2, 1.0);
  const int q = ((int)(long long)k) & 3;
  const double sv = (q == 0) ? sp : (q == 1) ? cp : (q == 2) ? -sp : -cp;
  const double cv = (q == 0) ? cp : (q == 1) ? -sp : (q == 2) ? -cp : sp;
  s = (float)sv; c = (float)cv;
}
__constant__ float INV16[16] = {1.0f, 0.5623413324356079f, 0.3162277638912201f, 0.17782793939113617f, 0.10000000149011612f, 0.05623413249850273f, 0.03162277489900589f, 0.017782794311642647f,
                             0.009999999776482582f, 0.005623413249850273f, 0.003162277629598975f, 0.0017782794311642647f, 0.0010000000474974513f, 0.000562341301701963f, 0.0003162277571391314f, 0.00017782794020604342f};
struct ConvJob { const float* src; const float* src2; bf16_t* dst; int N, K, ld, kind; };
DI ConvJob conv_job(KArgs a, int j) {
  const int l = j / 9, kd = j % 9; ConvJob J; J.src2 = nullptr; J.kind = 0;
  unsigned char* ws = a->ws;
  switch (kd) {
    case 0: case 1: { const int f = kd; J.src = a->in[7] + (size_t)(l * 2 + f) * 1024 * 2816; J.src2 = a->in[8] + (size_t)(l * 2 + f) * 1024 * 2816; J.dst = (bf16_t*)(ws + WS_W13) + (size_t)(l * 2 + f) * 5632 * 1024; J.N = 5632; J.K = 1024; J.ld = 2816; J.kind = 1; break; }
    case 2: case 3: { const int f = kd - 2; J.src = a->in[9] + (size_t)(l * 2 + f) * 2816 * 1024; J.dst = (bf16_t*)(ws + WS_W2) + (size_t)(l * 2 + f) * 1024 * 2816; J.N = 1024; J.K = 2816; J.ld = 1024; break; }
    case 4: { J.src = a->in[10] + (size_t)l * 1024 * 5632; J.dst = (bf16_t*)(ws + WS_WIN) + (size_t)l * 5888 * 1024; J.N = 5888; J.K = 1024; J.ld = 5632; J.kind = 2; break; }
    case 5: { J.src = a->in[14] + (size_t)l * 256 * 1024; J.dst = (bf16_t*)(ws + WS_WBF) + (size_t)l * 1024 * 256; J.N = 1024; J.K = 256; J.ld = 1024; break; }
    case 6: { J.src = a->in[15] + (size_t)l * 384 * 1024; J.dst = (bf16_t*)(ws + WS_WBR) + (size_t)l * 1024 * 384; J.N = 1024; J.K = 384; J.ld = 1024; break; }
    case 7: { J.src = a->in[16] + (size_t)l * 384 * 1024; J.dst = (bf16_t*)(ws + WS_WBD) + (size_t)l * 1024 * 384; J.N = 1024; J.K = 384; J.ld = 1024; break; }
    default: { J.src = a->in[17] + (size_t)l * 1024 * 1024; J.dst = (bf16_t*)(ws + WS_WO) + (size_t)l * 1024 * 1024; J.N = 1024; J.K = 1024; J.ld = 1024; break; }
  }
  return J;
}
DI int axial_perm(int s) { return s < 8 ? s : (s < 16 ? s + 8 : (s < 24 ? s - 8 : s)); }

DI void prologue(int WV, KArgs a, unsigned char* smem) {
  const int tid = ltid(), nb = lnb(), bid = lbid();
  float* t = (float*)smem;
  float* tr = t + 64 * 65;
  {
    constexpr int tiles_per_layer = 1408 * 2 + 704 * 2 + 1472 + 64 + 96 + 96 + 256;
    const int nn = tid & 63, kq = tid >> 6;
#pragma unroll 1
    for (int g = bid; g < 4 * tiles_per_layer; g += nb) {
      const int l = g / tiles_per_layer; int rem = g % tiles_per_layer; int kd;
      if (rem < 1408) kd = 0; else if (rem < 2816) { kd = 1; rem -= 1408; } else if (rem < 3520) { kd = 2; rem -= 2816; } else if (rem < 4224) { kd = 3; rem -= 3520; }
      else if (rem < 5696) { kd = 4; rem -= 4224; } else if (rem < 5760) { kd = 5; rem -= 5696; } else if (rem < 5856) { kd = 6; rem -= 5760; } else if (rem < 5952) { kd = 7; rem -= 5856; } else { kd = 8; rem -= 5952; }
      const ConvJob J = conv_job(a, l * 9 + kd);
      const int nkt = J.K / 64; const int n0 = (rem / nkt) * 64, k0 = (rem % nkt) * 64;
      const bool fold = (J.kind == 2) && (n0 < 512);
      const float* sp = J.src; int col = n0 + nn;
      if (J.kind == 1) { const int n = n0 + nn, gi = n >> 5, s = n & 31; sp = (s < 16) ? J.src : J.src2; col = 16 * gi + (s & 15); }
      else if (J.kind == 2) {
        const int n = n0 + nn;
        if (fold) col = (n0 & 192) + nn;
        else { col = n - 256; if (n >= C_DQ && n < C_DV) { const int s = n & 31; col = (n - 256 - s) + axial_perm(s); } }
      }
      const float* cp = sp + (size_t)(k0 + kq) * J.ld + col;
      float lv[8];
#pragma unroll
      for (int i = 0; i < 8; ++i) lv[i] = cp[(size_t)(8 * i) * J.ld];
#pragma unroll
      for (int i = 0; i < 8; ++i) t[nn * 65 + kq + 8 * i] = lv[i];
      if (fold && tid < 64) { const float ang = (float)tid * (1.0f / 32.0f); tr[tid] = (n0 >= 256) ? sinpif(ang) : cospif(ang); }
      __syncthreads();
      if (!fold) {
#pragma unroll
        for (int i = 0; i < 4; ++i) {
          const int e = tid + i * 512, n2 = e >> 5, kp = (e & 31) * 2;
          *(unsigned*)(J.dst + (size_t)(n0 + n2) * J.K + k0 + kp) = cvt_pk_bf16(t[n2 * 65 + kp], t[n2 * 65 + kp + 1]);
        }
      } else {
#pragma unroll 1
        for (int i = 0; i < 8; ++i) {
          const int m = kq + 8 * i, kk = nn;
          float acc = 0.f;
#pragma unroll 8
          for (int c = 0; c < 64; ++c) acc += t[c * 65 + kk] * tr[(m * c) & 63];
          J.dst[(size_t)(n0 + m) * J.K + k0 + kk] = f2bf(acc);
        }
      }
      __syncthreads();
    }
  }
  {
    float* sc = (float*)smem; float* scc = sc + 1024; float* red = scc + 1024;
    __syncthreads();
    for (int i = tid; i < 1024; i += 512) { sc[i] = silu_f(a->in[1][i]); scc[i] = silu_f(a->in[3][i]); }
    __syncthreads();
    float* MOD = (float*)(a->ws + WS_MOD);
    for (int it = bid; it < 4 * 72; it += nb) {
      const int l = it / 72, cb = it % 72;
      const int cgp = tid & 31, ks = tid >> 5;
      const float* wp = a->in[4] + ((size_t)l * 1024 + ks * 64) * 9216 + cb * 128 + cgp * 4;
      f32x4 am = {0.f, 0.f, 0.f, 0.f}, ac = {0.f, 0.f, 0.f, 0.f};
#pragma unroll 8
      for (int k = 0; k < 64; ++k) { const f32x4 w = *(const f32x4*)(wp + (size_t)k * 9216); am += w * sc[ks * 64 + k]; ac += w * scc[ks * 64 + k]; }
#pragma unroll
      for (int j = 0; j < 4; ++j) { red[(ks * 128 + cgp * 4 + j) * 2] = am[j]; red[(ks * 128 + cgp * 4 + j) * 2 + 1] = ac[j]; }
      __syncthreads();
      if (tid < 256) {
        const int col = tid >> 1, which = tid & 1; float s = 0.f;
#pragma unroll
        for (int q = 0; q < 16; ++q) s += red[(q * 128 + col) * 2 + which];
        const int gc = cb * 128 + col;
        MOD[(size_t)(which * 4 + l) * 9216 + gc] = s + a->in[5][(size_t)l * 9216 + gc];
      }
      __syncthreads();
    }
  }
  {
    float* TRET = (float*)(a->ws + WS_TRET); float* TROW = (float*)(a->ws + WS_TROW); float* TCOL = (float*)(a->ws + WS_TCOL);
    const int gt = bid * 512 + tid, gn = nb * 512;
    for (int e = gt; e < 16384 * 16; e += gn) { const int p = e >> 4, i = e & 15; float s, c; sincos_acc((float)p * INV16[i], s, c); TRET[2 * e] = c; TRET[2 * e + 1] = s; }
    for (int e = gt; e < 256 * 8; e += gn) { const int p = e >> 3, i = e & 7; float s, c; sincos_acc((float)p * INV16[2 * i], s, c); TROW[2 * e] = c; TROW[2 * e + 1] = s; }
    for (int e = gt; e < 64 * 8; e += gn) { const int p = e >> 3, i = e & 7; float s, c; sincos_acc((float)p * INV16[2 * i], s, c); TCOL[2 * e] = c; TCOL[2 * e + 1] = s; }
    if (bid == 0 && tid < 4) {
      const int l = tid; float* S = (float*)(a->ws + WS_SCAL) + l * 64;
      const float* lv = a->in[12] + l * 128; float d01 = 0.f, d23 = 0.f;
      for (int i = 0; i < 32; ++i) { d01 += lv[i] * lv[32 + i]; d23 += lv[64 + i] * lv[96 + i]; }
      const float lam_init = 0.8f - 0.6f * expf(-0.3f * (float)l);
      S[0] = expf(d01) - expf(d23) + lam_init; S[1] = lam_init;
      for (int i = 0; i < 12; ++i) { const float x = a->in[11][l * 12 + i]; S[4 + i] = -log1pf(expf(-x)); }
      for (int i = 0; i < 12; ++i) ((unsigned*)S)[16 + i] = 0u;
    }
  }
}
DI void norm_phase(int WV, KArgs a, int l, int which, bool first) {
  const int tid = ltid(), lane = tid & 63, wave = tid >> 6;
  const float* g = a->in[6] + (size_t)(l * 3 + which) * 1024;
  const float* mod = (const float*)(a->ws + WS_MOD) + (size_t)l * 9216;
  const float* modc = (const float*)(a->ws + WS_MOD) + (size_t)(4 + l) * 9216;
  float* X = (float*)(a->ws + WS_X); bf16_t* H = (bf16_t*)(a->ws + WS_H);
  const int stride = lnb() * 8;
  for (int r = lbid() * 8 + wave; r < MT_; r += 2 * stride) {
    const int r2 = r + stride; const bool has2 = r2 < MT_; const int rb = has2 ? r2 : r;
    const float* srcA = first ? (r < L_ ? a->in[0] + (size_t)r * 1024 : a->in[2] + (size_t)(r - L_) * 1024) : X + (size_t)r * 1024;
    const float* srcB = first ? (rb < L_ ? a->in[0] + (size_t)rb * 1024 : a->in[2] + (size_t)(rb - L_) * 1024) : X + (size_t)rb * 1024;
    f32x4 va[4], vb[4]; float sa = 0.f, sb = 0.f;
#pragma unroll
    for (int i = 0; i < 4; ++i) { va[i] = *(const f32x4*)(srcA + i * 256 + lane * 4); vb[i] = *(const f32x4*)(srcB + i * 256 + lane * 4); }
#pragma unroll
    for (int i = 0; i < 4; ++i) { sa += va[i][0] * va[i][0] + va[i][1] * va[i][1] + va[i][2] * va[i][2] + va[i][3] * va[i][3]; sb += vb[i][0] * vb[i][0] + vb[i][1] * vb[i][1] + vb[i][2] * vb[i][2] + vb[i][3] * vb[i][3]; }
    sa = wave_sum(sa); sb = wave_sum(sb);
    const float rsa = rsqrtf(sa * (1.0f / 1024.0f) + EPS_), rsb = rsqrtf(sb * (1.0f / 1024.0f) + EPS_);
#pragma unroll
    for (int q = 0; q < 2; ++q) {
      if (q == 1 && !has2) break;
      const int rr = q ? r2 : r; const float rstd = q ? rsb : rsa;
      const float* mm = (rr < L_) ? mod : modc;
#pragma unroll
      for (int i = 0; i < 4; ++i) {
        const int c = i * 256 + lane * 4;
        const f32x4 v = q ? vb[i] : va[i];
        const f32x4 gg = *(const f32x4*)(g + c), sh = *(const f32x4*)(mm + (which * 3) * 1024 + c), sc = *(const f32x4*)(mm + (which * 3 + 1) * 1024 + c);
        f32x4 y;
#pragma unroll
        for (int j = 0; j < 4; ++j) y[j] = v[j] * rstd * gg[j] * (1.0f + sc[j]) + sh[j];
        u32x2 w; w.x = cvt_pk_bf16(y[0], y[1]); w.y = cvt_pk_bf16(y[2], y[3]);
        *(u32x2*)(H + (size_t)rr * 1024 + c) = w;
        if (first) *(f32x4*)(X + (size_t)rr * 1024 + c) = v;
      }
    }
  }
}
DI void final_norm(int WV, KArgs a) {
  const int tid = ltid(), lane = tid & 63, wave = tid >> 6;
  const float* g = a->in[18]; const float* X = (const float*)(a->ws + WS_X);
  for (int r = lbid() * 8 + wave; r < L_; r += lnb() * 8) {
    f32x4 v[4]; float ss = 0.f;
#pragma unroll
    for (int i = 0; i < 4; ++i) { v[i] = *(const f32x4*)(X + (size_t)r * 1024 + i * 256 + lane * 4); ss += v[i][0] * v[i][0] + v[i][1] * v[i][1] + v[i][2] * v[i][2] + v[i][3] * v[i][3]; }
    ss = wave_sum(ss);
    const float rstd = rsqrtf(ss * (1.0f / 1024.0f) + EPS_);
#pragma unroll
    for (int i = 0; i < 4; ++i) { const int c = i * 256 + lane * 4; const f32x4 gg = *(const f32x4*)(g + c); f32x4 y; for (int j = 0; j < 4; ++j) y[j] = v[i][j] * rstd * gg[j]; *(f32x4*)(a->out + (size_t)r * 1024 + c) = y; }
  }
}

using pg8::Unit; using pg8::HALF; using pg8::BM;
struct EpiSwiglu {
  static constexpr bool PERM = false, AFTER_DRAIN = false;
  bf16_t* U;
  DI void operator()(const f32x4 (&acc)[2][2][4][2], const Unit& u, int wr, int wc, int fr_, int fq_) const {
    const int ln_ = lane_id_v(), fr = ln_ & 15, fq = ln_ >> 4;
#pragma unroll
    for (int ai = 0; ai < 2; ++ai)
#pragma unroll
      for (int m = 0; m < 4; ++m) {
        const int r = u.pm * BM + ai * HALF + wr * 64 + m * 16 + fr;
#pragma unroll
        for (int bj = 0; bj < 2; ++bj) {
          const int gi = u.pn * 8 + bj * 4 + wc;
          const f32x4 x = acc[ai][bj][m][0], y = acc[ai][bj][m][1];
          u32x2 w; w.x = cvt_pk_bf16(silu_f(x[0]) * y[0], silu_f(x[1]) * y[1]); w.y = cvt_pk_bf16(silu_f(x[2]) * y[2], silu_f(x[3]) * y[3]);
          *(u32x2*)(U + (size_t)r * DFF_ + gi * 16 + fq * 4) = w;
        }
        __builtin_amdgcn_sched_barrier(0);
      }
  }
};
struct EpiResid {
  static constexpr bool PERM = false, AFTER_DRAIN = false;
  float* X; const float* gate; float scale;
  DI void operator()(const f32x4 (&acc)[2][2][4][2], const Unit& u, int wr, int wc, int fr_, int fq_) const {
    const int ln_ = lane_id_v(), fr = ln_ & 15, fq = ln_ >> 4;
#pragma unroll
    for (int bj = 0; bj < 2; ++bj)
#pragma unroll
      for (int n = 0; n < 2; ++n) {
        const int c = u.pn * BM + bj * HALF + wc * 32 + n * 16 + fq * 4;
        const f32x4 gv = *(const f32x4*)(gate + c) * scale;
#pragma unroll
        for (int ai = 0; ai < 2; ++ai)
#pragma unroll
          for (int m = 0; m < 4; ++m) {
            const int r = u.pm * BM + ai * HALF + wr * 64 + m * 16 + fr;
            float* p = X + (size_t)r * 1024 + c;
            *(f32x4*)p = *(const f32x4*)p + gv * acc[ai][bj][m][n];
          }
      }
  }
};
template <int STEP> struct EpiMerge {
  static constexpr bool PERM = false, AFTER_DRAIN = false;
  bf16_t* MX; const bf16_t* G; bf16_t* Hout;
  DI void operator()(const f32x4 (&acc)[2][2][4][2], const Unit& u, int wr, int wc, int fr_, int fq_) const {
    const int ln_ = lane_id_v(), fr = ln_ & 15, fq = ln_ >> 4;
#pragma unroll
    for (int ai = 0; ai < 2; ++ai)
#pragma unroll
      for (int bj = 0; bj < 2; ++bj)
#pragma unroll
        for (int n = 0; n < 2; ++n) {
          const int c = u.pn * BM + bj * HALF + wc * 32 + n * 16 + fq * 4;
          const int r0 = u.pm * BM + ai * HALF + wr * 64 + fr;
          u32x2 gw[4], old[4];
#pragma unroll
          for (int m = 0; m < 4; ++m) {
            gw[m] = *(const u32x2*)(G + (size_t)(r0 + m * 16) * NGB_ + c);
            if (STEP > 0) old[m] = *(const u32x2*)(MX + (size_t)(r0 + m * 16) * 1024 + c);
          }
#pragma unroll
          for (int m = 0; m < 4; ++m) {
            f32x4 gv; gv[0] = bf2f(gw[m].x & 0xffffu); gv[1] = bf2f(gw[m].x >> 16); gv[2] = bf2f(gw[m].y & 0xffffu); gv[3] = bf2f(gw[m].y >> 16);
            f32x4 v = gv * acc[ai][bj][m][n];
            if (STEP > 0) { v[0] += bf2f(old[m].x & 0xffffu); v[1] += bf2f(old[m].x >> 16); v[2] += bf2f(old[m].y & 0xffffu); v[3] += bf2f(old[m].y >> 16); }
            u32x2 w; w.x = cvt_pk_bf16(v[0], v[1]); w.y = cvt_pk_bf16(v[2], v[3]);
            if (STEP < 2) *(u32x2*)(MX + (size_t)(r0 + m * 16) * 1024 + c) = w;
            else *(u32x2*)(Hout + (size_t)(r0 + m * 16) * 1024 + c) = w;
          }
          __builtin_amdgcn_sched_barrier(0);
        }
  }
};
struct EpiWin {
  static constexpr bool PERM = false, AFTER_DRAIN = false;
  bf16_t* PB; bf16_t* GB; const float* TRET; const float* TROW; const float* TCOL; unsigned* kmax;
  DI void operator()(const f32x4 (&acc)[2][2][4][2], const Unit& u, int wr, int wc, int fr_, int fq_) const {
    const int ln_ = lane_id_v(), fr = ln_ & 15, fq = ln_ >> 4;
#pragma unroll
    for (int bj = 0; bj < 2; ++bj) {
      const int cb = u.pn * BM + bj * HALF + wc * 32;
      float kmx = 0.f;
#pragma unroll
      for (int ai = 0; ai < 2; ++ai)
#pragma unroll
        for (int m = 0; m < 4; ++m) {
          const int r = u.pm * BM + ai * HALF + wr * 64 + m * 16 + fr;
          f32x4 x0 = acc[ai][bj][m][0], x1 = acc[ai][bj][m][1];
          if (cb >= NPB_) {
#pragma unroll
            for (int j = 0; j < 4; ++j) { x0[j] = sigmoid_f(x0[j]); x1[j] = sigmoid_f(x1[j]); }
            u32x2 w0, w1; w0.x = cvt_pk_bf16(x0[0], x0[1]); w0.y = cvt_pk_bf16(x0[2], x0[3]); w1.x = cvt_pk_bf16(x1[0], x1[1]); w1.y = cvt_pk_bf16(x1[2], x1[3]);
            bf16_t* p = GB + (size_t)r * NGB_ + (cb - NPB_) + fq * 4;
            *(u32x2*)p = w0; *(u32x2*)(p + 16) = w1;
            __builtin_amdgcn_sched_barrier(0);
            continue;
          }
          if (cb >= C_RQ && cb < C_RV) {
            if (r < L_) {
              const f32x4* tp = (const f32x4*)(TRET + ((size_t)r * 16 + fq * 4) * 2);
              const f32x4 t0 = tp[0], t1 = tp[1];
              const float cs[4] = {t0[0], t0[2], t1[0], t1[2]}, sn[4] = {t0[1], t0[3], t1[1], t1[3]};
#pragma unroll
              for (int j = 0; j < 4; ++j) { const float a_ = x0[j], b_ = x1[j]; x0[j] = a_ * cs[j] - b_ * sn[j]; x1[j] = a_ * sn[j] + b_ * cs[j]; }
            }
            if (cb >= C_RK) { x0 *= 0.17677669529663687f; x1 *= 0.17677669529663687f; }
          } else if (cb >= C_RG && cb < C_DQ) {
#pragma unroll
            for (int j = 0; j < 4; ++j) { x0[j] = silu_f(x0[j]); x1[j] = silu_f(x1[j]); }
          } else if (cb >= C_DQ && cb < C_DV) {
            if (r < L_) {
              const float* tb = (fq < 2) ? (TROW + ((size_t)(r >> 6) * 8 + fq * 4) * 2) : (TCOL + ((size_t)(r & 63) * 8 + (fq - 2) * 4) * 2);
              const f32x4 t0 = ((const f32x4*)tb)[0], t1 = ((const f32x4*)tb)[1];
              const float cs[4] = {t0[0], t0[2], t1[0], t1[2]}, sn[4] = {t0[1], t0[3], t1[1], t1[3]};
#pragma unroll
              for (int j = 0; j < 4; ++j) { const float a_ = x0[j], b_ = x1[j]; x0[j] = a_ * cs[j] - b_ * sn[j]; x1[j] = a_ * sn[j] + b_ * cs[j]; }
            }
            if (cb < C_DK) { x0 *= 0.25503486f; x1 *= 0.25503486f; }
            else { float ss = 0.f;
#pragma unroll
              for (int j = 0; j < 4; ++j) ss += x0[j] * x0[j] + x1[j] * x1[j];
              ss += shx(ss, 16, lane_id_v()); ss += shx(ss, 32, lane_id_v()); kmx = fmaxf(kmx, ss); }
          }
          u32x2 w0, w1; w0.x = cvt_pk_bf16(x0[0], x0[1]); w0.y = cvt_pk_bf16(x0[2], x0[3]); w1.x = cvt_pk_bf16(x1[0], x1[1]); w1.y = cvt_pk_bf16(x1[2], x1[3]);
          bf16_t* p = PB + (size_t)r * NPB_ + cb + fq * 4;
          *(u32x2*)p = w0; *(u32x2*)(p + 16) = w1;
          __builtin_amdgcn_sched_barrier(0);
        }
      if (cb >= C_DK && cb < C_DV) {
#pragma unroll
        for (int o = 1; o < 16; o <<= 1) kmx = fmaxf(kmx, shx(kmx, o, lane_id_v()));
        if (lane_id_v() == 0) atomicMax(kmax + ((cb - C_DK) >> 5), __float_as_uint(kmx));
      }
    }
  }
};
template <class F> DI void ctx_gemm32(int WV, const bf16_t* A, int lda, const bf16_t* Bt, int K, int N, unsigned char* smem, F epi) {
  const int tid = ltid(), lane = tid & 63, wave = tid >> 6, r31 = lane & 31, h = lane >> 5;
  float* red = (float*)smem;
  const int ntn = N / 32, ntiles = 8 * ntn, kper = K / 8;
  for (int tile = lbid(); tile < ntiles; tile += lnb()) {
    const int tm = tile / ntn, tn = tile % ntn;
    f32x16 acc; for (int i = 0; i < 16; ++i) acc[i] = 0.f;
    const bf16_t* ap = A + (size_t)(tm * 32 + r31) * lda + wave * kper + 8 * h;
    const bf16_t* bp = Bt + (size_t)(tn * 32 + r31) * K + wave * kper + 8 * h;
    int kk = 0;
    for (; kk + 64 <= kper; kk += 64) {
      bf16x8 av[4], bv[4];
#pragma unroll
      for (int q = 0; q < 4; ++q) { av[q] = *(const bf16x8*)(ap + kk + 16 * q); bv[q] = *(const bf16x8*)(bp + kk + 16 * q); }
#pragma unroll
      for (int q = 0; q < 4; ++q) acc = MFMA32(av[q], bv[q], acc);
    }
    for (; kk < kper; kk += 16) { const bf16x8 av = *(const bf16x8*)(ap + kk), bv = *(const bf16x8*)(bp + kk); acc = MFMA32(av, bv, acc); }
#pragma unroll
    for (int i = 0; i < 16; ++i) red[(wave * 16 + i) * 64 + lane] = acc[i];
    __syncthreads();
#pragma unroll
    for (int q = 0; q < 2; ++q) {
      const int o = tid + q * 512, i = o >> 6, ln = o & 63; float s = 0.f;
#pragma unroll
      for (int w = 0; w < 8; ++w) s += red[(w * 16 + i) * 64 + ln];
      epi(tm * 32 + crow(i, ln >> 5), tn * 32 + (ln & 31), s);
    }
    __syncthreads();
  }
}

constexpr int FR_LD = 136;
DI void fourier_tables(int WV, unsigned char* smem) {
  bf16_t* Cw = (bf16_t*)smem; bf16_t* Sw = Cw + 128 * FR_LD;
  for (int e = ltid(); e < 128 * 128; e += 512) { const int a_ = e >> 7, b_ = e & 127; const float x = (float)((a_ * b_) & 127) * (1.0f / 64.0f); Cw[a_ * FR_LD + b_] = f2bf(cospif(x)); Sw[a_ * FR_LD + b_] = f2bf(sinpif(x)); }
}
DI void fourier_load(int WV, const bf16_t* src, size_t rs, size_t po, unsigned char* smem) {
  bf16_t* dA = (bf16_t*)smem + 2 * 128 * FR_LD;
#pragma unroll
  for (int i = 0; i < 4; ++i) {
    const int id = ltid() + 512 * i, seg = id & 7, part = (id >> 3) & 1, row = id >> 4;
    const bf16x8 v = *(const bf16x8*)(src + (size_t)row * rs + (size_t)part * po + seg * 8);
    bf16_t* d = dA + part * 64 * FR_LD + (seg * 8) * FR_LD + (row ^ (seg << 3));
#pragma unroll
    for (int e = 0; e < 8; ++e) d[e * FR_LD] = (bf16_t)v[e];
  }
}
DI void fourier_stage1(int WV, KArgs a, unsigned char* smem) {
  const int tid = ltid(), lane = tid & 63, wave = tid >> 6, r31 = lane & 31, h = lane >> 5, rb = wave & 3, cbk = wave >> 2;
  const bf16_t* PB = (const bf16_t*)(a->ws + WS_PB); bf16_t* V = (bf16_t*)(a->ws + WS_V);
  const bf16_t* Cw = (const bf16_t*)smem; const bf16_t* Sw = Cw + 128 * FR_LD; const bf16_t* dA = Sw + 128 * FR_LD; const bf16_t* dB = dA + 64 * FR_LD;
  for (int it = lbid(); it < 512; it += lnb()) {
    const int t2 = it >> 2, c0 = (it & 3) * 64;
    __syncthreads();
    fourier_load(WV, PB + (size_t)t2 * NPB_ + C_FA + c0, (size_t)128 * NPB_, (size_t)(C_FB - C_FA), smem);
    __syncthreads();
    f32x16 R, nI; for (int i = 0; i < 16; ++i) { R[i] = 0.f; nI[i] = 0.f; }
#pragma unroll
    for (int s = 0; s < 8; ++s) {
      const bf16x8 cw = *(const bf16x8*)(Cw + (32 * rb + r31) * FR_LD + 16 * s + 8 * h), sw = *(const bf16x8*)(Sw + (32 * rb + r31) * FR_LD + 16 * s + 8 * h);
      const int so_ = (16 * s + 8 * h) ^ (((4 * cbk + (r31 >> 3)) & 7) << 3);
      const bf16x8 af = *(const bf16x8*)(dA + (32 * cbk + r31) * FR_LD + so_), bfv = *(const bf16x8*)(dB + (32 * cbk + r31) * FR_LD + so_);
      bf16x8 nb; for (int e = 0; e < 8; ++e) nb[e] = (short)(bfv[e] ^ (short)0x8000);
      R = MFMA32(cw, af, R); R = MFMA32(sw, nb, R); nI = MFMA32(sw, af, nI); nI = MFMA32(cw, bfv, nI);
    }
    const int col = c0 + 32 * cbk + r31;
#pragma unroll
    for (int i = 0; i < 16; ++i) {
      const int k1 = 32 * rb + crow(i, h);
      const float x = (float)(k1 * t2) * (1.0f / 8192.0f); const float ct = cospif(x), st = sinpif(x);
      const float vre = R[i] * ct - nI[i] * st, vim = -nI[i] * ct - R[i] * st;
      bf16_t* vp = V + ((size_t)(k1 * 128 + t2) * 2) * 256 + col;
      vp[0] = f2bf(vre); vp[256] = f2bf(vim);
    }
  }
}
DI void fourier_stage2(int WV, KArgs a, unsigned char* smem) {
  const int tid = ltid(), lane = tid & 63, wave = tid >> 6, r31 = lane & 31, h = lane >> 5, rb = wave & 3, cbk = wave >> 2;
  const bf16_t* V = (const bf16_t*)(a->ws + WS_V); bf16_t* BR = (bf16_t*)(a->ws + WS_BR);
  const bf16_t* Cw = (const bf16_t*)smem; const bf16_t* Sw = Cw + 128 * FR_LD; const bf16_t* dA = Sw + 128 * FR_LD; const bf16_t* dB = dA + 64 * FR_LD;
  for (int it = lbid(); it < 512; it += lnb()) {
    const int k1 = it >> 2, c0 = (it & 3) * 64;
    __syncthreads();
    fourier_load(WV, V + (size_t)k1 * 128 * 512 + c0, (size_t)512, (size_t)256, smem);
    __syncthreads();
    f32x16 Y; for (int i = 0; i < 16; ++i) Y[i] = 0.f;
#pragma unroll
    for (int s = 0; s < 8; ++s) {
      const bf16x8 cw = *(const bf16x8*)(Cw + (32 * rb + r31) * FR_LD + 16 * s + 8 * h), sw = *(const bf16x8*)(Sw + (32 * rb + r31) * FR_LD + 16 * s + 8 * h);
      const int so_ = (16 * s + 8 * h) ^ (((4 * cbk + (r31 >> 3)) & 7) << 3);
      const bf16x8 vr = *(const bf16x8*)(dA + (32 * cbk + r31) * FR_LD + so_), vi = *(const bf16x8*)(dB + (32 * cbk + r31) * FR_LD + so_);
      Y = MFMA32(cw, vr, Y); Y = MFMA32(sw, vi, Y);
    }
    const int col = c0 + 32 * cbk + r31;
#pragma unroll
    for (int i = 0; i < 16; ++i) { const int k2 = 32 * rb + crow(i, h); BR[(size_t)(k1 + 128 * k2) * 1024 + col] = f2bf(Y[i] * (1.0f / 1024.0f)); }
  }
}
DI void fourier_ctx(int WV, KArgs a, unsigned char* smem) {
  const int tid = ltid();
  const bf16_t* PB = (const bf16_t*)(a->ws + WS_PB) + (size_t)L_ * NPB_; bf16_t* BR = (bf16_t*)(a->ws + WS_BR) + (size_t)L_ * 1024;
  float* ct = (float*)smem; float* st = ct + 256; float* part = st + 256;
  __syncthreads();
  if (tid < 256) { const float x = (float)tid * (1.0f / 128.0f); ct[tid] = cospif(x); st[tid] = sinpif(x); }
  __syncthreads();
  for (int k = lbid(); k < 256; k += lnb()) {
    const int col = tid & 255, half = tid >> 8;
    float acc = 0.f;
#pragma unroll 8
    for (int t = half * 128; t < half * 128 + 128; ++t) {
      const int idx = (k * t) & 255;
      acc += ct[idx] * bf2f(PB[(size_t)t * NPB_ + C_FA + col]) - st[idx] * bf2f(PB[(size_t)t * NPB_ + C_FB + col]);
    }
    if (half == 1) part[col] = acc;
    __syncthreads();
    if (half == 0) BR[(size_t)k * 1024 + col] = f2bf((acc + part[col]) * (1.0f / 128.0f));
    __syncthreads();
  }
}
DI int chunk_row0(int ci) { return ci < 128 ? ci * 128 : L_ + (ci - 128) * 128; }
DI void ret_states(int WV, KArgs a, int l, unsigned char* smem) {
  const int tid = ltid();
  const bf16_t* PB = (const bf16_t*)(a->ws + WS_PB); float* T = (float*)(a->ws + WS_T);
  const float* S = (const float*)(a->ws + WS_SCAL) + l * 64;
  float* kL = (float*)smem; float* vL = kL + 128 * 33; float* wf = vL + 128 * 64; float* wb = wf + 128;
  for (int it = lbid(); it < 130 * 6; it += lnb()) {
    const int ci = it / 6, hh = it % 6, r0 = chunk_row0(ci);
    __syncthreads();
    { const int row = tid >> 2, seg = tid & 3; const bf16x8 v = *(const bf16x8*)(PB + (size_t)(r0 + row) * NPB_ + C_RK + hh * 32 + seg * 8);
#pragma unroll
      for (int e = 0; e < 8; ++e) kL[row * 33 + seg * 8 + e] = bf2f((unsigned)(unsigned short)v[e]); }
#pragma unroll
    for (int q = 0; q < 2; ++q) { const int id = tid + 512 * q, row = id >> 3, seg = id & 7; const bf16x8 v = *(const bf16x8*)(PB + (size_t)(r0 + row) * NPB_ + C_RV + hh * 64 + seg * 8);
#pragma unroll
      for (int e = 0; e < 8; ++e) vL[row * 64 + seg * 8 + e] = bf2f((unsigned)(unsigned short)v[e]); }
    if (tid < 128) { wf[tid] = expf(S[4 + hh] * (float)(127 - tid)); wb[tid] = expf(S[10 + hh] * (float)tid); }
    __syncthreads();
    const int d = tid >> 4, v4 = (tid & 15) * 4;
    f32x4 af = {0.f, 0.f, 0.f, 0.f}, ab = {0.f, 0.f, 0.f, 0.f};
#pragma unroll 4
    for (int j = 0; j < 128; ++j) { const float kd = kL[j * 33 + d]; const f32x4 vv = *(const f32x4*)(vL + j * 64 + v4); af += vv * (kd * wf[j]); ab += vv * (kd * wb[j]); }
    float* tp = T + ((size_t)(ci * 6 + hh) * 2) * 2048 + d * 64 + v4;
    *(f32x4*)tp = af; *(f32x4*)(tp + 2048) = ab;
  }
}
DI void ret_scan(int WV, KArgs a, int l) {
  const int gt = lbid() * 512 + ltid();
  if (gt >= 6 * 2 * 2048) return;
  const int idx = gt & 2047, dir = (gt >> 11) & 1, hh = gt >> 12;
  const float* T = (const float*)(a->ws + WS_T); float* S = (float*)(a->ws + WS_S);
  const float* SC = (const float*)(a->ws + WS_SCAL) + l * 64;
  const float dec = expf(SC[4 + dir * 6 + hh] * 128.0f);
  const size_t base = (size_t)(hh * 2 + dir) * 2048 + idx; const size_t cs = (size_t)6 * 2 * 2048;
  const float tc0 = T[base + 128 * cs], tc1 = T[base + 129 * cs];
  float tv[128];
#pragma unroll
  for (int i = 0; i < 128; ++i) tv[i] = T[base + (size_t)i * cs];
  if (dir == 0) {
    float s = tc0 * dec + tc1; S[base + 128 * cs] = 0.f; S[base + 129 * cs] = tc0;
#pragma unroll
    for (int i = 0; i < 128; ++i) { S[base + (size_t)i * cs] = s; s = s * dec + tv[i]; }
  } else {
    float s = tc0 + dec * tc1; S[base + 129 * cs] = 0.f; S[base + 128 * cs] = tc1;
#pragma unroll
    for (int i = 127; i >= 0; --i) { S[base + (size_t)i * cs] = s; s = s * dec + tv[i]; }
  }
}
DI void ret_out(int WV, KArgs a, int l, unsigned char* smem) {
  const int tid = ltid(), lane = tid & 63, wave = tid >> 6, r31 = lane & 31, h = lane >> 5, jb = wave & 3, vh = wave >> 2;
  const bf16_t* PB = (const bf16_t*)(a->ws + WS_PB); bf16_t* BR = (bf16_t*)(a->ws + WS_BR); const float* Sg = (const float*)(a->ws + WS_S);
  const float* SC = (const float*)(a->ws + WS_SCAL) + l * 64;
  bf16_t* Kl = (bf16_t*)smem;
  bf16_t* Vt = Kl + 128 * 40;
  bf16_t* SfT = Vt + 64 * 136;
  bf16_t* SbT = SfT + 64 * 40;
  float* pwf = (float*)(SbT + 64 * 40);
  float* pwb = pwf + 128;
  float* ssq = pwb + 128;
  for (int it = lbid(); it < 130 * 6; it += lnb()) {
    const int ci = it / 6, hh = it % 6, r0 = chunk_row0(ci);
    const float lgf = SC[4 + hh], lgb = SC[10 + hh];
    __syncthreads();
    { const int row = tid >> 2, seg = tid & 3; *(bf16x8*)(Kl + row * 40 + seg * 8) = *(const bf16x8*)(PB + (size_t)(r0 + row) * NPB_ + C_RK + hh * 32 + seg * 8); }
#pragma unroll
    for (int q = 0; q < 2; ++q) { const int id = tid + 512 * q, row = id >> 3, seg = id & 7; const bf16x8 v = *(const bf16x8*)(PB + (size_t)(r0 + row) * NPB_ + C_RV + hh * 64 + seg * 8);
#pragma unroll
      for (int e = 0; e < 8; ++e) Vt[(seg * 8 + e) * 136 + (row ^ (seg << 3))] = (bf16_t)v[e]; }
#pragma unroll
    for (int q = 0; q < 8; ++q) { const int e = tid + 512 * q, dir = e >> 11, idx = e & 2047, d = idx >> 6, v = idx & 63;
      const float sv = Sg[((size_t)(ci * 6 + hh) * 2 + dir) * 2048 + idx]; (dir ? SbT : SfT)[v * 40 + d] = f2bf(sv); }
    if (tid < 128) { pwf[tid] = expf(lgf * (float)tid); pwb[tid] = expf(lgb * (float)tid); }
    const int qrow = r0 + 32 * jb + r31, j = 32 * jb + r31;
    bf16x8 qf[2];
#pragma unroll
    for (int s = 0; s < 2; ++s) qf[s] = *(const bf16x8*)(PB + (size_t)qrow * NPB_ + C_RQ + hh * 32 + 16 * s + 8 * h);
    __syncthreads();
    f32x16 O; for (int i = 0; i < 16; ++i) O[i] = 0.f;
#pragma unroll
    for (int kb = 0; kb < 4; ++kb) {
      f32x16 St; for (int i = 0; i < 16; ++i) St[i] = 0.f;
#pragma unroll
      for (int s = 0; s < 2; ++s) { const bf16x8 kf = *(const bf16x8*)(Kl + (32 * kb + r31) * 40 + 16 * s + 8 * h); St = MFMA32(kf, qf[s], St); }
#pragma unroll
      for (int i = 0; i < 16; ++i) { const int jp = 32 * kb + crow(i, h); const int dl = j - jp; const float dv = dl > 0 ? pwf[dl] : (dl < 0 ? pwb[-dl] : 2.0f); St[i] *= dv; }
#pragma unroll
      for (int s = 0; s < 2; ++s) {
        const bf16x8 pb = pack_step(St, s);
        const bf16_t* vrow = Vt + (32 * vh + r31) * 136; const int px_ = ((4 * vh + (r31 >> 3)) & 7) << 3, p0_ = 32 * kb + 16 * s + 4 * h;
        const s16x4 lo = *(const s16x4*)(vrow + (p0_ ^ px_)), hi = *(const s16x4*)(vrow + ((p0_ + 8) ^ px_));
        const bf16x8 vf = __builtin_shufflevector(lo, hi, 0, 1, 2, 3, 4, 5, 6, 7);
        O = MFMA32(vf, pb, O);
      }
    }
    f32x16 Of, Ob; for (int i = 0; i < 16; ++i) { Of[i] = 0.f; Ob[i] = 0.f; }
#pragma unroll
    for (int s = 0; s < 2; ++s) {
      const bf16x8 sf = *(const bf16x8*)(SfT + (32 * vh + r31) * 40 + 16 * s + 8 * h), sb = *(const bf16x8*)(SbT + (32 * vh + r31) * 40 + 16 * s + 8 * h);
      Of = MFMA32(sf, qf[s], Of); Ob = MFMA32(sb, qf[s], Ob);
    }
    const float qdf = expf(lgf * (float)(j + 1)), qdb = expf(lgb * (float)(128 - j));
    float ss = 0.f;
#pragma unroll
    for (int i = 0; i < 16; ++i) { O[i] = O[i] + Of[i] * qdf + Ob[i] * qdb; ss += O[i] * O[i]; }
    ss += shx(ss, 32, lane_id_v());
    if (h == 0) ssq[vh * 128 + j] = ss;
    __syncthreads();
    const float rstd = rsqrtf((ssq[j] + ssq[128 + j]) * (1.0f / 64.0f) + EPS_);
#pragma unroll
    for (int g4 = 0; g4 < 4; ++g4) {
      const int v0 = 32 * vh + 8 * g4 + 4 * h;
      const u32x2 gw = *(const u32x2*)(PB + (size_t)qrow * NPB_ + C_RG + hh * 64 + v0);
      const float g0 = bf2f(gw.x & 0xffffu), g1 = bf2f(gw.x >> 16), g2 = bf2f(gw.y & 0xffffu), g3 = bf2f(gw.y >> 16);
      u32x2 w; w.x = cvt_pk_bf16(O[4 * g4] * rstd * g0, O[4 * g4 + 1] * rstd * g1); w.y = cvt_pk_bf16(O[4 * g4 + 2] * rstd * g2, O[4 * g4 + 3] * rstd * g3);
      *(u32x2*)(BR + (size_t)qrow * 1024 + 256 + hh * 64 + v0) = w;
    }
  }
}
constexpr int AT_LD = 72;
typedef __bf16 bf16x2_t __attribute__((ext_vector_type(2)));
typedef float f32x2_t __attribute__((ext_vector_type(2)));
DI unsigned cvt2(float a, float b) { f32x2_t v = {a, b}; return __builtin_bit_cast(unsigned, __builtin_convertvector(v, bf16x2_t)); }
template <int VAR> DI void attn_phase(int WV, KArgs a, int l, bool with_ctx, unsigned char* smem) {
  const int tid = ltid(), lane = tid & 63, wave = tid >> 6, r31 = lane & 31, h = lane >> 5, qsub = wave & 3, kh = wave >> 2;
  const bf16_t* PB = (const bf16_t*)(a->ws + WS_PB); bf16_t* BR = (bf16_t*)(a->ws + (VAR == 0 ? WS_BR : WS_H));
  const float* SC = (const float*)(a->ws + WS_SCAL) + l * 64;
  const float lam = SC[0], lam_init = SC[1];
  bf16_t* Ks = (bf16_t*)smem;
  bf16_t* Vt = Ks + 2 * 64 * AT_LD;
  float* cmb = (float*)(Vt + 2 * 64 * AT_LD);
  const int nitems = 6 * 128 + (with_ctx ? 12 : 0);
  const int skey = tid >> 3, sseg = tid & 7;
  for (int it = lbid(); it < nitems; it += lnb()) {
    int head, q0, krow0, nt;
    if (it < 768) { head = (it >> 8) * 2 + (it & 1); q0 = ((it & 255) >> 1) * 128; krow0 = 0; nt = MT_ / 64; }
    else { const int e = it - 768; head = e >> 1; q0 = L_ + (e & 1) * 128; krow0 = L_; nt = LC_ / 64; }
    const int qrow = q0 + 32 * qsub + r31;
    bf16x8 qf[2][2];
#pragma unroll
    for (int mp = 0; mp < 2; ++mp)
#pragma unroll
      for (int s = 0; s < 2; ++s) qf[mp][s] = *(const bf16x8*)(PB + (size_t)qrow * NPB_ + C_DQ + head * 64 + mp * 32 + 16 * s + 8 * h);
    float negm = 0.f;
#pragma unroll
    for (int mp = 0; mp < 2; ++mp) {
      float ss = 0.f;
#pragma unroll
      for (int s = 0; s < 2; ++s)
#pragma unroll
        for (int e = 0; e < 8; ++e) { const float x = bf2f((unsigned)(unsigned short)qf[mp][s][e]); ss += x * x; }
      ss += shx(ss, 32, lane_id_v());
      const float kmx = __uint_as_float(((const unsigned*)SC)[16 + head * 2 + mp]);
      negm = fminf(negm, -sqrtf(ss * kmx) * 1.01f);
    }
    f32x16 NM; for (int i = 0; i < 16; ++i) NM[i] = negm;
    f32x16 O1[2], O2[2]; for (int i = 0; i < 16; ++i) { O1[0][i] = 0.f; O1[1][i] = 0.f; O2[0][i] = 0.f; O2[1][i] = 0.f; }
    f32x4 LA = {0.f, 0.f, 0.f, 0.f}, LB = {0.f, 0.f, 0.f, 0.f};
    bf16x8 osel; { const bool on = ((lane & 15) == 0 && ((lane >> 4) & 1) == 0) || ((lane & 15) == 1 && ((lane >> 4) & 1) == 1);
      for (int e = 0; e < 8; ++e) osel[e] = on ? (short)0x3F80 : (short)0; }
#define MFMA16(a_, b_, c_) __builtin_amdgcn_mfma_f32_16x16x32_bf16((a_), (b_), (c_), 0, 0, 0)
    const bf16_t* kg = PB + (size_t)(krow0 + skey) * NPB_ + C_DK + head * 64 + sseg * 8;
    const bf16_t* vg = PB + (size_t)(krow0 + skey) * NPB_ + C_DV + head * 64 + sseg * 8;
    const int vslot = ((skey & ~12) | ((skey & 4) << 1) | ((skey & 8) >> 1)) ^ (sseg << 3);
    __syncthreads();
    bf16x8 kA = *(const bf16x8*)kg, vA = *(const bf16x8*)vg;
    bf16x8 kB = *(const bf16x8*)(kg + (size_t)64 * NPB_), vB = *(const bf16x8*)(vg + (size_t)64 * NPB_);
    { *(bf16x8*)(Ks + skey * AT_LD + sseg * 8) = kA;
#pragma unroll
      for (int e = 0; e < 8; ++e) Vt[(sseg * 8 + e) * AT_LD + vslot] = (bf16_t)vA[e]; }
    __syncthreads();
    for (int t = 0; t < nt; ++t) {
      const int buf = t & 1;
      const bf16_t* ks = Ks + buf * 64 * AT_LD + (32 * kh + r31) * AT_LD + 8 * h;
      const bf16_t* vt = Vt + buf * 64 * AT_LD + r31 * AT_LD;
      const bf16x8 k00 = *(const bf16x8*)(ks), k01 = *(const bf16x8*)(ks + 16), k10 = *(const bf16x8*)(ks + 32), k11 = *(const bf16x8*)(ks + 48);
      bf16x8 vf[2][2];
#pragma unroll
      for (int s = 0; s < 2; ++s)
#pragma unroll
        for (int mt = 0; mt < 2; ++mt) vf[mt][s] = *(const bf16x8*)(vt + mt * 32 * AT_LD + (((4 * kh + 2 * s + h) ^ ((4 * mt + (r31 >> 3)) & 7)) << 3));
      f32x16 S1 = MFMA32(k00, qf[0][0], NM); f32x16 S2 = MFMA32(k10, qf[1][0], NM); S1 = MFMA32(k01, qf[0][1], S1); S2 = MFMA32(k11, qf[1][1], S2);
      bf16x8 p1[2], p2[2];
      { u32x4 w0, w1;
#pragma unroll
        for (int i = 0; i < 4; ++i) { w0[i] = cvt2(VAR == 1 ? S1[2 * i] * 0.001f : __builtin_amdgcn_exp2f(S1[2 * i]), VAR == 1 ? S1[2 * i + 1] * 0.001f : __builtin_amdgcn_exp2f(S1[2 * i + 1]));
                                       w1[i] = cvt2(VAR == 1 ? S1[8 + 2 * i] * 0.001f : __builtin_amdgcn_exp2f(S1[8 + 2 * i]), VAR == 1 ? S1[9 + 2 * i] * 0.001f : __builtin_amdgcn_exp2f(S1[9 + 2 * i])); }
        p1[0] = __builtin_bit_cast(bf16x8, w0); p1[1] = __builtin_bit_cast(bf16x8, w1); }
      O1[0] = MFMA32(vf[0][0], p1[0], O1[0]); O1[1] = MFMA32(vf[1][0], p1[0], O1[1]); LA = MFMA16(osel, p1[0], LA);
      O1[0] = MFMA32(vf[0][1], p1[1], O1[0]); O1[1] = MFMA32(vf[1][1], p1[1], O1[1]); LA = MFMA16(osel, p1[1], LA);
      { u32x4 w0, w1;
#pragma unroll
        for (int i = 0; i < 4; ++i) { w0[i] = cvt2(VAR == 1 ? S2[2 * i] * 0.001f : __builtin_amdgcn_exp2f(S2[2 * i]), VAR == 1 ? S2[2 * i + 1] * 0.001f : __builtin_amdgcn_exp2f(S2[2 * i + 1]));
                                       w1[i] = cvt2(VAR == 1 ? S2[8 + 2 * i] * 0.001f : __builtin_amdgcn_exp2f(S2[8 + 2 * i]), VAR == 1 ? S2[9 + 2 * i] * 0.001f : __builtin_amdgcn_exp2f(S2[9 + 2 * i])); }
        p2[0] = __builtin_bit_cast(bf16x8, w0); p2[1] = __builtin_bit_cast(bf16x8, w1); }
      if (VAR != 5) {
      O2[0] = MFMA32(vf[0][0], p2[0], O2[0]); O2[1] = MFMA32(vf[1][0], p2[0], O2[1]); LB = MFMA16(osel, p2[0], LB);
      O2[0] = MFMA32(vf[0][1], p2[1], O2[0]); O2[1] = MFMA32(vf[1][1], p2[1], O2[1]); LB = MFMA16(osel, p2[1], LB); }
      __builtin_amdgcn_iglp_opt(2);
      { const int nb_ = buf ^ 1;
        *(bf16x8*)(Ks + nb_ * 64 * AT_LD + skey * AT_LD + sseg * 8) = kB;
#pragma unroll
        for (int e = 0; e < 8; ++e) Vt[nb_ * 64 * AT_LD + (sseg * 8 + e) * AT_LD + vslot] = (bf16_t)vB[e];
        const int tl_ = (t + 2 < nt) ? t + 2 : nt - 1;
        kB = *(const bf16x8*)(kg + (size_t)tl_ * 64 * NPB_); vB = *(const bf16x8*)(vg + (size_t)tl_ * 64 * NPB_); }
      __syncthreads();
    }
    float* cw = cmb + (size_t)(qsub * 64 + lane) * 66;
    const int sl_ = ((lane & 15) << 2);
    const float a0_ = __int_as_float(__builtin_amdgcn_ds_bpermute(sl_, __float_as_int(LA[0]))), a1_ = __int_as_float(__builtin_amdgcn_ds_bpermute(sl_, __float_as_int(LA[1])));
    const float b0_ = __int_as_float(__builtin_amdgcn_ds_bpermute(sl_, __float_as_int(LB[0]))), b1_ = __int_as_float(__builtin_amdgcn_ds_bpermute(sl_, __float_as_int(LB[1])));
    const float lq1 = (r31 >> 4) ? a1_ : a0_, lq2 = (r31 >> 4) ? b1_ : b0_;
    if (kh == 1) {
#pragma unroll
      for (int i = 0; i < 16; ++i) { cw[i] = O1[0][i]; cw[16 + i] = O1[1][i]; cw[32 + i] = O2[0][i]; cw[48 + i] = O2[1][i]; }
      cw[64] = lq1; cw[65] = lq2;
    }
    __syncthreads();
    if (kh == 0) {
#pragma unroll
      for (int i = 0; i < 16; ++i) { O1[0][i] += cw[i]; O1[1][i] += cw[16 + i]; O2[0][i] += cw[32 + i]; O2[1][i] += cw[48 + i]; }
      const float l1 = lq1 + cw[64], l2 = lq2 + cw[65];
      const float i1 = 1.0f / l1, i2 = lam / l2;
      float ss = 0.f;
#pragma unroll
      for (int mt = 0; mt < 2; ++mt)
#pragma unroll
        for (int i = 0; i < 16; ++i) { const float o = O1[mt][i] * i1 - O2[mt][i] * i2; O1[mt][i] = o; ss += o * o; }
      ss += shx(ss, 32, lane_id_v());
      const float sc = rsqrtf(ss * (1.0f / 64.0f) + EPS_) * (1.0f - lam_init);
      const float* sw = a->in[13] + l * 64;
#pragma unroll
      for (int mt = 0; mt < 2; ++mt)
#pragma unroll
        for (int g4 = 0; g4 < 4; ++g4) {
          const int v0 = 32 * mt + 8 * g4 + 4 * h;
          const f32x4 wv = *(const f32x4*)(sw + v0);
          u32x2 w; w.x = cvt_pk_bf16(O1[mt][4 * g4] * sc * wv[0], O1[mt][4 * g4 + 1] * sc * wv[1]); w.y = cvt_pk_bf16(O1[mt][4 * g4 + 2] * sc * wv[2], O1[mt][4 * g4 + 3] * sc * wv[3]);
          *(u32x2*)(BR + (size_t)qrow * 1024 + 640 + head * 64 + v0) = w;
        }
    }
  }
}
template <class Epi> DI void run_gemm(int WV, LAS unsigned char* lds, const bf16_t* A, int lda, const bf16_t* Bt, int M, int N, int K, const Epi& E) {
  pg8::Gemm g; g.A = A; g.Bt = Bt; g.M = M; g.N = N; g.K = K; g.lda = lda;
  pg8::StaticOrder S; S.init(M, N, lnb(), lbid());
  pg8::gemm_phase<Epi, pg8::StaticOrder, false>(WV, lds, g, S, E, nullptr);
}
struct EpiNull { static constexpr bool PERM = false, AFTER_DRAIN = false; float* U;
  DI void operator()(const f32x4 (&acc)[2][2][4][2], const Unit& u, int wr, int wc, int fr_, int fq_) const {
    f32x4 s = {0.f, 0.f, 0.f, 0.f};
#pragma unroll
    for (int ai = 0; ai < 2; ++ai) for (int bj = 0; bj < 2; ++bj) for (int m = 0; m < 4; ++m) for (int n = 0; n < 2; ++n) s += acc[ai][bj][m][n];
    if (s[0] == 123.456f) U[lane_id_v()] = s[1] + s[2] + s[3]; } };
struct CtxMerge0 { float* MXC; const bf16_t* G; DI void operator()(int r, int c, float v) const { MXC[r * 1024 + c] = bf2f(G[(size_t)r * NGB_ + c]) * v; } };
struct CtxMerge1 { float* MXC; const bf16_t* G; DI void operator()(int r, int c, float v) const { MXC[r * 1024 + c] += bf2f(G[(size_t)r * NGB_ + c]) * v; } };
struct CtxMerge2 { const float* MXC; const bf16_t* G; bf16_t* Hc; DI void operator()(int r, int c, float v) const { Hc[r * 1024 + c] = f2bf(MXC[r * 1024 + c] + bf2f(G[(size_t)r * NGB_ + c]) * v); } };
struct CtxResid { float* Xc; const float* gate; float scale; DI void operator()(int r, int c, float v) const { Xc[r * 1024 + c] += scale * gate[c] * v; } };

DI void phase_win(int WV, int l, unsigned char* smem) {
  KArgs a = kargs(); unsigned char* ws = a->ws;
  EpiWin E; E.PB = (bf16_t*)(ws + WS_PB); E.GB = (bf16_t*)(ws + WS_GB); E.TRET = (const float*)(ws + WS_TRET); E.TROW = (const float*)(ws + WS_TROW); E.TCOL = (const float*)(ws + WS_TCOL);
  E.kmax = (unsigned*)(ws + WS_SCAL) + l * 64 + 16;
  run_gemm(WV, (LAS unsigned char*)smem, (const bf16_t*)(ws + WS_H), 1024, (const bf16_t*)(ws + WS_WIN) + (size_t)l * 5888 * 1024, MT_, NWIN_, 1024, E);
}
DI void phase_merge(int WV, int l, unsigned char* smem) {
  LAS unsigned char* lds = (LAS unsigned char*)smem;
  { KArgs a = kargs(); unsigned char* ws = a->ws; EpiMerge<0> E; E.MX = (bf16_t*)a->out; E.G = (const bf16_t*)(ws + WS_GB); E.Hout = (bf16_t*)(ws + WS_H);
    run_gemm(WV, lds, (const bf16_t*)(ws + WS_BR), 1024, (const bf16_t*)(ws + WS_WBF) + (size_t)l * 1024 * 256, L_, 1024, 256, E); }
  { KArgs a = kargs(); unsigned char* ws = a->ws; EpiMerge<1> E; E.MX = (bf16_t*)a->out; E.G = (const bf16_t*)(ws + WS_GB) + 1024; E.Hout = (bf16_t*)(ws + WS_H);
    run_gemm(WV, lds, (const bf16_t*)(ws + WS_BR) + 256, 1024, (const bf16_t*)(ws + WS_WBR) + (size_t)l * 1024 * 384, L_, 1024, 384, E); }
  { KArgs a = kargs(); unsigned char* ws = a->ws; EpiMerge<2> E; E.MX = (bf16_t*)a->out; E.G = (const bf16_t*)(ws + WS_GB) + 2048; E.Hout = (bf16_t*)(ws + WS_H);
    run_gemm(WV, lds, (const bf16_t*)(ws + WS_BR) + 640, 1024, (const bf16_t*)(ws + WS_WBD) + (size_t)l * 1024 * 384, L_, 1024, 384, E); }
  { KArgs a = kargs(); unsigned char* ws = a->ws;
    const bf16_t* BRc = (const bf16_t*)(ws + WS_BR) + (size_t)L_ * 1024; const bf16_t* GBc = (const bf16_t*)(ws + WS_GB) + (size_t)L_ * NGB_;
    CtxMerge0 e0; e0.MXC = (float*)(ws + WS_MXC); e0.G = GBc;
    ctx_gemm32(WV, BRc, 1024, (const bf16_t*)(ws + WS_WBF) + (size_t)l * 1024 * 256, 256, 1024, smem, e0);
    CtxMerge1 e1; e1.MXC = (float*)(ws + WS_MXC); e1.G = GBc + 1024;
    ctx_gemm32(WV, BRc + 256, 1024, (const bf16_t*)(ws + WS_WBR) + (size_t)l * 1024 * 384, 384, 1024, smem, e1);
    CtxMerge2 e2; e2.MXC = (const float*)(ws + WS_MXC); e2.G = GBc + 2048; e2.Hc = (bf16_t*)(ws + WS_H) + (size_t)L_ * 1024;
    ctx_gemm32(WV, BRc + 640, 1024, (const bf16_t*)(ws + WS_WBD) + (size_t)l * 1024 * 384, 384, 1024, smem, e2); }
}
DI void phase_wo(int WV, int l, unsigned char* smem) {
  { KArgs a = kargs(); unsigned char* ws = a->ws; EpiResid E; E.X = (float*)(ws + WS_X); E.gate = (const float*)(ws + WS_MOD) + (size_t)l * 9216 + 5 * 1024; E.scale = 1.0f;
    run_gemm(WV, (LAS unsigned char*)smem, (const bf16_t*)(ws + WS_H), 1024, (const bf16_t*)(ws + WS_WO) + (size_t)l * 1024 * 1024, L_, 1024, 1024, E); }
  { KArgs a = kargs(); unsigned char* ws = a->ws; CtxResid e; e.Xc = (float*)(ws + WS_X) + (size_t)L_ * 1024; e.gate = (const float*)(ws + WS_MOD) + (size_t)(4 + l) * 9216 + 5 * 1024; e.scale = 1.0f;
    ctx_gemm32(WV, (const bf16_t*)(ws + WS_H) + (size_t)L_ * 1024, 1024, (const bf16_t*)(ws + WS_WO) + (size_t)l * 1024 * 1024, 1024, 1024, smem, e); }
}
DI void phase_g1(int WV, int l, int f, unsigned char* smem) {
  KArgs a = kargs(); unsigned char* ws = a->ws; EpiSwiglu E; E.U = (bf16_t*)(ws + WS_U);
  run_gemm(WV, (LAS unsigned char*)smem, (const bf16_t*)(ws + WS_H), 1024, (const bf16_t*)(ws + WS_W13) + (size_t)(l * 2 + f) * 5632 * 1024, MT_, 5632, 1024, E);
}
DI void phase_g2(int WV, int l, int f, unsigned char* smem) {
  const int gi = f == 0 ? 2 : 8;
  { KArgs a = kargs(); unsigned char* ws = a->ws; EpiResid E; E.X = (float*)(ws + WS_X); E.gate = (const float*)(ws + WS_MOD) + (size_t)l * 9216 + gi * 1024; E.scale = 0.5f;
    run_gemm(WV, (LAS unsigned char*)smem, (const bf16_t*)(ws + WS_U), 2816, (const bf16_t*)(ws + WS_W2) + (size_t)(l * 2 + f) * 1024 * 2816, L_, 1024, 2816, E); }
  { KArgs a = kargs(); unsigned char* ws = a->ws; CtxResid e; e.Xc = (float*)(ws + WS_X) + (size_t)L_ * 1024; e.gate = (const float*)(ws + WS_MOD) + (size_t)(4 + l) * 9216 + gi * 1024; e.scale = 0.5f;
    ctx_gemm32(WV, (const bf16_t*)(ws + WS_U) + (size_t)L_ * 2816, 2816, (const bf16_t*)(ws + WS_W2) + (size_t)(l * 2 + f) * 1024 * 2816, 2816, 1024, smem, e); }
}

DI unsigned xcc_id() { return (unsigned)__builtin_amdgcn_s_getreg((3 << 11) | 20) & 0xFu; }
DI void grid_bar(int WV, unsigned& gen, unsigned xcc, unsigned nloc, unsigned nx) {
  asm volatile("s_waitcnt vmcnt(0)" ::: "memory");
  __syncthreads();
  gen += 1;
  if (ltid() == 0) {
    unsigned* bar = (unsigned*)(kargs()->ws + WS_BAR);
    const unsigned old = __hip_atomic_fetch_add(bar + 320 + 16 * xcc, 1u, __ATOMIC_RELAXED, __HIP_MEMORY_SCOPE_AGENT);
    if (old + 1u == gen * nloc) {
      __builtin_amdgcn_fence(__ATOMIC_RELEASE, "agent");
      asm volatile("s_waitcnt vmcnt(0)" ::: "memory");
      __hip_atomic_fetch_add(bar + 640, 1u, __ATOMIC_RELAXED, __HIP_MEMORY_SCOPE_AGENT);
    }
    const unsigned target = gen * nx;
    while (__hip_atomic_load(bar + 640, __ATOMIC_RELAXED, __HIP_MEMORY_SCOPE_AGENT) < target) __builtin_amdgcn_s_sleep(1);
    __builtin_amdgcn_fence(__ATOMIC_ACQUIRE, "agent");
    asm volatile("s_waitcnt vmcnt(0)" ::: "memory");
  }
  __syncthreads();
}

__global__ void __launch_bounds__(512, 2) mega(Args a_unused) {
  extern __shared__ __attribute__((aligned(16))) unsigned char smem[];
  cg::grid_group grid = cg::this_grid();
  const int WV = __builtin_amdgcn_readfirstlane((int)(threadIdx.x >> 6));
  const unsigned xcc = xcc_id();
  if (threadIdx.x == 0) __hip_atomic_fetch_add((unsigned*)(kargs()->ws + WS_BAR) + 16 + 16 * xcc, 1u, __ATOMIC_RELAXED, __HIP_MEMORY_SCOPE_AGENT);
#ifndef NO_PRO
  prologue(WV, kargs(), smem);
#ifdef PROBE_PRO
  __syncthreads(); prologue(WV, kargs(), smem);
#endif
#endif
  grid.sync();
  unsigned gen = 0, nloc = 1, nx = 0;
  { const unsigned* cen = (const unsigned*)(kargs()->ws + WS_BAR) + 16;
    for (int j = 0; j < 16; ++j) { const unsigned cj = __hip_atomic_load(cen + 16 * j, __ATOMIC_RELAXED, __HIP_MEMORY_SCOPE_AGENT); nx += cj ? 1u : 0u; if ((unsigned)j == xcc) nloc = cj; }
    nloc = __builtin_amdgcn_readfirstlane(nloc); nx = __builtin_amdgcn_readfirstlane(nx); }
#pragma unroll 1
  for (int l = 0; l < DEPTH_; ++l) {
#pragma unroll 1
    for (int f = 0; f < 2; ++f) {
      if (f == 1) {
        norm_phase(WV, kargs(), l, 1, false);
        grid_bar(WV, gen, xcc, nloc, nx);
        phase_win(WV, l, smem);
#ifdef PROBE_WIN
        phase_win(WV, l, smem);
#endif
        grid_bar(WV, gen, xcc, nloc, nx);
#ifndef NO_MIXA
        fourier_tables(WV, smem); __syncthreads(); fourier_stage1(WV, kargs(), smem); fourier_ctx(WV, kargs(), smem); __syncthreads(); ret_states(WV, kargs(), l, smem);
#ifdef PROBE_MIXA
        __syncthreads();
        fourier_tables(WV, smem); __syncthreads(); fourier_stage1(WV, kargs(), smem); fourier_ctx(WV, kargs(), smem); __syncthreads(); ret_states(WV, kargs(), l, smem);
#endif
#endif
        grid_bar(WV, gen, xcc, nloc, nx);
#ifndef NO_MIXB
        ret_scan(WV, kargs(), l); __syncthreads(); fourier_tables(WV, smem); __syncthreads(); fourier_stage2(WV, kargs(), smem);
#ifdef PROBE_MIXB
        __syncthreads();
        ret_scan(WV, kargs(), l); __syncthreads(); fourier_tables(WV, smem); __syncthreads(); fourier_stage2(WV, kargs(), smem);
#endif
#endif
        grid_bar(WV, gen, xcc, nloc, nx);
#ifndef NO_RETOUT
        ret_out(WV, kargs(), l, smem); __syncthreads();
#ifdef PROBE_RET
        ret_out(WV, kargs(), l, smem); __syncthreads();
#endif
#endif
#ifndef NO_ATTN
        attn_phase<0>(WV, kargs(), l, l < DEPTH_ - 1, smem);
#ifdef PROBE_ATTN
        __syncthreads(); attn_phase<PROBE_ATTN>(WV, kargs(), l, l < DEPTH_ - 1, smem);
#endif
#endif
        grid_bar(WV, gen, xcc, nloc, nx);
        phase_merge(WV, l, smem);
#ifdef PROBE_MERGE
        phase_merge(WV, l, smem);
#endif
        grid_bar(WV, gen, xcc, nloc, nx);
        phase_wo(WV, l, smem);
        grid_bar(WV, gen, xcc, nloc, nx);
      }
      norm_phase(WV, kargs(), l, f == 0 ? 0 : 2, l == 0 && f == 0);
      grid_bar(WV, gen, xcc, nloc, nx);
      phase_g1(WV, l, f, smem);
#ifdef PROBE_G1
      phase_g1(WV, l, f, smem);
#endif
#ifdef PROBE_G1NULL
      { KArgs a = kargs(); unsigned char* ws = a->ws; EpiNull E; E.U = (float*)a->out;
        run_gemm(WV, (LAS unsigned char*)smem, (const bf16_t*)(ws + WS_H), 1024, (const bf16_t*)(ws + WS_W13) + (size_t)(l * 2 + f) * 5632 * 1024, MT_, 5632, 1024, E); }
#endif
      grid_bar(WV, gen, xcc, nloc, nx);
      phase_g2(WV, l, f, smem);
      grid_bar(WV, gen, xcc, nloc, nx);
    }
  }
  final_norm(WV, kargs());
}

extern "C" void kernel_launch(void* const* d_in, const int* in_sizes, int n_in, void* d_out, int out_size, void* d_ws, size_t ws_size, hipStream_t stream) {
  static int grid = 0;
  if (grid == 0) {
    int dev = 0, cus = 0, per_cu = 0;
    (void)hipGetDevice(&dev); (void)hipDeviceGetAttribute(&cus, hipDeviceAttributeMultiprocessorCount, dev);
    if (hipFuncSetAttribute((const void*)mega, hipFuncAttributeMaxDynamicSharedMemorySize, LDS_BYTES) != hipSuccess) fprintf(stderr, "kernel_launch: hipFuncSetAttribute failed\n");
    if (hipOccupancyMaxActiveBlocksPerMultiprocessor(&per_cu, (const void*)mega, 512, LDS_BYTES) != hipSuccess || per_cu < 1) fprintf(stderr, "kernel_launch: occupancy query says %d blocks per CU\n", per_cu);
    (void)hipGetLastError();
    grid = cus > 0 ? cus : 256;
    if (ws_size < WS_END) { fprintf(stderr, "kernel_launch: workspace too small: %zu < %zu\n", ws_size, (size_t)WS_END); }
  }
  Args a{};
  for (int i = 0; i < 19; ++i) a.in[i] = (const float*)d_in[i];
  a.out = (float*)d_out; a.ws = (unsigned char*)d_ws;
  (void)hipMemsetAsync((unsigned char*)d_ws + WS_BAR, 0, 8192, stream);
  void* args[] = {&a};
  hipError_t e = hipLaunchCooperativeKernel((const void*)mega, dim3(grid), dim3(512), args, LDS_BYTES, stream);
  if (e != hipSuccess) fprintf(stderr, "kernel_launch: cooperative launch failed: %s (grid %d)\n", hipGetErrorString(e), grid);
}
```

```cpp
#include <hip/hip_runtime.h>
#include <hip/hip_cooperative_groups.h>
#include <cstdio>
namespace cg = cooperative_groups;
__device__ __forceinline__ int lane_id_v() { int l; asm volatile("v_mbcnt_lo_u32_b32 %0, -1, 0\n\tv_mbcnt_hi_u32_b32 %0, -1, %0" : "=v"(l)); return l; }
#define ltid() ((WV << 6) | lane_id_v())
__device__ __forceinline__ float shx(float v, int m, int lane) { return __int_as_float(__builtin_amdgcn_ds_bpermute((lane ^ m) << 2, __float_as_int(v))); }
namespace pg8 {
#define PG8_LAS __attribute__((address_space(3)))
typedef unsigned short bf16_t;
typedef short bf16x8 __attribute__((ext_vector_type(8)));
typedef float f32x4 __attribute__((ext_vector_type(4)));
typedef unsigned u32x4 __attribute__((ext_vector_type(4)));
constexpr int BM = 256, BK = 64, HALF = 128, HTB = HALF * BK * 2  , STAGE_BYTES = 8 * HTB, NXCD = 8, WGM = 8;

__host__ __device__ __forceinline__ int lds_byte(int r, int c) { const int st = (r >> 4) * 2 + (c >> 5), rr = r & 15, cc = c & 31, ob = rr * 64 + cc * 2; return st * 1024 + (ob ^ (((ob >> 9) & 1) << 5)); }
__host__ __device__ __forceinline__ void stage_rc(int b, int& R, int& C) { const int st = b / 1024, sb = b % 1024, swz = sb ^ (((sb >> 9) & 1) << 5); R = (st >> 1) * 16 + swz / 64; C = (st & 1) * 32 + (swz % 64) / 2; }
__host__ __device__ __forceinline__ int perm32(int rho) { const int n = rho >> 4, i = rho & 15; return 8 * (i >> 2) + 4 * n + (i & 3); }

struct Unit { int pm, pn; };
struct Gemm { const bf16_t* A; const bf16_t* Bt; int M, N, K, lda; };

struct StaticOrder {
    int nM, nN, nwg, G, c;
    __host__ __device__ void init(int M, int N, int G_, int c_) { nM = M / BM; nN = N / BM; nwg = nM * nN; G = G_; c = c_; }
    __host__ __device__ bool next(int i, Unit& u) const {
        const long L = (long)i * G + c; if (L >= nwg) return false;
        int wgid = (int)L; { const int q = nwg / NXCD, r = nwg % NXCD, xcd = wgid % NXCD, off = wgid / NXCD; wgid = (xcd < r ? xcd * (q + 1) : r * (q + 1) + (xcd - r) * q) + off; }
        const int nig = WGM * nN, gid = wgid / nig, fm = gid * WGM, gsz = (nM - fm) < WGM ? (nM - fm) : WGM;
        u.pm = fm + ((wgid % nig) % gsz); u.pn = (wgid % nig) / gsz; return true;
    }
    __device__ __forceinline__ void a_ready(const Unit&) const {}
    __device__ __forceinline__ void done(const Unit&) const {}
};
__device__ __forceinline__ unsigned cvt_pk_bf16(float lo, float hi) { unsigned r; asm volatile("v_cvt_pk_bf16_f32 %0, %1, %2" : "=v"(r) : "v"(lo), "v"(hi)); return r; }
template <class Epi, class Sched, bool STAMP = false>
__device__ __forceinline__ void gemm_phase(const int WV, PG8_LAS unsigned char* lds, const Gemm g, const Sched& S, const Epi& E, unsigned long long* stamps) {
    const int tid = ltid(); const int wid = __builtin_amdgcn_readfirstlane(tid >> 6), lane = tid & 63, wr = wid >> 2, wc = wid & 3, fr = lane & 15, fq = lane >> 4;
    const int K = g.K, nt = K / BK;
    int ts_lo = 0, ts_hi = 0, nts = 0; const unsigned long long rt_entry = STAMP ? (unsigned long long)wall_clock64() : 0ull;
#define PG8_STAMP() do { if (STAMP && wid == 0 && nts < 64) { const unsigned long long _c = (unsigned long long)clock64(); \
        ts_lo = (lane == nts) ? (int)(unsigned)_c : ts_lo; ts_hi = (lane == nts) ? (int)(unsigned)(_c >> 32) : ts_hi; ++nts; } } while (0)
    PG8_STAMP();
    unsigned voffA[2], voffB[2];
#pragma unroll
    for (int i = 0; i < 2; ++i) { int R, C; stage_rc(tid * 16 + i * 8192, R, C); const int Rb = Epi::PERM ? ((R & ~31) + perm32(R & 31)) : R;
        voffA[i] = (unsigned)(R * g.lda + C) * 2u; voffB[i] = (unsigned)(Rb * K + C) * 2u; }
    const size_t kstep = (size_t)(BK * 2);
    const size_t hstep = (size_t)HALF * K * 2;
    const size_t tstep = 2 * hstep; const size_t hstepA = (size_t)HALF * g.lda * 2; const size_t tstepA = 2 * hstepA;
    const unsigned ldsw = (unsigned)wid * 1024u;
    const int aoff = lds_byte(wr * 64 + fr, fq * 8), boff = lds_byte(wc * 32 + fr, fq * 8);
#define PG8_SA(b, h) (((b) * 2 + (h)) * HTB)
#define PG8_SB(b, h) ((4 + (b) * 2 + (h)) * HTB)
#define PG8_STAGE(bufoff, gbase, voff) do { _Pragma("unroll") for (int _i = 0; _i < 2; ++_i) \
        __builtin_amdgcn_global_load_lds((const unsigned*)((const char*)(gbase) + (voff)[_i]), (PG8_LAS unsigned*)(lds + (bufoff) + ldsw + _i * 8192), 16, 0, 0); } while (0)
#define PG8_LDA(dst, b, h) do { _Pragma("unroll") for (int m = 0; m < 4; ++m) _Pragma("unroll") for (int k = 0; k < 2; ++k) dst[m][k] = *(const PG8_LAS bf16x8*)(lds + PG8_SA(b, h) + aoff + m * 2048 + k * 1024); } while (0)
#define PG8_LDB(dst, b, h) do { _Pragma("unroll") for (int n = 0; n < 2; ++n) _Pragma("unroll") for (int k = 0; k < 2; ++k) dst[n][k] = *(const PG8_LAS bf16x8*)(lds + PG8_SB(b, h) + boff + n * 2048 + k * 1024); } while (0)
#define PG8_MMA(ai, bj, At, Bt) do { __builtin_amdgcn_s_setprio(1); _Pragma("unroll") for (int m = 0; m < 4; ++m) _Pragma("unroll") for (int n = 0; n < 2; ++n) _Pragma("unroll") for (int k = 0; k < 2; ++k) \
        acc[ai][bj][m][n] = __builtin_amdgcn_mfma_f32_16x16x32_bf16(Bt[n][k], At[m][k], acc[ai][bj][m][n], 0, 0, 0); __builtin_amdgcn_s_setprio(0); } while (0)
#define PG8_WAIT_V(n) asm volatile("s_waitcnt vmcnt(" #n ")" ::: "memory")
#define PG8_WAIT_L(n) asm volatile("s_waitcnt lgkmcnt(" #n ")" ::: "memory")
#define PG8_BAR __builtin_amdgcn_s_barrier()
#define PG8_SCHED __builtin_amdgcn_sched_barrier(0)
    Unit cur, nxt; int ui = 0;
    if (!S.next(0, cur)) return;
    f32x4 acc[2][2][4][2];
#pragma unroll
    for (int a = 0; a < 2; ++a)
#pragma unroll
        for (int b = 0; b < 2; ++b)
#pragma unroll
            for (int m = 0; m < 4; ++m)
#pragma unroll
                for (int n = 0; n < 2; ++n) acc[a][b][m][n] = (f32x4){0.f, 0.f, 0.f, 0.f};
    bf16x8 At[4][2], B0[2][2], B1[2][2];
    const char* cA = (const char*)g.A + (size_t)cur.pm * tstepA; const char* cB = (const char*)g.Bt + (size_t)cur.pn * tstep;
    S.a_ready(cur);
    PG8_STAGE(PG8_SB(0, 0), cB, voffB); PG8_STAGE(PG8_SA(0, 0), cA, voffA); PG8_STAGE(PG8_SB(0, 1), cB + hstep, voffB); PG8_STAGE(PG8_SA(0, 1), cA + hstepA, voffA);
    if (wr == 1) PG8_BAR;
    PG8_WAIT_V(4); PG8_BAR;
    PG8_STAGE(PG8_SB(1, 0), cB + kstep, voffB); PG8_STAGE(PG8_SA(1, 0), cA + kstep, voffA); PG8_STAGE(PG8_SB(1, 1), cB + hstep + kstep, voffB);
    PG8_WAIT_V(6); PG8_BAR;
    PG8_STAMP();
    for (;;) {
        const bool has_next = S.next(ui + 1, nxt);
        const char* nA = has_next ? (const char*)g.A + (size_t)nxt.pm * tstepA : cA; const char* nB = has_next ? (const char*)g.Bt + (size_t)nxt.pn * tstep : cB;
        for (int t = 0; t < nt; t += 2) {
            const bool last = (t == nt - 2);
            const char* a1 = cA + (size_t)(t + 1) * kstep;
            const char* a2 = last ? nA : cA + (size_t)(t + 2) * kstep; const char* b2 = last ? nB : cB + (size_t)(t + 2) * kstep;
            const char* a3 = a2 + kstep; const char* b3 = b2 + kstep;
            if (last && has_next) S.a_ready(nxt);
            PG8_LDB(B0, 0, 0); PG8_SCHED; PG8_LDA(At, 0, 0); PG8_STAGE(PG8_SA(1, 1), a1 + hstepA, voffA);
            PG8_WAIT_L(8); PG8_BAR; PG8_WAIT_L(0); PG8_MMA(0, 0, At, B0); PG8_BAR; PG8_SCHED;
            PG8_LDB(B1, 0, 1); PG8_STAGE(PG8_SB(0, 0), b2, voffB);
            PG8_BAR; PG8_WAIT_L(0); PG8_MMA(0, 1, At, B1); PG8_BAR;
            PG8_LDA(At, 0, 1); PG8_STAGE(PG8_SA(0, 0), a2, voffA);
            PG8_BAR; PG8_WAIT_L(0); PG8_MMA(1, 0, At, B0); PG8_BAR; PG8_SCHED;
            PG8_STAGE(PG8_SB(0, 1), b2 + hstep, voffB);
            PG8_WAIT_V(6); PG8_BAR; PG8_MMA(1, 1, At, B1); PG8_BAR;
            PG8_LDB(B0, 1, 0); PG8_SCHED; PG8_LDA(At, 1, 0); PG8_STAGE(PG8_SA(0, 1), a2 + hstepA, voffA);
            PG8_WAIT_L(8); PG8_BAR; PG8_WAIT_L(0); PG8_MMA(0, 0, At, B0); PG8_BAR; PG8_SCHED;
            PG8_LDB(B1, 1, 1); PG8_STAGE(PG8_SB(1, 0), b3, voffB);
            PG8_BAR; PG8_WAIT_L(0); PG8_MMA(0, 1, At, B1); PG8_BAR;
            PG8_LDA(At, 1, 1); PG8_STAGE(PG8_SA(1, 0), a3, voffA);
            PG8_BAR; PG8_WAIT_L(0); PG8_MMA(1, 0, At, B0); PG8_BAR; PG8_SCHED;
            PG8_STAGE(PG8_SB(1, 1), b3 + hstep, voffB);
            PG8_WAIT_V(6); PG8_BAR; PG8_MMA(1, 1, At, B1); PG8_BAR;
        }
        PG8_STAMP();
        if constexpr (!Epi::AFTER_DRAIN) { E(acc, cur, wr, wc, fr, fq); S.done(cur); }
        PG8_STAMP();
        if (!has_next) break;
#pragma unroll
        for (int a = 0; a < 2; ++a)
#pragma unroll
            for (int b = 0; b < 2; ++b)
#pragma unroll
                for (int m = 0; m < 4; ++m)
#pragma unroll
                    for (int n = 0; n < 2; ++n) acc[a][b][m][n] = (f32x4){0.f, 0.f, 0.f, 0.f};
        cur = nxt; cA = nA; cB = nB; ++ui;
    }
    PG8_WAIT_V(0);
    if (wr == 0) PG8_BAR;
    PG8_BAR;
    if constexpr (Epi::AFTER_DRAIN) { E.fused(acc, cur, wr, wc, fr, fq, lds, wid, lane); S.done(cur); }
    PG8_STAMP();
    if (STAMP && wid == 0) { stamps[lane] = lane < nts ? (((unsigned long long)(unsigned)ts_hi << 32) | (unsigned)ts_lo) : 0ull;
        if (lane == 62) stamps[62] = rt_entry; if (lane == 63) stamps[63] = (unsigned long long)wall_clock64(); }
#undef PG8_STAMP
#undef PG8_SA
#undef PG8_SB
#undef PG8_STAGE
#undef PG8_LDA
#undef PG8_LDB
#undef PG8_MMA
#undef PG8_WAIT_V
#undef PG8_WAIT_L
#undef PG8_BAR
#undef PG8_SCHED
}
}
using pg8::bf16_t; using pg8::bf16x8; using pg8::f32x4; using pg8::u32x4; using pg8::cvt_pk_bf16;
typedef float f32x16 __attribute__((ext_vector_type(16)));
typedef short s16x4 __attribute__((ext_vector_type(4)));
typedef unsigned u32x2 __attribute__((ext_vector_type(2)));
#define DI __device__ __forceinline__
#define LAS __attribute__((address_space(3)))
#define MFMA32(a, b, c) __builtin_amdgcn_mfma_f32_32x32x16_bf16((a), (b), (c), 0, 0, 0)

constexpr int L_ = 16384, LC_ = 256, MT_ = 16640, D_ = 1024, DFF_ = 2816, DEPTH_ = 4;
constexpr int NWIN_ = 5888, NPB_ = 2816, NGB_ = 3072;
constexpr int C_FA = 0, C_FB = 256, C_RQ = 512, C_RK = 704, C_RV = 896, C_RG = 1280, C_DQ = 1664, C_DK = 2048, C_DV = 2432;
constexpr int LDS_BYTES = 147456;
constexpr float EPS_ = 1e-6f;

constexpr size_t al256(size_t x) { return (x + 255) & ~(size_t)255; }
constexpr size_t WS_W13 = 0;
constexpr size_t WS_W2  = WS_W13 + (size_t)4 * 2 * 5632 * 1024 * 2;
constexpr size_t WS_WIN = WS_W2 + (size_t)4 * 2 * 1024 * 2816 * 2;
constexpr size_t WS_WBF = WS_WIN + (size_t)4 * 5888 * 1024 * 2;
constexpr size_t WS_WBR = WS_WBF + (size_t)4 * 1024 * 256 * 2;
constexpr size_t WS_WBD = WS_WBR + (size_t)4 * 1024 * 384 * 2;
constexpr size_t WS_WO  = WS_WBD + (size_t)4 * 1024 * 384 * 2;
constexpr size_t WS_X   = WS_WO + (size_t)4 * 1024 * 1024 * 2;
constexpr size_t WS_H   = WS_X + (size_t)MT_ * 1024 * 4;
constexpr size_t WS_BR  = WS_H + (size_t)MT_ * 1024 * 2;
constexpr size_t WS_AL  = WS_BR + (size_t)MT_ * 1024 * 2;
constexpr size_t WS_U   = WS_AL;
constexpr size_t WS_PB  = WS_AL;
constexpr size_t WS_GB  = WS_AL + (size_t)MT_ * 2816 * 2;
constexpr size_t WS_V   = WS_GB + (size_t)MT_ * 3072 * 2;
constexpr size_t WS_T   = WS_V + (size_t)128 * 128 * 2 * 256 * 2;
constexpr size_t WS_S   = WS_T + (size_t)130 * 6 * 2 * 2048 * 4;
constexpr size_t WS_MXC = WS_S + (size_t)130 * 6 * 2 * 2048 * 4;
constexpr size_t WS_MOD = WS_MXC + (size_t)256 * 1024 * 4;
constexpr size_t WS_TRET = WS_MOD + (size_t)2 * 4 * 9216 * 4;
constexpr size_t WS_TROW = WS_TRET + (size_t)16384 * 16 * 2 * 4;
constexpr size_t WS_TCOL = WS_TROW + (size_t)256 * 8 * 2 * 4;
constexpr size_t WS_SCAL = WS_TCOL + (size_t)64 * 8 * 2 * 4;
constexpr size_t WS_BAR = WS_SCAL + 4 * 64 * 4;
constexpr size_t WS_END = WS_BAR + 8192;

__device__ __forceinline__ int lbid() { int t = blockIdx.x; asm volatile("" : "+s"(t)); return t; }
__device__ __forceinline__ int lnb() { int t = gridDim.x; asm volatile("" : "+s"(t)); return t; }
struct Args { const float* in[19]; float* out; unsigned char* ws; };
typedef const Args __attribute__((address_space(4)))* KArgs;
__device__ __forceinline__ KArgs kargs() { KArgs p = (KArgs)__builtin_amdgcn_kernarg_segment_ptr(); asm volatile("" : "+s"(p)); return p; }

DI float bf2f(unsigned v) { return __uint_as_float(v << 16); }
DI bf16_t f2bf(float x) { return (bf16_t)(cvt_pk_bf16(x, 0.f) & 0xffffu); }
DI int crow(int reg, int h) { return (reg & 3) + 8 * (reg >> 2) + 4 * h; }
DI bf16x8 pack_step(const f32x16& x, int s) {
  u32x4 p;
  asm volatile("v_cvt_pk_bf16_f32 %0, %4, %5\n\tv_cvt_pk_bf16_f32 %1, %6, %7\n\tv_cvt_pk_bf16_f32 %2, %8, %9\n\tv_cvt_pk_bf16_f32 %3, %10, %11\n\ts_nop 1"
               : "=&v"(p[0]), "=&v"(p[1]), "=&v"(p[2]), "=&v"(p[3])
               : "v"(x[8 * s]), "v"(x[8 * s + 1]), "v"(x[8 * s + 2]), "v"(x[8 * s + 3]), "v"(x[8 * s + 4]), "v"(x[8 * s + 5]), "v"(x[8 * s + 6]), "v"(x[8 * s + 7]));
  return __builtin_bit_cast(bf16x8, p);
}
DI float silu_f(float a) { return a * __builtin_amdgcn_rcpf(1.0f + __expf(-a)); }
DI float sigmoid_f(float a) { return __builtin_amdgcn_rcpf(1.0f + __expf(-a)); }
DI float wave_sum(float v) {
  const int lane = lane_id_v();
#pragma unroll
  for (int o = 32; o > 0; o >>= 1) v += shx(v, o, lane);
  return v;
}
DI void sincos_acc(float xf, float& s, float& c) {
  const double x = (double)xf;
  const double k = rint(x * 0.63661977236758134308);
  double r = fma(-k, 1.57079632679489655800e+00, x); r = fma(-k, 6.12323399573676603587e-17, r);
  const double r2 = r * r;
  double sp = -1.0 / 39916800.0; sp = fma(sp, r2, 1.0 / 362880.0); sp = fma(sp, r2, -1.0 / 5040.0); sp = fma(sp, r2, 1.0 / 120.0); sp = fma(sp, r2, -1.0 / 6.0); sp = fma(sp * r2, r, r);
  double cp = 1.0 / 479001600.0; cp = fma(cp, r2, -1.0 / 3628800.0); cp = fma(cp, r2, 1.0 / 40320.0); cp = fma(cp, r2, -1.0 / 720.0); cp = fma(cp, r2, 1.0 / 24.0); cp = fma(cp, r2, -0.5); cp = fma(cp, r2, 1.0);
  const int q = ((int)(long long)k) & 3;
  const double sv = (q == 0) ? sp : (q == 1) ? cp : (q == 2) ? -sp : -cp;
  const double cv = (q == 0) ? cp : (q == 1) ? -sp : (q == 2) ? -cp : sp;
  s = (float)sv; c = (float)cv;
}
__constant__ float INV16[16] = {1.0f, 0.5623413324356079f, 0.3162277638912201f, 0.17782793939113617f, 0.10000000149011612f, 0.05623413249850273f, 0.03162277489900589f, 0.017782794311642647f,
                             0.009999999776482582f, 0.005623413249850273f, 0.003162277629598975f, 0.0017782794311642647f, 0.0010000000474974513f, 0.000562341301701963f, 0.0003162277571391314f, 0.00017782794020604342f};
struct ConvJob { const float* src; const float* src2; bf16_t* dst; int N, K, ld, kind; };
DI ConvJob conv_job(KArgs a, int j) {
  const int l = j / 9, kd = j % 9; ConvJob J; J.src2 = nullptr; J.kind = 0;
  unsigned char* ws = a->ws;
  switch (kd) {
    case 0: case 1: { const int f = kd; J.src = a->in[7] + (size_t)(l * 2 + f) * 1024 * 2816; J.src2 = a->in[8] + (size_t)(l * 2 + f) * 1024 * 2816; J.dst = (bf16_t*)(ws + WS_W13) + (size_t)(l * 2 + f) * 5632 * 1024; J.N = 5632; J.K = 1024; J.ld = 2816; J.kind = 1; break; }
    case 2: case 3: { const int f = kd - 2; J.src = a->in[9] + (size_t)(l * 2 + f) * 2816 * 1024; J.dst = (bf16_t*)(ws + WS_W2) + (size_t)(l * 2 + f) * 1024 * 2816; J.N = 1024; J.K = 2816; J.ld = 1024; break; }
    case 4: { J.src = a->in[10] + (size_t)l * 1024 * 5632; J.dst = (bf16_t*)(ws + WS_WIN) + (size_t)l * 5888 * 1024; J.N = 5888; J.K = 1024; J.ld = 5632; J.kind = 2; break; }
    case 5: { J.src = a->in[14] + (size_t)l * 256 * 1024; J.dst = (bf16_t*)(ws + WS_WBF) + (size_t)l * 1024 * 256; J.N = 1024; J.K = 256; J.ld = 1024; break; }
    case 6: { J.src = a->in[15] + (size_t)l * 384 * 1024; J.dst = (bf16_t*)(ws + WS_WBR) + (size_t)l * 1024 * 384; J.N = 1024; J.K = 384; J.ld = 1024; break; }
    case 7: { J.src = a->in[16] + (size_t)l * 384 * 1024; J.dst = (bf16_t*)(ws + WS_WBD) + (size_t)l * 1024 * 384; J.N = 1024; J.K = 384; J.ld = 1024; break; }
    default: { J.src = a->in[17] + (size_t)l * 1024 * 1024; J.dst = (bf16_t*)(ws + WS_WO) + (size_t)l * 1024 * 1024; J.N = 1024; J.K = 1024; J.ld = 1024; break; }
  }
  return J;
}
DI int axial_perm(int s) { return s < 8 ? s : (s < 16 ? s + 8 : (s < 24 ? s - 8 : s)); }

DI void prologue(int WV, KArgs a, unsigned char* smem) {
  const int tid = ltid(), nb = lnb(), bid = lbid();
  float* t = (float*)smem;
  float* tr = t + 64 * 65;
  {
    constexpr int tiles_per_layer = 1408 * 2 + 704 * 2 + 1472 + 64 + 96 + 96 + 256;
    const int nn = tid & 63, kq = tid >> 6;
#pragma unroll 1
    for (int g = bid; g < 4 * tiles_per_layer; g += nb) {
      const int l = g / tiles_per_layer; int rem = g % tiles_per_layer; int kd;
      if (rem < 1408) kd = 0; else if (rem < 2816) { kd = 1; rem -= 1408; } else if (rem < 3520) { kd = 2; rem -= 2816; } else if (rem < 4224) { kd = 3; rem -= 3520; }
      else if (rem < 5696) { kd = 4; rem -= 4224; } else if (rem < 5760) { kd = 5; rem -= 5696; } else if (rem < 5856) { kd = 6; rem -= 5760; } else if (rem < 5952) { kd = 7; rem -= 5856; } else { kd = 8; rem -= 5952; }
      const ConvJob J = conv_job(a, l * 9 + kd);
      const int nkt = J.K / 64; const int n0 = (rem / nkt) * 64, k0 = (rem % nkt) * 64;
      const bool fold = (J.kind == 2) && (n0 < 512);
      const float* sp = J.src; int col = n0 + nn;
      if (J.kind == 1) { const int n = n0 + nn, gi = n >> 5, s = n & 31; sp = (s < 16) ? J.src : J.src2; col = 16 * gi + (s & 15); }
      else if (J.kind == 2) {
        const int n = n0 + nn;
        if (fold) col = (n0 & 192) + nn;
        else { col = n - 256; if (n >= C_DQ && n < C_DV) { const int s = n & 31; col = (n - 256 - s) + axial_perm(s); } }
      }
      const float* cp = sp + (size_t)(k0 + kq) * J.ld + col;
      float lv[8];
#pragma unroll
      for (int i = 0; i < 8; ++i) lv[i] = cp[(size_t)(8 * i) * J.ld];
#pragma unroll
      for (int i = 0; i < 8; ++i) t[nn * 65 + kq + 8 * i] = lv[i];
      if (fold && tid < 64) { const float ang = (float)tid * (1.0f / 32.0f); tr[tid] = (n0 >= 256) ? sinpif(ang) : cospif(ang); }
      __syncthreads();
      if (!fold) {
#pragma unroll
        for (int i = 0; i < 4; ++i) {
          const int e = tid + i * 512, n2 = e >> 5, kp = (e & 31) * 2;
          *(unsigned*)(J.dst + (size_t)(n0 + n2) * J.K + k0 + kp) = cvt_pk_bf16(t[n2 * 65 + kp], t[n2 * 65 + kp + 1]);
        }
      } else {
#pragma unroll 1
        for (int i = 0; i < 8; ++i) {
          const int m = kq + 8 * i, kk = nn;
          float acc = 0.f;
#pragma unroll 8
          for (int c = 0; c < 64; ++c) acc += t[c * 65 + kk] * tr[(m * c) & 63];
          J.dst[(size_t)(n0 + m) * J.K + k0 + kk] = f2bf(acc);
        }
      }
      __syncthreads();
    }
  }
  {
    float* sc = (float*)smem; float* scc = sc + 1024; float* red = scc + 1024;
    __syncthreads();
    for (int i = tid; i < 1024; i += 512) { sc[i] = silu_f(a->in[1][i]); scc[i] = silu_f(a->in[3][i]); }
    __syncthreads();
    float* MOD = (float*)(a->ws + WS_MOD);
    for (int it = bid; it < 4 * 72; it += nb) {
      const int l = it / 72, cb = it % 72;
      const int cgp = tid & 31, ks = tid >> 5;
      const float* wp = a->in[4] + ((size_t)l * 1024 + ks * 64) * 9216 + cb * 128 + cgp * 4;
      f32x4 am = {0.f, 0.f, 0.f, 0.f}, ac = {0.f, 0.f, 0.f, 0.f};
#pragma unroll 8
      for (int k = 0; k < 64; ++k) { const f32x4 w = *(const f32x4*)(wp + (size_t)k * 9216); am += w * sc[ks * 64 + k]; ac += w * scc[ks * 64 + k]; }
#pragma unroll
      for (int j = 0; j < 4; ++j) { red[(ks * 128 + cgp * 4 + j) * 2] = am[j]; red[(ks * 128 + cgp * 4 + j) * 2 + 1] = ac[j]; }
      __syncthreads();
      if (tid < 256) {
        const int col = tid >> 1, which = tid & 1; float s = 0.f;
#pragma unroll
        for (int q = 0; q < 16; ++q) s += red[(q * 128 + col) * 2 + which];
        const int gc = cb * 128 + col;
        MOD[(size_t)(which * 4 + l) * 9216 + gc] = s + a->in[5][(size_t)l * 9216 + gc];
      }
      __syncthreads();
    }
  }
  {
    float* TRET = (float*)(a->ws + WS_TRET); float* TROW = (float*)(a->ws + WS_TROW); float* TCOL = (float*)(a->ws + WS_TCOL);
    const int gt = bid * 512 + tid, gn = nb * 512;
    for (int e = gt; e < 16384 * 16; e += gn) { const int p = e >> 4, i = e & 15; float s, c; sincos_acc((float)p * INV16[i], s, c); TRET[2 * e] = c; TRET[2 * e + 1] = s; }
    for (int e = gt; e < 256 * 8; e += gn) { const int p = e >> 3, i = e & 7; float s, c; sincos_acc((float)p * INV16[2 * i], s, c); TROW[2 * e] = c; TROW[2 * e + 1] = s; }
    for (int e = gt; e < 64 * 8; e += gn) { const int p = e >> 3, i = e & 7; float s, c; sincos_acc((float)p * INV16[2 * i], s, c); TCOL[2 * e] = c; TCOL[2 * e + 1] = s; }
    if (bid == 0 && tid < 4) {
      const int l = tid; float* S = (float*)(a->ws + WS_SCAL) + l * 64;
      const float* lv = a->in[12] + l * 128; float d01 = 0.f, d23 = 0.f;
      for (int i = 0; i < 32; ++i) { d01 += lv[i] * lv[32 + i]; d23 += lv[64 + i] * lv[96 + i]; }
      const float lam_init = 0.8f - 0.6f * expf(-0.3f * (float)l);
      S[0] = expf(d01) - expf(d23) + lam_init; S[1] = lam_init;
      for (int i = 0; i < 12; ++i) { const float x = a->in[11][l * 12 + i]; S[4 + i] = -log1pf(expf(-x)); }
      for (int i = 0; i < 12; ++i) ((unsigned*)S)[16 + i] = 0u;
    }
  }
}
DI void norm_phase(int WV, KArgs a, int l, int which, bool first) {
  const int tid = ltid(), lane = tid & 63, wave = tid >> 6;
  const float* g = a->in[6] + (size_t)(l * 3 + which) * 1024;
  const float* mod = (const float*)(a->ws + WS_MOD) + (size_t)l * 9216;
  const float* modc = (const float*)(a->ws + WS_MOD) + (size_t)(4 + l) * 9216;
  float* X = (float*)(a->ws + WS_X); bf16_t* H = (bf16_t*)(a->ws + WS_H);
  const int stride = lnb() * 8;
  for (int r = lbid() * 8 + wave; r < MT_; r += 2 * stride) {
    const int r2 = r + stride; const bool has2 = r2 < MT_; const int rb = has2 ? r2 : r;
    const float* srcA = first ? (r < L_ ? a->in[0] + (size_t)r * 1024 : a->in[2] + (size_t)(r - L_) * 1024) : X + (size_t)r * 1024;
    const float* srcB = first ? (rb < L_ ? a->in[0] + (size_t)rb * 1024 : a->in[2] + (size_t)(rb - L_) * 1024) : X + (size_t)rb * 1024;
    f32x4 va[4], vb[4]; float sa = 0.f, sb = 0.f;
#pragma unroll
    for (int i = 0; i < 4; ++i) { va[i] = *(const f32x4*)(srcA + i * 256 + lane * 4); vb[i] = *(const f32x4*)(srcB + i * 256 + lane * 4); }
#pragma unroll
    for (int i = 0; i < 4; ++i) { sa += va[i][0] * va[i][0] + va[i][1] * va[i][1] + va[i][2] * va[i][2] + va[i][3] * va[i][3]; sb += vb[i][0] * vb[i][0] + vb[i][1] * vb[i][1] + vb[i][2] * vb[i][2] + vb[i][3] * vb[i][3]; }
    sa = wave_sum(sa); sb = wave_sum(sb);
    const float rsa = rsqrtf(sa * (1.0f / 1024.0f) + EPS_), rsb = rsqrtf(sb * (1.0f / 1024.0f) + EPS_);
#pragma unroll
    for (int q = 0; q < 2; ++q) {
      if (q == 1 && !has2) break;
      const int rr = q ? r2 : r; const float rstd = q ? rsb : rsa;
      const float* mm = (rr < L_) ? mod : modc;
#pragma unroll
      for (int i = 0; i < 4; ++i) {
        const int c = i * 256 + lane * 4;
        const f32x4 v = q ? vb[i] : va[i];
        const f32x4 gg = *(const f32x4*)(g + c), sh = *(const f32x4*)(mm + (which * 3) * 1024 + c), sc = *(const f32x4*)(mm + (which * 3 + 1) * 1024 + c);
        f32x4 y;
#pragma unroll
        for (int j = 0; j < 4; ++j) y[j] = v[j] * rstd * gg[j] * (1.0f + sc[j]) + sh[j];
        u32x2 w; w.x = cvt_pk_bf16(y[0], y[1]); w.y = cvt_pk_bf16(y[2], y[3]);
        *(u32x2*)(H + (size_t)rr * 1024 + c) = w;
        if (first) *(f32x4*)(X + (size_t)rr * 1024 + c) = v;
      }
    }
  }
}
DI void final_norm(int WV, KArgs a) {
  const int tid = ltid(), lane = tid & 63, wave = tid >> 6;
  const float* g = a->in[18]; const float* X = (const float*)(a->ws + WS_X);
  for (int r = lbid() * 8 + wave; r < L_; r += lnb() * 8) {
    f32x4 v[4]; float ss = 0.f;
#pragma unroll
    for (int i = 0; i < 4; ++i) { v[i] = *(const f32x4*)(X + (size_t)r * 1024 + i * 256 + lane * 4); ss += v[i][0] * v[i][0] + v[i][1] * v[i][1] + v[i][2] * v[i][2] + v[i][3] * v[i][3]; }
    ss = wave_sum(ss);
    const float rstd = rsqrtf(ss * (1.0f / 1024.0f) + EPS_);
#pragma unroll
    for (int i = 0; i < 4; ++i) { const int c = i * 256 + lane * 4; const f32x4 gg = *(const f32x4*)(g + c); f32x4 y; for (int j = 0; j < 4; ++j) y[j] = v[i][j] * rstd * gg[j]; *(f32x4*)(a->out + (size_t)r * 1024 + c) = y; }
  }
}

using pg8::Unit; using pg8::HALF; using pg8::BM;
struct EpiSwiglu {
  static constexpr bool PERM = false, AFTER_DRAIN = false;
  bf16_t* U;
  DI void operator()(const f32x4 (&acc)[2][2][4][2], const Unit& u, int wr, int wc, int fr_, int fq_) const {
    const int ln_ = lane_id_v(), fr = ln_ & 15, fq = ln_ >> 4;
#pragma unroll
    for (int ai = 0; ai < 2; ++ai)
#pragma unroll
      for (int m = 0; m < 4; ++m) {
        const int r = u.pm * BM + ai * HALF + wr * 64 + m * 16 + fr;
#pragma unroll
        for (int bj = 0; bj < 2; ++bj) {
          const int gi = u.pn * 8 + bj * 4 + wc;
          const f32x4 x = acc[ai][bj][m][0], y = acc[ai][bj][m][1];
          u32x2 w; w.x = cvt_pk_bf16(silu_f(x[0]) * y[0], silu_f(x[1]) * y[1]); w.y = cvt_pk_bf16(silu_f(x[2]) * y[2], silu_f(x[3]) * y[3]);
          *(u32x2*)(U + (size_t)r * DFF_ + gi * 16 + fq * 4) = w;
        }
        __builtin_amdgcn_sched_barrier(0);
      }
  }
};
struct EpiResid {
  static constexpr bool PERM = false, AFTER_DRAIN = false;
  float* X; const float* gate; float scale;
  DI void operator()(const f32x4 (&acc)[2][2][4][2], const Unit& u, int wr, int wc, int fr_, int fq_) const {
    const int ln_ = lane_id_v(), fr = ln_ & 15, fq = ln_ >> 4;
#pragma unroll
    for (int bj = 0; bj < 2; ++bj)
#pragma unroll
      for (int n = 0; n < 2; ++n) {
        const int c = u.pn * BM + bj * HALF + wc * 32 + n * 16 + fq * 4;
        const f32x4 gv = *(const f32x4*)(gate + c) * scale;
#pragma unroll
        for (int ai = 0; ai < 2; ++ai)
#pragma unroll
          for (int m = 0; m < 4; ++m) {
            const int r = u.pm * BM + ai * HALF + wr * 64 + m * 16 + fr;
            float* p = X + (size_t)r * 1024 + c;
            *(f32x4*)p = *(const f32x4*)p + gv * acc[ai][bj][m][n];
          }
      }
  }
};
template <int STEP> struct EpiMerge {
  static constexpr bool PERM = false, AFTER_DRAIN = false;
  bf16_t* MX; const bf16_t* G; bf16_t* Hout;
  DI void operator()(const f32x4 (&acc)[2][2][4][2], const Unit& u, int wr, int wc, int fr_, int fq_) const {
    const int ln_ = lane_id_v(), fr = ln_ & 15, fq = ln_ >> 4;
#pragma unroll
    for (int ai = 0; ai < 2; ++ai)
#pragma unroll
      for (int bj = 0; bj < 2; ++bj)
#pragma unroll
        for (int n = 0; n < 2; ++n) {
          const int c = u.pn * BM + bj * HALF + wc * 32 + n * 16 + fq * 4;
          const int r0 = u.pm * BM + ai * HALF + wr * 64 + fr;
          u32x2 gw[4], old[4];
#pragma unroll
          for (int m = 0; m < 4; ++m) {
            gw[m] = *(const u32x2*)(G + (size_t)(r0 + m * 16) * NGB_ + c);
            if (STEP > 0) old[m] = *(const u32x2*)(MX + (size_t)(r0 + m * 16) * 1024 + c);
          }
#pragma unroll
          for (int m = 0; m < 4; ++m) {
            f32x4 gv; gv[0] = bf2f(gw[m].x & 0xffffu); gv[1] = bf2f(gw[m].x >> 16); gv[2] = bf2f(gw[m].y & 0xffffu); gv[3] = bf2f(gw[m].y >> 16);
            f32x4 v = gv * acc[ai][bj][m][n];
            if (STEP > 0) { v[0] += bf2f(old[m].x & 0xffffu); v[1] += bf2f(old[m].x >> 16); v[2] += bf2f(old[m].y & 0xffffu); v[3] += bf2f(old[m].y >> 16); }
            u32x2 w; w.x = cvt_pk_bf16(v[0], v[1]); w.y = cvt_pk_bf16(v[2], v[3]);
            if (STEP < 2) *(u32x2*)(MX + (size_t)(r0 + m * 16) * 1024 + c) = w;
            else *(u32x2*)(Hout + (size_t)(r0 + m * 16) * 1024 + c) = w;
          }
          __builtin_amdgcn_sched_barrier(0);
        }
  }
};
struct EpiWin {
  static constexpr bool PERM = false, AFTER_DRAIN = false;
  bf16_t* PB; bf16_t* GB; const float* TRET; const float* TROW; const float* TCOL; unsigned* kmax;
  DI void operator()(const f32x4 (&acc)[2][2][4][2], const Unit& u, int wr, int wc, int fr_, int fq_) const {
    const int ln_ = lane_id_v(), fr = ln_ & 15, fq = ln_ >> 4;
#pragma unroll
    for (int bj = 0; bj < 2; ++bj) {
      const int cb = u.pn * BM + bj * HALF + wc * 32;
      float kmx = 0.f;
#pragma unroll
      for (int ai = 0; ai < 2; ++ai)
#pragma unroll
        for (int m = 0; m < 4; ++m) {
          const int r = u.pm * BM + ai * HALF + wr * 64 + m * 16 + fr;
          f32x4 x0 = acc[ai][bj][m][0], x1 = acc[ai][bj][m][1];
          if (cb >= NPB_) {
#pragma unroll
            for (int j = 0; j < 4; ++j) { x0[j] = sigmoid_f(x0[j]); x1[j] = sigmoid_f(x1[j]); }
            u32x2 w0, w1; w0.x = cvt_pk_bf16(x0[0], x0[1]); w0.y = cvt_pk_bf16(x0[2], x0[3]); w1.x = cvt_pk_bf16(x1[0], x1[1]); w1.y = cvt_pk_bf16(x1[2], x1[3]);
            bf16_t* p = GB + (size_t)r * NGB_ + (cb - NPB_) + fq * 4;
            *(u32x2*)p = w0; *(u32x2*)(p + 16) = w1;
            __builtin_amdgcn_sched_barrier(0);
            continue;
          }
          if (cb >= C_RQ && cb < C_RV) {
            if (r < L_) {
              const f32x4* tp = (const f32x4*)(TRET + ((size_t)r * 16 + fq * 4) * 2);
              const f32x4 t0 = tp[0], t1 = tp[1];
              const float cs[4] = {t0[0], t0[2], t1[0], t1[2]}, sn[4] = {t0[1], t0[3], t1[1], t1[3]};
#pragma unroll
              for (int j = 0; j < 4; ++j) { const float a_ = x0[j], b_ = x1[j]; x0[j] = a_ * cs[j] - b_ * sn[j]; x1[j] = a_ * sn[j] + b_ * cs[j]; }
            }
            if (cb >= C_RK) { x0 *= 0.17677669529663687f; x1 *= 0.17677669529663687f; }
          } else if (cb >= C_RG && cb < C_DQ) {
#pragma unroll
            for (int j = 0; j < 4; ++j) { x0[j] = silu_f(x0[j]); x1[j] = silu_f(x1[j]); }
          } else if (cb >= C_DQ && cb < C_DV) {
            if (r < L_) {
              const float* tb = (fq < 2) ? (TROW + ((size_t)(r >> 6) * 8 + fq * 4) * 2) : (TCOL + ((size_t)(r & 63) * 8 + (fq - 2) * 4) * 2);
              const f32x4 t0 = ((const f32x4*)tb)[0], t1 = ((const f32x4*)tb)[1];
              const float cs[4] = {t0[0], t0[2], t1[0], t1[2]}, sn[4] = {t0[1], t0[3], t1[1], t1[3]};
#pragma unroll
              for (int j = 0; j < 4; ++j) { const float a_ = x0[j], b_ = x1[j]; x0[j] = a_ * cs[j] - b_ * sn[j]; x1[j] = a_ * sn[j] + b_ * cs[j]; }
            }
            if (cb < C_DK) { x0 *= 0.25503486f; x1 *= 0.25503486f; }
            else { float ss = 0.f;
#pragma unroll
              for (int j = 0; j < 4; ++j) ss += x0[j] * x0[j] + x1[j] * x1[j];
              ss += shx(ss, 16, lane_id_v()); ss += shx(ss, 32, lane_id_v()); kmx = fmaxf(kmx, ss); }
          }
          u32x2 w0, w1; w0.x = cvt_pk_bf16(x0[0], x0[1]); w0.y = cvt_pk_bf16(x0[2], x0[3]); w1.x = cvt_pk_bf16(x1[0], x1[1]); w1.y = cvt_pk_bf16(x1[2], x1[3]);
          bf16_t* p = PB + (size_t)r * NPB_ + cb + fq * 4;
          *(u32x2*)p = w0; *(u32x2*)(p + 16) = w1;
          __builtin_amdgcn_sched_barrier(0);
        }
      if (cb >= C_DK && cb < C_DV) {
#pragma unroll
        for (int o = 1; o < 16; o <<= 1) kmx = fmaxf(kmx, shx(kmx, o, lane_id_v()));
        if (lane_id_v() == 0) atomicMax(kmax + ((cb - C_DK) >> 5), __float_as_uint(kmx));
      }
    }
  }
};
template <class F> DI void ctx_gemm32(int WV, const bf16_t* A, int lda, const bf16_t* Bt, int K, int N, unsigned char* smem, F epi) {
  const int tid = ltid(), lane = tid & 63, wave = tid >> 6, r31 = lane & 31, h = lane >> 5;
  float* red = (float*)smem;
  const int ntn = N / 32, ntiles = 8 * ntn, kper = K / 8;
  for (int tile = lbid(); tile < ntiles; tile += lnb()) {
    const int tm = tile / ntn, tn = tile % ntn;
    f32x16 acc; for (int i = 0; i < 16; ++i) acc[i] = 0.f;
    const bf16_t* ap = A + (size_t)(tm * 32 + r31) * lda + wave * kper + 8 * h;
    const bf16_t* bp = Bt + (size_t)(tn * 32 + r31) * K + wave * kper + 8 * h;
    const int nsteps = kper >> 4;
    bf16x8 a0[8], b0[8], a1[8], b1[8];
#define CG_LOAD(A_, B_, S_) do { _Pragma("unroll") for (int q = 0; q < 8; ++q) { const int st_ = ((S_) + q < nsteps) ? (S_) + q : nsteps - 1; A_[q] = *(const bf16x8*)(ap + st_ * 16); B_[q] = *(const bf16x8*)(bp + st_ * 16); } } while (0)
#define CG_COMP(A_, B_, S_) do { _Pragma("unroll") for (int q = 0; q < 8; ++q) { const bf16x8 z_ = {0, 0, 0, 0, 0, 0, 0, 0}; acc = MFMA32(((S_) + q < nsteps) ? A_[q] : z_, B_[q], acc); } } while (0)
    CG_LOAD(a0, b0, 0);
    for (int s = 0; s < nsteps; s += 16) { CG_LOAD(a1, b1, s + 8); CG_COMP(a0, b0, s); CG_LOAD(a0, b0, s + 16); CG_COMP(a1, b1, s + 8); }
#undef CG_LOAD
#undef CG_COMP
#pragma unroll
    for (int i = 0; i < 16; ++i) red[(wave * 16 + i) * 64 + lane] = acc[i];
    __syncthreads();
#pragma unroll
    for (int q = 0; q < 2; ++q) {
      const int o = tid + q * 512, i = o >> 6, ln = o & 63; float s = 0.f;
#pragma unroll
      for (int w = 0; w < 8; ++w) s += red[(w * 16 + i) * 64 + ln];
      epi(tm * 32 + crow(i, ln >> 5), tn * 32 + (ln & 31), s);
    }
    __syncthreads();
  }
}

constexpr int FR_LD = 136;
DI void fourier_tables(int WV, unsigned char* smem) {
  bf16_t* Cw = (bf16_t*)smem; bf16_t* Sw = Cw + 128 * FR_LD;
  for (int e = ltid(); e < 128 * 128; e += 512) { const int a_ = e >> 7, b_ = e & 127; const float x = (float)((a_ * b_) & 127) * (1.0f / 64.0f); Cw[a_ * FR_LD + b_] = f2bf(cospif(x)); Sw[a_ * FR_LD + b_] = f2bf(sinpif(x)); }
}
DI void fourier_load(int WV, const bf16_t* src, size_t rs, size_t po, unsigned char* smem) {
  bf16_t* dA = (bf16_t*)smem + 2 * 128 * FR_LD;
#pragma unroll
  for (int i = 0; i < 4; ++i) {
    const int id = ltid() + 512 * i, seg = id & 7, part = (id >> 3) & 1, row = id >> 4;
    const bf16x8 v = *(const bf16x8*)(src + (size_t)row * rs + (size_t)part * po + seg * 8);
    bf16_t* d = dA + part * 64 * FR_LD + (seg * 8) * FR_LD + (row ^ (seg << 3));
#pragma unroll
    for (int e = 0; e < 8; ++e) d[e * FR_LD] = (bf16_t)v[e];
  }
}
DI void fourier_stage1(int WV, KArgs a, unsigned char* smem) {
  const int tid = ltid(), lane = tid & 63, wave = tid >> 6, r31 = lane & 31, h = lane >> 5, rb = wave & 3, cbk = wave >> 2;
  const bf16_t* PB = (const bf16_t*)(a->ws + WS_PB); bf16_t* V = (bf16_t*)(a->ws + WS_V);
  const bf16_t* Cw = (const bf16_t*)smem; const bf16_t* Sw = Cw + 128 * FR_LD; const bf16_t* dA = Sw + 128 * FR_LD; const bf16_t* dB = dA + 64 * FR_LD;
  for (int it = lbid(); it < 512; it += lnb()) {
    const int t2 = it >> 2, c0 = (it & 3) * 64;
    __syncthreads();
    fourier_load(WV, PB + (size_t)t2 * NPB_ + C_FA + c0, (size_t)128 * NPB_, (size_t)(C_FB - C_FA), smem);
    __syncthreads();
    f32x16 R, nI; for (int i = 0; i < 16; ++i) { R[i] = 0.f; nI[i] = 0.f; }
#pragma unroll
    for (int s = 0; s < 8; ++s) {
      const bf16x8 cw = *(const bf16x8*)(Cw + (32 * rb + r31) * FR_LD + 16 * s + 8 * h), sw = *(const bf16x8*)(Sw + (32 * rb + r31) * FR_LD + 16 * s + 8 * h);
      const int so_ = (16 * s + 8 * h) ^ (((4 * cbk + (r31 >> 3)) & 7) << 3);
      const bf16x8 af = *(const bf16x8*)(dA + (32 * cbk + r31) * FR_LD + so_), bfv = *(const bf16x8*)(dB + (32 * cbk + r31) * FR_LD + so_);
      bf16x8 nb; for (int e = 0; e < 8; ++e) nb[e] = (short)(bfv[e] ^ (short)0x8000);
      R = MFMA32(cw, af, R); R = MFMA32(sw, nb, R); nI = MFMA32(sw, af, nI); nI = MFMA32(cw, bfv, nI);
    }
    const int col = c0 + 32 * cbk + r31;
#pragma unroll
    for (int i = 0; i < 16; ++i) {
      const int k1 = 32 * rb + crow(i, h);
      const float x = (float)(k1 * t2) * (1.0f / 8192.0f); const float ct = cospif(x), st = sinpif(x);
      const float vre = R[i] * ct - nI[i] * st, vim = -nI[i] * ct - R[i] * st;
      bf16_t* vp = V + ((size_t)(k1 * 128 + t2) * 2) * 256 + col;
      vp[0] = f2bf(vre); vp[256] = f2bf(vim);
    }
  }
}
DI void fourier_stage2(int WV, KArgs a, unsigned char* smem) {
  const int tid = ltid(), lane = tid & 63, wave = tid >> 6, r31 = lane & 31, h = lane >> 5, rb = wave & 3, cbk = wave >> 2;
  const bf16_t* V = (const bf16_t*)(a->ws + WS_V); bf16_t* BR = (bf16_t*)(a->ws + WS_BR);
  const bf16_t* Cw = (const bf16_t*)smem; const bf16_t* Sw = Cw + 128 * FR_LD; const bf16_t* dA = Sw + 128 * FR_LD; const bf16_t* dB = dA + 64 * FR_LD;
  for (int it = lbid(); it < 512; it += lnb()) {
    const int k1 = it >> 2, c0 = (it & 3) * 64;
    __syncthreads();
    fourier_load(WV, V + (size_t)k1 * 128 * 512 + c0, (size_t)512, (size_t)256, smem);
    __syncthreads();
    f32x16 Y; for (int i = 0; i < 16; ++i) Y[i] = 0.f;
#pragma unroll
    for (int s = 0; s < 8; ++s) {
      const bf16x8 cw = *(const bf16x8*)(Cw + (32 * rb + r31) * FR_LD + 16 * s + 8 * h), sw = *(const bf16x8*)(Sw + (32 * rb + r31) * FR_LD + 16 * s + 8 * h);
      const int so_ = (16 * s + 8 * h) ^ (((4 * cbk + (r31 >> 3)) & 7) << 3);
      const bf16x8 vr = *(const bf16x8*)(dA + (32 * cbk + r31) * FR_LD + so_), vi = *(const bf16x8*)(dB + (32 * cbk + r31) * FR_LD + so_);
      Y = MFMA32(cw, vr, Y); Y = MFMA32(sw, vi, Y);
    }
    const int col = c0 + 32 * cbk + r31;
#pragma unroll
    for (int i = 0; i < 16; ++i) { const int k2 = 32 * rb + crow(i, h); BR[(size_t)(k1 + 128 * k2) * 1024 + col] = f2bf(Y[i] * (1.0f / 1024.0f)); }
  }
}
DI void fourier_ctx(int WV, KArgs a, unsigned char* smem) {
  const int tid = ltid();
  const bf16_t* PB = (const bf16_t*)(a->ws + WS_PB) + (size_t)L_ * NPB_; bf16_t* BR = (bf16_t*)(a->ws + WS_BR) + (size_t)L_ * 1024;
  float* ct = (float*)smem; float* st = ct + 256; float* red = st + 256;
  __syncthreads();
  if (tid < 256) { const float x = (float)tid * (1.0f / 128.0f); ct[tid] = cospif(x); st[tid] = sinpif(x); }
  __syncthreads();
  const int tg = tid >> 5, c8 = (tid & 31) * 8;
  for (int k = lbid(); k < 256; k += lnb()) {
    bf16x8 av[16], bv[16];
#pragma unroll
    for (int j = 0; j < 16; ++j) { const int t = tg + 16 * j; av[j] = *(const bf16x8*)(PB + (size_t)t * NPB_ + C_FA + c8); bv[j] = *(const bf16x8*)(PB + (size_t)t * NPB_ + C_FB + c8); }
    float acc[8];
#pragma unroll
    for (int e = 0; e < 8; ++e) acc[e] = 0.f;
#pragma unroll
    for (int j = 0; j < 16; ++j) {
      const int idx = (k * (tg + 16 * j)) & 255; const float c_ = ct[idx], s_ = st[idx];
#pragma unroll
      for (int e = 0; e < 8; ++e) acc[e] += c_ * bf2f((unsigned)(unsigned short)av[j][e]) - s_ * bf2f((unsigned)(unsigned short)bv[j][e]);
    }
#pragma unroll
    for (int e = 0; e < 8; ++e) red[tg * 256 + c8 + e] = acc[e];
    __syncthreads();
    if (tid < 256) { float s = 0.f;
#pragma unroll
      for (int q = 0; q < 16; ++q) s += red[q * 256 + tid];
      BR[(size_t)k * 1024 + tid] = f2bf(s * (1.0f / 128.0f)); }
    __syncthreads();
  }
}
DI int chunk_row0(int ci) { return ci < 128 ? ci * 128 : L_ + (ci - 128) * 128; }
DI void ret_states(int WV, KArgs a, int l, unsigned char* smem) {
  const int tid = ltid();
  const bf16_t* PB = (const bf16_t*)(a->ws + WS_PB); float* T = (float*)(a->ws + WS_T);
  const float* S = (const float*)(a->ws + WS_SCAL) + l * 64;
  float* kL = (float*)smem; float* vL = kL + 128 * 33; float* wf = vL + 128 * 64; float* wb = wf + 128;
  for (int it = lbid(); it < 130 * 6; it += lnb()) {
    const int ci = it / 6, hh = it % 6, r0 = chunk_row0(ci);
    __syncthreads();
    { const int row = tid >> 2, seg = tid & 3; const bf16x8 v = *(const bf16x8*)(PB + (size_t)(r0 + row) * NPB_ + C_RK + hh * 32 + seg * 8);
#pragma unroll
      for (int e = 0; e < 8; ++e) kL[row * 33 + seg * 8 + e] = bf2f((unsigned)(unsigned short)v[e]); }
#pragma unroll
    for (int q = 0; q < 2; ++q) { const int id = tid + 512 * q, row = id >> 3, seg = id & 7; const bf16x8 v = *(const bf16x8*)(PB + (size_t)(r0 + row) * NPB_ + C_RV + hh * 64 + seg * 8);
#pragma unroll
      for (int e = 0; e < 8; ++e) vL[row * 64 + seg * 8 + e] = bf2f((unsigned)(unsigned short)v[e]); }
    if (tid < 128) { wf[tid] = expf(S[4 + hh] * (float)(127 - tid)); wb[tid] = expf(S[10 + hh] * (float)tid); }
    __syncthreads();
    const int d = tid >> 4, v4 = (tid & 15) * 4;
    f32x4 af = {0.f, 0.f, 0.f, 0.f}, ab = {0.f, 0.f, 0.f, 0.f};
#pragma unroll 4
    for (int j = 0; j < 128; ++j) { const float kd = kL[j * 33 + d]; const f32x4 vv = *(const f32x4*)(vL + j * 64 + v4); af += vv * (kd * wf[j]); ab += vv * (kd * wb[j]); }
    float* tp = T + ((size_t)(ci * 6 + hh) * 2) * 2048 + d * 64 + v4;
    *(f32x4*)tp = af; *(f32x4*)(tp + 2048) = ab;
  }
}
DI void ret_scan(int WV, KArgs a, int l) {
  const int gt = lbid() * 512 + ltid();
  if (gt >= 6 * 2 * 2048) return;
  const int idx = gt & 2047, dir = (gt >> 11) & 1, hh = gt >> 12;
  const float* T = (const float*)(a->ws + WS_T); float* S = (float*)(a->ws + WS_S);
  const float* SC = (const float*)(a->ws + WS_SCAL) + l * 64;
  const float dec = expf(SC[4 + dir * 6 + hh] * 128.0f);
  const size_t base = (size_t)(hh * 2 + dir) * 2048 + idx; const size_t cs = (size_t)6 * 2 * 2048;
  const float tc0 = T[base + 128 * cs], tc1 = T[base + 129 * cs];
  float tv[128];
#pragma unroll
  for (int i = 0; i < 128; ++i) tv[i] = T[base + (size_t)i * cs];
  if (dir == 0) {
    float s = tc0 * dec + tc1; S[base + 128 * cs] = 0.f; S[base + 129 * cs] = tc0;
#pragma unroll
    for (int i = 0; i < 128; ++i) { S[base + (size_t)i * cs] = s; s = s * dec + tv[i]; }
  } else {
    float s = tc0 + dec * tc1; S[base + 129 * cs] = 0.f; S[base + 128 * cs] = tc1;
#pragma unroll
    for (int i = 127; i >= 0; --i) { S[base + (size_t)i * cs] = s; s = s * dec + tv[i]; }
  }
}
DI void ret_out(int WV, KArgs a, int l, unsigned char* smem) {
  const int tid = ltid(), lane = tid & 63, wave = tid >> 6, r31 = lane & 31, h = lane >> 5, jb = wave & 3, vh = wave >> 2;
  const bf16_t* PB = (const bf16_t*)(a->ws + WS_PB); bf16_t* BR = (bf16_t*)(a->ws + WS_BR); const float* Sg = (const float*)(a->ws + WS_S);
  const float* SC = (const float*)(a->ws + WS_SCAL) + l * 64;
  bf16_t* Kl = (bf16_t*)smem;
  bf16_t* Vt = Kl + 128 * 40;
  bf16_t* SfT = Vt + 64 * 136;
  bf16_t* SbT = SfT + 64 * 40;
  float* pwf = (float*)(SbT + 64 * 40);
  float* pwb = pwf + 128;
  float* ssq = pwb + 128;
  const int nit_ = (l < DEPTH_ - 1) ? 130 * 6 : 128 * 6;
  for (int it = lbid(); it < nit_; it += lnb()) {
    const int ci = it / 6, hh = it % 6, r0 = chunk_row0(ci);
    const float lgf = SC[4 + hh], lgb = SC[10 + hh];
    __syncthreads();
    { const int row = tid >> 2, seg = tid & 3; *(bf16x8*)(Kl + row * 40 + seg * 8) = *(const bf16x8*)(PB + (size_t)(r0 + row) * NPB_ + C_RK + hh * 32 + seg * 8); }
#pragma unroll
    for (int q = 0; q < 2; ++q) { const int id = tid + 512 * q, row = id >> 3, seg = id & 7; const bf16x8 v = *(const bf16x8*)(PB + (size_t)(r0 + row) * NPB_ + C_RV + hh * 64 + seg * 8);
#pragma unroll
      for (int e = 0; e < 8; ++e) Vt[(seg * 8 + e) * 136 + (row ^ (seg << 3))] = (bf16_t)v[e]; }
#pragma unroll
    for (int q = 0; q < 8; ++q) { const int e = tid + 512 * q, dir = e >> 11, idx = e & 2047, d = idx >> 6, v = idx & 63;
      const float sv = Sg[((size_t)(ci * 6 + hh) * 2 + dir) * 2048 + idx]; (dir ? SbT : SfT)[v * 40 + d] = f2bf(sv); }
    if (tid < 128) { pwf[tid] = expf(lgf * (float)tid); pwb[tid] = expf(lgb * (float)tid); }
    const int qrow = r0 + 32 * jb + r31, j = 32 * jb + r31;
    bf16x8 qf[2];
#pragma unroll
    for (int s = 0; s < 2; ++s) qf[s] = *(const bf16x8*)(PB + (size_t)qrow * NPB_ + C_RQ + hh * 32 + 16 * s + 8 * h);
    __syncthreads();
    f32x16 O; for (int i = 0; i < 16; ++i) O[i] = 0.f;
#pragma unroll
    for (int kb = 0; kb < 4; ++kb) {
      f32x16 St; for (int i = 0; i < 16; ++i) St[i] = 0.f;
#pragma unroll
      for (int s = 0; s < 2; ++s) { const bf16x8 kf = *(const bf16x8*)(Kl + (32 * kb + r31) * 40 + 16 * s + 8 * h); St = MFMA32(kf, qf[s], St); }
#pragma unroll
      for (int i = 0; i < 16; ++i) { const int jp = 32 * kb + crow(i, h); const int dl = j - jp; const float dv = dl > 0 ? pwf[dl] : (dl < 0 ? pwb[-dl] : 2.0f); St[i] *= dv; }
#pragma unroll
      for (int s = 0; s < 2; ++s) {
        const bf16x8 pb = pack_step(St, s);
        const bf16_t* vrow = Vt + (32 * vh + r31) * 136; const int px_ = ((4 * vh + (r31 >> 3)) & 7) << 3, p0_ = 32 * kb + 16 * s + 4 * h;
        const s16x4 lo = *(const s16x4*)(vrow + (p0_ ^ px_)), hi = *(const s16x4*)(vrow + ((p0_ + 8) ^ px_));
        const bf16x8 vf = __builtin_shufflevector(lo, hi, 0, 1, 2, 3, 4, 5, 6, 7);
        O = MFMA32(vf, pb, O);
      }
    }
    f32x16 Of, Ob; for (int i = 0; i < 16; ++i) { Of[i] = 0.f; Ob[i] = 0.f; }
#pragma unroll
    for (int s = 0; s < 2; ++s) {
      const bf16x8 sf = *(const bf16x8*)(SfT + (32 * vh + r31) * 40 + 16 * s + 8 * h), sb = *(const bf16x8*)(SbT + (32 * vh + r31) * 40 + 16 * s + 8 * h);
      Of = MFMA32(sf, qf[s], Of); Ob = MFMA32(sb, qf[s], Ob);
    }
    const float qdf = expf(lgf * (float)(j + 1)), qdb = expf(lgb * (float)(128 - j));
    float ss = 0.f;
#pragma unroll
    for (int i = 0; i < 16; ++i) { O[i] = O[i] + Of[i] * qdf + Ob[i] * qdb; ss += O[i] * O[i]; }
    ss += shx(ss, 32, lane_id_v());
    if (h == 0) ssq[vh * 128 + j] = ss;
    __syncthreads();
    const float rstd = rsqrtf((ssq[j] + ssq[128 + j]) * (1.0f / 64.0f) + EPS_);
#pragma unroll
    for (int g4 = 0; g4 < 4; ++g4) {
      const int v0 = 32 * vh + 8 * g4 + 4 * h;
      const u32x2 gw = *(const u32x2*)(PB + (size_t)qrow * NPB_ + C_RG + hh * 64 + v0);
      const float g0 = bf2f(gw.x & 0xffffu), g1 = bf2f(gw.x >> 16), g2 = bf2f(gw.y & 0xffffu), g3 = bf2f(gw.y >> 16);
      u32x2 w; w.x = cvt_pk_bf16(O[4 * g4] * rstd * g0, O[4 * g4 + 1] * rstd * g1); w.y = cvt_pk_bf16(O[4 * g4 + 2] * rstd * g2, O[4 * g4 + 3] * rstd * g3);
      *(u32x2*)(BR + (size_t)qrow * 1024 + 256 + hh * 64 + v0) = w;
    }
  }
}
constexpr int AT_LD = 72;
typedef __bf16 bf16x2_t __attribute__((ext_vector_type(2)));
typedef float f32x2_t __attribute__((ext_vector_type(2)));
DI unsigned cvt2(float a, float b) { f32x2_t v = {a, b}; return __builtin_bit_cast(unsigned, __builtin_convertvector(v, bf16x2_t)); }
template <int VAR> DI void attn_phase(int WV, KArgs a, int l, bool with_ctx, unsigned char* smem) {
  const int tid = ltid(), lane = tid & 63, wave = tid >> 6, r31 = lane & 31, h = lane >> 5, qsub = wave & 3, kh = wave >> 2;
  const bf16_t* PB = (const bf16_t*)(a->ws + WS_PB); bf16_t* BR = (bf16_t*)(a->ws + (VAR == 0 ? WS_BR : WS_H));
  const float* SC = (const float*)(a->ws + WS_SCAL) + l * 64;
  const float lam = SC[0], lam_init = SC[1];
  bf16_t* Ks = (bf16_t*)smem;
  bf16_t* Vt = Ks + 2 * 64 * AT_LD;
  float* cmb = (float*)(Vt + 2 * 64 * AT_LD);
  const int nitems = 6 * 128 + (with_ctx ? 12 : 0);
  const int skey = tid >> 3, sseg = tid & 7;
  for (int it = lbid(); it < (with_ctx ? 768 + lnb() : 768); it += lnb()) {
    int head, q0, krow0, nt;
    if (it >= 768) { const int e_ = lnb() - 1 - lbid(); if (e_ >= 12) continue; it = 768 + e_; }
    if (it < 768) { head = (it >> 8) * 2 + (it & 1); q0 = ((it & 255) >> 1) * 128; krow0 = 0; nt = MT_ / 64; }
    else { const int e = it - 768; head = e >> 1; q0 = L_ + (e & 1) * 128; krow0 = L_; nt = LC_ / 64; }
    const int qrow = q0 + 32 * qsub + r31;
    bf16x8 qf[2][2];
#pragma unroll
    for (int mp = 0; mp < 2; ++mp)
#pragma unroll
      for (int s = 0; s < 2; ++s) qf[mp][s] = *(const bf16x8*)(PB + (size_t)qrow * NPB_ + C_DQ + head * 64 + mp * 32 + 16 * s + 8 * h);
    float negm = 0.f;
#pragma unroll
    for (int mp = 0; mp < 2; ++mp) {
      float ss = 0.f;
#pragma unroll
      for (int s = 0; s < 2; ++s)
#pragma unroll
        for (int e = 0; e < 8; ++e) { const float x = bf2f((unsigned)(unsigned short)qf[mp][s][e]); ss += x * x; }
      ss += shx(ss, 32, lane_id_v());
      const float kmx = __uint_as_float(((const unsigned*)SC)[16 + head * 2 + mp]);
      negm = fminf(negm, -sqrtf(ss * kmx) * 1.01f);
    }
    f32x16 NM; for (int i = 0; i < 16; ++i) NM[i] = negm;
    f32x16 O1[2], O2[2]; for (int i = 0; i < 16; ++i) { O1[0][i] = 0.f; O1[1][i] = 0.f; O2[0][i] = 0.f; O2[1][i] = 0.f; }
    f32x4 LA = {0.f, 0.f, 0.f, 0.f}, LB = {0.f, 0.f, 0.f, 0.f};
    bf16x8 osel; { const bool on = ((lane & 15) == 0 && ((lane >> 4) & 1) == 0) || ((lane & 15) == 1 && ((lane >> 4) & 1) == 1);
      for (int e = 0; e < 8; ++e) osel[e] = on ? (short)0x3F80 : (short)0; }
#define MFMA16(a_, b_, c_) __builtin_amdgcn_mfma_f32_16x16x32_bf16((a_), (b_), (c_), 0, 0, 0)
    const bf16_t* kg = PB + (size_t)(krow0 + skey) * NPB_ + C_DK + head * 64 + sseg * 8;
    const bf16_t* vg = PB + (size_t)(krow0 + skey) * NPB_ + C_DV + head * 64 + sseg * 8;
    const int vslot = ((skey & ~12) | ((skey & 4) << 1) | ((skey & 8) >> 1)) ^ (sseg << 3);
    __syncthreads();
    bf16x8 kA = *(const bf16x8*)kg, vA = *(const bf16x8*)vg;
    bf16x8 kB = *(const bf16x8*)(kg + (size_t)64 * NPB_), vB = *(const bf16x8*)(vg + (size_t)64 * NPB_);
    { *(bf16x8*)(Ks + skey * AT_LD + sseg * 8) = kA;
#pragma unroll
      for (int e = 0; e < 8; ++e) Vt[(sseg * 8 + e) * AT_LD + vslot] = (bf16_t)vA[e]; }
    __syncthreads();
    for (int t = 0; t < nt; ++t) {
      const int buf = t & 1;
      const bf16_t* ks = Ks + buf * 64 * AT_LD + (32 * kh + r31) * AT_LD + 8 * h;
      const bf16_t* vt = Vt + buf * 64 * AT_LD + r31 * AT_LD;
      const bf16x8 k00 = *(const bf16x8*)(ks), k01 = *(const bf16x8*)(ks + 16), k10 = *(const bf16x8*)(ks + 32), k11 = *(const bf16x8*)(ks + 48);
      bf16x8 vf[2][2];
#pragma unroll
      for (int s = 0; s < 2; ++s)
#pragma unroll
        for (int mt = 0; mt < 2; ++mt) vf[mt][s] = *(const bf16x8*)(vt + mt * 32 * AT_LD + (((4 * kh + 2 * s + h) ^ ((4 * mt + (r31 >> 3)) & 7)) << 3));
      f32x16 S1 = MFMA32(k00, qf[0][0], NM); f32x16 S2 = MFMA32(k10, qf[1][0], NM); S1 = MFMA32(k01, qf[0][1], S1); S2 = MFMA32(k11, qf[1][1], S2);
      bf16x8 p1[2], p2[2];
      { u32x4 w0, w1;
#pragma unroll
        for (int i = 0; i < 4; ++i) { w0[i] = cvt2(VAR == 1 ? S1[2 * i] * 0.001f : __builtin_amdgcn_exp2f(S1[2 * i]), VAR == 1 ? S1[2 * i + 1] * 0.001f : __builtin_amdgcn_exp2f(S1[2 * i + 1]));
                                       w1[i] = cvt2(VAR == 1 ? S1[8 + 2 * i] * 0.001f : __builtin_amdgcn_exp2f(S1[8 + 2 * i]), VAR == 1 ? S1[9 + 2 * i] * 0.001f : __builtin_amdgcn_exp2f(S1[9 + 2 * i])); }
        p1[0] = __builtin_bit_cast(bf16x8, w0); p1[1] = __builtin_bit_cast(bf16x8, w1); }
      O1[0] = MFMA32(vf[0][0], p1[0], O1[0]); O1[1] = MFMA32(vf[1][0], p1[0], O1[1]); LA = MFMA16(osel, p1[0], LA);
      O1[0] = MFMA32(vf[0][1], p1[1], O1[0]); O1[1] = MFMA32(vf[1][1], p1[1], O1[1]); LA = MFMA16(osel, p1[1], LA);
      { u32x4 w0, w1;
#pragma unroll
        for (int i = 0; i < 4; ++i) { w0[i] = cvt2(VAR == 1 ? S2[2 * i] * 0.001f : __builtin_amdgcn_exp2f(S2[2 * i]), VAR == 1 ? S2[2 * i + 1] * 0.001f : __builtin_amdgcn_exp2f(S2[2 * i + 1]));
                                       w1[i] = cvt2(VAR == 1 ? S2[8 + 2 * i] * 0.001f : __builtin_amdgcn_exp2f(S2[8 + 2 * i]), VAR == 1 ? S2[9 + 2 * i] * 0.001f : __builtin_amdgcn_exp2f(S2[9 + 2 * i])); }
        p2[0] = __builtin_bit_cast(bf16x8, w0); p2[1] = __builtin_bit_cast(bf16x8, w1); }
      if (VAR != 5) {
      O2[0] = MFMA32(vf[0][0], p2[0], O2[0]); O2[1] = MFMA32(vf[1][0], p2[0], O2[1]); LB = MFMA16(osel, p2[0], LB);
      O2[0] = MFMA32(vf[0][1], p2[1], O2[0]); O2[1] = MFMA32(vf[1][1], p2[1], O2[1]); LB = MFMA16(osel, p2[1], LB); }
      __builtin_amdgcn_iglp_opt(2);
      { const int nb_ = buf ^ 1;
        *(bf16x8*)(Ks + nb_ * 64 * AT_LD + skey * AT_LD + sseg * 8) = kB;
#pragma unroll
        for (int e = 0; e < 8; ++e) Vt[nb_ * 64 * AT_LD + (sseg * 8 + e) * AT_LD + vslot] = (bf16_t)vB[e];
        const int tl_ = (t + 2 < nt) ? t + 2 : nt - 1;
        kB = *(const bf16x8*)(kg + (size_t)tl_ * 64 * NPB_); vB = *(const bf16x8*)(vg + (size_t)tl_ * 64 * NPB_); }
      __syncthreads();
    }
    float* cw = cmb + (size_t)(qsub * 64 + lane) * 66;
    const int sl_ = ((lane & 15) << 2);
    const float a0_ = __int_as_float(__builtin_amdgcn_ds_bpermute(sl_, __float_as_int(LA[0]))), a1_ = __int_as_float(__builtin_amdgcn_ds_bpermute(sl_, __float_as_int(LA[1])));
    const float b0_ = __int_as_float(__builtin_amdgcn_ds_bpermute(sl_, __float_as_int(LB[0]))), b1_ = __int_as_float(__builtin_amdgcn_ds_bpermute(sl_, __float_as_int(LB[1])));
    const float lq1 = (r31 >> 4) ? a1_ : a0_, lq2 = (r31 >> 4) ? b1_ : b0_;
    if (kh == 1) {
#pragma unroll
      for (int i = 0; i < 16; ++i) { cw[i] = O1[0][i]; cw[16 + i] = O1[1][i]; cw[32 + i] = O2[0][i]; cw[48 + i] = O2[1][i]; }
      cw[64] = lq1; cw[65] = lq2;
    }
    __syncthreads();
    if (kh == 0) {
#pragma unroll
      for (int i = 0; i < 16; ++i) { O1[0][i] += cw[i]; O1[1][i] += cw[16 + i]; O2[0][i] += cw[32 + i]; O2[1][i] += cw[48 + i]; }
      const float l1 = lq1 + cw[64], l2 = lq2 + cw[65];
      const float i1 = 1.0f / l1, i2 = lam / l2;
      float ss = 0.f;
#pragma unroll
      for (int mt = 0; mt < 2; ++mt)
#pragma unroll
        for (int i = 0; i < 16; ++i) { const float o = O1[mt][i] * i1 - O2[mt][i] * i2; O1[mt][i] = o; ss += o * o; }
      ss += shx(ss, 32, lane_id_v());
      const float sc = rsqrtf(ss * (1.0f / 64.0f) + EPS_) * (1.0f - lam_init);
      const float* sw = a->in[13] + l * 64;
#pragma unroll
      for (int mt = 0; mt < 2; ++mt)
#pragma unroll
        for (int g4 = 0; g4 < 4; ++g4) {
          const int v0 = 32 * mt + 8 * g4 + 4 * h;
          const f32x4 wv = *(const f32x4*)(sw + v0);
          u32x2 w; w.x = cvt_pk_bf16(O1[mt][4 * g4] * sc * wv[0], O1[mt][4 * g4 + 1] * sc * wv[1]); w.y = cvt_pk_bf16(O1[mt][4 * g4 + 2] * sc * wv[2], O1[mt][4 * g4 + 3] * sc * wv[3]);
          *(u32x2*)(BR + (size_t)qrow * 1024 + 640 + head * 64 + v0) = w;
        }
    }
  }
}
template <class Epi> DI void run_gemm(int WV, LAS unsigned char* lds, const bf16_t* A, int lda, const bf16_t* Bt, int M, int N, int K, const Epi& E) {
  pg8::Gemm g; g.A = A; g.Bt = Bt; g.M = M; g.N = N; g.K = K; g.lda = lda;
  pg8::StaticOrder S; S.init(M, N, lnb(), lbid());
  pg8::gemm_phase<Epi, pg8::StaticOrder, false>(WV, lds, g, S, E, nullptr);
}
struct EpiNull { static constexpr bool PERM = false, AFTER_DRAIN = false; float* U;
  DI void operator()(const f32x4 (&acc)[2][2][4][2], const Unit& u, int wr, int wc, int fr_, int fq_) const {
    f32x4 s = {0.f, 0.f, 0.f, 0.f};
#pragma unroll
    for (int ai = 0; ai < 2; ++ai) for (int bj = 0; bj < 2; ++bj) for (int m = 0; m < 4; ++m) for (int n = 0; n < 2; ++n) s += acc[ai][bj][m][n];
    if (s[0] == 123.456f) U[lane_id_v()] = s[1] + s[2] + s[3]; } };
struct CtxMerge0 { float* MXC; const bf16_t* G; DI void operator()(int r, int c, float v) const { MXC[r * 1024 + c] = bf2f(G[(size_t)r * NGB_ + c]) * v; } };
struct CtxMerge1 { float* MXC; const bf16_t* G; DI void operator()(int r, int c, float v) const { MXC[r * 1024 + c] += bf2f(G[(size_t)r * NGB_ + c]) * v; } };
struct CtxMerge2 { const float* MXC; const bf16_t* G; bf16_t* Hc; DI void operator()(int r, int c, float v) const { Hc[r * 1024 + c] = f2bf(MXC[r * 1024 + c] + bf2f(G[(size_t)r * NGB_ + c]) * v); } };
struct CtxResid { float* Xc; const float* gate; float scale; DI void operator()(int r, int c, float v) const { Xc[r * 1024 + c] += scale * gate[c] * v; } };

DI void phase_win(int WV, int l, unsigned char* smem) {
  KArgs a = kargs(); unsigned char* ws = a->ws;
  EpiWin E; E.PB = (bf16_t*)(ws + WS_PB); E.GB = (bf16_t*)(ws + WS_GB); E.TRET = (const float*)(ws + WS_TRET); E.TROW = (const float*)(ws + WS_TROW); E.TCOL = (const float*)(ws + WS_TCOL);
  E.kmax = (unsigned*)(ws + WS_SCAL) + l * 64 + 16;
  run_gemm(WV, (LAS unsigned char*)smem, (const bf16_t*)(ws + WS_H), 1024, (const bf16_t*)(ws + WS_WIN) + (size_t)l * 5888 * 1024, MT_, NWIN_, 1024, E);
}
DI void phase_merge(int WV, int l, unsigned char* smem) {
  LAS unsigned char* lds = (LAS unsigned char*)smem;
  { KArgs a = kargs(); unsigned char* ws = a->ws; EpiMerge<0> E; E.MX = (bf16_t*)a->out; E.G = (const bf16_t*)(ws + WS_GB); E.Hout = (bf16_t*)(ws + WS_H);
    run_gemm(WV, lds, (const bf16_t*)(ws + WS_BR), 1024, (const bf16_t*)(ws + WS_WBF) + (size_t)l * 1024 * 256, L_, 1024, 256, E); }
  { KArgs a = kargs(); unsigned char* ws = a->ws; EpiMerge<1> E; E.MX = (bf16_t*)a->out; E.G = (const bf16_t*)(ws + WS_GB) + 1024; E.Hout = (bf16_t*)(ws + WS_H);
    run_gemm(WV, lds, (const bf16_t*)(ws + WS_BR) + 256, 1024, (const bf16_t*)(ws + WS_WBR) + (size_t)l * 1024 * 384, L_, 1024, 384, E); }
  { KArgs a = kargs(); unsigned char* ws = a->ws; EpiMerge<2> E; E.MX = (bf16_t*)a->out; E.G = (const bf16_t*)(ws + WS_GB) + 2048; E.Hout = (bf16_t*)(ws + WS_H);
    run_gemm(WV, lds, (const bf16_t*)(ws + WS_BR) + 640, 1024, (const bf16_t*)(ws + WS_WBD) + (size_t)l * 1024 * 384, L_, 1024, 384, E); }
  if (l < DEPTH_ - 1) { KArgs a = kargs(); unsigned char* ws = a->ws;
    const bf16_t* BRc = (const bf16_t*)(ws + WS_BR) + (size_t)L_ * 1024; const bf16_t* GBc = (const bf16_t*)(ws + WS_GB) + (size_t)L_ * NGB_;
    CtxMerge0 e0; e0.MXC = (float*)(ws + WS_MXC); e0.G = GBc;
    ctx_gemm32(WV, BRc, 1024, (const bf16_t*)(ws + WS_WBF) + (size_t)l * 1024 * 256, 256, 1024, smem, e0);
    CtxMerge1 e1; e1.MXC = (float*)(ws + WS_MXC); e1.G = GBc + 1024;
    ctx_gemm32(WV, BRc + 256, 1024, (const bf16_t*)(ws + WS_WBR) + (size_t)l * 1024 * 384, 384, 1024, smem, e1);
    CtxMerge2 e2; e2.MXC = (const float*)(ws + WS_MXC); e2.G = GBc + 2048; e2.Hc = (bf16_t*)(ws + WS_H) + (size_t)L_ * 1024;
    ctx_gemm32(WV, BRc + 640, 1024, (const bf16_t*)(ws + WS_WBD) + (size_t)l * 1024 * 384, 384, 1024, smem, e2); }
}
DI void phase_wo(int WV, int l, unsigned char* smem) {
  { KArgs a = kargs(); unsigned char* ws = a->ws; EpiResid E; E.X = (float*)(ws + WS_X); E.gate = (const float*)(ws + WS_MOD) + (size_t)l * 9216 + 5 * 1024; E.scale = 1.0f;
    run_gemm(WV, (LAS unsigned char*)smem, (const bf16_t*)(ws + WS_H), 1024, (const bf16_t*)(ws + WS_WO) + (size_t)l * 1024 * 1024, L_, 1024, 1024, E); }
  if (l < DEPTH_ - 1) { KArgs a = kargs(); unsigned char* ws = a->ws; CtxResid e; e.Xc = (float*)(ws + WS_X) + (size_t)L_ * 1024; e.gate = (const float*)(ws + WS_MOD) + (size_t)(4 + l) * 9216 + 5 * 1024; e.scale = 1.0f;
    ctx_gemm32(WV, (const bf16_t*)(ws + WS_H) + (size_t)L_ * 1024, 1024, (const bf16_t*)(ws + WS_WO) + (size_t)l * 1024 * 1024, 1024, 1024, smem, e); }
}
DI void phase_g1(int WV, int l, int f, unsigned char* smem) {
  KArgs a = kargs(); unsigned char* ws = a->ws; EpiSwiglu E; E.U = (bf16_t*)(ws + WS_U);
  run_gemm(WV, (LAS unsigned char*)smem, (const bf16_t*)(ws + WS_H), 1024, (const bf16_t*)(ws + WS_W13) + (size_t)(l * 2 + f) * 5632 * 1024, MT_, 5632, 1024, E);
}
DI void phase_g2(int WV, int l, int f, unsigned char* smem) {
  const int gi = f == 0 ? 2 : 8;
  { KArgs a = kargs(); unsigned char* ws = a->ws; EpiResid E; E.X = (float*)(ws + WS_X); E.gate = (const float*)(ws + WS_MOD) + (size_t)l * 9216 + gi * 1024; E.scale = 0.5f;
    run_gemm(WV, (LAS unsigned char*)smem, (const bf16_t*)(ws + WS_U), 2816, (const bf16_t*)(ws + WS_W2) + (size_t)(l * 2 + f) * 1024 * 2816, L_, 1024, 2816, E); }
  if (!(l == DEPTH_ - 1 && f == 1)) { KArgs a = kargs(); unsigned char* ws = a->ws; CtxResid e; e.Xc = (float*)(ws + WS_X) + (size_t)L_ * 1024; e.gate = (const float*)(ws + WS_MOD) + (size_t)(4 + l) * 9216 + gi * 1024; e.scale = 0.5f;
    ctx_gemm32(WV, (const bf16_t*)(ws + WS_U) + (size_t)L_ * 2816, 2816, (const bf16_t*)(ws + WS_W2) + (size_t)(l * 2 + f) * 1024 * 2816, 2816, 1024, smem, e); }
}

DI unsigned xcc_id() { return (unsigned)__builtin_amdgcn_s_getreg((3 << 11) | 20) & 0xFu; }
DI void grid_bar(int WV, unsigned& gen, unsigned xcc, unsigned nloc, unsigned nx) {
  asm volatile("s_waitcnt vmcnt(0)" ::: "memory");
  __syncthreads();
  gen += 1;
  if (ltid() == 0) {
    unsigned* bar = (unsigned*)(kargs()->ws + WS_BAR);
    const unsigned old = __hip_atomic_fetch_add(bar + 320 + 16 * xcc, 1u, __ATOMIC_RELAXED, __HIP_MEMORY_SCOPE_AGENT);
    if (old + 1u == gen * nloc) {
      __builtin_amdgcn_fence(__ATOMIC_RELEASE, "agent");
      asm volatile("s_waitcnt vmcnt(0)" ::: "memory");
      __hip_atomic_fetch_add(bar + 640, 1u, __ATOMIC_RELAXED, __HIP_MEMORY_SCOPE_AGENT);
    }
    const unsigned target = gen * nx;
    while (__hip_atomic_load(bar + 640, __ATOMIC_RELAXED, __HIP_MEMORY_SCOPE_AGENT) < target) __builtin_amdgcn_s_sleep(1);
    __builtin_amdgcn_fence(__ATOMIC_ACQUIRE, "agent");
    asm volatile("s_waitcnt vmcnt(0)" ::: "memory");
  }
  __syncthreads();
}

__global__ void __launch_bounds__(512, 2) mega(Args a_unused) {
  extern __shared__ __attribute__((aligned(16))) unsigned char smem[];
  cg::grid_group grid = cg::this_grid();
  const int WV = __builtin_amdgcn_readfirstlane((int)(threadIdx.x >> 6));
  const unsigned xcc = xcc_id();
  if (threadIdx.x == 0) __hip_atomic_fetch_add((unsigned*)(kargs()->ws + WS_BAR) + 16 + 16 * xcc, 1u, __ATOMIC_RELAXED, __HIP_MEMORY_SCOPE_AGENT);
#ifndef NO_PRO
  prologue(WV, kargs(), smem);
#ifdef PROBE_PRO
  __syncthreads(); prologue(WV, kargs(), smem);
#endif
#endif
  grid.sync();
  unsigned gen = 0, nloc = 1, nx = 0;
  { const unsigned* cen = (const unsigned*)(kargs()->ws + WS_BAR) + 16;
    for (int j = 0; j < 16; ++j) { const unsigned cj = __hip_atomic_load(cen + 16 * j, __ATOMIC_RELAXED, __HIP_MEMORY_SCOPE_AGENT); nx += cj ? 1u : 0u; if ((unsigned)j == xcc) nloc = cj; }
    nloc = __builtin_amdgcn_readfirstlane(nloc); nx = __builtin_amdgcn_readfirstlane(nx); }
#pragma unroll 1
  for (int l = 0; l < DEPTH_; ++l) {
#pragma unroll 1
    for (int f = 0; f < 2; ++f) {
      if (f == 1) {
        norm_phase(WV, kargs(), l, 1, false);
        grid_bar(WV, gen, xcc, nloc, nx);
        phase_win(WV, l, smem);
#ifdef PROBE_WIN
        phase_win(WV, l, smem);
#endif
        grid_bar(WV, gen, xcc, nloc, nx);
#ifndef NO_MIXA
        fourier_tables(WV, smem); __syncthreads(); fourier_stage1(WV, kargs(), smem); if (l < DEPTH_ - 1) fourier_ctx(WV, kargs(), smem); __syncthreads(); ret_states(WV, kargs(), l, smem);
#ifdef PROBE_RS
        __syncthreads(); ret_states(WV, kargs(), l, smem);
#endif
#ifdef PROBE_F1
        __syncthreads(); fourier_tables(WV, smem); __syncthreads(); fourier_stage1(WV, kargs(), smem);
#endif
#ifdef PROBE_FC
        __syncthreads(); fourier_ctx(WV, kargs(), smem);
#endif
#ifdef PROBE_MIXA
        __syncthreads();
        fourier_tables(WV, smem); __syncthreads(); fourier_stage1(WV, kargs(), smem); fourier_ctx(WV, kargs(), smem); __syncthreads(); ret_states(WV, kargs(), l, smem);
#endif
#endif
        grid_bar(WV, gen, xcc, nloc, nx);
#ifndef NO_MIXB
        ret_scan(WV, kargs(), l); __syncthreads(); fourier_tables(WV, smem); __syncthreads(); fourier_stage2(WV, kargs(), smem);
#ifdef PROBE_MIXB
        __syncthreads();
        ret_scan(WV, kargs(), l); __syncthreads(); fourier_tables(WV, smem); __syncthreads(); fourier_stage2(WV, kargs(), smem);
#endif
#endif
        grid_bar(WV, gen, xcc, nloc, nx);
#ifndef NO_RETOUT
        ret_out(WV, kargs(), l, smem); __syncthreads();
#ifdef PROBE_RET
        ret_out(WV, kargs(), l, smem); __syncthreads();
#endif
#endif
#ifndef NO_ATTN
        attn_phase<0>(WV, kargs(), l, l < DEPTH_ - 1, smem);
#ifdef PROBE_ATTN
        __syncthreads(); attn_phase<PROBE_ATTN>(WV, kargs(), l, l < DEPTH_ - 1, smem);
#endif
#endif
        grid_bar(WV, gen, xcc, nloc, nx);
        phase_merge(WV, l, smem);
#ifdef PROBE_MERGE
        phase_merge(WV, l, smem);
#endif
        grid_bar(WV, gen, xcc, nloc, nx);
        phase_wo(WV, l, smem);
        grid_bar(WV, gen, xcc, nloc, nx);
      }
      norm_phase(WV, kargs(), l, f == 0 ? 0 : 2, l == 0 && f == 0);
      grid_bar(WV, gen, xcc, nloc, nx);
      phase_g1(WV, l, f, smem);
#ifdef PROBE_G1
      phase_g1(WV, l, f, smem);
#endif
#ifdef PROBE_G1NULL
      { KArgs a = kargs(); unsigned char* ws = a->ws; EpiNull E; E.U = (float*)a->out;
        run_gemm(WV, (LAS unsigned char*)smem, (const bf16_t*)(ws + WS_H), 1024, (const bf16_t*)(ws + WS_W13) + (size_t)(l * 2 + f) * 5632 * 1024, MT_, 5632, 1024, E); }
#endif
      grid_bar(WV, gen, xcc, nloc, nx);
      phase_g2(WV, l, f, smem);
      grid_bar(WV, gen, xcc, nloc, nx);
    }
  }
  final_norm(WV, kargs());
}

extern "C" void kernel_launch(void* const* d_in, const int* in_sizes, int n_in, void* d_out, int out_size, void* d_ws, size_t ws_size, hipStream_t stream) {
  static int grid = 0;
  if (grid == 0) {
    int dev = 0, cus = 0, per_cu = 0;
    (void)hipGetDevice(&dev); (void)hipDeviceGetAttribute(&cus, hipDeviceAttributeMultiprocessorCount, dev);
    if (hipFuncSetAttribute((const void*)mega, hipFuncAttributeMaxDynamicSharedMemorySize, LDS_BYTES) != hipSuccess) fprintf(stderr, "kernel_launch: hipFuncSetAttribute failed\n");
    if (hipOccupancyMaxActiveBlocksPerMultiprocessor(&per_cu, (const void*)mega, 512, LDS_BYTES) != hipSuccess || per_cu < 1) fprintf(stderr, "kernel_launch: occupancy query says %d blocks per CU\n", per_cu);
    (void)hipGetLastError();
    grid = cus > 0 ? cus : 256;
    if (ws_size < WS_END) { fprintf(stderr, "kernel_launch: workspace too small: %zu < %zu\n", ws_size, (size_t)WS_END); }
  }
  Args a{};
  for (int i = 0; i < 19; ++i) a.in[i] = (const float*)d_in[i];
  a.out = (float*)d_out; a.ws = (unsigned char*)d_ws;
  (void)hipMemsetAsync((unsigned char*)d_ws + WS_BAR, 0, 8192, stream);
  void* args[] = {&a};
  hipError_t e = hipLaunchCooperativeKernel((const void*)mega, dim3(grid), dim3(512), args, LDS_BYTES, stream);
  if (e != hipSuccess) fprintf(stderr, "kernel_launch: cooperative launch failed: %s (grid %d)\n", hipGetErrorString(e), grid);
}
```

```cpp
#include <hip/hip_runtime.h>
#include <hip/hip_cooperative_groups.h>
#include <cstdio>
namespace cg = cooperative_groups;
__device__ __forceinline__ int lane_id_v() { int l; asm volatile("v_mbcnt_lo_u32_b32 %0, -1, 0\n\tv_mbcnt_hi_u32_b32 %0, -1, %0" : "=v"(l)); return l; }
#define ltid() ((WV << 6) | lane_id_v())
__device__ __forceinline__ float shx(float v, int m, int lane) { return __int_as_float(__builtin_amdgcn_ds_bpermute((lane ^ m) << 2, __float_as_int(v))); }
namespace pg8 {
#define PG8_LAS __attribute__((address_space(3)))
typedef unsigned short bf16_t;
typedef short bf16x8 __attribute__((ext_vector_type(8)));
typedef float f32x4 __attribute__((ext_vector_type(4)));
typedef unsigned u32x4 __attribute__((ext_vector_type(4)));
constexpr int BM = 256, BK = 64, HALF = 128, HTB = HALF * BK * 2  , STAGE_BYTES = 8 * HTB, NXCD = 8, WGM = 8;

__host__ __device__ __forceinline__ int lds_byte(int r, int c) { const int st = (r >> 4) * 2 + (c >> 5), rr = r & 15, cc = c & 31, ob = rr * 64 + cc * 2; return st * 1024 + (ob ^ (((ob >> 9) & 1) << 5)); }
__host__ __device__ __forceinline__ void stage_rc(int b, int& R, int& C) { const int st = b / 1024, sb = b % 1024, swz = sb ^ (((sb >> 9) & 1) << 5); R = (st >> 1) * 16 + swz / 64; C = (st & 1) * 32 + (swz % 64) / 2; }
__host__ __device__ __forceinline__ int perm32(int rho) { const int n = rho >> 4, i = rho & 15; return 8 * (i >> 2) + 4 * n + (i & 3); }

struct Unit { int pm, pn; };
struct Gemm { const bf16_t* A; const bf16_t* Bt; int M, N, K, lda; };

struct StaticOrder {
    int nM, nN, nwg, G, c;
    __host__ __device__ void init(int M, int N, int G_, int c_) { nM = M / BM; nN = N / BM; nwg = nM * nN; G = G_; c = c_; }
    __host__ __device__ bool next(int i, Unit& u) const {
        const long L = (long)i * G + c; if (L >= nwg) return false;
        int wgid = (int)L; { const int q = nwg / NXCD, r = nwg % NXCD, xcd = wgid % NXCD, off = wgid / NXCD; wgid = (xcd < r ? xcd * (q + 1) : r * (q + 1) + (xcd - r) * q) + off; }
        const int nig = WGM * nN, gid = wgid / nig, fm = gid * WGM, gsz = (nM - fm) < WGM ? (nM - fm) : WGM;
        u.pm = fm + ((wgid % nig) % gsz); u.pn = (wgid % nig) / gsz; return true;
    }
    __device__ __forceinline__ void a_ready(const Unit&) const {}
    __device__ __forceinline__ void done(const Unit&) const {}
};
__device__ __forceinline__ unsigned cvt_pk_bf16(float lo, float hi) { unsigned r; asm volatile("v_cvt_pk_bf16_f32 %0, %1, %2" : "=v"(r) : "v"(lo), "v"(hi)); return r; }
template <class Epi, class Sched, bool STAMP = false>
__device__ __forceinline__ void gemm_phase(const int WV, PG8_LAS unsigned char* lds, const Gemm g, const Sched& S, const Epi& E, unsigned long long* stamps) {
    const int tid = ltid(); const int wid = __builtin_amdgcn_readfirstlane(tid >> 6), lane = tid & 63, wr = wid >> 2, wc = wid & 3, fr = lane & 15, fq = lane >> 4;
    const int K = g.K, nt = K / BK;
    int ts_lo = 0, ts_hi = 0, nts = 0; const unsigned long long rt_entry = STAMP ? (unsigned long long)wall_clock64() : 0ull;
#define PG8_STAMP() do { if (STAMP && wid == 0 && nts < 64) { const unsigned long long _c = (unsigned long long)clock64(); \
        ts_lo = (lane == nts) ? (int)(unsigned)_c : ts_lo; ts_hi = (lane == nts) ? (int)(unsigned)(_c >> 32) : ts_hi; ++nts; } } while (0)
    PG8_STAMP();
    unsigned voffA[2], voffB[2];
#pragma unroll
    for (int i = 0; i < 2; ++i) { int R, C; stage_rc(tid * 16 + i * 8192, R, C); const int Rb = Epi::PERM ? ((R & ~31) + perm32(R & 31)) : R;
        voffA[i] = (unsigned)(R * g.lda + C) * 2u; voffB[i] = (unsigned)(Rb * K + C) * 2u; }
    const size_t kstep = (size_t)(BK * 2);
    const size_t hstep = (size_t)HALF * K * 2;
    const size_t tstep = 2 * hstep; const size_t hstepA = (size_t)HALF * g.lda * 2; const size_t tstepA = 2 * hstepA;
    const unsigned ldsw = (unsigned)wid * 1024u;
    const int aoff = lds_byte(wr * 64 + fr, fq * 8), boff = lds_byte(wc * 32 + fr, fq * 8);
#define PG8_SA(b, h) (((b) * 2 + (h)) * HTB)
#define PG8_SB(b, h) ((4 + (b) * 2 + (h)) * HTB)
#define PG8_STAGE(bufoff, gbase, voff) do { _Pragma("unroll") for (int _i = 0; _i < 2; ++_i) \
        __builtin_amdgcn_global_load_lds((const unsigned*)((const char*)(gbase) + (voff)[_i]), (PG8_LAS unsigned*)(lds + (bufoff) + ldsw + _i * 8192), 16, 0, 0); } while (0)
#define PG8_LDA(dst, b, h) do { _Pragma("unroll") for (int m = 0; m < 4; ++m) _Pragma("unroll") for (int k = 0; k < 2; ++k) dst[m][k] = *(const PG8_LAS bf16x8*)(lds + PG8_SA(b, h) + aoff + m * 2048 + k * 1024); } while (0)
#define PG8_LDB(dst, b, h) do { _Pragma("unroll") for (int n = 0; n < 2; ++n) _Pragma("unroll") for (int k = 0; k < 2; ++k) dst[n][k] = *(const PG8_LAS bf16x8*)(lds + PG8_SB(b, h) + boff + n * 2048 + k * 1024); } while (0)
#define PG8_MMA(ai, bj, At, Bt) do { __builtin_amdgcn_s_setprio(1); _Pragma("unroll") for (int m = 0; m < 4; ++m) _Pragma("unroll") for (int n = 0; n < 2; ++n) _Pragma("unroll") for (int k = 0; k < 2; ++k) \
        acc[ai][bj][m][n] = __builtin_amdgcn_mfma_f32_16x16x32_bf16(Bt[n][k], At[m][k], acc[ai][bj][m][n], 0, 0, 0); __builtin_amdgcn_s_setprio(0); } while (0)
#define PG8_WAIT_V(n) asm volatile("s_waitcnt vmcnt(" #n ")" ::: "memory")
#define PG8_WAIT_L(n) asm volatile("s_waitcnt lgkmcnt(" #n ")" ::: "memory")
#define PG8_BAR __builtin_amdgcn_s_barrier()
#define PG8_SCHED __builtin_amdgcn_sched_barrier(0)
    Unit cur, nxt; int ui = 0;
    if (!S.next(0, cur)) return;
    f32x4 acc[2][2][4][2];
#pragma unroll
    for (int a = 0; a < 2; ++a)
#pragma unroll
        for (int b = 0; b < 2; ++b)
#pragma unroll
            for (int m = 0; m < 4; ++m)
#pragma unroll
                for (int n = 0; n < 2; ++n) acc[a][b][m][n] = (f32x4){0.f, 0.f, 0.f, 0.f};
    bf16x8 At[4][2], B0[2][2], B1[2][2];
    const char* cA = (const char*)g.A + (size_t)cur.pm * tstepA; const char* cB = (const char*)g.Bt + (size_t)cur.pn * tstep;
    S.a_ready(cur);
    PG8_STAGE(PG8_SB(0, 0), cB, voffB); PG8_STAGE(PG8_SA(0, 0), cA, voffA); PG8_STAGE(PG8_SB(0, 1), cB + hstep, voffB); PG8_STAGE(PG8_SA(0, 1), cA + hstepA, voffA);
    if (wr == 1) PG8_BAR;
    PG8_WAIT_V(4); PG8_BAR;
    PG8_STAGE(PG8_SB(1, 0), cB + kstep, voffB); PG8_STAGE(PG8_SA(1, 0), cA + kstep, voffA); PG8_STAGE(PG8_SB(1, 1), cB + hstep + kstep, voffB);
    PG8_WAIT_V(6); PG8_BAR;
    PG8_STAMP();
    for (;;) {
        const bool has_next = S.next(ui + 1, nxt);
        const char* nA = has_next ? (const char*)g.A + (size_t)nxt.pm * tstepA : cA; const char* nB = has_next ? (const char*)g.Bt + (size_t)nxt.pn * tstep : cB;
        for (int t = 0; t < nt; t += 2) {
            const bool last = (t == nt - 2);
            const char* a1 = cA + (size_t)(t + 1) * kstep;
            const char* a2 = last ? nA : cA + (size_t)(t + 2) * kstep; const char* b2 = last ? nB : cB + (size_t)(t + 2) * kstep;
            const char* a3 = a2 + kstep; const char* b3 = b2 + kstep;
            if (last && has_next) S.a_ready(nxt);
            PG8_LDB(B0, 0, 0); PG8_SCHED; PG8_LDA(At, 0, 0); PG8_STAGE(PG8_SA(1, 1), a1 + hstepA, voffA);
            PG8_WAIT_L(8); PG8_BAR; PG8_WAIT_L(0); PG8_MMA(0, 0, At, B0); PG8_BAR; PG8_SCHED;
            PG8_LDB(B1, 0, 1); PG8_STAGE(PG8_SB(0, 0), b2, voffB);
            PG8_BAR; PG8_WAIT_L(0); PG8_MMA(0, 1, At, B1); PG8_BAR;
            PG8_LDA(At, 0, 1); PG8_STAGE(PG8_SA(0, 0), a2, voffA);
            PG8_BAR; PG8_WAIT_L(0); PG8_MMA(1, 0, At, B0); PG8_BAR; PG8_SCHED;
            PG8_STAGE(PG8_SB(0, 1), b2 + hstep, voffB);
            PG8_WAIT_V(6); PG8_BAR; PG8_MMA(1, 1, At, B1); PG8_BAR;
            PG8_LDB(B0, 1, 0); PG8_SCHED; PG8_LDA(At, 1, 0); PG8_STAGE(PG8_SA(0, 1), a2 + hstepA, voffA);
            PG8_WAIT_L(8); PG8_BAR; PG8_WAIT_L(0); PG8_MMA(0, 0, At, B0); PG8_BAR; PG8_SCHED;
            PG8_LDB(B1, 1, 1); PG8_STAGE(PG8_SB(1, 0), b3, voffB);
            PG8_BAR; PG8_WAIT_L(0); PG8_MMA(0, 1, At, B1); PG8_BAR;
            PG8_LDA(At, 1, 1); PG8_STAGE(PG8_SA(1, 0), a3, voffA);
            PG8_BAR; PG8_WAIT_L(0); PG8_MMA(1, 0, At, B0); PG8_BAR; PG8_SCHED;
            PG8_STAGE(PG8_SB(1, 1), b3 + hstep, voffB);
            PG8_WAIT_V(6); PG8_BAR; PG8_MMA(1, 1, At, B1); PG8_BAR;
        }
        PG8_STAMP();
        if constexpr (!Epi::AFTER_DRAIN) { E(acc, cur, wr, wc, fr, fq); S.done(cur); }
        PG8_STAMP();
        if (!has_next) break;
#pragma unroll
        for (int a = 0; a < 2; ++a)
#pragma unroll
            for (int b = 0; b < 2; ++b)
#pragma unroll
                for (int m = 0; m < 4; ++m)
#pragma unroll
                    for (int n = 0; n < 2; ++n) acc[a][b][m][n] = (f32x4){0.f, 0.f, 0.f, 0.f};
        cur = nxt; cA = nA; cB = nB; ++ui;
    }
    PG8_WAIT_V(0);
    if (wr == 0) PG8_BAR;
    PG8_BAR;
    if constexpr (Epi::AFTER_DRAIN) { E.fused(acc, cur, wr, wc, fr, fq, lds, wid, lane); S.done(cur); }
    PG8_STAMP();
    if (STAMP && wid == 0) { stamps[lane] = lane < nts ? (((unsigned long long)(unsigned)ts_hi << 32) | (unsigned)ts_lo) : 0ull;
        if (lane == 62) stamps[62] = rt_entry; if (lane == 63) stamps[63] = (unsigned long long)wall_clock64(); }
#undef PG8_STAMP
#undef PG8_SA
#undef PG8_SB
#undef PG8_STAGE
#undef PG8_LDA
#undef PG8_LDB
#undef PG8_MMA
#undef PG8_WAIT_V
#undef PG8_WAIT_L
#undef PG8_BAR
#undef PG8_SCHED
}
}
using pg8::bf16_t; using pg8::bf16x8; using pg8::f32x4; using pg8::u32x4; using pg8::cvt_pk_bf16;
typedef float f32x16 __attribute__((ext_vector_type(16)));
typedef short s16x4 __attribute__((ext_vector_type(4)));
typedef unsigned u32x2 __attribute__((ext_vector_type(2)));
#define DI __device__ __forceinline__
#define LAS __attribute__((address_space(3)))
#define MFMA32(a, b, c) __builtin_amdgcn_mfma_f32_32x32x16_bf16((a), (b), (c), 0, 0, 0)

constexpr int L_ = 16384, LC_ = 256, MT_ = 16640, D_ = 1024, DFF_ = 2816, DEPTH_ = 4;
constexpr int NWIN_ = 5888, NPB_ = 2816, NGB_ = 3072;
constexpr int C_FA = 0, C_FB = 256, C_RQ = 512, C_RK = 704, C_RV = 896, C_RG = 1280, C_DQ = 1664, C_DK = 2048, C_DV = 2432;
constexpr int LDS_BYTES = 147456;
constexpr float EPS_ = 1e-6f;

constexpr size_t al256(size_t x) { return (x + 255) & ~(size_t)255; }
constexpr size_t WS_W13 = 0;
constexpr size_t WS_W2  = WS_W13 + (size_t)4 * 2 * 5632 * 1024 * 2;
constexpr size_t WS_WIN = WS_W2 + (size_t)4 * 2 * 1024 * 2816 * 2;
constexpr size_t WS_WBF = WS_WIN + (size_t)4 * 5888 * 1024 * 2;
constexpr size_t WS_WBR = WS_WBF + (size_t)4 * 1024 * 256 * 2;
constexpr size_t WS_WBD = WS_WBR + (size_t)4 * 1024 * 384 * 2;
constexpr size_t WS_WO  = WS_WBD + (size_t)4 * 1024 * 384 * 2;
constexpr size_t WS_X   = WS_WO + (size_t)4 * 1024 * 1024 * 2;
constexpr size_t WS_H   = WS_X + (size_t)MT_ * 1024 * 4;
constexpr size_t WS_BR  = WS_H + (size_t)MT_ * 1024 * 2;
constexpr size_t WS_AL  = WS_BR + (size_t)MT_ * 1024 * 2;
constexpr size_t WS_U   = WS_AL;
constexpr size_t WS_PB  = WS_AL;
constexpr size_t WS_GB  = WS_AL + (size_t)MT_ * 2816 * 2;
constexpr size_t WS_V   = WS_GB + (size_t)MT_ * 3072 * 2;
constexpr size_t WS_T   = WS_V + (size_t)128 * 128 * 2 * 256 * 2;
constexpr size_t WS_S   = WS_T + (size_t)130 * 6 * 2 * 2048 * 4;
constexpr size_t WS_MXC = WS_S + (size_t)130 * 6 * 2 * 2048 * 4;
constexpr size_t WS_MOD = WS_MXC + (size_t)256 * 1024 * 4;
constexpr size_t WS_TRET = WS_MOD + (size_t)2 * 4 * 9216 * 4;
constexpr size_t WS_TROW = WS_TRET + (size_t)16384 * 16 * 2 * 4;
constexpr size_t WS_TCOL = WS_TROW + (size_t)256 * 8 * 2 * 4;
constexpr size_t WS_SCAL = WS_TCOL + (size_t)64 * 8 * 2 * 4;
constexpr size_t WS_BAR = WS_SCAL + 4 * 64 * 4;
constexpr size_t WS_END = WS_BAR + 8192;

__device__ __forceinline__ int lbid() { int t = blockIdx.x; asm volatile("" : "+s"(t)); return t; }
__device__ __forceinline__ int lnb() { int t = gridDim.x; asm volatile("" : "+s"(t)); return t; }
struct Args { const float* in[19]; float* out; unsigned char* ws; };
typedef const Args __attribute__((address_space(4)))* KArgs;
__device__ __forceinline__ KArgs kargs() { KArgs p = (KArgs)__builtin_amdgcn_kernarg_segment_ptr(); asm volatile("" : "+s"(p)); return p; }

DI float bf2f(unsigned v) { return __uint_as_float(v << 16); }
DI bf16_t f2bf(float x) { return (bf16_t)(cvt_pk_bf16(x, 0.f) & 0xffffu); }
DI int crow(int reg, int h) { return (reg & 3) + 8 * (reg >> 2) + 4 * h; }
DI bf16x8 pack_step(const f32x16& x, int s) {
  u32x4 p;
  asm volatile("v_cvt_pk_bf16_f32 %0, %4, %5\n\tv_cvt_pk_bf16_f32 %1, %6, %7\n\tv_cvt_pk_bf16_f32 %2, %8, %9\n\tv_cvt_pk_bf16_f32 %3, %10, %11\n\ts_nop 1"
               : "=&v"(p[0]), "=&v"(p[1]), "=&v"(p[2]), "=&v"(p[3])
               : "v"(x[8 * s]), "v"(x[8 * s + 1]), "v"(x[8 * s + 2]), "v"(x[8 * s + 3]), "v"(x[8 * s + 4]), "v"(x[8 * s + 5]), "v"(x[8 * s + 6]), "v"(x[8 * s + 7]));
  return __builtin_bit_cast(bf16x8, p);
}
DI float silu_f(float a) { return a * __builtin_amdgcn_rcpf(1.0f + __expf(-a)); }
DI float sigmoid_f(float a) { return __builtin_amdgcn_rcpf(1.0f + __expf(-a)); }
DI float wave_sum(float v) {
  const int lane = lane_id_v();
#pragma unroll
  for (int o = 32; o > 0; o >>= 1) v += shx(v, o, lane);
  return v;
}
DI void sincos_acc(float xf, float& s, float& c) {
  const double x = (double)xf;
  const double k = rint(x * 0.63661977236758134308);
  double r = fma(-k, 1.57079632679489655800e+00, x); r = fma(-k, 6.12323399573676603587e-17, r);
  const double r2 = r * r;
  double sp = -1.0 / 39916800.0; sp = fma(sp, r2, 1.0 / 362880.0); sp = fma(sp, r2, -1.0 / 5040.0); sp = fma(sp, r2, 1.0 / 120.0); sp = fma(sp, r2, -1.0 / 6.0); sp = fma(sp * r2, r, r);
  double cp = 1.0 / 479001600.0; cp = fma(cp, r2, -1.0 / 3628800.0); cp = fma(cp, r2, 1.0 / 40320.0); cp = fma(cp, r2, -1.0 / 720.0); cp = fma(cp, r2, 1.0 / 24.0); cp = fma(cp, r2, -0.5); cp = fma(cp, r2, 1.0);
  const int q = ((int)(long long)k) & 3;
  const double sv = (q == 0) ? sp : (q == 1) ? cp : (q == 2) ? -sp : -cp;
  const double cv = (q == 0) ? cp : (q == 1) ? -sp : (q == 2) ? -cp : sp;
  s = (float)sv; c = (float)cv;
}
__constant__ float INV16[16] = {1.0f, 0.5623413324356079f, 0.3162277638912201f, 0.17782793939113617f, 0.10000000149011612f, 0.05623413249850273f, 0.03162277489900589f, 0.017782794311642647f,
                             0.009999999776482582f, 0.005623413249850273f, 0.003162277629598975f, 0.0017782794311642647f, 0.0010000000474974513f, 0.000562341301701963f, 0.0003162277571391314f, 0.00017782794020604342f};
struct ConvJob { const float* src; const float* src2; bf16_t* dst; int N, K, ld, kind; };
DI ConvJob conv_job(KArgs a, int j) {
  const int l = j / 9, kd = j % 9; ConvJob J; J.src2 = nullptr; J.kind = 0;
  unsigned char* ws = a->ws;
  switch (kd) {
    case 0: case 1: { const int f = kd; J.src = a->in[7] + (size_t)(l * 2 + f) * 1024 * 2816; J.src2 = a->in[8] + (size_t)(l * 2 + f) * 1024 * 2816; J.dst = (bf16_t*)(ws + WS_W13) + (size_t)(l * 2 + f) * 5632 * 1024; J.N = 5632; J.K = 1024; J.ld = 2816; J.kind = 1; break; }
    case 2: case 3: { const int f = kd - 2; J.src = a->in[9] + (size_t)(l * 2 + f) * 2816 * 1024; J.dst = (bf16_t*)(ws + WS_W2) + (size_t)(l * 2 + f) * 1024 * 2816; J.N = 1024; J.K = 2816; J.ld = 1024; break; }
    case 4: { J.src = a->in[10] + (size_t)l * 1024 * 5632; J.dst = (bf16_t*)(ws + WS_WIN) + (size_t)l * 5888 * 1024; J.N = 5888; J.K = 1024; J.ld = 5632; J.kind = 2; break; }
    case 5: { J.src = a->in[14] + (size_t)l * 256 * 1024; J.dst = (bf16_t*)(ws + WS_WBF) + (size_t)l * 1024 * 256; J.N = 1024; J.K = 256; J.ld = 1024; break; }
    case 6: { J.src = a->in[15] + (size_t)l * 384 * 1024; J.dst = (bf16_t*)(ws + WS_WBR) + (size_t)l * 1024 * 384; J.N = 1024; J.K = 384; J.ld = 1024; break; }
    case 7: { J.src = a->in[16] + (size_t)l * 384 * 1024; J.dst = (bf16_t*)(ws + WS_WBD) + (size_t)l * 1024 * 384; J.N = 1024; J.K = 384; J.ld = 1024; break; }
    default: { J.src = a->in[17] + (size_t)l * 1024 * 1024; J.dst = (bf16_t*)(ws + WS_WO) + (size_t)l * 1024 * 1024; J.N = 1024; J.K = 1024; J.ld = 1024; break; }
  }
  return J;
}
DI int axial_perm(int s) { return s < 8 ? s : (s < 16 ? s + 8 : (s < 24 ? s - 8 : s)); }

DI void prologue(int WV, KArgs a, unsigned char* smem) {
  const int tid = ltid(), nb = lnb(), bid = lbid();
  float* t = (float*)smem;
  float* tr = t + 64 * 65;
  {
    constexpr int tiles_per_layer = 1408 * 2 + 704 * 2 + 1472 + 64 + 96 + 96 + 256;
    const int nn = tid & 63, kq = tid >> 6;
#pragma unroll 1
    for (int g = bid; g < 4 * tiles_per_layer; g += nb) {
      const int l = g / tiles_per_layer; int rem = g % tiles_per_layer; int kd;
      if (rem < 1408) kd = 0; else if (rem < 2816) { kd = 1; rem -= 1408; } else if (rem < 3520) { kd = 2; rem -= 2816; } else if (rem < 4224) { kd = 3; rem -= 3520; }
      else if (rem < 5696) { kd = 4; rem -= 4224; } else if (rem < 5760) { kd = 5; rem -= 5696; } else if (rem < 5856) { kd = 6; rem -= 5760; } else if (rem < 5952) { kd = 7; rem -= 5856; } else { kd = 8; rem -= 5952; }
      const ConvJob J = conv_job(a, l * 9 + kd);
      const int nkt = J.K / 64; const int n0 = (rem / nkt) * 64, k0 = (rem % nkt) * 64;
      const bool fold = (J.kind == 2) && (n0 < 512);
      const float* sp = J.src; int col = n0 + nn;
      if (J.kind == 1) { const int n = n0 + nn, gi = n >> 5, s = n & 31; sp = (s < 16) ? J.src : J.src2; col = 16 * gi + (s & 15); }
      else if (J.kind == 2) {
        const int n = n0 + nn;
        if (fold) col = (n0 & 192) + nn;
        else { col = n - 256; if (n >= C_DQ && n < C_DV) { const int s = n & 31; col = (n - 256 - s) + axial_perm(s); } }
      }
      const float* cp = sp + (size_t)(k0 + kq) * J.ld + col;
      float lv[8];
#pragma unroll
      for (int i = 0; i < 8; ++i) lv[i] = cp[(size_t)(8 * i) * J.ld];
#pragma unroll
      for (int i = 0; i < 8; ++i) t[nn * 65 + kq + 8 * i] = lv[i];
      if (fold && tid < 64) { const float ang = (float)tid * (1.0f / 32.0f); tr[tid] = (n0 >= 256) ? sinpif(ang) : cospif(ang); }
      __syncthreads();
      if (!fold) {
#pragma unroll
        for (int i = 0; i < 4; ++i) {
          const int e = tid + i * 512, n2 = e >> 5, kp = (e & 31) * 2;
          *(unsigned*)(J.dst + (size_t)(n0 + n2) * J.K + k0 + kp) = cvt_pk_bf16(t[n2 * 65 + kp], t[n2 * 65 + kp + 1]);
        }
      } else {
#pragma unroll 1
        for (int i = 0; i < 8; ++i) {
          const int m = kq + 8 * i, kk = nn;
          float acc = 0.f;
#pragma unroll 8
          for (int c = 0; c < 64; ++c) acc += t[c * 65 + kk] * tr[(m * c) & 63];
          J.dst[(size_t)(n0 + m) * J.K + k0 + kk] = f2bf(acc);
        }
      }
      __syncthreads();
    }
  }
  {
    float* sc = (float*)smem; float* scc = sc + 1024; float* red = scc + 1024;
    __syncthreads();
    for (int i = tid; i < 1024; i += 512) { sc[i] = silu_f(a->in[1][i]); scc[i] = silu_f(a->in[3][i]); }
    __syncthreads();
    float* MOD = (float*)(a->ws + WS_MOD);
    for (int it = bid; it < 4 * 72; it += nb) {
      const int l = it / 72, cb = it % 72;
      const int cgp = tid & 31, ks = tid >> 5;
      const float* wp = a->in[4] + ((size_t)l * 1024 + ks * 64) * 9216 + cb * 128 + cgp * 4;
      f32x4 am = {0.f, 0.f, 0.f, 0.f}, ac = {0.f, 0.f, 0.f, 0.f};
#pragma unroll 8
      for (int k = 0; k < 64; ++k) { const f32x4 w = *(const f32x4*)(wp + (size_t)k * 9216); am += w * sc[ks * 64 + k]; ac += w * scc[ks * 64 + k]; }
#pragma unroll
      for (int j = 0; j < 4; ++j) { red[(ks * 128 + cgp * 4 + j) * 2] = am[j]; red[(ks * 128 + cgp * 4 + j) * 2 + 1] = ac[j]; }
      __syncthreads();
      if (tid < 256) {
        const int col = tid >> 1, which = tid & 1; float s = 0.f;
#pragma unroll
        for (int q = 0; q < 16; ++q) s += red[(q * 128 + col) * 2 + which];
        const int gc = cb * 128 + col;
        MOD[(size_t)(which * 4 + l) * 9216 + gc] = s + a->in[5][(size_t)l * 9216 + gc];
      }
      __syncthreads();
    }
  }
  {
    float* TRET = (float*)(a->ws + WS_TRET); float* TROW = (float*)(a->ws + WS_TROW); float* TCOL = (float*)(a->ws + WS_TCOL);
    const int gt = bid * 512 + tid, gn = nb * 512;
    for (int e = gt; e < 16384 * 16; e += gn) { const int p = e >> 4, i = e & 15; float s, c; sincos_acc((float)p * INV16[i], s, c); TRET[2 * e] = c; TRET[2 * e + 1] = s; }
    for (int e = gt; e < 256 * 8; e += gn) { const int p = e >> 3, i = e & 7; float s, c; sincos_acc((float)p * INV16[2 * i], s, c); TROW[2 * e] = c; TROW[2 * e + 1] = s; }
    for (int e = gt; e < 64 * 8; e += gn) { const int p = e >> 3, i = e & 7; float s, c; sincos_acc((float)p * INV16[2 * i], s, c); TCOL[2 * e] = c; TCOL[2 * e + 1] = s; }
    if (bid == 0 && tid < 4) {
      const int l = tid; float* S = (float*)(a->ws + WS_SCAL) + l * 64;
      const float* lv = a->in[12] + l * 128; float d01 = 0.f, d23 = 0.f;
      for (int i = 0; i < 32; ++i) { d01 += lv[i] * lv[32 + i]; d23 += lv[64 + i] * lv[96 + i]; }
      const float lam_init = 0.8f - 0.6f * expf(-0.3f * (float)l);
      S[0] = expf(d01) - expf(d23) + lam_init; S[1] = lam_init;
      for (int i = 0; i < 12; ++i) { const float x = a->in[11][l * 12 + i]; S[4 + i] = -log1pf(expf(-x)); }
      for (int i = 0; i < 12; ++i) ((unsigned*)S)[16 + i] = 0u;
    }
  }
}
DI void norm_phase(int WV, KArgs a, int l, int which, bool first) {
  const int tid = ltid(), lane = tid & 63, wave = tid >> 6;
  const float* g = a->in[6] + (size_t)(l * 3 + which) * 1024;
  const float* mod = (const float*)(a->ws + WS_MOD) + (size_t)l * 9216;
  const float* modc = (const float*)(a->ws + WS_MOD) + (size_t)(4 + l) * 9216;
  float* X = (float*)(a->ws + WS_X); bf16_t* H = (bf16_t*)(a->ws + WS_H);
  const int stride = lnb() * 8;
  for (int r = lbid() * 8 + wave; r < MT_; r += 2 * stride) {
    const int r2 = r + stride; const bool has2 = r2 < MT_; const int rb = has2 ? r2 : r;
    const float* srcA = first ? (r < L_ ? a->in[0] + (size_t)r * 1024 : a->in[2] + (size_t)(r - L_) * 1024) : X + (size_t)r * 1024;
    const float* srcB = first ? (rb < L_ ? a->in[0] + (size_t)rb * 1024 : a->in[2] + (size_t)(rb - L_) * 1024) : X + (size_t)rb * 1024;
    f32x4 va[4], vb[4]; float sa = 0.f, sb = 0.f;
#pragma unroll
    for (int i = 0; i < 4; ++i) { va[i] = *(const f32x4*)(srcA + i * 256 + lane * 4); vb[i] = *(const f32x4*)(srcB + i * 256 + lane * 4); }
#pragma unroll
    for (int i = 0; i < 4; ++i) { sa += va[i][0] * va[i][0] + va[i][1] * va[i][1] + va[i][2] * va[i][2] + va[i][3] * va[i][3]; sb += vb[i][0] * vb[i][0] + vb[i][1] * vb[i][1] + vb[i][2] * vb[i][2] + vb[i][3] * vb[i][3]; }
    sa = wave_sum(sa); sb = wave_sum(sb);
    const float rsa = rsqrtf(sa * (1.0f / 1024.0f) + EPS_), rsb = rsqrtf(sb * (1.0f / 1024.0f) + EPS_);
#pragma unroll
    for (int q = 0; q < 2; ++q) {
      if (q == 1 && !has2) break;
      const int rr = q ? r2 : r; const float rstd = q ? rsb : rsa;
      const float* mm = (rr < L_) ? mod : modc;
#pragma unroll
      for (int i = 0; i < 4; ++i) {
        const int c = i * 256 + lane * 4;
        const f32x4 v = q ? vb[i] : va[i];
        const f32x4 gg = *(const f32x4*)(g + c), sh = *(const f32x4*)(mm + (which * 3) * 1024 + c), sc = *(const f32x4*)(mm + (which * 3 + 1) * 1024 + c);
        f32x4 y;
#pragma unroll
        for (int j = 0; j < 4; ++j) y[j] = v[j] * rstd * gg[j] * (1.0f + sc[j]) + sh[j];
        u32x2 w; w.x = cvt_pk_bf16(y[0], y[1]); w.y = cvt_pk_bf16(y[2], y[3]);
        *(u32x2*)(H + (size_t)rr * 1024 + c) = w;
        if (first) *(f32x4*)(X + (size_t)rr * 1024 + c) = v;
      }
    }
  }
}
DI void final_norm(int WV, KArgs a) {
  const int tid = ltid(), lane = tid & 63, wave = tid >> 6;
  const float* g = a->in[18]; const float* X = (const float*)(a->ws + WS_X);
  for (int r = lbid() * 8 + wave; r < L_; r += lnb() * 8) {
    f32x4 v[4]; float ss = 0.f;
#pragma unroll
    for (int i = 0; i < 4; ++i) { v[i] = *(const f32x4*)(X + (size_t)r * 1024 + i * 256 + lane * 4); ss += v[i][0] * v[i][0] + v[i][1] * v[i][1] + v[i][2] * v[i][2] + v[i][3] * v[i][3]; }
    ss = wave_sum(ss);
    const float rstd = rsqrtf(ss * (1.0f / 1024.0f) + EPS_);
#pragma unroll
    for (int i = 0; i < 4; ++i) { const int c = i * 256 + lane * 4; const f32x4 gg = *(const f32x4*)(g + c); f32x4 y; for (int j = 0; j < 4; ++j) y[j] = v[i][j] * rstd * gg[j]; *(f32x4*)(a->out + (size_t)r * 1024 + c) = y; }
  }
}

using pg8::Unit; using pg8::HALF; using pg8::BM;
struct EpiSwiglu {
  static constexpr bool PERM = false, AFTER_DRAIN = false;
  bf16_t* U;
  DI void operator()(const f32x4 (&acc)[2][2][4][2], const Unit& u, int wr, int wc, int fr_, int fq_) const {
    const int ln_ = lane_id_v(), fr = ln_ & 15, fq = ln_ >> 4;
#pragma unroll
    for (int ai = 0; ai < 2; ++ai)
#pragma unroll
      for (int m = 0; m < 4; ++m) {
        const int r = u.pm * BM + ai * HALF + wr * 64 + m * 16 + fr;
#pragma unroll
        for (int bj = 0; bj < 2; ++bj) {
          const int gi = u.pn * 8 + bj * 4 + wc;
          const f32x4 x = acc[ai][bj][m][0], y = acc[ai][bj][m][1];
          u32x2 w; w.x = cvt_pk_bf16(silu_f(x[0]) * y[0], silu_f(x[1]) * y[1]); w.y = cvt_pk_bf16(silu_f(x[2]) * y[2], silu_f(x[3]) * y[3]);
          *(u32x2*)(U + (size_t)r * DFF_ + gi * 16 + fq * 4) = w;
        }
        __builtin_amdgcn_sched_barrier(0);
      }
  }
};
struct EpiResid {
  static constexpr bool PERM = false, AFTER_DRAIN = false;
  float* X; const float* gate; float scale;
  DI void operator()(const f32x4 (&acc)[2][2][4][2], const Unit& u, int wr, int wc, int fr_, int fq_) const {
    const int ln_ = lane_id_v(), fr = ln_ & 15, fq = ln_ >> 4;
#pragma unroll
    for (int bj = 0; bj < 2; ++bj)
#pragma unroll
      for (int n = 0; n < 2; ++n) {
        const int c = u.pn * BM + bj * HALF + wc * 32 + n * 16 + fq * 4;
        const f32x4 gv = *(const f32x4*)(gate + c) * scale;
#pragma unroll
        for (int ai = 0; ai < 2; ++ai)
#pragma unroll
          for (int m = 0; m < 4; ++m) {
            const int r = u.pm * BM + ai * HALF + wr * 64 + m * 16 + fr;
            float* p = X + (size_t)r * 1024 + c;
            *(f32x4*)p = *(const f32x4*)p + gv * acc[ai][bj][m][n];
          }
      }
  }
};
template <int STEP> struct EpiMerge {
  static constexpr bool PERM = false, AFTER_DRAIN = false;
  bf16_t* MX; const bf16_t* G; bf16_t* Hout;
  DI void operator()(const f32x4 (&acc)[2][2][4][2], const Unit& u, int wr, int wc, int fr_, int fq_) const {
    const int ln_ = lane_id_v(), fr = ln_ & 15, fq = ln_ >> 4;
#pragma unroll
    for (int ai = 0; ai < 2; ++ai)
#pragma unroll
      for (int bj = 0; bj < 2; ++bj)
#pragma unroll
        for (int n = 0; n < 2; ++n) {
          const int c = u.pn * BM + bj * HALF + wc * 32 + n * 16 + fq * 4;
          const int r0 = u.pm * BM + ai * HALF + wr * 64 + fr;
          u32x2 gw[4], old[4];
#pragma unroll
          for (int m = 0; m < 4; ++m) {
            gw[m] = *(const u32x2*)(G + (size_t)(r0 + m * 16) * NGB_ + c);
            if (STEP > 0) old[m] = *(const u32x2*)(MX + (size_t)(r0 + m * 16) * 1024 + c);
          }
#pragma unroll
          for (int m = 0; m < 4; ++m) {
            f32x4 gv; gv[0] = sigmoid_f(bf2f(gw[m].x & 0xffffu)); gv[1] = sigmoid_f(bf2f(gw[m].x >> 16)); gv[2] = sigmoid_f(bf2f(gw[m].y & 0xffffu)); gv[3] = sigmoid_f(bf2f(gw[m].y >> 16));
            f32x4 v = gv * acc[ai][bj][m][n];
            if (STEP > 0) { v[0] += bf2f(old[m].x & 0xffffu); v[1] += bf2f(old[m].x >> 16); v[2] += bf2f(old[m].y & 0xffffu); v[3] += bf2f(old[m].y >> 16); }
            u32x2 w; w.x = cvt_pk_bf16(v[0], v[1]); w.y = cvt_pk_bf16(v[2], v[3]);
            if (STEP < 2) *(u32x2*)(MX + (size_t)(r0 + m * 16) * 1024 + c) = w;
            else *(u32x2*)(Hout + (size_t)(r0 + m * 16) * 1024 + c) = w;
          }
          __builtin_amdgcn_sched_barrier(0);
        }
  }
};
struct EpiWin {
  static constexpr bool PERM = false, AFTER_DRAIN = false;
  bf16_t* PB; bf16_t* GB; const float* TRET; const float* TROW; const float* TCOL; unsigned* kmax;
  DI void operator()(const f32x4 (&acc)[2][2][4][2], const Unit& u, int wr, int wc, int fr_, int fq_) const {
    const int ln_ = lane_id_v(), fr = ln_ & 15, fq = ln_ >> 4;
#pragma unroll
    for (int bj = 0; bj < 2; ++bj) {
      const int cb = u.pn * BM + bj * HALF + wc * 32;
      float kmx = 0.f;
#pragma unroll
      for (int ai = 0; ai < 2; ++ai)
#pragma unroll
        for (int m = 0; m < 4; ++m) {
          const int r = u.pm * BM + ai * HALF + wr * 64 + m * 16 + fr;
          f32x4 x0 = acc[ai][bj][m][0], x1 = acc[ai][bj][m][1];
          if (cb >= NPB_) {
            u32x2 w0, w1; w0.x = cvt_pk_bf16(x0[0], x0[1]); w0.y = cvt_pk_bf16(x0[2], x0[3]); w1.x = cvt_pk_bf16(x1[0], x1[1]); w1.y = cvt_pk_bf16(x1[2], x1[3]);
            bf16_t* p = GB + (size_t)r * NGB_ + (cb - NPB_) + fq * 4;
            *(u32x2*)p = w0; *(u32x2*)(p + 16) = w1;
            __builtin_amdgcn_sched_barrier(0);
            continue;
          }
          if (cb >= C_RQ && cb < C_RV) {
            if (r < L_) {
              const f32x4* tp = (const f32x4*)(TRET + ((size_t)r * 16 + fq * 4) * 2);
              const f32x4 t0 = tp[0], t1 = tp[1];
              const float cs[4] = {t0[0], t0[2], t1[0], t1[2]}, sn[4] = {t0[1], t0[3], t1[1], t1[3]};
#pragma unroll
              for (int j = 0; j < 4; ++j) { const float a_ = x0[j], b_ = x1[j]; x0[j] = a_ * cs[j] - b_ * sn[j]; x1[j] = a_ * sn[j] + b_ * cs[j]; }
            }
            if (cb >= C_RK) { x0 *= 0.17677669529663687f; x1 *= 0.17677669529663687f; }
          } else if (cb >= C_RG && cb < C_DQ) {
#pragma unroll
            for (int j = 0; j < 4; ++j) { x0[j] = silu_f(x0[j]); x1[j] = silu_f(x1[j]); }
          } else if (cb >= C_DQ && cb < C_DV) {
            if (r < L_) {
              const float* tb = (fq < 2) ? (TROW + ((size_t)(r >> 6) * 8 + fq * 4) * 2) : (TCOL + ((size_t)(r & 63) * 8 + (fq - 2) * 4) * 2);
              const f32x4 t0 = ((const f32x4*)tb)[0], t1 = ((const f32x4*)tb)[1];
              const float cs[4] = {t0[0], t0[2], t1[0], t1[2]}, sn[4] = {t0[1], t0[3], t1[1], t1[3]};
#pragma unroll
              for (int j = 0; j < 4; ++j) { const float a_ = x0[j], b_ = x1[j]; x0[j] = a_ * cs[j] - b_ * sn[j]; x1[j] = a_ * sn[j] + b_ * cs[j]; }
            }
            if (cb < C_DK) { x0 *= 0.25503486f; x1 *= 0.25503486f; }
            else { float ss = 0.f;
#pragma unroll
              for (int j = 0; j < 4; ++j) ss += x0[j] * x0[j] + x1[j] * x1[j];
              ss += shx(ss, 16, lane_id_v()); ss += shx(ss, 32, lane_id_v()); kmx = fmaxf(kmx, ss); }
          }
          u32x2 w0, w1; w0.x = cvt_pk_bf16(x0[0], x0[1]); w0.y = cvt_pk_bf16(x0[2], x0[3]); w1.x = cvt_pk_bf16(x1[0], x1[1]); w1.y = cvt_pk_bf16(x1[2], x1[3]);
          bf16_t* p = PB + (size_t)r * NPB_ + cb + fq * 4;
          *(u32x2*)p = w0; *(u32x2*)(p + 16) = w1;
          __builtin_amdgcn_sched_barrier(0);
        }
      if (cb >= C_DK && cb < C_DV) {
#pragma unroll
        for (int o = 1; o < 16; o <<= 1) kmx = fmaxf(kmx, shx(kmx, o, lane_id_v()));
        if (lane_id_v() == 0) atomicMax(kmax + ((cb - C_DK) >> 5), __float_as_uint(kmx));
      }
    }
  }
};
template <class F> DI void ctx_gemm32(int WV, const bf16_t* A, int lda, const bf16_t* Bt, int K, int N, unsigned char* smem, F epi) {
  const int tid = ltid(), lane = tid & 63, wave = tid >> 6, r31 = lane & 31, h = lane >> 5;
  float* red = (float*)smem;
  const int ntn = N / 32, ntiles = 8 * ntn, kper = K / 8;
  for (int tile = lbid(); tile < ntiles; tile += lnb()) {
    const int tm = tile / ntn, tn = tile % ntn;
    f32x16 acc; for (int i = 0; i < 16; ++i) acc[i] = 0.f;
    const bf16_t* ap = A + (size_t)(tm * 32 + r31) * lda + wave * kper + 8 * h;
    const bf16_t* bp = Bt + (size_t)(tn * 32 + r31) * K + wave * kper + 8 * h;
    const int nsteps = kper >> 4;
    bf16x8 a0[8], b0[8], a1[8], b1[8];
#define CG_LOAD(A_, B_, S_) do { _Pragma("unroll") for (int q = 0; q < 8; ++q) { const int st_ = ((S_) + q < nsteps) ? (S_) + q : nsteps - 1; A_[q] = *(const bf16x8*)(ap + st_ * 16); B_[q] = *(const bf16x8*)(bp + st_ * 16); } } while (0)
#define CG_COMP(A_, B_, S_) do { _Pragma("unroll") for (int q = 0; q < 8; ++q) { const bf16x8 z_ = {0, 0, 0, 0, 0, 0, 0, 0}; acc = MFMA32(((S_) + q < nsteps) ? A_[q] : z_, B_[q], acc); } } while (0)
    CG_LOAD(a0, b0, 0);
    for (int s = 0; s < nsteps; s += 16) { CG_LOAD(a1, b1, s + 8); CG_COMP(a0, b0, s); CG_LOAD(a0, b0, s + 16); CG_COMP(a1, b1, s + 8); }
#undef CG_LOAD
#undef CG_COMP
#pragma unroll
    for (int i = 0; i < 16; ++i) red[(wave * 16 + i) * 64 + lane] = acc[i];
    __syncthreads();
#pragma unroll
    for (int q = 0; q < 2; ++q) {
      const int o = tid + q * 512, i = o >> 6, ln = o & 63; float s = 0.f;
#pragma unroll
      for (int w = 0; w < 8; ++w) s += red[(w * 16 + i) * 64 + ln];
      epi(tm * 32 + crow(i, ln >> 5), tn * 32 + (ln & 31), s);
    }
    __syncthreads();
  }
}

constexpr int FR_LD = 136;
DI void fourier_tables(int WV, unsigned char* smem) {
  bf16_t* Cw = (bf16_t*)smem; bf16_t* Sw = Cw + 128 * FR_LD;
  for (int e = ltid(); e < 128 * 128; e += 512) { const int a_ = e >> 7, b_ = e & 127; const float x = (float)((a_ * b_) & 127) * (1.0f / 64.0f); Cw[a_ * FR_LD + b_] = f2bf(cospif(x)); Sw[a_ * FR_LD + b_] = f2bf(sinpif(x)); }
}
DI void fourier_load(int WV, const bf16_t* src, size_t rs, size_t po, unsigned char* smem) {
  bf16_t* dA = (bf16_t*)smem + 2 * 128 * FR_LD;
#pragma unroll
  for (int i = 0; i < 4; ++i) {
    const int id = ltid() + 512 * i, seg = id & 7, part = (id >> 3) & 1, row = id >> 4;
    const bf16x8 v = *(const bf16x8*)(src + (size_t)row * rs + (size_t)part * po + seg * 8);
    bf16_t* d = dA + part * 64 * FR_LD + (seg * 8) * FR_LD + (row ^ (seg << 3));
#pragma unroll
    for (int e = 0; e < 8; ++e) d[e * FR_LD] = (bf16_t)v[e];
  }
}
DI void fourier_stage1(int WV, KArgs a, unsigned char* smem) {
  const int tid = ltid(), lane = tid & 63, wave = tid >> 6, r31 = lane & 31, h = lane >> 5, rb = wave & 3, cbk = wave >> 2;
  const bf16_t* PB = (const bf16_t*)(a->ws + WS_PB); bf16_t* V = (bf16_t*)(a->ws + WS_V);
  const bf16_t* Cw = (const bf16_t*)smem; const bf16_t* Sw = Cw + 128 * FR_LD; const bf16_t* dA = Sw + 128 * FR_LD; const bf16_t* dB = dA + 64 * FR_LD;
  for (int it = lbid(); it < 512; it += lnb()) {
    const int t2 = it >> 2, c0 = (it & 3) * 64;
    __syncthreads();
    fourier_load(WV, PB + (size_t)t2 * NPB_ + C_FA + c0, (size_t)128 * NPB_, (size_t)(C_FB - C_FA), smem);
    __syncthreads();
    f32x16 R, nI; for (int i = 0; i < 16; ++i) { R[i] = 0.f; nI[i] = 0.f; }
#pragma unroll
    for (int s = 0; s < 8; ++s) {
      const bf16x8 cw = *(const bf16x8*)(Cw + (32 * rb + r31) * FR_LD + 16 * s + 8 * h), sw = *(const bf16x8*)(Sw + (32 * rb + r31) * FR_LD + 16 * s + 8 * h);
      const int so_ = (16 * s + 8 * h) ^ (((4 * cbk + (r31 >> 3)) & 7) << 3);
      const bf16x8 af = *(const bf16x8*)(dA + (32 * cbk + r31) * FR_LD + so_), bfv = *(const bf16x8*)(dB + (32 * cbk + r31) * FR_LD + so_);
      bf16x8 nb; for (int e = 0; e < 8; ++e) nb[e] = (short)(bfv[e] ^ (short)0x8000);
      R = MFMA32(cw, af, R); R = MFMA32(sw, nb, R); nI = MFMA32(sw, af, nI); nI = MFMA32(cw, bfv, nI);
    }
    const int col = c0 + 32 * cbk + r31;
#pragma unroll
    for (int i = 0; i < 16; ++i) {
      const int k1 = 32 * rb + crow(i, h);
      const float x = (float)(k1 * t2) * (1.0f / 8192.0f); const float ct = cospif(x), st = sinpif(x);
      const float vre = R[i] * ct - nI[i] * st, vim = -nI[i] * ct - R[i] * st;
      bf16_t* vp = V + ((size_t)(k1 * 128 + t2) * 2) * 256 + col;
      vp[0] = f2bf(vre); vp[256] = f2bf(vim);
    }
  }
}
DI void fourier_stage2(int WV, KArgs a, unsigned char* smem) {
  const int tid = ltid(), lane = tid & 63, wave = tid >> 6, r31 = lane & 31, h = lane >> 5, rb = wave & 3, cbk = wave >> 2;
  const bf16_t* V = (const bf16_t*)(a->ws + WS_V); bf16_t* BR = (bf16_t*)(a->ws + WS_BR);
  const bf16_t* Cw = (const bf16_t*)smem; const bf16_t* Sw = Cw + 128 * FR_LD; const bf16_t* dA = Sw + 128 * FR_LD; const bf16_t* dB = dA + 64 * FR_LD;
  for (int it = lbid(); it < 512; it += lnb()) {
    const int k1 = it >> 2, c0 = (it & 3) * 64;
    __syncthreads();
    fourier_load(WV, V + (size_t)k1 * 128 * 512 + c0, (size_t)512, (size_t)256, smem);
    __syncthreads();
    f32x16 Y; for (int i = 0; i < 16; ++i) Y[i] = 0.f;
#pragma unroll
    for (int s = 0; s < 8; ++s) {
      const bf16x8 cw = *(const bf16x8*)(Cw + (32 * rb + r31) * FR_LD + 16 * s + 8 * h), sw = *(const bf16x8*)(Sw + (32 * rb + r31) * FR_LD + 16 * s + 8 * h);
      const int so_ = (16 * s + 8 * h) ^ (((4 * cbk + (r31 >> 3)) & 7) << 3);
      const bf16x8 vr = *(const bf16x8*)(dA + (32 * cbk + r31) * FR_LD + so_), vi = *(const bf16x8*)(dB + (32 * cbk + r31) * FR_LD + so_);
      Y = MFMA32(cw, vr, Y); Y = MFMA32(sw, vi, Y);
    }
    const int col = c0 + 32 * cbk + r31;
#pragma unroll
    for (int i = 0; i < 16; ++i) { const int k2 = 32 * rb + crow(i, h); BR[(size_t)(k1 + 128 * k2) * 1024 + col] = f2bf(Y[i] * (1.0f / 1024.0f)); }
  }
}
DI void fourier_ctx(int WV, KArgs a, unsigned char* smem) {
  const int tid = ltid();
  const bf16_t* PB = (const bf16_t*)(a->ws + WS_PB) + (size_t)L_ * NPB_; bf16_t* BR = (bf16_t*)(a->ws + WS_BR) + (size_t)L_ * 1024;
  float* ct = (float*)smem; float* st = ct + 256; float* red = st + 256;
  __syncthreads();
  if (tid < 256) { const float x = (float)tid * (1.0f / 128.0f); ct[tid] = cospif(x); st[tid] = sinpif(x); }
  __syncthreads();
  const int tg = tid >> 5, c8 = (tid & 31) * 8;
  for (int k = lbid(); k < 256; k += lnb()) {
    bf16x8 av[16], bv[16];
#pragma unroll
    for (int j = 0; j < 16; ++j) { const int t = tg + 16 * j; av[j] = *(const bf16x8*)(PB + (size_t)t * NPB_ + C_FA + c8); bv[j] = *(const bf16x8*)(PB + (size_t)t * NPB_ + C_FB + c8); }
    float acc[8];
#pragma unroll
    for (int e = 0; e < 8; ++e) acc[e] = 0.f;
#pragma unroll
    for (int j = 0; j < 16; ++j) {
      const int idx = (k * (tg + 16 * j)) & 255; const float c_ = ct[idx], s_ = st[idx];
#pragma unroll
      for (int e = 0; e < 8; ++e) acc[e] += c_ * bf2f((unsigned)(unsigned short)av[j][e]) - s_ * bf2f((unsigned)(unsigned short)bv[j][e]);
    }
#pragma unroll
    for (int e = 0; e < 8; ++e) red[tg * 256 + c8 + e] = acc[e];
    __syncthreads();
    if (tid < 256) { float s = 0.f;
#pragma unroll
      for (int q = 0; q < 16; ++q) s += red[q * 256 + tid];
      BR[(size_t)k * 1024 + tid] = f2bf(s * (1.0f / 128.0f)); }
    __syncthreads();
  }
}
DI int chunk_row0(int ci) { return ci < 128 ? ci * 128 : L_ + (ci - 128) * 128; }
DI void ret_states(int WV, KArgs a, int l, unsigned char* smem) {
  const int tid = ltid();
  const bf16_t* PB = (const bf16_t*)(a->ws + WS_PB); float* T = (float*)(a->ws + WS_T);
  const float* S = (const float*)(a->ws + WS_SCAL) + l * 64;
  float* kL = (float*)smem; float* vL = kL + 128 * 33; float* wf = vL + 128 * 64; float* wb = wf + 128;
  for (int it = lbid(); it < 130 * 6; it += lnb()) {
    const int ci = it / 6, hh = it % 6, r0 = chunk_row0(ci);
    __syncthreads();
    { const int row = tid >> 2, seg = tid & 3; const bf16x8 v = *(const bf16x8*)(PB + (size_t)(r0 + row) * NPB_ + C_RK + hh * 32 + seg * 8);
#pragma unroll
      for (int e = 0; e < 8; ++e) kL[row * 33 + seg * 8 + e] = bf2f((unsigned)(unsigned short)v[e]); }
#pragma unroll
    for (int q = 0; q < 2; ++q) { const int id = tid + 512 * q, row = id >> 3, seg = id & 7; const bf16x8 v = *(const bf16x8*)(PB + (size_t)(r0 + row) * NPB_ + C_RV + hh * 64 + seg * 8);
#pragma unroll
      for (int e = 0; e < 8; ++e) vL[row * 64 + seg * 8 + e] = bf2f((unsigned)(unsigned short)v[e]); }
    if (tid < 128) { wf[tid] = expf(S[4 + hh] * (float)(127 - tid)); wb[tid] = expf(S[10 + hh] * (float)tid); }
    __syncthreads();
    const int d = tid >> 4, v4 = (tid & 15) * 4;
    f32x4 af = {0.f, 0.f, 0.f, 0.f}, ab = {0.f, 0.f, 0.f, 0.f};
#pragma unroll 4
    for (int j = 0; j < 128; ++j) { const float kd = kL[j * 33 + d]; const f32x4 vv = *(const f32x4*)(vL + j * 64 + v4); af += vv * (kd * wf[j]); ab += vv * (kd * wb[j]); }
    float* tp = T + ((size_t)(ci * 6 + hh) * 2) * 2048 + d * 64 + v4;
    *(f32x4*)tp = af; *(f32x4*)(tp + 2048) = ab;
  }
}
DI void ret_scan(int WV, KArgs a, int l) {
  const int gt = lbid() * 512 + ltid();
  if (gt >= 6 * 2 * 2048) return;
  const int idx = gt & 2047, dir = (gt >> 11) & 1, hh = gt >> 12;
  const float* T = (const float*)(a->ws + WS_T); float* S = (float*)(a->ws + WS_S);
  const float* SC = (const float*)(a->ws + WS_SCAL) + l * 64;
  const float dec = expf(SC[4 + dir * 6 + hh] * 128.0f);
  const size_t base = (size_t)(hh * 2 + dir) * 2048 + idx; const size_t cs = (size_t)6 * 2 * 2048;
  const float tc0 = T[base + 128 * cs], tc1 = T[base + 129 * cs];
  float tv[128];
#pragma unroll
  for (int i = 0; i < 128; ++i) tv[i] = T[base + (size_t)i * cs];
  if (dir == 0) {
    float s = tc0 * dec + tc1; S[base + 128 * cs] = 0.f; S[base + 129 * cs] = tc0;
#pragma unroll
    for (int i = 0; i < 128; ++i) { S[base + (size_t)i * cs] = s; s = s * dec + tv[i]; }
  } else {
    float s = tc0 + dec * tc1; S[base + 129 * cs] = 0.f; S[base + 128 * cs] = tc1;
#pragma unroll
    for (int i = 127; i >= 0; --i) { S[base + (size_t)i * cs] = s; s = s * dec + tv[i]; }
  }
}
DI void ret_out(int WV, KArgs a, int l, unsigned char* smem) {
  const int tid = ltid(), lane = tid & 63, wave = tid >> 6, r31 = lane & 31, h = lane >> 5, jb = wave & 3, vh = wave >> 2;
  const bf16_t* PB = (const bf16_t*)(a->ws + WS_PB); bf16_t* BR = (bf16_t*)(a->ws + WS_BR); const float* Sg = (const float*)(a->ws + WS_S);
  const float* SC = (const float*)(a->ws + WS_SCAL) + l * 64;
  bf16_t* Kl = (bf16_t*)smem;
  bf16_t* Vt = Kl + 128 * 40;
  bf16_t* SfT = Vt + 64 * 136;
  bf16_t* SbT = SfT + 64 * 40;
  float* pwf = (float*)(SbT + 64 * 40);
  float* pwb = pwf + 128;
  float* ssq = pwb + 128;
  const int nit_ = (l < DEPTH_ - 1) ? 130 * 6 : 128 * 6;
  for (int it = lbid(); it < nit_; it += lnb()) {
    const int ci = it / 6, hh = it % 6, r0 = chunk_row0(ci);
    const float lgf = SC[4 + hh], lgb = SC[10 + hh];
    __syncthreads();
    { const int row = tid >> 2, seg = tid & 3; *(bf16x8*)(Kl + row * 40 + seg * 8) = *(const bf16x8*)(PB + (size_t)(r0 + row) * NPB_ + C_RK + hh * 32 + seg * 8); }
#pragma unroll
    for (int q = 0; q < 2; ++q) { const int id = tid + 512 * q, row = id >> 3, seg = id & 7; const bf16x8 v = *(const bf16x8*)(PB + (size_t)(r0 + row) * NPB_ + C_RV + hh * 64 + seg * 8);
#pragma unroll
      for (int e = 0; e < 8; ++e) Vt[(seg * 8 + e) * 136 + (row ^ (seg << 3))] = (bf16_t)v[e]; }
#pragma unroll
    for (int q = 0; q < 8; ++q) { const int e = tid + 512 * q, dir = e >> 11, idx = e & 2047, d = idx >> 6, v = idx & 63;
      const float sv = Sg[((size_t)(ci * 6 + hh) * 2 + dir) * 2048 + idx]; (dir ? SbT : SfT)[v * 40 + d] = f2bf(sv); }
    if (tid < 128) { pwf[tid] = expf(lgf * (float)tid); pwb[tid] = expf(lgb * (float)tid); }
    const int qrow = r0 + 32 * jb + r31, j = 32 * jb + r31;
    bf16x8 qf[2];
#pragma unroll
    for (int s = 0; s < 2; ++s) qf[s] = *(const bf16x8*)(PB + (size_t)qrow * NPB_ + C_RQ + hh * 32 + 16 * s + 8 * h);
    __syncthreads();
    f32x16 O; for (int i = 0; i < 16; ++i) O[i] = 0.f;
#pragma unroll
    for (int kb = 0; kb < 4; ++kb) {
      f32x16 St; for (int i = 0; i < 16; ++i) St[i] = 0.f;
#pragma unroll
      for (int s = 0; s < 2; ++s) { const bf16x8 kf = *(const bf16x8*)(Kl + (32 * kb + r31) * 40 + 16 * s + 8 * h); St = MFMA32(kf, qf[s], St); }
#pragma unroll
      for (int i = 0; i < 16; ++i) { const int jp = 32 * kb + crow(i, h); const int dl = j - jp; const float dv = dl > 0 ? pwf[dl] : (dl < 0 ? pwb[-dl] : 2.0f); St[i] *= dv; }
#pragma unroll
      for (int s = 0; s < 2; ++s) {
        const bf16x8 pb = pack_step(St, s);
        const bf16_t* vrow = Vt + (32 * vh + r31) * 136; const int px_ = ((4 * vh + (r31 >> 3)) & 7) << 3, p0_ = 32 * kb + 16 * s + 4 * h;
        const s16x4 lo = *(const s16x4*)(vrow + (p0_ ^ px_)), hi = *(const s16x4*)(vrow + ((p0_ + 8) ^ px_));
        const bf16x8 vf = __builtin_shufflevector(lo, hi, 0, 1, 2, 3, 4, 5, 6, 7);
        O = MFMA32(vf, pb, O);
      }
    }
    f32x16 Of, Ob; for (int i = 0; i < 16; ++i) { Of[i] = 0.f; Ob[i] = 0.f; }
#pragma unroll
    for (int s = 0; s < 2; ++s) {
      const bf16x8 sf = *(const bf16x8*)(SfT + (32 * vh + r31) * 40 + 16 * s + 8 * h), sb = *(const bf16x8*)(SbT + (32 * vh + r31) * 40 + 16 * s + 8 * h);
      Of = MFMA32(sf, qf[s], Of); Ob = MFMA32(sb, qf[s], Ob);
    }
    const float qdf = expf(lgf * (float)(j + 1)), qdb = expf(lgb * (float)(128 - j));
    float ss = 0.f;
#pragma unroll
    for (int i = 0; i < 16; ++i) { O[i] = O[i] + Of[i] * qdf + Ob[i] * qdb; ss += O[i] * O[i]; }
    ss += shx(ss, 32, lane_id_v());
    if (h == 0) ssq[vh * 128 + j] = ss;
    __syncthreads();
    const float rstd = rsqrtf((ssq[j] + ssq[128 + j]) * (1.0f / 64.0f) + EPS_);
#pragma unroll
    for (int g4 = 0; g4 < 4; ++g4) {
      const int v0 = 32 * vh + 8 * g4 + 4 * h;
      const u32x2 gw = *(const u32x2*)(PB + (size_t)qrow * NPB_ + C_RG + hh * 64 + v0);
      const float g0 = bf2f(gw.x & 0xffffu), g1 = bf2f(gw.x >> 16), g2 = bf2f(gw.y & 0xffffu), g3 = bf2f(gw.y >> 16);
      u32x2 w; w.x = cvt_pk_bf16(O[4 * g4] * rstd * g0, O[4 * g4 + 1] * rstd * g1); w.y = cvt_pk_bf16(O[4 * g4 + 2] * rstd * g2, O[4 * g4 + 3] * rstd * g3);
      *(u32x2*)(BR + (size_t)qrow * 1024 + 256 + hh * 64 + v0) = w;
    }
  }
}
constexpr int AT_LD = 72, VS_LD = 96;
typedef __bf16 bf16x2_t __attribute__((ext_vector_type(2)));
typedef float f32x2_t __attribute__((ext_vector_type(2)));
DI unsigned cvt2(float a, float b) { f32x2_t v = {a, b}; return __builtin_bit_cast(unsigned, __builtin_convertvector(v, bf16x2_t)); }
template <int VAR> DI void attn_phase(int WV, KArgs a, int l, bool with_ctx, unsigned char* smem) {
  const int tid = ltid(), lane = tid & 63, wave = tid >> 6, r31 = lane & 31, h = lane >> 5, qsub = wave & 3, kh = wave >> 2;
  const bf16_t* PB = (const bf16_t*)(a->ws + WS_PB); bf16_t* BR = (bf16_t*)(a->ws + (VAR == 0 ? WS_BR : WS_H));
  const float* SC = (const float*)(a->ws + WS_SCAL) + l * 64;
  const float lam = SC[0], lam_init = SC[1];
  bf16_t* Ks = (bf16_t*)smem;
  bf16_t* Vt = Ks + 2 * 64 * AT_LD;
  float* cmb = (float*)(Vt + 2 * 64 * VS_LD);
  const int nitems = 6 * 128 + (with_ctx ? 12 : 0);
  const int skey = tid >> 3, sseg = tid & 7;
  for (int it = lbid(); it < (with_ctx ? 768 + lnb() : 768); it += lnb()) {
    int head, q0, krow0, nt;
    if (it >= 768) { const int e_ = lnb() - 1 - lbid(); if (e_ >= 12) continue; it = 768 + e_; }
    if (it < 768) { head = (it >> 8) * 2 + (it & 1); q0 = ((it & 255) >> 1) * 128; krow0 = 0; nt = MT_ / 64; }
    else { const int e = it - 768; head = e >> 1; q0 = L_ + (e & 1) * 128; krow0 = L_; nt = LC_ / 64; }
    const int qrow = q0 + 32 * qsub + r31;
    bf16x8 qf[2][2];
#pragma unroll
    for (int mp = 0; mp < 2; ++mp)
#pragma unroll
      for (int s = 0; s < 2; ++s) qf[mp][s] = *(const bf16x8*)(PB + (size_t)qrow * NPB_ + C_DQ + head * 64 + mp * 32 + 16 * s + 8 * h);
    float negm = 0.f;
#pragma unroll
    for (int mp = 0; mp < 2; ++mp) {
      float ss = 0.f;
#pragma unroll
      for (int s = 0; s < 2; ++s)
#pragma unroll
        for (int e = 0; e < 8; ++e) { const float x = bf2f((unsigned)(unsigned short)qf[mp][s][e]); ss += x * x; }
      ss += shx(ss, 32, lane_id_v());
      const float kmx = __uint_as_float(((const unsigned*)SC)[16 + head * 2 + mp]);
      negm = fminf(negm, -sqrtf(ss * kmx) * 1.01f);
    }
    f32x16 NM; for (int i = 0; i < 16; ++i) NM[i] = negm;
    f32x16 O1[2], O2[2]; for (int i = 0; i < 16; ++i) { O1[0][i] = 0.f; O1[1][i] = 0.f; O2[0][i] = 0.f; O2[1][i] = 0.f; }
    f32x4 LA = {0.f, 0.f, 0.f, 0.f}, LB = {0.f, 0.f, 0.f, 0.f};
    bf16x8 osel; { const bool on = ((lane & 15) == 0 && ((lane >> 4) & 1) == 0) || ((lane & 15) == 1 && ((lane >> 4) & 1) == 1);
      for (int e = 0; e < 8; ++e) osel[e] = on ? (short)0x3F80 : (short)0; }
#define MFMA16(a_, b_, c_) __builtin_amdgcn_mfma_f32_16x16x32_bf16((a_), (b_), (c_), 0, 0, 0)
    const bf16_t* kg = PB + (size_t)(krow0 + skey) * NPB_ + C_DK + head * 64 + sseg * 8;
    const bf16_t* vg = PB + (size_t)(krow0 + skey) * NPB_ + C_DV + head * 64 + sseg * 8;
    const int vslot = ((skey & ~12) | ((skey & 4) << 1) | ((skey & 8) >> 1)) ^ (sseg << 3);
    __syncthreads();
    bf16x8 kA = *(const bf16x8*)kg, vA = *(const bf16x8*)vg;
    bf16x8 kB = *(const bf16x8*)(kg + (size_t)64 * NPB_), vB = *(const bf16x8*)(vg + (size_t)64 * NPB_);
    { *(bf16x8*)(Ks + skey * AT_LD + sseg * 8) = kA; *(bf16x8*)(Vt + skey * VS_LD + sseg * 8) = vA; }
    __syncthreads();
    for (int t = 0; t < nt; ++t) {
      const int buf = t & 1;
      const bf16_t* ks = Ks + buf * 64 * AT_LD + (32 * kh + r31) * AT_LD + 8 * h;
      const bf16_t* vt = Vt + buf * 64 * VS_LD + (32 * kh + 4 * h + ((lane & 15) >> 2)) * VS_LD + 16 * ((lane >> 4) & 1) + 4 * (lane & 3);
      const bf16x8 k00 = *(const bf16x8*)(ks), k01 = *(const bf16x8*)(ks + 16), k10 = *(const bf16x8*)(ks + 32), k11 = *(const bf16x8*)(ks + 48);
      bf16x8 vf[2][2];
#pragma unroll
      for (int s = 0; s < 2; ++s)
#pragma unroll
        for (int mt = 0; mt < 2; ++mt) {
          const s16x4 lo = __builtin_amdgcn_ds_read_tr16_b64_v4i16((LAS s16x4*)(vt + (16 * s) * VS_LD + 32 * mt));
          const s16x4 hi = __builtin_amdgcn_ds_read_tr16_b64_v4i16((LAS s16x4*)(vt + (16 * s + 8) * VS_LD + 32 * mt));
          vf[mt][s] = __builtin_shufflevector(lo, hi, 0, 1, 2, 3, 4, 5, 6, 7); }
      f32x16 S1 = MFMA32(k00, qf[0][0], NM); f32x16 S2 = MFMA32(k10, qf[1][0], NM); S1 = MFMA32(k01, qf[0][1], S1); S2 = MFMA32(k11, qf[1][1], S2);
      bf16x8 p1[2], p2[2];
      { u32x4 w0, w1;
#pragma unroll
        for (int i = 0; i < 4; ++i) { w0[i] = cvt2(VAR == 1 ? S1[2 * i] * 0.001f : __builtin_amdgcn_exp2f(S1[2 * i]), VAR == 1 ? S1[2 * i + 1] * 0.001f : __builtin_amdgcn_exp2f(S1[2 * i + 1]));
                                       w1[i] = cvt2(VAR == 1 ? S1[8 + 2 * i] * 0.001f : __builtin_amdgcn_exp2f(S1[8 + 2 * i]), VAR == 1 ? S1[9 + 2 * i] * 0.001f : __builtin_amdgcn_exp2f(S1[9 + 2 * i])); }
        p1[0] = __builtin_bit_cast(bf16x8, w0); p1[1] = __builtin_bit_cast(bf16x8, w1); }
      O1[0] = MFMA32(vf[0][0], p1[0], O1[0]); O1[1] = MFMA32(vf[1][0], p1[0], O1[1]); LA = MFMA16(osel, p1[0], LA);
      O1[0] = MFMA32(vf[0][1], p1[1], O1[0]); O1[1] = MFMA32(vf[1][1], p1[1], O1[1]); LA = MFMA16(osel, p1[1], LA);
      { u32x4 w0, w1;
#pragma unroll
        for (int i = 0; i < 4; ++i) { w0[i] = cvt2(VAR == 1 ? S2[2 * i] * 0.001f : __builtin_amdgcn_exp2f(S2[2 * i]), VAR == 1 ? S2[2 * i + 1] * 0.001f : __builtin_amdgcn_exp2f(S2[2 * i + 1]));
                                       w1[i] = cvt2(VAR == 1 ? S2[8 + 2 * i] * 0.001f : __builtin_amdgcn_exp2f(S2[8 + 2 * i]), VAR == 1 ? S2[9 + 2 * i] * 0.001f : __builtin_amdgcn_exp2f(S2[9 + 2 * i])); }
        p2[0] = __builtin_bit_cast(bf16x8, w0); p2[1] = __builtin_bit_cast(bf16x8, w1); }
      if (VAR != 5) {
      O2[0] = MFMA32(vf[0][0], p2[0], O2[0]); O2[1] = MFMA32(vf[1][0], p2[0], O2[1]); LB = MFMA16(osel, p2[0], LB);
      O2[0] = MFMA32(vf[0][1], p2[1], O2[0]); O2[1] = MFMA32(vf[1][1], p2[1], O2[1]); LB = MFMA16(osel, p2[1], LB); }
      __builtin_amdgcn_iglp_opt(2);
      { const int nb_ = buf ^ 1;
        *(bf16x8*)(Ks + nb_ * 64 * AT_LD + skey * AT_LD + sseg * 8) = kB; *(bf16x8*)(Vt + nb_ * 64 * VS_LD + skey * VS_LD + sseg * 8) = vB;
        const int tl_ = (t + 2 < nt) ? t + 2 : nt - 1;
        kB = *(const bf16x8*)(kg + (size_t)tl_ * 64 * NPB_); vB = *(const bf16x8*)(vg + (size_t)tl_ * 64 * NPB_); }
      __syncthreads();
    }
    float* cw = cmb + (size_t)(qsub * 64 + lane) * 66;
    const int sl_ = ((lane & 15) << 2);
    const float a0_ = __int_as_float(__builtin_amdgcn_ds_bpermute(sl_, __float_as_int(LA[0]))), a1_ = __int_as_float(__builtin_amdgcn_ds_bpermute(sl_, __float_as_int(LA[1])));
    const float b0_ = __int_as_float(__builtin_amdgcn_ds_bpermute(sl_, __float_as_int(LB[0]))), b1_ = __int_as_float(__builtin_amdgcn_ds_bpermute(sl_, __float_as_int(LB[1])));
    const float lq1 = (r31 >> 4) ? a1_ : a0_, lq2 = (r31 >> 4) ? b1_ : b0_;
    if (kh == 1) {
#pragma unroll
      for (int i = 0; i < 16; ++i) { cw[i] = O1[0][i]; cw[16 + i] = O1[1][i]; cw[32 + i] = O2[0][i]; cw[48 + i] = O2[1][i]; }
      cw[64] = lq1; cw[65] = lq2;
    }
    __syncthreads();
    if (kh == 0) {
#pragma unroll
      for (int i = 0; i < 16; ++i) { O1[0][i] += cw[i]; O1[1][i] += cw[16 + i]; O2[0][i] += cw[32 + i]; O2[1][i] += cw[48 + i]; }
      const float l1 = lq1 + cw[64], l2 = lq2 + cw[65];
      const float i1 = 1.0f / l1, i2 = lam / l2;
      float ss = 0.f;
#pragma unroll
      for (int mt = 0; mt < 2; ++mt)
#pragma unroll
        for (int i = 0; i < 16; ++i) { const float o = O1[mt][i] * i1 - O2[mt][i] * i2; O1[mt][i] = o; ss += o * o; }
      ss += shx(ss, 32, lane_id_v());
      const float sc = rsqrtf(ss * (1.0f / 64.0f) + EPS_) * (1.0f - lam_init);
      const float* sw = a->in[13] + l * 64;
#pragma unroll
      for (int mt = 0; mt < 2; ++mt)
#pragma unroll
        for (int g4 = 0; g4 < 4; ++g4) {
          const int v0 = 32 * mt + 8 * g4 + 4 * h;
          const f32x4 wv = *(const f32x4*)(sw + v0);
          u32x2 w; w.x = cvt_pk_bf16(O1[mt][4 * g4] * sc * wv[0], O1[mt][4 * g4 + 1] * sc * wv[1]); w.y = cvt_pk_bf16(O1[mt][4 * g4 + 2] * sc * wv[2], O1[mt][4 * g4 + 3] * sc * wv[3]);
          *(u32x2*)(BR + (size_t)qrow * 1024 + 640 + head * 64 + v0) = w;
        }
    }
  }
}
template <class Epi> DI void run_gemm(int WV, LAS unsigned char* lds, const bf16_t* A, int lda, const bf16_t* Bt, int M, int N, int K, const Epi& E) {
  pg8::Gemm g; g.A = A; g.Bt = Bt; g.M = M; g.N = N; g.K = K; g.lda = lda;
  pg8::StaticOrder S; S.init(M, N, lnb(), lbid());
  pg8::gemm_phase<Epi, pg8::StaticOrder, false>(WV, lds, g, S, E, nullptr);
}
struct EpiNull { static constexpr bool PERM = false, AFTER_DRAIN = false; float* U;
  DI void operator()(const f32x4 (&acc)[2][2][4][2], const Unit& u, int wr, int wc, int fr_, int fq_) const {
    f32x4 s = {0.f, 0.f, 0.f, 0.f};
#pragma unroll
    for (int ai = 0; ai < 2; ++ai) for (int bj = 0; bj < 2; ++bj) for (int m = 0; m < 4; ++m) for (int n = 0; n < 2; ++n) s += acc[ai][bj][m][n];
    if (s[0] == 123.456f) U[lane_id_v()] = s[1] + s[2] + s[3]; } };
struct CtxMerge0 { float* MXC; const bf16_t* G; DI void operator()(int r, int c, float v) const { MXC[r * 1024 + c] = sigmoid_f(bf2f(G[(size_t)r * NGB_ + c])) * v; } };
struct CtxMerge1 { float* MXC; const bf16_t* G; DI void operator()(int r, int c, float v) const { MXC[r * 1024 + c] += sigmoid_f(bf2f(G[(size_t)r * NGB_ + c])) * v; } };
struct CtxMerge2 { const float* MXC; const bf16_t* G; bf16_t* Hc; DI void operator()(int r, int c, float v) const { Hc[r * 1024 + c] = f2bf(MXC[r * 1024 + c] + sigmoid_f(bf2f(G[(size_t)r * NGB_ + c])) * v); } };
struct CtxResid { float* Xc; const float* gate; float scale; DI void operator()(int r, int c, float v) const { Xc[r * 1024 + c] += scale * gate[c] * v; } };

DI void phase_win(int WV, int l, unsigned char* smem) {
  KArgs a = kargs(); unsigned char* ws = a->ws;
  EpiWin E; E.PB = (bf16_t*)(ws + WS_PB); E.GB = (bf16_t*)(ws + WS_GB); E.TRET = (const float*)(ws + WS_TRET); E.TROW = (const float*)(ws + WS_TROW); E.TCOL = (const float*)(ws + WS_TCOL);
  E.kmax = (unsigned*)(ws + WS_SCAL) + l * 64 + 16;
  run_gemm(WV, (LAS unsigned char*)smem, (const bf16_t*)(ws + WS_H), 1024, (const bf16_t*)(ws + WS_WIN) + (size_t)l * 5888 * 1024, MT_, NWIN_, 1024, E);
}
DI void phase_merge(int WV, int l, unsigned char* smem) {
  LAS unsigned char* lds = (LAS unsigned char*)smem;
  { KArgs a = kargs(); unsigned char* ws = a->ws; EpiMerge<0> E; E.MX = (bf16_t*)a->out; E.G = (const bf16_t*)(ws + WS_GB); E.Hout = (bf16_t*)(ws + WS_H);
    run_gemm(WV, lds, (const bf16_t*)(ws + WS_BR), 1024, (const bf16_t*)(ws + WS_WBF) + (size_t)l * 1024 * 256, L_, 1024, 256, E); }
  { KArgs a = kargs(); unsigned char* ws = a->ws; EpiMerge<1> E; E.MX = (bf16_t*)a->out; E.G = (const bf16_t*)(ws + WS_GB) + 1024; E.Hout = (bf16_t*)(ws + WS_H);
    run_gemm(WV, lds, (const bf16_t*)(ws + WS_BR) + 256, 1024, (const bf16_t*)(ws + WS_WBR) + (size_t)l * 1024 * 384, L_, 1024, 384, E); }
  { KArgs a = kargs(); unsigned char* ws = a->ws; EpiMerge<2> E; E.MX = (bf16_t*)a->out; E.G = (const bf16_t*)(ws + WS_GB) + 2048; E.Hout = (bf16_t*)(ws + WS_H);
    run_gemm(WV, lds, (const bf16_t*)(ws + WS_BR) + 640, 1024, (const bf16_t*)(ws + WS_WBD) + (size_t)l * 1024 * 384, L_, 1024, 384, E); }
  if (l < DEPTH_ - 1) { KArgs a = kargs(); unsigned char* ws = a->ws;
    const bf16_t* BRc = (const bf16_t*)(ws + WS_BR) + (size_t)L_ * 1024; const bf16_t* GBc = (const bf16_t*)(ws + WS_GB) + (size_t)L_ * NGB_;
    CtxMerge0 e0; e0.MXC = (float*)(ws + WS_MXC); e0.G = GBc;
    ctx_gemm32(WV, BRc, 1024, (const bf16_t*)(ws + WS_WBF) + (size_t)l * 1024 * 256, 256, 1024, smem, e0);
    CtxMerge1 e1; e1.MXC = (float*)(ws + WS_MXC); e1.G = GBc + 1024;
    ctx_gemm32(WV, BRc + 256, 1024, (const bf16_t*)(ws + WS_WBR) + (size_t)l * 1024 * 384, 384, 1024, smem, e1);
    CtxMerge2 e2; e2.MXC = (const float*)(ws + WS_MXC); e2.G = GBc + 2048; e2.Hc = (bf16_t*)(ws + WS_H) + (size_t)L_ * 1024;
    ctx_gemm32(WV, BRc + 640, 1024, (const bf16_t*)(ws + WS_WBD) + (size_t)l * 1024 * 384, 384, 1024, smem, e2); }
}
DI void phase_wo(int WV, int l, unsigned char* smem) {
  { KArgs a = kargs(); unsigned char* ws = a->ws; EpiResid E; E.X = (float*)(ws + WS_X); E.gate = (const float*)(ws + WS_MOD) + (size_t)l * 9216 + 5 * 1024; E.scale = 1.0f;
    run_gemm(WV, (LAS unsigned char*)smem, (const bf16_t*)(ws + WS_H), 1024, (const bf16_t*)(ws + WS_WO) + (size_t)l * 1024 * 1024, L_, 1024, 1024, E); }
  if (l < DEPTH_ - 1) { KArgs a = kargs(); unsigned char* ws = a->ws; CtxResid e; e.Xc = (float*)(ws + WS_X) + (size_t)L_ * 1024; e.gate = (const float*)(ws + WS_MOD) + (size_t)(4 + l) * 9216 + 5 * 1024; e.scale = 1.0f;
    ctx_gemm32(WV, (const bf16_t*)(ws + WS_H) + (size_t)L_ * 1024, 1024, (const bf16_t*)(ws + WS_WO) + (size_t)l * 1024 * 1024, 1024, 1024, smem, e); }
}
DI void phase_g1(int WV, int l, int f, unsigned char* smem) {
  KArgs a = kargs(); unsigned char* ws = a->ws; EpiSwiglu E; E.U = (bf16_t*)(ws + WS_U);
  run_gemm(WV, (LAS unsigned char*)smem, (const bf16_t*)(ws + WS_H), 1024, (const bf16_t*)(ws + WS_W13) + (size_t)(l * 2 + f) * 5632 * 1024, MT_, 5632, 1024, E);
}
DI void phase_g2(int WV, int l, int f, unsigned char* smem) {
  const int gi = f == 0 ? 2 : 8;
  { KArgs a = kargs(); unsigned char* ws = a->ws; EpiResid E; E.X = (float*)(ws + WS_X); E.gate = (const float*)(ws + WS_MOD) + (size_t)l * 9216 + gi * 1024; E.scale = 0.5f;
    run_gemm(WV, (LAS unsigned char*)smem, (const bf16_t*)(ws + WS_U), 2816, (const bf16_t*)(ws + WS_W2) + (size_t)(l * 2 + f) * 1024 * 2816, L_, 1024, 2816, E); }
  if (!(l == DEPTH_ - 1 && f == 1)) { KArgs a = kargs(); unsigned char* ws = a->ws; CtxResid e; e.Xc = (float*)(ws + WS_X) + (size_t)L_ * 1024; e.gate = (const float*)(ws + WS_MOD) + (size_t)(4 + l) * 9216 + gi * 1024; e.scale = 0.5f;
    ctx_gemm32(WV, (const bf16_t*)(ws + WS_U) + (size_t)L_ * 2816, 2816, (const bf16_t*)(ws + WS_W2) + (size_t)(l * 2 + f) * 1024 * 2816, 2816, 1024, smem, e); }
}

DI unsigned xcc_id() { return (unsigned)__builtin_amdgcn_s_getreg((3 << 11) | 20) & 0xFu; }
DI void grid_bar(int WV, unsigned& gen, unsigned xcc, unsigned nloc, unsigned nx) {
  asm volatile("s_waitcnt vmcnt(0)" ::: "memory");
  __syncthreads();
  gen += 1;
  if (ltid() == 0) {
    unsigned* bar = (unsigned*)(kargs()->ws + WS_BAR);
    const unsigned old = __hip_atomic_fetch_add(bar + 320 + 16 * xcc, 1u, __ATOMIC_RELAXED, __HIP_MEMORY_SCOPE_AGENT);
    if (old + 1u == gen * nloc) {
      __builtin_amdgcn_fence(__ATOMIC_RELEASE, "agent");
      asm volatile("s_waitcnt vmcnt(0)" ::: "memory");
      __hip_atomic_fetch_add(bar + 640, 1u, __ATOMIC_RELAXED, __HIP_MEMORY_SCOPE_AGENT);
    }
    const unsigned target = gen * nx;
    while (__hip_atomic_load(bar + 640, __ATOMIC_RELAXED, __HIP_MEMORY_SCOPE_AGENT) < target) __builtin_amdgcn_s_sleep(1);
    __builtin_amdgcn_fence(__ATOMIC_ACQUIRE, "agent");
    asm volatile("s_waitcnt vmcnt(0)" ::: "memory");
  }
  __syncthreads();
}

__global__ void __launch_bounds__(512, 2) mega(Args a_unused) {
  extern __shared__ __attribute__((aligned(16))) unsigned char smem[];
  cg::grid_group grid = cg::this_grid();
  const int WV = __builtin_amdgcn_readfirstlane((int)(threadIdx.x >> 6));
  const unsigned xcc = xcc_id();
  if (threadIdx.x == 0) __hip_atomic_fetch_add((unsigned*)(kargs()->ws + WS_BAR) + 16 + 16 * xcc, 1u, __ATOMIC_RELAXED, __HIP_MEMORY_SCOPE_AGENT);
#ifndef NO_PRO
  prologue(WV, kargs(), smem);
#ifdef PROBE_PRO
  __syncthreads(); prologue(WV, kargs(), smem);
#endif
#endif
  grid.sync();
  unsigned gen = 0, nloc = 1, nx = 0;
  { const unsigned* cen = (const unsigned*)(kargs()->ws + WS_BAR) + 16;
    for (int j = 0; j < 16; ++j) { const unsigned cj = __hip_atomic_load(cen + 16 * j, __ATOMIC_RELAXED, __HIP_MEMORY_SCOPE_AGENT); nx += cj ? 1u : 0u; if ((unsigned)j == xcc) nloc = cj; }
    nloc = __builtin_amdgcn_readfirstlane(nloc); nx = __builtin_amdgcn_readfirstlane(nx); }
#pragma unroll 1
  for (int l = 0; l < DEPTH_; ++l) {
#pragma unroll 1
    for (int f = 0; f < 2; ++f) {
      if (f == 1) {
        norm_phase(WV, kargs(), l, 1, false);
        grid_bar(WV, gen, xcc, nloc, nx);
        phase_win(WV, l, smem);
#ifdef PROBE_WIN
        phase_win(WV, l, smem);
#endif
        grid_bar(WV, gen, xcc, nloc, nx);
#ifndef NO_MIXA
        fourier_tables(WV, smem); __syncthreads(); fourier_stage1(WV, kargs(), smem); if (l < DEPTH_ - 1) fourier_ctx(WV, kargs(), smem); __syncthreads(); ret_states(WV, kargs(), l, smem);
#ifdef PROBE_RS
        __syncthreads(); ret_states(WV, kargs(), l, smem);
#endif
#ifdef PROBE_F1
        __syncthreads(); fourier_tables(WV, smem); __syncthreads(); fourier_stage1(WV, kargs(), smem);
#endif
#ifdef PROBE_FC
        __syncthreads(); fourier_ctx(WV, kargs(), smem);
#endif
#ifdef PROBE_MIXA
        __syncthreads();
        fourier_tables(WV, smem); __syncthreads(); fourier_stage1(WV, kargs(), smem); fourier_ctx(WV, kargs(), smem); __syncthreads(); ret_states(WV, kargs(), l, smem);
#endif
#endif
        grid_bar(WV, gen, xcc, nloc, nx);
#ifndef NO_MIXB
        ret_scan(WV, kargs(), l); __syncthreads(); fourier_tables(WV, smem); __syncthreads(); fourier_stage2(WV, kargs(), smem);
#ifdef PROBE_MIXB
        __syncthreads();
        ret_scan(WV, kargs(), l); __syncthreads(); fourier_tables(WV, smem); __syncthreads(); fourier_stage2(WV, kargs(), smem);
#endif
#endif
        grid_bar(WV, gen, xcc, nloc, nx);
#ifndef NO_RETOUT
        ret_out(WV, kargs(), l, smem); __syncthreads();
#ifdef PROBE_RET
        ret_out(WV, kargs(), l, smem); __syncthreads();
#endif
#endif
#ifndef NO_ATTN
        attn_phase<0>(WV, kargs(), l, l < DEPTH_ - 1, smem);
#ifdef PROBE_ATTN
        __syncthreads(); attn_phase<PROBE_ATTN>(WV, kargs(), l, l < DEPTH_ - 1, smem);
#endif
#endif
        grid_bar(WV, gen, xcc, nloc, nx);
        phase_merge(WV, l, smem);
#ifdef PROBE_MERGE
        phase_merge(WV, l, smem);
#endif
        grid_bar(WV, gen, xcc, nloc, nx);
        phase_wo(WV, l, smem);
        grid_bar(WV, gen, xcc, nloc, nx);
      }
      norm_phase(WV, kargs(), l, f == 0 ? 0 : 2, l == 0 && f == 0);
      grid_bar(WV, gen, xcc, nloc, nx);
      phase_g1(WV, l, f, smem);
#ifdef PROBE_G1
      phase_g1(WV, l, f, smem);
#endif
#ifdef PROBE_G1NULL
      { KArgs a = kargs(); unsigned char* ws = a->ws; EpiNull E; E.U = (float*)a->out;
        run_gemm(WV, (LAS unsigned char*)smem, (const bf16_t*)(ws + WS_H), 1024, (const bf16_t*)(ws + WS_W13) + (size_t)(l * 2 + f) * 5632 * 1024, MT_, 5632, 1024, E); }
#endif
      grid_bar(WV, gen, xcc, nloc, nx);
      phase_g2(WV, l, f, smem);
      grid_bar(WV, gen, xcc, nloc, nx);
    }
  }
  final_norm(WV, kargs());
}

extern "C" void kernel_launch(void* const* d_in, const int* in_sizes, int n_in, void* d_out, int out_size, void* d_ws, size_t ws_size, hipStream_t stream) {
  static int grid = 0;
  if (grid == 0) {
    int dev = 0, cus = 0, per_cu = 0;
    (void)hipGetDevice(&dev); (void)hipDeviceGetAttribute(&cus, hipDeviceAttributeMultiprocessorCount, dev);
    if (hipFuncSetAttribute((const void*)mega, hipFuncAttributeMaxDynamicSharedMemorySize, LDS_BYTES) != hipSuccess) fprintf(stderr, "kernel_launch: hipFuncSetAttribute failed\n");
    if (hipOccupancyMaxActiveBlocksPerMultiprocessor(&per_cu, (const void*)mega, 512, LDS_BYTES) != hipSuccess || per_cu < 1) fprintf(stderr, "kernel_launch: occupancy query says %d blocks per CU\n", per_cu);
    (void)hipGetLastError();
    grid = cus > 0 ? cus : 256;
    if (ws_size < WS_END) { fprintf(stderr, "kernel_launch: workspace too small: %zu < %zu\n", ws_size, (size_t)WS_END); }
  }
  Args a{};
  for (int i = 0; i < 19; ++i) a.in[i] = (const float*)d_in[i];
  a.out = (float*)d_out; a.ws = (unsigned char*)d_ws;
  (void)hipMemsetAsync((unsigned char*)d_ws + WS_BAR, 0, 8192, stream);
  void* args[] = {&a};
  hipError_t e = hipLaunchCooperativeKernel((const void*)mega, dim3(grid), dim3(512), args, LDS_BYTES, stream);
  if (e != hipSuccess) fprintf(stderr, "kernel_launch: cooperative launch failed: %s (grid %d)\n", hipGetErrorString(e), grid);
}
```

```cpp
#include <hip/hip_runtime.h>
#include <hip/hip_cooperative_groups.h>
#include <cstdio>
namespace cg = cooperative_groups;
__device__ __forceinline__ int lane_id_v() { int l; asm volatile("v_mbcnt_lo_u32_b32 %0, -1, 0\n\tv_mbcnt_hi_u32_b32 %0, -1, %0" : "=v"(l)); return l; }
#define ltid() ((WV << 6) | lane_id_v())
__device__ __forceinline__ float shx(float v, int m, int lane) { return __int_as_float(__builtin_amdgcn_ds_bpermute((lane ^ m) << 2, __float_as_int(v))); }
namespace pg8 {
#define PG8_LAS __attribute__((address_space(3)))
typedef unsigned short bf16_t;
typedef short bf16x8 __attribute__((ext_vector_type(8)));
typedef float f32x4 __attribute__((ext_vector_type(4)));
typedef unsigned u32x4 __attribute__((ext_vector_type(4)));
constexpr int BM = 256, BK = 64, HALF = 128, HTB = HALF * BK * 2  , STAGE_BYTES = 8 * HTB, NXCD = 8, WGM = 8;

__host__ __device__ __forceinline__ int lds_byte(int r, int c) { const int st = (r >> 4) * 2 + (c >> 5), rr = r & 15, cc = c & 31, ob = rr * 64 + cc * 2; return st * 1024 + (ob ^ (((ob >> 9) & 1) << 5)); }
__host__ __device__ __forceinline__ void stage_rc(int b, int& R, int& C) { const int st = b / 1024, sb = b % 1024, swz = sb ^ (((sb >> 9) & 1) << 5); R = (st >> 1) * 16 + swz / 64; C = (st & 1) * 32 + (swz % 64) / 2; }
__host__ __device__ __forceinline__ int perm32(int rho) { const int n = rho >> 4, i = rho & 15; return 8 * (i >> 2) + 4 * n + (i & 3); }

struct Unit { int pm, pn; };
struct Gemm { const bf16_t* A; const bf16_t* Bt; int M, N, K, lda; };

struct StaticOrder {
    int nM, nN, nwg, G, c;
    __host__ __device__ void init(int M, int N, int G_, int c_) { nM = M / BM; nN = N / BM; nwg = nM * nN; G = G_; c = c_; }
    __host__ __device__ bool next(int i, Unit& u) const {
        const long L = (long)i * G + c; if (L >= nwg) return false;
        int wgid = (int)L; { const int q = nwg / NXCD, r = nwg % NXCD, xcd = wgid % NXCD, off = wgid / NXCD; wgid = (xcd < r ? xcd * (q + 1) : r * (q + 1) + (xcd - r) * q) + off; }
        const int nig = WGM * nN, gid = wgid / nig, fm = gid * WGM, gsz = (nM - fm) < WGM ? (nM - fm) : WGM;
        u.pm = fm + ((wgid % nig) % gsz); u.pn = (wgid % nig) / gsz; return true;
    }
    __device__ __forceinline__ void a_ready(const Unit&) const {}
    __device__ __forceinline__ void done(const Unit&) const {}
};
__device__ __forceinline__ unsigned cvt_pk_bf16(float lo, float hi) { unsigned r; asm volatile("v_cvt_pk_bf16_f32 %0, %1, %2" : "=v"(r) : "v"(lo), "v"(hi)); return r; }
template <class Epi, class Sched, bool STAMP = false>
__device__ __forceinline__ void gemm_phase(const int WV, PG8_LAS unsigned char* lds, const Gemm g, const Sched& S, const Epi& E, unsigned long long* stamps) {
    const int tid = ltid(); const int wid = __builtin_amdgcn_readfirstlane(tid >> 6), lane = tid & 63, wr = wid >> 2, wc = wid & 3, fr = lane & 15, fq = lane >> 4;
    const int K = g.K, nt = K / BK;
    int ts_lo = 0, ts_hi = 0, nts = 0; const unsigned long long rt_entry = STAMP ? (unsigned long long)wall_clock64() : 0ull;
#define PG8_STAMP() do { if (STAMP && wid == 0 && nts < 64) { const unsigned long long _c = (unsigned long long)clock64(); \
        ts_lo = (lane == nts) ? (int)(unsigned)_c : ts_lo; ts_hi = (lane == nts) ? (int)(unsigned)(_c >> 32) : ts_hi; ++nts; } } while (0)
    PG8_STAMP();
    unsigned voffA[2], voffB[2];
#pragma unroll
    for (int i = 0; i < 2; ++i) { int R, C; stage_rc(tid * 16 + i * 8192, R, C); const int Rb = Epi::PERM ? ((R & ~31) + perm32(R & 31)) : R;
        voffA[i] = (unsigned)(R * g.lda + C) * 2u; voffB[i] = (unsigned)(Rb * K + C) * 2u; }
    const size_t kstep = (size_t)(BK * 2);
    const size_t hstep = (size_t)HALF * K * 2;
    const size_t tstep = 2 * hstep; const size_t hstepA = (size_t)HALF * g.lda * 2; const size_t tstepA = 2 * hstepA;
    const unsigned ldsw = (unsigned)wid * 1024u;
    const int aoff = lds_byte(wr * 64 + fr, fq * 8), boff = lds_byte(wc * 32 + fr, fq * 8);
#define PG8_SA(b, h) (((b) * 2 + (h)) * HTB)
#define PG8_SB(b, h) ((4 + (b) * 2 + (h)) * HTB)
#define PG8_STAGE(bufoff, gbase, voff) do { _Pragma("unroll") for (int _i = 0; _i < 2; ++_i) \
        __builtin_amdgcn_global_load_lds((const unsigned*)((const char*)(gbase) + (voff)[_i]), (PG8_LAS unsigned*)(lds + (bufoff) + ldsw + _i * 8192), 16, 0, 0); } while (0)
#define PG8_LDA(dst, b, h) do { _Pragma("unroll") for (int m = 0; m < 4; ++m) _Pragma("unroll") for (int k = 0; k < 2; ++k) dst[m][k] = *(const PG8_LAS bf16x8*)(lds + PG8_SA(b, h) + aoff + m * 2048 + k * 1024); } while (0)
#define PG8_LDB(dst, b, h) do { _Pragma("unroll") for (int n = 0; n < 2; ++n) _Pragma("unroll") for (int k = 0; k < 2; ++k) dst[n][k] = *(const PG8_LAS bf16x8*)(lds + PG8_SB(b, h) + boff + n * 2048 + k * 1024); } while (0)
#define PG8_MMA(ai, bj, At, Bt) do { __builtin_amdgcn_s_setprio(1); _Pragma("unroll") for (int m = 0; m < 4; ++m) _Pragma("unroll") for (int n = 0; n < 2; ++n) _Pragma("unroll") for (int k = 0; k < 2; ++k) \
        acc[ai][bj][m][n] = __builtin_amdgcn_mfma_f32_16x16x32_bf16(Bt[n][k], At[m][k], acc[ai][bj][m][n], 0, 0, 0); __builtin_amdgcn_s_setprio(0); } while (0)
#define PG8_WAIT_V(n) asm volatile("s_waitcnt vmcnt(" #n ")" ::: "memory")
#define PG8_WAIT_L(n) asm volatile("s_waitcnt lgkmcnt(" #n ")" ::: "memory")
#define PG8_BAR __builtin_amdgcn_s_barrier()
#define PG8_SCHED __builtin_amdgcn_sched_barrier(0)
    Unit cur, nxt; int ui = 0;
    if (!S.next(0, cur)) return;
    f32x4 acc[2][2][4][2];
#pragma unroll
    for (int a = 0; a < 2; ++a)
#pragma unroll
        for (int b = 0; b < 2; ++b)
#pragma unroll
            for (int m = 0; m < 4; ++m)
#pragma unroll
                for (int n = 0; n < 2; ++n) acc[a][b][m][n] = (f32x4){0.f, 0.f, 0.f, 0.f};
    bf16x8 At[4][2], B0[2][2], B1[2][2];
    const char* cA = (const char*)g.A + (size_t)cur.pm * tstepA; const char* cB = (const char*)g.Bt + (size_t)cur.pn * tstep;
    S.a_ready(cur);
    PG8_STAGE(PG8_SB(0, 0), cB, voffB); PG8_STAGE(PG8_SA(0, 0), cA, voffA); PG8_STAGE(PG8_SB(0, 1), cB + hstep, voffB); PG8_STAGE(PG8_SA(0, 1), cA + hstepA, voffA);
    if (wr == 1) PG8_BAR;
    PG8_WAIT_V(4); PG8_BAR;
    PG8_STAGE(PG8_SB(1, 0), cB + kstep, voffB); PG8_STAGE(PG8_SA(1, 0), cA + kstep, voffA); PG8_STAGE(PG8_SB(1, 1), cB + hstep + kstep, voffB);
    PG8_WAIT_V(6); PG8_BAR;
    PG8_STAMP();
    for (;;) {
        const bool has_next = S.next(ui + 1, nxt);
        const char* nA = has_next ? (const char*)g.A + (size_t)nxt.pm * tstepA : cA; const char* nB = has_next ? (const char*)g.Bt + (size_t)nxt.pn * tstep : cB;
        for (int t = 0; t < nt; t += 2) {
            const bool last = (t == nt - 2);
            const char* a1 = cA + (size_t)(t + 1) * kstep;
            const char* a2 = last ? nA : cA + (size_t)(t + 2) * kstep; const char* b2 = last ? nB : cB + (size_t)(t + 2) * kstep;
            const char* a3 = a2 + kstep; const char* b3 = b2 + kstep;
            if (last && has_next) S.a_ready(nxt);
            PG8_LDB(B0, 0, 0); PG8_SCHED; PG8_LDA(At, 0, 0); PG8_STAGE(PG8_SA(1, 1), a1 + hstepA, voffA);
            PG8_WAIT_L(8); PG8_BAR; PG8_WAIT_L(0); PG8_MMA(0, 0, At, B0); PG8_BAR; PG8_SCHED;
            PG8_LDB(B1, 0, 1); PG8_STAGE(PG8_SB(0, 0), b2, voffB);
            PG8_BAR; PG8_WAIT_L(0); PG8_MMA(0, 1, At, B1); PG8_BAR;
            PG8_LDA(At, 0, 1); PG8_STAGE(PG8_SA(0, 0), a2, voffA);
            PG8_BAR; PG8_WAIT_L(0); PG8_MMA(1, 0, At, B0); PG8_BAR; PG8_SCHED;
            PG8_STAGE(PG8_SB(0, 1), b2 + hstep, voffB);
            PG8_WAIT_V(6); PG8_BAR; PG8_MMA(1, 1, At, B1); PG8_BAR;
            PG8_LDB(B0, 1, 0); PG8_SCHED; PG8_LDA(At, 1, 0); PG8_STAGE(PG8_SA(0, 1), a2 + hstepA, voffA);
            PG8_WAIT_L(8); PG8_BAR; PG8_WAIT_L(0); PG8_MMA(0, 0, At, B0); PG8_BAR; PG8_SCHED;
            PG8_LDB(B1, 1, 1); PG8_STAGE(PG8_SB(1, 0), b3, voffB);
            PG8_BAR; PG8_WAIT_L(0); PG8_MMA(0, 1, At, B1); PG8_BAR;
            PG8_LDA(At, 1, 1); PG8_STAGE(PG8_SA(1, 0), a3, voffA);
            PG8_BAR; PG8_WAIT_L(0); PG8_MMA(1, 0, At, B0); PG8_BAR; PG8_SCHED;
            PG8_STAGE(PG8_SB(1, 1), b3 + hstep, voffB);
            PG8_WAIT_V(6); PG8_BAR; PG8_MMA(1, 1, At, B1); PG8_BAR;
        }
        PG8_STAMP();
        if constexpr (!Epi::AFTER_DRAIN) { E(acc, cur, wr, wc, fr, fq); S.done(cur); }
        PG8_STAMP();
        if (!has_next) break;
#pragma unroll
        for (int a = 0; a < 2; ++a)
#pragma unroll
            for (int b = 0; b < 2; ++b)
#pragma unroll
                for (int m = 0; m < 4; ++m)
#pragma unroll
                    for (int n = 0; n < 2; ++n) acc[a][b][m][n] = (f32x4){0.f, 0.f, 0.f, 0.f};
        cur = nxt; cA = nA; cB = nB; ++ui;
    }
    PG8_WAIT_V(0);
    if (wr == 0) PG8_BAR;
    PG8_BAR;
    if constexpr (Epi::AFTER_DRAIN) { E.fused(acc, cur, wr, wc, fr, fq, lds, wid, lane); S.done(cur); }
    PG8_STAMP();
    if (STAMP && wid == 0) { stamps[lane] = lane < nts ? (((unsigned long long)(unsigned)ts_hi << 32) | (unsigned)ts_lo) : 0ull;
        if (lane == 62) stamps[62] = rt_entry; if (lane == 63) stamps[63] = (unsigned long long)wall_clock64(); }
#undef PG8_STAMP
#undef PG8_SA
#undef PG8_SB
#undef PG8_STAGE
#undef PG8_LDA
#undef PG8_LDB
#undef PG8_MMA
#undef PG8_WAIT_V
#undef PG8_WAIT_L
#undef PG8_BAR
#undef PG8_SCHED
}
}
using pg8::bf16_t; using pg8::bf16x8; using pg8::f32x4; using pg8::u32x4; using pg8::cvt_pk_bf16;
typedef float f32x16 __attribute__((ext_vector_type(16)));
typedef short s16x4 __attribute__((ext_vector_type(4)));
typedef unsigned u32x2 __attribute__((ext_vector_type(2)));
#define DI __device__ __forceinline__
#define LAS __attribute__((address_space(3)))
#define MFMA32(a, b, c) __builtin_amdgcn_mfma_f32_32x32x16_bf16((a), (b), (c), 0, 0, 0)

constexpr int L_ = 16384, LC_ = 256, MT_ = 16640, D_ = 1024, DFF_ = 2816, DEPTH_ = 4;
constexpr int NWIN_ = 5888, NPB_ = 2816, NGB_ = 3072;
constexpr int C_FA = 0, C_FB = 256, C_RQ = 512, C_RK = 704, C_RV = 896, C_RG = 1280, C_DQ = 1664, C_DK = 2048, C_DV = 2432;
constexpr int LDS_BYTES = 147456;
constexpr float EPS_ = 1e-6f;

constexpr size_t al256(size_t x) { return (x + 255) & ~(size_t)255; }
constexpr size_t WS_W13 = 0;
constexpr size_t WS_W2  = WS_W13 + (size_t)4 * 2 * 5632 * 1024 * 2;
constexpr size_t WS_WIN = WS_W2 + (size_t)4 * 2 * 1024 * 2816 * 2;
constexpr size_t WS_WBF = WS_WIN + (size_t)4 * 5888 * 1024 * 2;
constexpr size_t WS_WBR = WS_WBF + (size_t)4 * 1024 * 256 * 2;
constexpr size_t WS_WBD = WS_WBR + (size_t)4 * 1024 * 384 * 2;
constexpr size_t WS_WO  = WS_WBD + (size_t)4 * 1024 * 384 * 2;
constexpr size_t WS_X   = WS_WO + (size_t)4 * 1024 * 1024 * 2;
constexpr size_t WS_H   = WS_X + (size_t)MT_ * 1024 * 4;
constexpr size_t WS_BR  = WS_H + (size_t)MT_ * 1024 * 2;
constexpr size_t WS_AL  = WS_BR + (size_t)MT_ * 1024 * 2;
constexpr size_t WS_U   = WS_AL;
constexpr size_t WS_PB  = WS_AL;
constexpr size_t WS_GB  = WS_AL + (size_t)MT_ * 2816 * 2;
constexpr size_t WS_V   = WS_GB + (size_t)MT_ * 3072 * 2;
constexpr size_t WS_T   = WS_V + (size_t)128 * 128 * 2 * 256 * 2;
constexpr size_t WS_S   = WS_T + (size_t)130 * 6 * 2 * 2048 * 4;
constexpr size_t WS_MXC = WS_S + (size_t)130 * 6 * 2 * 2048 * 4;
constexpr size_t WS_MOD = WS_MXC + (size_t)256 * 1024 * 4;
constexpr size_t WS_TRET = WS_MOD + (size_t)2 * 4 * 9216 * 4;
constexpr size_t WS_TROW = WS_TRET + (size_t)16384 * 16 * 2 * 4;
constexpr size_t WS_TCOL = WS_TROW + (size_t)256 * 8 * 2 * 4;
constexpr size_t WS_SCAL = WS_TCOL + (size_t)64 * 8 * 2 * 4;
constexpr size_t WS_BAR = WS_SCAL + 4 * 64 * 4;
constexpr size_t WS_END = WS_BAR + 8192;

__device__ __forceinline__ int lbid() { int t = blockIdx.x; asm volatile("" : "+s"(t)); return t; }
__device__ __forceinline__ int lnb() { int t = gridDim.x; asm volatile("" : "+s"(t)); return t; }
struct Args { const float* in[19]; float* out; unsigned char* ws; };
typedef const Args __attribute__((address_space(4)))* KArgs;
__device__ __forceinline__ KArgs kargs() { KArgs p = (KArgs)__builtin_amdgcn_kernarg_segment_ptr(); asm volatile("" : "+s"(p)); return p; }

DI float bf2f(unsigned v) { return __uint_as_float(v << 16); }
DI bf16_t f2bf(float x) { return (bf16_t)(cvt_pk_bf16(x, 0.f) & 0xffffu); }
DI int crow(int reg, int h) { return (reg & 3) + 8 * (reg >> 2) + 4 * h; }
DI bf16x8 pack_step(const f32x16& x, int s) {
  u32x4 p;
  asm volatile("v_cvt_pk_bf16_f32 %0, %4, %5\n\tv_cvt_pk_bf16_f32 %1, %6, %7\n\tv_cvt_pk_bf16_f32 %2, %8, %9\n\tv_cvt_pk_bf16_f32 %3, %10, %11\n\ts_nop 1"
               : "=&v"(p[0]), "=&v"(p[1]), "=&v"(p[2]), "=&v"(p[3])
               : "v"(x[8 * s]), "v"(x[8 * s + 1]), "v"(x[8 * s + 2]), "v"(x[8 * s + 3]), "v"(x[8 * s + 4]), "v"(x[8 * s + 5]), "v"(x[8 * s + 6]), "v"(x[8 * s + 7]));
  return __builtin_bit_cast(bf16x8, p);
}
DI float silu_f(float a) { return a * __builtin_amdgcn_rcpf(1.0f + __expf(-a)); }
DI float sigmoid_f(float a) { return __builtin_amdgcn_rcpf(1.0f + __expf(-a)); }
DI float wave_sum(float v) {
  const int lane = lane_id_v();
#pragma unroll
  for (int o = 32; o > 0; o >>= 1) v += shx(v, o, lane);
  return v;
}
DI void sincos_acc(float xf, float& s, float& c) {
  const double x = (double)xf;
  const double k = rint(x * 0.63661977236758134308);
  double r = fma(-k, 1.57079632679489655800e+00, x); r = fma(-k, 6.12323399573676603587e-17, r);
  const double r2 = r * r;
  double sp = -1.0 / 39916800.0; sp = fma(sp, r2, 1.0 / 362880.0); sp = fma(sp, r2, -1.0 / 5040.0); sp = fma(sp, r2, 1.0 / 120.0); sp = fma(sp, r2, -1.0 / 6.0); sp = fma(sp * r2, r, r);
  double cp = 1.0 / 479001600.0; cp = fma(cp, r2, -1.0 / 3628800.0); cp = fma(cp, r2, 1.0 / 40320.0); cp = fma(cp, r2, -1.0 / 720.0); cp = fma(cp, r2, 1.0 / 24.0); cp = fma(cp, r2, -0.5); cp = fma(cp, r2, 1.0);
  const int q = ((int)(long long)k) & 3;
  const double sv = (q == 0) ? sp : (q == 1) ? cp : (q == 2) ? -sp : -cp;
  const double cv = (q == 0) ? cp : (q == 1) ? -sp : (q == 2) ? -cp : sp;
  s = (float)sv; c = (float)cv;
}
__constant__ float INV16[16] = {1.0f, 0.5623413324356079f, 0.3162277638912201f, 0.17782793939113617f, 0.10000000149011612f, 0.05623413249850273f, 0.03162277489900589f, 0.017782794311642647f,
                             0.009999999776482582f, 0.005623413249850273f, 0.003162277629598975f, 0.0017782794311642647f, 0.0010000000474974513f, 0.000562341301701963f, 0.0003162277571391314f, 0.00017782794020604342f};
struct ConvJob { const float* src; const float* src2; bf16_t* dst; int N, K, ld, kind; };
DI ConvJob conv_job(KArgs a, int j) {
  const int l = j / 9, kd = j % 9; ConvJob J; J.src2 = nullptr; J.kind = 0;
  unsigned char* ws = a->ws;
  switch (kd) {
    case 0: case 1: { const int f = kd; J.src = a->in[7] + (size_t)(l * 2 + f) * 1024 * 2816; J.src2 = a->in[8] + (size_t)(l * 2 + f) * 1024 * 2816; J.dst = (bf16_t*)(ws + WS_W13) + (size_t)(l * 2 + f) * 5632 * 1024; J.N = 5632; J.K = 1024; J.ld = 2816; J.kind = 1; break; }
    case 2: case 3: { const int f = kd - 2; J.src = a->in[9] + (size_t)(l * 2 + f) * 2816 * 1024; J.dst = (bf16_t*)(ws + WS_W2) + (size_t)(l * 2 + f) * 1024 * 2816; J.N = 1024; J.K = 2816; J.ld = 1024; break; }
    case 4: { J.src = a->in[10] + (size_t)l * 1024 * 5632; J.dst = (bf16_t*)(ws + WS_WIN) + (size_t)l * 5888 * 1024; J.N = 5888; J.K = 1024; J.ld = 5632; J.kind = 2; break; }
    case 5: { J.src = a->in[14] + (size_t)l * 256 * 1024; J.dst = (bf16_t*)(ws + WS_WBF) + (size_t)l * 1024 * 256; J.N = 1024; J.K = 256; J.ld = 1024; break; }
    case 6: { J.src = a->in[15] + (size_t)l * 384 * 1024; J.dst = (bf16_t*)(ws + WS_WBR) + (size_t)l * 1024 * 384; J.N = 1024; J.K = 384; J.ld = 1024; break; }
    case 7: { J.src = a->in[16] + (size_t)l * 384 * 1024; J.dst = (bf16_t*)(ws + WS_WBD) + (size_t)l * 1024 * 384; J.N = 1024; J.K = 384; J.ld = 1024; break; }
    default: { J.src = a->in[17] + (size_t)l * 1024 * 1024; J.dst = (bf16_t*)(ws + WS_WO) + (size_t)l * 1024 * 1024; J.N = 1024; J.K = 1024; J.ld = 1024; break; }
  }
  return J;
}
DI int axial_perm(int s) { return s < 8 ? s : (s < 16 ? s + 8 : (s < 24 ? s - 8 : s)); }

DI void prologue(int WV, KArgs a, unsigned char* smem) {
  const int tid = ltid(), nb = lnb(), bid = lbid();
  float* t = (float*)smem;
  float* tr = t + 64 * 65;
  {
    constexpr int tiles_per_layer = 1408 * 2 + 704 * 2 + 1472 + 64 + 96 + 96 + 256;
    const int nn = tid & 63, kq = tid >> 6;
#pragma unroll 1
    for (int g = bid; g < 4 * tiles_per_layer; g += nb) {
      const int l = g / tiles_per_layer; int rem = g % tiles_per_layer; int kd;
      if (rem < 1408) kd = 0; else if (rem < 2816) { kd = 1; rem -= 1408; } else if (rem < 3520) { kd = 2; rem -= 2816; } else if (rem < 4224) { kd = 3; rem -= 3520; }
      else if (rem < 5696) { kd = 4; rem -= 4224; } else if (rem < 5760) { kd = 5; rem -= 5696; } else if (rem < 5856) { kd = 6; rem -= 5760; } else if (rem < 5952) { kd = 7; rem -= 5856; } else { kd = 8; rem -= 5952; }
      const ConvJob J = conv_job(a, l * 9 + kd);
      const int nkt = J.K / 64; const int n0 = (rem / nkt) * 64, k0 = (rem % nkt) * 64;
      const bool fold = (J.kind == 2) && (n0 < 512);
      const float* sp = J.src; int col = n0 + nn;
      if (J.kind == 1) { const int n = n0 + nn, gi = n >> 5, s = n & 31; sp = (s < 16) ? J.src : J.src2; col = 16 * gi + (s & 15); }
      else if (J.kind == 2) {
        const int n = n0 + nn;
        if (fold) col = (n0 & 192) + nn;
        else { col = n - 256; if (n >= C_DQ && n < C_DV) { const int s = n & 31; col = (n - 256 - s) + axial_perm(s); } }
      }
      const float* cp = sp + (size_t)(k0 + kq) * J.ld + col;
      float lv[8];
#pragma unroll
      for (int i = 0; i < 8; ++i) lv[i] = cp[(size_t)(8 * i) * J.ld];
#pragma unroll
      for (int i = 0; i < 8; ++i) t[nn * 65 + kq + 8 * i] = lv[i];
      if (fold && tid < 64) { const float ang = (float)tid * (1.0f / 32.0f); tr[tid] = (n0 >= 256) ? sinpif(ang) : cospif(ang); }
      __syncthreads();
      if (!fold) {
#pragma unroll
        for (int i = 0; i < 4; ++i) {
          const int e = tid + i * 512, n2 = e >> 5, kp = (e & 31) * 2;
          *(unsigned*)(J.dst + (size_t)(n0 + n2) * J.K + k0 + kp) = cvt_pk_bf16(t[n2 * 65 + kp], t[n2 * 65 + kp + 1]);
        }
      } else {
#pragma unroll 1
        for (int i = 0; i < 8; ++i) {
          const int m = kq + 8 * i, kk = nn;
          float acc = 0.f;
#pragma unroll 8
          for (int c = 0; c < 64; ++c) acc += t[c * 65 + kk] * tr[(m * c) & 63];
          J.dst[(size_t)(n0 + m) * J.K + k0 + kk] = f2bf(acc);
        }
      }
      __syncthreads();
    }
  }
  {
    float* sc = (float*)smem; float* scc = sc + 1024; float* red = scc + 1024;
    __syncthreads();
    for (int i = tid; i < 1024; i += 512) { sc[i] = silu_f(a->in[1][i]); scc[i] = silu_f(a->in[3][i]); }
    __syncthreads();
    float* MOD = (float*)(a->ws + WS_MOD);
    for (int it = bid; it < 4 * 72; it += nb) {
      const int l = it / 72, cb = it % 72;
      const int cgp = tid & 31, ks = tid >> 5;
      const float* wp = a->in[4] + ((size_t)l * 1024 + ks * 64) * 9216 + cb * 128 + cgp * 4;
      f32x4 am = {0.f, 0.f, 0.f, 0.f}, ac = {0.f, 0.f, 0.f, 0.f};
#pragma unroll 8
      for (int k = 0; k < 64; ++k) { const f32x4 w = *(const f32x4*)(wp + (size_t)k * 9216); am += w * sc[ks * 64 + k]; ac += w * scc[ks * 64 + k]; }
#pragma unroll
      for (int j = 0; j < 4; ++j) { red[(ks * 128 + cgp * 4 + j) * 2] = am[j]; red[(ks * 128 + cgp * 4 + j) * 2 + 1] = ac[j]; }
      __syncthreads();
      if (tid < 256) {
        const int col = tid >> 1, which = tid & 1; float s = 0.f;
#pragma unroll
        for (int q = 0; q < 16; ++q) s += red[(q * 128 + col) * 2 + which];
        const int gc = cb * 128 + col;
        MOD[(size_t)(which * 4 + l) * 9216 + gc] = s + a->in[5][(size_t)l * 9216 + gc];
      }
      __syncthreads();
    }
  }
  {
    float* TRET = (float*)(a->ws + WS_TRET); float* TROW = (float*)(a->ws + WS_TROW); float* TCOL = (float*)(a->ws + WS_TCOL);
    const int gt = bid * 512 + tid, gn = nb * 512;
    for (int e = gt; e < 16384 * 16; e += gn) { const int p = e >> 4, i = e & 15; float s, c; sincos_acc((float)p * INV16[i], s, c); TRET[2 * e] = c; TRET[2 * e + 1] = s; }
    for (int e = gt; e < 256 * 8; e += gn) { const int p = e >> 3, i = e & 7; float s, c; sincos_acc((float)p * INV16[2 * i], s, c); TROW[2 * e] = c; TROW[2 * e + 1] = s; }
    for (int e = gt; e < 64 * 8; e += gn) { const int p = e >> 3, i = e & 7; float s, c; sincos_acc((float)p * INV16[2 * i], s, c); TCOL[2 * e] = c; TCOL[2 * e + 1] = s; }
    if (bid == 0 && tid < 4) {
      const int l = tid; float* S = (float*)(a->ws + WS_SCAL) + l * 64;
      const float* lv = a->in[12] + l * 128; float d01 = 0.f, d23 = 0.f;
      for (int i = 0; i < 32; ++i) { d01 += lv[i] * lv[32 + i]; d23 += lv[64 + i] * lv[96 + i]; }
      const float lam_init = 0.8f - 0.6f * expf(-0.3f * (float)l);
      S[0] = expf(d01) - expf(d23) + lam_init; S[1] = lam_init;
      for (int i = 0; i < 12; ++i) { const float x = a->in[11][l * 12 + i]; S[4 + i] = -log1pf(expf(-x)); }
      for (int i = 0; i < 12; ++i) ((unsigned*)S)[16 + i] = 0u;
    }
  }
}
DI void norm_phase(int WV, KArgs a, int l, int which, bool first) {
  const int tid = ltid(), lane = tid & 63, wave = tid >> 6;
  const float* g = a->in[6] + (size_t)(l * 3 + which) * 1024;
  const float* mod = (const float*)(a->ws + WS_MOD) + (size_t)l * 9216;
  const float* modc = (const float*)(a->ws + WS_MOD) + (size_t)(4 + l) * 9216;
  float* X = (float*)(a->ws + WS_X); bf16_t* H = (bf16_t*)(a->ws + WS_H);
  const int stride = lnb() * 8;
  for (int r = lbid() * 8 + wave; r < MT_; r += 2 * stride) {
    const int r2 = r + stride; const bool has2 = r2 < MT_; const int rb = has2 ? r2 : r;
    const float* srcA = first ? (r < L_ ? a->in[0] + (size_t)r * 1024 : a->in[2] + (size_t)(r - L_) * 1024) : X + (size_t)r * 1024;
    const float* srcB = first ? (rb < L_ ? a->in[0] + (size_t)rb * 1024 : a->in[2] + (size_t)(rb - L_) * 1024) : X + (size_t)rb * 1024;
    f32x4 va[4], vb[4]; float sa = 0.f, sb = 0.f;
#pragma unroll
    for (int i = 0; i < 4; ++i) { va[i] = *(const f32x4*)(srcA + i * 256 + lane * 4); vb[i] = *(const f32x4*)(srcB + i * 256 + lane * 4); }
#pragma unroll
    for (int i = 0; i < 4; ++i) { sa += va[i][0] * va[i][0] + va[i][1] * va[i][1] + va[i][2] * va[i][2] + va[i][3] * va[i][3]; sb += vb[i][0] * vb[i][0] + vb[i][1] * vb[i][1] + vb[i][2] * vb[i][2] + vb[i][3] * vb[i][3]; }
    sa = wave_sum(sa); sb = wave_sum(sb);
    const float rsa = rsqrtf(sa * (1.0f / 1024.0f) + EPS_), rsb = rsqrtf(sb * (1.0f / 1024.0f) + EPS_);
#pragma unroll
    for (int q = 0; q < 2; ++q) {
      if (q == 1 && !has2) break;
      const int rr = q ? r2 : r; const float rstd = q ? rsb : rsa;
      const float* mm = (rr < L_) ? mod : modc;
#pragma unroll
      for (int i = 0; i < 4; ++i) {
        const int c = i * 256 + lane * 4;
        const f32x4 v = q ? vb[i] : va[i];
        const f32x4 gg = *(const f32x4*)(g + c), sh = *(const f32x4*)(mm + (which * 3) * 1024 + c), sc = *(const f32x4*)(mm + (which * 3 + 1) * 1024 + c);
        f32x4 y;
#pragma unroll
        for (int j = 0; j < 4; ++j) y[j] = v[j] * rstd * gg[j] * (1.0f + sc[j]) + sh[j];
        u32x2 w; w.x = cvt_pk_bf16(y[0], y[1]); w.y = cvt_pk_bf16(y[2], y[3]);
        *(u32x2*)(H + (size_t)rr * 1024 + c) = w;
        if (first) *(f32x4*)(X + (size_t)rr * 1024 + c) = v;
      }
    }
  }
}
DI void final_norm(int WV, KArgs a) {
  const int tid = ltid(), lane = tid & 63, wave = tid >> 6;
  const float* g = a->in[18]; const float* X = (const float*)(a->ws + WS_X);
  for (int r = lbid() * 8 + wave; r < L_; r += lnb() * 8) {
    f32x4 v[4]; float ss = 0.f;
#pragma unroll
    for (int i = 0; i < 4; ++i) { v[i] = *(const f32x4*)(X + (size_t)r * 1024 + i * 256 + lane * 4); ss += v[i][0] * v[i][0] + v[i][1] * v[i][1] + v[i][2] * v[i][2] + v[i][3] * v[i][3]; }
    ss = wave_sum(ss);
    const float rstd = rsqrtf(ss * (1.0f / 1024.0f) + EPS_);
#pragma unroll
    for (int i = 0; i < 4; ++i) { const int c = i * 256 + lane * 4; const f32x4 gg = *(const f32x4*)(g + c); f32x4 y; for (int j = 0; j < 4; ++j) y[j] = v[i][j] * rstd * gg[j]; *(f32x4*)(a->out + (size_t)r * 1024 + c) = y; }
  }
}

using pg8::Unit; using pg8::HALF; using pg8::BM;
struct EpiSwiglu {
  static constexpr bool PERM = false, AFTER_DRAIN = false;
  bf16_t* U;
  DI void operator()(const f32x4 (&acc)[2][2][4][2], const Unit& u, int wr, int wc, int fr_, int fq_) const {
    const int ln_ = lane_id_v(), fr = ln_ & 15, fq = ln_ >> 4;
#pragma unroll
    for (int ai = 0; ai < 2; ++ai)
#pragma unroll
      for (int m = 0; m < 4; ++m) {
        const int r = u.pm * BM + ai * HALF + wr * 64 + m * 16 + fr;
#pragma unroll
        for (int bj = 0; bj < 2; ++bj) {
          const int gi = u.pn * 8 + bj * 4 + wc;
          const f32x4 x = acc[ai][bj][m][0], y = acc[ai][bj][m][1];
          u32x2 w; w.x = cvt_pk_bf16(silu_f(x[0]) * y[0], silu_f(x[1]) * y[1]); w.y = cvt_pk_bf16(silu_f(x[2]) * y[2], silu_f(x[3]) * y[3]);
          *(u32x2*)(U + (size_t)r * DFF_ + gi * 16 + fq * 4) = w;
        }
        __builtin_amdgcn_sched_barrier(0);
      }
  }
};
struct EpiResid {
  static constexpr bool PERM = false, AFTER_DRAIN = false;
  float* X; const float* gate; float scale;
  DI void operator()(const f32x4 (&acc)[2][2][4][2], const Unit& u, int wr, int wc, int fr_, int fq_) const {
    const int ln_ = lane_id_v(), fr = ln_ & 15, fq = ln_ >> 4;
#pragma unroll
    for (int bj = 0; bj < 2; ++bj)
#pragma unroll
      for (int n = 0; n < 2; ++n) {
        const int c = u.pn * BM + bj * HALF + wc * 32 + n * 16 + fq * 4;
        const f32x4 gv = *(const f32x4*)(gate + c) * scale;
#pragma unroll
        for (int ai = 0; ai < 2; ++ai)
#pragma unroll
          for (int m = 0; m < 4; ++m) {
            const int r = u.pm * BM + ai * HALF + wr * 64 + m * 16 + fr;
            float* p = X + (size_t)r * 1024 + c;
            *(f32x4*)p = *(const f32x4*)p + gv * acc[ai][bj][m][n];
          }
      }
  }
};
template <int STEP> struct EpiMerge {
  static constexpr bool PERM = false, AFTER_DRAIN = false;
  bf16_t* MX; const bf16_t* G; bf16_t* Hout;
  DI void operator()(const f32x4 (&acc)[2][2][4][2], const Unit& u, int wr, int wc, int fr_, int fq_) const {
    const int ln_ = lane_id_v(), fr = ln_ & 15, fq = ln_ >> 4;
#pragma unroll
    for (int ai = 0; ai < 2; ++ai)
#pragma unroll
      for (int bj = 0; bj < 2; ++bj)
#pragma unroll
        for (int n = 0; n < 2; ++n) {
          const int c = u.pn * BM + bj * HALF + wc * 32 + n * 16 + fq * 4;
          const int r0 = u.pm * BM + ai * HALF + wr * 64 + fr;
          u32x2 gw[4], old[4];
#pragma unroll
          for (int m = 0; m < 4; ++m) {
            gw[m] = *(const u32x2*)(G + (size_t)(r0 + m * 16) * NGB_ + c);
            if (STEP > 0) old[m] = *(const u32x2*)(MX + (size_t)(r0 + m * 16) * 1024 + c);
          }
#pragma unroll
          for (int m = 0; m < 4; ++m) {
            f32x4 gv; gv[0] = sigmoid_f(bf2f(gw[m].x & 0xffffu)); gv[1] = sigmoid_f(bf2f(gw[m].x >> 16)); gv[2] = sigmoid_f(bf2f(gw[m].y & 0xffffu)); gv[3] = sigmoid_f(bf2f(gw[m].y >> 16));
            f32x4 v = gv * acc[ai][bj][m][n];
            if (STEP > 0) { v[0] += bf2f(old[m].x & 0xffffu); v[1] += bf2f(old[m].x >> 16); v[2] += bf2f(old[m].y & 0xffffu); v[3] += bf2f(old[m].y >> 16); }
            u32x2 w; w.x = cvt_pk_bf16(v[0], v[1]); w.y = cvt_pk_bf16(v[2], v[3]);
            if (STEP < 2) *(u32x2*)(MX + (size_t)(r0 + m * 16) * 1024 + c) = w;
            else *(u32x2*)(Hout + (size_t)(r0 + m * 16) * 1024 + c) = w;
          }
          __builtin_amdgcn_sched_barrier(0);
        }
  }
};
struct EpiWin {
  static constexpr bool PERM = false, AFTER_DRAIN = false;
  bf16_t* PB; bf16_t* GB; const float* TRET; const float* TROW; const float* TCOL; unsigned* kmax;
  DI void operator()(const f32x4 (&acc)[2][2][4][2], const Unit& u, int wr, int wc, int fr_, int fq_) const {
    const int ln_ = lane_id_v(), fr = ln_ & 15, fq = ln_ >> 4;
#pragma unroll
    for (int bj = 0; bj < 2; ++bj) {
      const int cb = u.pn * BM + bj * HALF + wc * 32;
      float kmx = 0.f;
#pragma unroll
      for (int ai = 0; ai < 2; ++ai)
#pragma unroll
        for (int m = 0; m < 4; ++m) {
          const int r = u.pm * BM + ai * HALF + wr * 64 + m * 16 + fr;
          f32x4 x0 = acc[ai][bj][m][0], x1 = acc[ai][bj][m][1];
          if (cb >= NPB_) {
            u32x2 w0, w1; w0.x = cvt_pk_bf16(x0[0], x0[1]); w0.y = cvt_pk_bf16(x0[2], x0[3]); w1.x = cvt_pk_bf16(x1[0], x1[1]); w1.y = cvt_pk_bf16(x1[2], x1[3]);
            bf16_t* p = GB + (size_t)r * NGB_ + (cb - NPB_) + fq * 4;
            *(u32x2*)p = w0; *(u32x2*)(p + 16) = w1;
            __builtin_amdgcn_sched_barrier(0);
            continue;
          }
          if (cb >= C_RQ && cb < C_RV) {
            if (r < L_) {
              const f32x4* tp = (const f32x4*)(TRET + ((size_t)r * 16 + fq * 4) * 2);
              const f32x4 t0 = tp[0], t1 = tp[1];
              const float cs[4] = {t0[0], t0[2], t1[0], t1[2]}, sn[4] = {t0[1], t0[3], t1[1], t1[3]};
#pragma unroll
              for (int j = 0; j < 4; ++j) { const float a_ = x0[j], b_ = x1[j]; x0[j] = a_ * cs[j] - b_ * sn[j]; x1[j] = a_ * sn[j] + b_ * cs[j]; }
            }
            if (cb >= C_RK) { x0 *= 0.17677669529663687f; x1 *= 0.17677669529663687f; }
          } else if (cb >= C_RG && cb < C_DQ) {
#pragma unroll
            for (int j = 0; j < 4; ++j) { x0[j] = silu_f(x0[j]); x1[j] = silu_f(x1[j]); }
          } else if (cb >= C_DQ && cb < C_DV) {
            if (r < L_) {
              const float* tb = (fq < 2) ? (TROW + ((size_t)(r >> 6) * 8 + fq * 4) * 2) : (TCOL + ((size_t)(r & 63) * 8 + (fq - 2) * 4) * 2);
              const f32x4 t0 = ((const f32x4*)tb)[0], t1 = ((const f32x4*)tb)[1];
              const float cs[4] = {t0[0], t0[2], t1[0], t1[2]}, sn[4] = {t0[1], t0[3], t1[1], t1[3]};
#pragma unroll
              for (int j = 0; j < 4; ++j) { const float a_ = x0[j], b_ = x1[j]; x0[j] = a_ * cs[j] - b_ * sn[j]; x1[j] = a_ * sn[j] + b_ * cs[j]; }
            }
            if (cb < C_DK) { x0 *= 0.25503486f; x1 *= 0.25503486f; }
            else { float ss = 0.f;
#pragma unroll
              for (int j = 0; j < 4; ++j) ss += x0[j] * x0[j] + x1[j] * x1[j];
              ss += shx(ss, 16, lane_id_v()); ss += shx(ss, 32, lane_id_v()); kmx = fmaxf(kmx, ss); }
          }
          u32x2 w0, w1; w0.x = cvt_pk_bf16(x0[0], x0[1]); w0.y = cvt_pk_bf16(x0[2], x0[3]); w1.x = cvt_pk_bf16(x1[0], x1[1]); w1.y = cvt_pk_bf16(x1[2], x1[3]);
          bf16_t* p = PB + (size_t)r * NPB_ + cb + fq * 4;
          *(u32x2*)p = w0; *(u32x2*)(p + 16) = w1;
          __builtin_amdgcn_sched_barrier(0);
        }
      if (cb >= C_DK && cb < C_DV) {
#pragma unroll
        for (int o = 1; o < 16; o <<= 1) kmx = fmaxf(kmx, shx(kmx, o, lane_id_v()));
        if (lane_id_v() == 0) atomicMax(kmax + ((cb - C_DK) >> 5), __float_as_uint(kmx));
      }
    }
  }
};
template <class F> DI void ctx_gemm32(int WV, const bf16_t* A, int lda, const bf16_t* Bt, int K, int N, unsigned char* smem, F epi) {
  const int tid = ltid(), lane = tid & 63, wave = tid >> 6, r31 = lane & 31, h = lane >> 5;
  float* red = (float*)smem;
  const int ntn = N / 32, ntiles = 8 * ntn, kper = K / 8;
  for (int tile = lbid(); tile < ntiles; tile += lnb()) {
    const int tm = tile / ntn, tn = tile % ntn;
    f32x16 acc; for (int i = 0; i < 16; ++i) acc[i] = 0.f;
    const bf16_t* ap = A + (size_t)(tm * 32 + r31) * lda + wave * kper + 8 * h;
    const bf16_t* bp = Bt + (size_t)(tn * 32 + r31) * K + wave * kper + 8 * h;
    const int nsteps = kper >> 4;
    bf16x8 a0[8], b0[8], a1[8], b1[8];
#define CG_LOAD(A_, B_, S_) do { _Pragma("unroll") for (int q = 0; q < 8; ++q) { const int st_ = ((S_) + q < nsteps) ? (S_) + q : nsteps - 1; A_[q] = *(const bf16x8*)(ap + st_ * 16); B_[q] = *(const bf16x8*)(bp + st_ * 16); } } while (0)
#define CG_COMP(A_, B_, S_) do { _Pragma("unroll") for (int q = 0; q < 8; ++q) { const bf16x8 z_ = {0, 0, 0, 0, 0, 0, 0, 0}; acc = MFMA32(((S_) + q < nsteps) ? A_[q] : z_, B_[q], acc); } } while (0)
    CG_LOAD(a0, b0, 0);
    for (int s = 0; s < nsteps; s += 16) { CG_LOAD(a1, b1, s + 8); CG_COMP(a0, b0, s); CG_LOAD(a0, b0, s + 16); CG_COMP(a1, b1, s + 8); }
#undef CG_LOAD
#undef CG_COMP
#pragma unroll
    for (int i = 0; i < 16; ++i) red[(wave * 16 + i) * 64 + lane] = acc[i];
    __syncthreads();
#pragma unroll
    for (int q = 0; q < 2; ++q) {
      const int o = tid + q * 512, i = o >> 6, ln = o & 63; float s = 0.f;
#pragma unroll
      for (int w = 0; w < 8; ++w) s += red[(w * 16 + i) * 64 + ln];
      epi(tm * 32 + crow(i, ln >> 5), tn * 32 + (ln & 31), s);
    }
    __syncthreads();
  }
}

constexpr int FR_LD = 136;
DI void fourier_tables(int WV, unsigned char* smem) {
  bf16_t* Cw = (bf16_t*)smem; bf16_t* Sw = Cw + 128 * FR_LD;
  for (int e = ltid(); e < 128 * 128; e += 512) { const int a_ = e >> 7, b_ = e & 127; const float x = (float)((a_ * b_) & 127) * (1.0f / 64.0f); Cw[a_ * FR_LD + b_] = f2bf(cospif(x)); Sw[a_ * FR_LD + b_] = f2bf(sinpif(x)); }
}
DI void fourier_load(int WV, const bf16_t* src, size_t rs, size_t po, unsigned char* smem) {
  bf16_t* dA = (bf16_t*)smem + 2 * 128 * FR_LD;
#pragma unroll
  for (int i = 0; i < 4; ++i) {
    const int id = ltid() + 512 * i, seg = id & 7, part = (id >> 3) & 1, row = id >> 4;
    const bf16x8 v = *(const bf16x8*)(src + (size_t)row * rs + (size_t)part * po + seg * 8);
    bf16_t* d = dA + part * 64 * FR_LD + (seg * 8) * FR_LD + (row ^ (seg << 3));
#pragma unroll
    for (int e = 0; e < 8; ++e) d[e * FR_LD] = (bf16_t)v[e];
  }
}
DI void fourier_stage1(int WV, KArgs a, unsigned char* smem) {
  const int tid = ltid(), lane = tid & 63, wave = tid >> 6, r31 = lane & 31, h = lane >> 5, rb = wave & 3, cbk = wave >> 2;
  const bf16_t* PB = (const bf16_t*)(a->ws + WS_PB); bf16_t* V = (bf16_t*)(a->ws + WS_V);
  const bf16_t* Cw = (const bf16_t*)smem; const bf16_t* Sw = Cw + 128 * FR_LD; const bf16_t* dA = Sw + 128 * FR_LD; const bf16_t* dB = dA + 64 * FR_LD;
  for (int it = lbid(); it < 512; it += lnb()) {
    const int t2 = it >> 2, c0 = (it & 3) * 64;
    __syncthreads();
    fourier_load(WV, PB + (size_t)t2 * NPB_ + C_FA + c0, (size_t)128 * NPB_, (size_t)(C_FB - C_FA), smem);
    __syncthreads();
    f32x16 R, nI; for (int i = 0; i < 16; ++i) { R[i] = 0.f; nI[i] = 0.f; }
#pragma unroll
    for (int s = 0; s < 8; ++s) {
      const bf16x8 cw = *(const bf16x8*)(Cw + (32 * rb + r31) * FR_LD + 16 * s + 8 * h), sw = *(const bf16x8*)(Sw + (32 * rb + r31) * FR_LD + 16 * s + 8 * h);
      const int so_ = (16 * s + 8 * h) ^ (((4 * cbk + (r31 >> 3)) & 7) << 3);
      const bf16x8 af = *(const bf16x8*)(dA + (32 * cbk + r31) * FR_LD + so_), bfv = *(const bf16x8*)(dB + (32 * cbk + r31) * FR_LD + so_);
      bf16x8 nb; for (int e = 0; e < 8; ++e) nb[e] = (short)(bfv[e] ^ (short)0x8000);
      R = MFMA32(cw, af, R); R = MFMA32(sw, nb, R); nI = MFMA32(sw, af, nI); nI = MFMA32(cw, bfv, nI);
    }
    const int col = c0 + 32 * cbk + r31;
#pragma unroll
    for (int i = 0; i < 16; ++i) {
      const int k1 = 32 * rb + crow(i, h);
      const float x = (float)(k1 * t2) * (1.0f / 8192.0f); const float ct = cospif(x), st = sinpif(x);
      const float vre = R[i] * ct - nI[i] * st, vim = -nI[i] * ct - R[i] * st;
      bf16_t* vp = V + ((size_t)(k1 * 128 + t2) * 2) * 256 + col;
      vp[0] = f2bf(vre); vp[256] = f2bf(vim);
    }
  }
}
DI void fourier_stage2(int WV, KArgs a, unsigned char* smem) {
  const int tid = ltid(), lane = tid & 63, wave = tid >> 6, r31 = lane & 31, h = lane >> 5, rb = wave & 3, cbk = wave >> 2;
  const bf16_t* V = (const bf16_t*)(a->ws + WS_V); bf16_t* BR = (bf16_t*)(a->ws + WS_BR);
  const bf16_t* Cw = (const bf16_t*)smem; const bf16_t* Sw = Cw + 128 * FR_LD; const bf16_t* dA = Sw + 128 * FR_LD; const bf16_t* dB = dA + 64 * FR_LD;
  for (int it = lbid(); it < 512; it += lnb()) {
    const int k1 = it >> 2, c0 = (it & 3) * 64;
    __syncthreads();
    fourier_load(WV, V + (size_t)k1 * 128 * 512 + c0, (size_t)512, (size_t)256, smem);
    __syncthreads();
    f32x16 Y; for (int i = 0; i < 16; ++i) Y[i] = 0.f;
#pragma unroll
    for (int s = 0; s < 8; ++s) {
      const bf16x8 cw = *(const bf16x8*)(Cw + (32 * rb + r31) * FR_LD + 16 * s + 8 * h), sw = *(const bf16x8*)(Sw + (32 * rb + r31) * FR_LD + 16 * s + 8 * h);
      const int so_ = (16 * s + 8 * h) ^ (((4 * cbk + (r31 >> 3)) & 7) << 3);
      const bf16x8 vr = *(const bf16x8*)(dA + (32 * cbk + r31) * FR_LD + so_), vi = *(const bf16x8*)(dB + (32 * cbk + r31) * FR_LD + so_);
      Y = MFMA32(cw, vr, Y); Y = MFMA32(sw, vi, Y);
    }
    const int col = c0 + 32 * cbk + r31;
#pragma unroll
    for (int i = 0; i < 16; ++i) { const int k2 = 32 * rb + crow(i, h); BR[(size_t)(k1 + 128 * k2) * 1024 + col] = f2bf(Y[i] * (1.0f / 1024.0f)); }
  }
}
DI void fourier_ctx(int WV, KArgs a, unsigned char* smem) {
  const int tid = ltid();
  const bf16_t* PB = (const bf16_t*)(a->ws + WS_PB) + (size_t)L_ * NPB_; bf16_t* BR = (bf16_t*)(a->ws + WS_BR) + (size_t)L_ * 1024;
  float* ct = (float*)smem; float* st = ct + 256; float* red = st + 256;
  __syncthreads();
  if (tid < 256) { const float x = (float)tid * (1.0f / 128.0f); ct[tid] = cospif(x); st[tid] = sinpif(x); }
  __syncthreads();
  const int tg = tid >> 5, c8 = (tid & 31) * 8;
  for (int k = lbid(); k < 256; k += lnb()) {
    bf16x8 av[16], bv[16];
#pragma unroll
    for (int j = 0; j < 16; ++j) { const int t = tg + 16 * j; av[j] = *(const bf16x8*)(PB + (size_t)t * NPB_ + C_FA + c8); bv[j] = *(const bf16x8*)(PB + (size_t)t * NPB_ + C_FB + c8); }
    float acc[8];
#pragma unroll
    for (int e = 0; e < 8; ++e) acc[e] = 0.f;
#pragma unroll
    for (int j = 0; j < 16; ++j) {
      const int idx = (k * (tg + 16 * j)) & 255; const float c_ = ct[idx], s_ = st[idx];
#pragma unroll
      for (int e = 0; e < 8; ++e) acc[e] += c_ * bf2f((unsigned)(unsigned short)av[j][e]) - s_ * bf2f((unsigned)(unsigned short)bv[j][e]);
    }
#pragma unroll
    for (int e = 0; e < 8; ++e) red[tg * 256 + c8 + e] = acc[e];
    __syncthreads();
    if (tid < 256) { float s = 0.f;
#pragma unroll
      for (int q = 0; q < 16; ++q) s += red[q * 256 + tid];
      BR[(size_t)k * 1024 + tid] = f2bf(s * (1.0f / 128.0f)); }
    __syncthreads();
  }
}
DI int chunk_row0(int ci) { return ci < 128 ? ci * 128 : L_ + (ci - 128) * 128; }
constexpr int RS_KLD = 48, RS_VLD = 96;
DI void ret_states(int WV, KArgs a, int l, unsigned char* smem) {
  const int tid = ltid(), lane = tid & 63, wave = tid >> 6, h = lane >> 5;
  const bf16_t* PB = (const bf16_t*)(a->ws + WS_PB); float* T = (float*)(a->ws + WS_T);
  const float* S = (const float*)(a->ws + WS_SCAL) + l * 64;
  bf16_t* kwf = (bf16_t*)smem; bf16_t* kwb = kwf + 128 * RS_KLD; bf16_t* vs = kwb + 128 * RS_KLD;
  for (int it = lbid(); it < 130 * 6; it += lnb()) {
    const int ci = it / 6, hh = it % 6, r0 = chunk_row0(ci);
    __syncthreads();
    { const int row = tid >> 2, seg = tid & 3;
      const bf16x8 kv = *(const bf16x8*)(PB + (size_t)(r0 + row) * NPB_ + C_RK + hh * 32 + seg * 8);
      const float wf = expf(S[4 + hh] * (float)(127 - row)), wb = expf(S[10 + hh] * (float)row);
      u32x4 pf, pb;
#pragma unroll
      for (int e = 0; e < 4; ++e) { const float x0 = bf2f((unsigned)(unsigned short)kv[2 * e]), x1 = bf2f((unsigned)(unsigned short)kv[2 * e + 1]);
        pf[e] = cvt_pk_bf16(x0 * wf, x1 * wf); pb[e] = cvt_pk_bf16(x0 * wb, x1 * wb); }
      *(u32x4*)(kwf + row * RS_KLD + seg * 8) = pf; *(u32x4*)(kwb + row * RS_KLD + seg * 8) = pb; }
#pragma unroll
    for (int q = 0; q < 2; ++q) { const int id = tid + 512 * q, row = id >> 3, seg = id & 7;
      *(bf16x8*)(vs + row * RS_VLD + seg * 8) = *(const bf16x8*)(PB + (size_t)(r0 + row) * NPB_ + C_RV + hh * 64 + seg * 8); }
    __syncthreads();
    if (wave < 4) {
      const int dir = wave >> 1, nt = wave & 1;
      const bf16_t* kw = dir ? kwb : kwf;
      const int q4 = (lane & 15) >> 2, cg = 16 * ((lane >> 4) & 1) + 4 * (lane & 3);
      f32x16 acc; for (int i = 0; i < 16; ++i) acc[i] = 0.f;
#pragma unroll
      for (int s = 0; s < 8; ++s) {
        const bf16_t* ka = kw + (16 * s + 8 * h + q4) * RS_KLD + cg;
        const bf16_t* vb = vs + (16 * s + 8 * h + q4) * RS_VLD + 32 * nt + cg;
        const s16x4 alo = __builtin_amdgcn_ds_read_tr16_b64_v4i16((LAS s16x4*)ka), ahi = __builtin_amdgcn_ds_read_tr16_b64_v4i16((LAS s16x4*)(ka + 4 * RS_KLD));
        const s16x4 blo = __builtin_amdgcn_ds_read_tr16_b64_v4i16((LAS s16x4*)vb), bhi = __builtin_amdgcn_ds_read_tr16_b64_v4i16((LAS s16x4*)(vb + 4 * RS_VLD));
        acc = MFMA32(__builtin_shufflevector(alo, ahi, 0, 1, 2, 3, 4, 5, 6, 7), __builtin_shufflevector(blo, bhi, 0, 1, 2, 3, 4, 5, 6, 7), acc);
      }
      float* tp = T + ((size_t)(ci * 6 + hh) * 2 + dir) * 2048 + 32 * nt + (lane & 31);
#pragma unroll
      for (int i = 0; i < 16; ++i) tp[crow(i, h) * 64] = acc[i];
    }
  }
}
DI void ret_scan(int WV, KArgs a, int l) {
  const int gt = lbid() * 512 + ltid();
  if (gt >= 6 * 2 * 2048) return;
  const int idx = gt & 2047, dir = (gt >> 11) & 1, hh = gt >> 12;
  const float* T = (const float*)(a->ws + WS_T); float* S = (float*)(a->ws + WS_S);
  const float* SC = (const float*)(a->ws + WS_SCAL) + l * 64;
  const float dec = expf(SC[4 + dir * 6 + hh] * 128.0f);
  const size_t base = (size_t)(hh * 2 + dir) * 2048 + idx; const size_t cs = (size_t)6 * 2 * 2048;
  const float tc0 = T[base + 128 * cs], tc1 = T[base + 129 * cs];
  float tv[128];
#pragma unroll
  for (int i = 0; i < 128; ++i) tv[i] = T[base + (size_t)i * cs];
  if (dir == 0) {
    float s = tc0 * dec + tc1; S[base + 128 * cs] = 0.f; S[base + 129 * cs] = tc0;
#pragma unroll
    for (int i = 0; i < 128; ++i) { S[base + (size_t)i * cs] = s; s = s * dec + tv[i]; }
  } else {
    float s = tc0 + dec * tc1; S[base + 129 * cs] = 0.f; S[base + 128 * cs] = tc1;
#pragma unroll
    for (int i = 127; i >= 0; --i) { S[base + (size_t)i * cs] = s; s = s * dec + tv[i]; }
  }
}
DI void ret_out(int WV, KArgs a, int l, unsigned char* smem) {
  const int tid = ltid(), lane = tid & 63, wave = tid >> 6, r31 = lane & 31, h = lane >> 5, jb = wave & 3, vh = wave >> 2;
  const bf16_t* PB = (const bf16_t*)(a->ws + WS_PB); bf16_t* BR = (bf16_t*)(a->ws + WS_BR); const float* Sg = (const float*)(a->ws + WS_S);
  const float* SC = (const float*)(a->ws + WS_SCAL) + l * 64;
  bf16_t* Kl = (bf16_t*)smem;
  bf16_t* Vt = Kl + 128 * 40;
  bf16_t* SfT = Vt + 64 * 136;
  bf16_t* SbT = SfT + 64 * 40;
  float* pwf = (float*)(SbT + 64 * 40);
  float* pwb = pwf + 128;
  float* ssq = pwb + 128;
  const int nit_ = (l < DEPTH_ - 1) ? 130 * 6 : 128 * 6;
  for (int it = lbid(); it < nit_; it += lnb()) {
    const int ci = it / 6, hh = it % 6, r0 = chunk_row0(ci);
    const float lgf = SC[4 + hh], lgb = SC[10 + hh];
    __syncthreads();
    { const int row = tid >> 2, seg = tid & 3; *(bf16x8*)(Kl + row * 40 + seg * 8) = *(const bf16x8*)(PB + (size_t)(r0 + row) * NPB_ + C_RK + hh * 32 + seg * 8); }
#pragma unroll
    for (int q = 0; q < 2; ++q) { const int id = tid + 512 * q, row = id >> 3, seg = id & 7; const bf16x8 v = *(const bf16x8*)(PB + (size_t)(r0 + row) * NPB_ + C_RV + hh * 64 + seg * 8);
#pragma unroll
      for (int e = 0; e < 8; ++e) Vt[(seg * 8 + e) * 136 + (row ^ (seg << 3))] = (bf16_t)v[e]; }
#pragma unroll
    for (int q = 0; q < 8; ++q) { const int e = tid + 512 * q, dir = e >> 11, idx = e & 2047, d = idx >> 6, v = idx & 63;
      const float sv = Sg[((size_t)(ci * 6 + hh) * 2 + dir) * 2048 + idx]; (dir ? SbT : SfT)[v * 40 + d] = f2bf(sv); }
    if (tid < 128) { pwf[tid] = expf(lgf * (float)tid); pwb[tid] = expf(lgb * (float)tid); }
    const int qrow = r0 + 32 * jb + r31, j = 32 * jb + r31;
    bf16x8 qf[2];
#pragma unroll
    for (int s = 0; s < 2; ++s) qf[s] = *(const bf16x8*)(PB + (size_t)qrow * NPB_ + C_RQ + hh * 32 + 16 * s + 8 * h);
    __syncthreads();
    f32x16 O; for (int i = 0; i < 16; ++i) O[i] = 0.f;
#pragma unroll
    for (int kb = 0; kb < 4; ++kb) {
      f32x16 St; for (int i = 0; i < 16; ++i) St[i] = 0.f;
#pragma unroll
      for (int s = 0; s < 2; ++s) { const bf16x8 kf = *(const bf16x8*)(Kl + (32 * kb + r31) * 40 + 16 * s + 8 * h); St = MFMA32(kf, qf[s], St); }
#pragma unroll
      for (int i = 0; i < 16; ++i) { const int jp = 32 * kb + crow(i, h); const int dl = j - jp; const float dv = dl > 0 ? pwf[dl] : (dl < 0 ? pwb[-dl] : 2.0f); St[i] *= dv; }
#pragma unroll
      for (int s = 0; s < 2; ++s) {
        const bf16x8 pb = pack_step(St, s);
        const bf16_t* vrow = Vt + (32 * vh + r31) * 136; const int px_ = ((4 * vh + (r31 >> 3)) & 7) << 3, p0_ = 32 * kb + 16 * s + 4 * h;
        const s16x4 lo = *(const s16x4*)(vrow + (p0_ ^ px_)), hi = *(const s16x4*)(vrow + ((p0_ + 8) ^ px_));
        const bf16x8 vf = __builtin_shufflevector(lo, hi, 0, 1, 2, 3, 4, 5, 6, 7);
        O = MFMA32(vf, pb, O);
      }
    }
    f32x16 Of, Ob; for (int i = 0; i < 16; ++i) { Of[i] = 0.f; Ob[i] = 0.f; }
#pragma unroll
    for (int s = 0; s < 2; ++s) {
      const bf16x8 sf = *(const bf16x8*)(SfT + (32 * vh + r31) * 40 + 16 * s + 8 * h), sb = *(const bf16x8*)(SbT + (32 * vh + r31) * 40 + 16 * s + 8 * h);
      Of = MFMA32(sf, qf[s], Of); Ob = MFMA32(sb, qf[s], Ob);
    }
    const float qdf = expf(lgf * (float)(j + 1)), qdb = expf(lgb * (float)(128 - j));
    float ss = 0.f;
#pragma unroll
    for (int i = 0; i < 16; ++i) { O[i] = O[i] + Of[i] * qdf + Ob[i] * qdb; ss += O[i] * O[i]; }
    ss += shx(ss, 32, lane_id_v());
    if (h == 0) ssq[vh * 128 + j] = ss;
    __syncthreads();
    const float rstd = rsqrtf((ssq[j] + ssq[128 + j]) * (1.0f / 64.0f) + EPS_);
#pragma unroll
    for (int g4 = 0; g4 < 4; ++g4) {
      const int v0 = 32 * vh + 8 * g4 + 4 * h;
      const u32x2 gw = *(const u32x2*)(PB + (size_t)qrow * NPB_ + C_RG + hh * 64 + v0);
      const float g0 = bf2f(gw.x & 0xffffu), g1 = bf2f(gw.x >> 16), g2 = bf2f(gw.y & 0xffffu), g3 = bf2f(gw.y >> 16);
      u32x2 w; w.x = cvt_pk_bf16(O[4 * g4] * rstd * g0, O[4 * g4 + 1] * rstd * g1); w.y = cvt_pk_bf16(O[4 * g4 + 2] * rstd * g2, O[4 * g4 + 3] * rstd * g3);
      *(u32x2*)(BR + (size_t)qrow * 1024 + 256 + hh * 64 + v0) = w;
    }
  }
}
constexpr int AT_LD = 72, VS_LD = 96;
typedef __bf16 bf16x2_t __attribute__((ext_vector_type(2)));
typedef float f32x2_t __attribute__((ext_vector_type(2)));
DI unsigned cvt2(float a, float b) { f32x2_t v = {a, b}; return __builtin_bit_cast(unsigned, __builtin_convertvector(v, bf16x2_t)); }
template <int VAR> DI void attn_phase(int WV, KArgs a, int l, bool with_ctx, unsigned char* smem) {
  const int tid = ltid(), lane = tid & 63, wave = tid >> 6, r31 = lane & 31, h = lane >> 5, qsub = wave & 3, kh = wave >> 2;
  const bf16_t* PB = (const bf16_t*)(a->ws + WS_PB); bf16_t* BR = (bf16_t*)(a->ws + (VAR == 0 ? WS_BR : WS_H));
  const float* SC = (const float*)(a->ws + WS_SCAL) + l * 64;
  const float lam = SC[0], lam_init = SC[1];
  bf16_t* Ks = (bf16_t*)smem;
  bf16_t* Vt = Ks + 2 * 64 * AT_LD;
  float* cmb = (float*)(Vt + 2 * 64 * VS_LD);
  const int nitems = 6 * 128 + (with_ctx ? 12 : 0);
  const int skey = tid >> 3, sseg = tid & 7;
  for (int it = lbid(); it < (with_ctx ? 768 + lnb() : 768); it += lnb()) {
    int head, q0, krow0, nt;
    if (it >= 768) { const int e_ = lnb() - 1 - lbid(); if (e_ >= 12) continue; it = 768 + e_; }
    if (it < 768) { head = (it >> 8) * 2 + (it & 1); q0 = ((it & 255) >> 1) * 128; krow0 = 0; nt = MT_ / 64; }
    else { const int e = it - 768; head = e >> 1; q0 = L_ + (e & 1) * 128; krow0 = L_; nt = LC_ / 64; }
    const int qrow = q0 + 32 * qsub + r31;
    bf16x8 qf[2][2];
#pragma unroll
    for (int mp = 0; mp < 2; ++mp)
#pragma unroll
      for (int s = 0; s < 2; ++s) qf[mp][s] = *(const bf16x8*)(PB + (size_t)qrow * NPB_ + C_DQ + head * 64 + mp * 32 + 16 * s + 8 * h);
    float negm = 0.f;
#pragma unroll
    for (int mp = 0; mp < 2; ++mp) {
      float ss = 0.f;
#pragma unroll
      for (int s = 0; s < 2; ++s)
#pragma unroll
        for (int e = 0; e < 8; ++e) { const float x = bf2f((unsigned)(unsigned short)qf[mp][s][e]); ss += x * x; }
      ss += shx(ss, 32, lane_id_v());
      const float kmx = __uint_as_float(((const unsigned*)SC)[16 + head * 2 + mp]);
      negm = fminf(negm, -sqrtf(ss * kmx) * 1.01f);
    }
    f32x16 NM; for (int i = 0; i < 16; ++i) NM[i] = negm;
    f32x16 O1[2], O2[2]; for (int i = 0; i < 16; ++i) { O1[0][i] = 0.f; O1[1][i] = 0.f; O2[0][i] = 0.f; O2[1][i] = 0.f; }
    f32x4 LA = {0.f, 0.f, 0.f, 0.f}, LB = {0.f, 0.f, 0.f, 0.f};
    bf16x8 osel; { const bool on = ((lane & 15) == 0 && ((lane >> 4) & 1) == 0) || ((lane & 15) == 1 && ((lane >> 4) & 1) == 1);
      for (int e = 0; e < 8; ++e) osel[e] = on ? (short)0x3F80 : (short)0; }
#define MFMA16(a_, b_, c_) __builtin_amdgcn_mfma_f32_16x16x32_bf16((a_), (b_), (c_), 0, 0, 0)
    const bf16_t* kg = PB + (size_t)(krow0 + skey) * NPB_ + C_DK + head * 64 + sseg * 8;
    const bf16_t* vg = PB + (size_t)(krow0 + skey) * NPB_ + C_DV + head * 64 + sseg * 8;
    const int vslot = ((skey & ~12) | ((skey & 4) << 1) | ((skey & 8) >> 1)) ^ (sseg << 3);
    __syncthreads();
    bf16x8 kA = *(const bf16x8*)kg, vA = *(const bf16x8*)vg;
    bf16x8 kB = *(const bf16x8*)(kg + (size_t)64 * NPB_), vB = *(const bf16x8*)(vg + (size_t)64 * NPB_);
    { *(bf16x8*)(Ks + skey * AT_LD + sseg * 8) = kA; *(bf16x8*)(Vt + skey * VS_LD + sseg * 8) = vA; }
    __syncthreads();
    for (int t = 0; t < nt; ++t) {
      const int buf = t & 1;
      const bf16_t* ks = Ks + buf * 64 * AT_LD + (32 * kh + r31) * AT_LD + 8 * h;
      const bf16_t* vt = Vt + buf * 64 * VS_LD + (32 * kh + 4 * h + ((lane & 15) >> 2)) * VS_LD + 16 * ((lane >> 4) & 1) + 4 * (lane & 3);
      const bf16x8 k00 = *(const bf16x8*)(ks), k01 = *(const bf16x8*)(ks + 16), k10 = *(const bf16x8*)(ks + 32), k11 = *(const bf16x8*)(ks + 48);
      bf16x8 vf[2][2];
#pragma unroll
      for (int s = 0; s < 2; ++s)
#pragma unroll
        for (int mt = 0; mt < 2; ++mt) {
          const s16x4 lo = __builtin_amdgcn_ds_read_tr16_b64_v4i16((LAS s16x4*)(vt + (16 * s) * VS_LD + 32 * mt));
          const s16x4 hi = __builtin_amdgcn_ds_read_tr16_b64_v4i16((LAS s16x4*)(vt + (16 * s + 8) * VS_LD + 32 * mt));
          vf[mt][s] = __builtin_shufflevector(lo, hi, 0, 1, 2, 3, 4, 5, 6, 7); }
      f32x16 S1 = MFMA32(k00, qf[0][0], NM); f32x16 S2 = MFMA32(k10, qf[1][0], NM); S1 = MFMA32(k01, qf[0][1], S1); S2 = MFMA32(k11, qf[1][1], S2);
      bf16x8 p1[2], p2[2];
      { u32x4 w0, w1;
#pragma unroll
        for (int i = 0; i < 4; ++i) { w0[i] = cvt2(VAR == 1 ? S1[2 * i] * 0.001f : __builtin_amdgcn_exp2f(S1[2 * i]), VAR == 1 ? S1[2 * i + 1] * 0.001f : __builtin_amdgcn_exp2f(S1[2 * i + 1]));
                                       w1[i] = cvt2(VAR == 1 ? S1[8 + 2 * i] * 0.001f : __builtin_amdgcn_exp2f(S1[8 + 2 * i]), VAR == 1 ? S1[9 + 2 * i] * 0.001f : __builtin_amdgcn_exp2f(S1[9 + 2 * i])); }
        p1[0] = __builtin_bit_cast(bf16x8, w0); p1[1] = __builtin_bit_cast(bf16x8, w1); }
      O1[0] = MFMA32(vf[0][0], p1[0], O1[0]); O1[1] = MFMA32(vf[1][0], p1[0], O1[1]); LA = MFMA16(osel, p1[0], LA);
      O1[0] = MFMA32(vf[0][1], p1[1], O1[0]); O1[1] = MFMA32(vf[1][1], p1[1], O1[1]); LA = MFMA16(osel, p1[1], LA);
      { u32x4 w0, w1;
#pragma unroll
        for (int i = 0; i < 4; ++i) { w0[i] = cvt2(VAR == 1 ? S2[2 * i] * 0.001f : __builtin_amdgcn_exp2f(S2[2 * i]), VAR == 1 ? S2[2 * i + 1] * 0.001f : __builtin_amdgcn_exp2f(S2[2 * i + 1]));
                                       w1[i] = cvt2(VAR == 1 ? S2[8 + 2 * i] * 0.001f : __builtin_amdgcn_exp2f(S2[8 + 2 * i]), VAR == 1 ? S2[9 + 2 * i] * 0.001f : __builtin_amdgcn_exp2f(S2[9 + 2 * i])); }
        p2[0] = __builtin_bit_cast(bf16x8, w0); p2[1] = __builtin_bit_cast(bf16x8, w1); }
      if (VAR != 5) {
      O2[0] = MFMA32(vf[0][0], p2[0], O2[0]); O2[1] = MFMA32(vf[1][0], p2[0], O2[1]); LB = MFMA16(osel, p2[0], LB);
      O2[0] = MFMA32(vf[0][1], p2[1], O2[0]); O2[1] = MFMA32(vf[1][1], p2[1], O2[1]); LB = MFMA16(osel, p2[1], LB); }
      __builtin_amdgcn_iglp_opt(2);
      { const int nb_ = buf ^ 1;
        *(bf16x8*)(Ks + nb_ * 64 * AT_LD + skey * AT_LD + sseg * 8) = kB; *(bf16x8*)(Vt + nb_ * 64 * VS_LD + skey * VS_LD + sseg * 8) = vB;
        const int tl_ = (t + 2 < nt) ? t + 2 : nt - 1;
        kB = *(const bf16x8*)(kg + (size_t)tl_ * 64 * NPB_); vB = *(const bf16x8*)(vg + (size_t)tl_ * 64 * NPB_); }
      __syncthreads();
    }
    float* cw = cmb + (size_t)(qsub * 64 + lane) * 66;
    const int sl_ = ((lane & 15) << 2);
    const float a0_ = __int_as_float(__builtin_amdgcn_ds_bpermute(sl_, __float_as_int(LA[0]))), a1_ = __int_as_float(__builtin_amdgcn_ds_bpermute(sl_, __float_as_int(LA[1])));
    const float b0_ = __int_as_float(__builtin_amdgcn_ds_bpermute(sl_, __float_as_int(LB[0]))), b1_ = __int_as_float(__builtin_amdgcn_ds_bpermute(sl_, __float_as_int(LB[1])));
    const float lq1 = (r31 >> 4) ? a1_ : a0_, lq2 = (r31 >> 4) ? b1_ : b0_;
    if (kh == 1) {
#pragma unroll
      for (int i = 0; i < 16; ++i) { cw[i] = O1[0][i]; cw[16 + i] = O1[1][i]; cw[32 + i] = O2[0][i]; cw[48 + i] = O2[1][i]; }
      cw[64] = lq1; cw[65] = lq2;
    }
    __syncthreads();
    if (kh == 0) {
#pragma unroll
      for (int i = 0; i < 16; ++i) { O1[0][i] += cw[i]; O1[1][i] += cw[16 + i]; O2[0][i] += cw[32 + i]; O2[1][i] += cw[48 + i]; }
      const float l1 = lq1 + cw[64], l2 = lq2 + cw[65];
      const float i1 = 1.0f / l1, i2 = lam / l2;
      float ss = 0.f;
#pragma unroll
      for (int mt = 0; mt < 2; ++mt)
#pragma unroll
        for (int i = 0; i < 16; ++i) { const float o = O1[mt][i] * i1 - O2[mt][i] * i2; O1[mt][i] = o; ss += o * o; }
      ss += shx(ss, 32, lane_id_v());
      const float sc = rsqrtf(ss * (1.0f / 64.0f) + EPS_) * (1.0f - lam_init);
      const float* sw = a->in[13] + l * 64;
#pragma unroll
      for (int mt = 0; mt < 2; ++mt)
#pragma unroll
        for (int g4 = 0; g4 < 4; ++g4) {
          const int v0 = 32 * mt + 8 * g4 + 4 * h;
          const f32x4 wv = *(const f32x4*)(sw + v0);
          u32x2 w; w.x = cvt_pk_bf16(O1[mt][4 * g4] * sc * wv[0], O1[mt][4 * g4 + 1] * sc * wv[1]); w.y = cvt_pk_bf16(O1[mt][4 * g4 + 2] * sc * wv[2], O1[mt][4 * g4 + 3] * sc * wv[3]);
          *(u32x2*)(BR + (size_t)qrow * 1024 + 640 + head * 64 + v0) = w;
        }
    }
  }
}
template <class Epi> DI void run_gemm(int WV, LAS unsigned char* lds, const bf16_t* A, int lda, const bf16_t* Bt, int M, int N, int K, const Epi& E) {
  pg8::Gemm g; g.A = A; g.Bt = Bt; g.M = M; g.N = N; g.K = K; g.lda = lda;
  pg8::StaticOrder S; S.init(M, N, lnb(), lbid());
  pg8::gemm_phase<Epi, pg8::StaticOrder, false>(WV, lds, g, S, E, nullptr);
}
struct EpiNull { static constexpr bool PERM = false, AFTER_DRAIN = false; float* U;
  DI void operator()(const f32x4 (&acc)[2][2][4][2], const Unit& u, int wr, int wc, int fr_, int fq_) const {
    f32x4 s = {0.f, 0.f, 0.f, 0.f};
#pragma unroll
    for (int ai = 0; ai < 2; ++ai) for (int bj = 0; bj < 2; ++bj) for (int m = 0; m < 4; ++m) for (int n = 0; n < 2; ++n) s += acc[ai][bj][m][n];
    if (s[0] == 123.456f) U[lane_id_v()] = s[1] + s[2] + s[3]; } };
struct CtxMerge0 { float* MXC; const bf16_t* G; DI void operator()(int r, int c, float v) const { MXC[r * 1024 + c] = sigmoid_f(bf2f(G[(size_t)r * NGB_ + c])) * v; } };
struct CtxMerge1 { float* MXC; const bf16_t* G; DI void operator()(int r, int c, float v) const { MXC[r * 1024 + c] += sigmoid_f(bf2f(G[(size_t)r * NGB_ + c])) * v; } };
struct CtxMerge2 { const float* MXC; const bf16_t* G; bf16_t* Hc; DI void operator()(int r, int c, float v) const { Hc[r * 1024 + c] = f2bf(MXC[r * 1024 + c] + sigmoid_f(bf2f(G[(size_t)r * NGB_ + c])) * v); } };
struct CtxResid { float* Xc; const float* gate; float scale; DI void operator()(int r, int c, float v) const { Xc[r * 1024 + c] += scale * gate[c] * v; } };

DI void phase_win(int WV, int l, unsigned char* smem) {
  KArgs a = kargs(); unsigned char* ws = a->ws;
  EpiWin E; E.PB = (bf16_t*)(ws + WS_PB); E.GB = (bf16_t*)(ws + WS_GB); E.TRET = (const float*)(ws + WS_TRET); E.TROW = (const float*)(ws + WS_TROW); E.TCOL = (const float*)(ws + WS_TCOL);
  E.kmax = (unsigned*)(ws + WS_SCAL) + l * 64 + 16;
  run_gemm(WV, (LAS unsigned char*)smem, (const bf16_t*)(ws + WS_H), 1024, (const bf16_t*)(ws + WS_WIN) + (size_t)l * 5888 * 1024, MT_, NWIN_, 1024, E);
}
DI void phase_merge(int WV, int l, unsigned char* smem) {
  LAS unsigned char* lds = (LAS unsigned char*)smem;
  { KArgs a = kargs(); unsigned char* ws = a->ws; EpiMerge<0> E; E.MX = (bf16_t*)a->out; E.G = (const bf16_t*)(ws + WS_GB); E.Hout = (bf16_t*)(ws + WS_H);
    run_gemm(WV, lds, (const bf16_t*)(ws + WS_BR), 1024, (const bf16_t*)(ws + WS_WBF) + (size_t)l * 1024 * 256, L_, 1024, 256, E); }
  { KArgs a = kargs(); unsigned char* ws = a->ws; EpiMerge<1> E; E.MX = (bf16_t*)a->out; E.G = (const bf16_t*)(ws + WS_GB) + 1024; E.Hout = (bf16_t*)(ws + WS_H);
    run_gemm(WV, lds, (const bf16_t*)(ws + WS_BR) + 256, 1024, (const bf16_t*)(ws + WS_WBR) + (size_t)l * 1024 * 384, L_, 1024, 384, E); }
  { KArgs a = kargs(); unsigned char* ws = a->ws; EpiMerge<2> E; E.MX = (bf16_t*)a->out; E.G = (const bf16_t*)(ws + WS_GB) + 2048; E.Hout = (bf16_t*)(ws + WS_H);
    run_gemm(WV, lds, (const bf16_t*)(ws + WS_BR) + 640, 1024, (const bf16_t*)(ws + WS_WBD) + (size_t)l * 1024 * 384, L_, 1024, 384, E); }
  if (l < DEPTH_ - 1) { KArgs a = kargs(); unsigned char* ws = a->ws;
    const bf16_t* BRc = (const bf16_t*)(ws + WS_BR) + (size_t)L_ * 1024; const bf16_t* GBc = (const bf16_t*)(ws + WS_GB) + (size_t)L_ * NGB_;
    CtxMerge0 e0; e0.MXC = (float*)(ws + WS_MXC); e0.G = GBc;
    ctx_gemm32(WV, BRc, 1024, (const bf16_t*)(ws + WS_WBF) + (size_t)l * 1024 * 256, 256, 1024, smem, e0);
    CtxMerge1 e1; e1.MXC = (float*)(ws + WS_MXC); e1.G = GBc + 1024;
    ctx_gemm32(WV, BRc + 256, 1024, (const bf16_t*)(ws + WS_WBR) + (size_t)l * 1024 * 384, 384, 1024, smem, e1);
    CtxMerge2 e2; e2.MXC = (const float*)(ws + WS_MXC); e2.G = GBc + 2048; e2.Hc = (bf16_t*)(ws + WS_H) + (size_t)L_ * 1024;
    ctx_gemm32(WV, BRc + 640, 1024, (const bf16_t*)(ws + WS_WBD) + (size_t)l * 1024 * 384, 384, 1024, smem, e2); }
}
DI void phase_wo(int WV, int l, unsigned char* smem) {
  { KArgs a = kargs(); unsigned char* ws = a->ws; EpiResid E; E.X = (float*)(ws + WS_X); E.gate = (const float*)(ws + WS_MOD) + (size_t)l * 9216 + 5 * 1024; E.scale = 1.0f;
    run_gemm(WV, (LAS unsigned char*)smem, (const bf16_t*)(ws + WS_H), 1024, (const bf16_t*)(ws + WS_WO) + (size_t)l * 1024 * 1024, L_, 1024, 1024, E); }
  if (l < DEPTH_ - 1) { KArgs a = kargs(); unsigned char* ws = a->ws; CtxResid e; e.Xc = (float*)(ws + WS_X) + (size_t)L_ * 1024; e.gate = (const float*)(ws + WS_MOD) + (size_t)(4 + l) * 9216 + 5 * 1024; e.scale = 1.0f;
    ctx_gemm32(WV, (const bf16_t*)(ws + WS_H) + (size_t)L_ * 1024, 1024, (const bf16_t*)(ws + WS_WO) + (size_t)l * 1024 * 1024, 1024, 1024, smem, e); }
}
DI void phase_g1(int WV, int l, int f, unsigned char* smem) {
  KArgs a = kargs(); unsigned char* ws = a->ws; EpiSwiglu E; E.U = (bf16_t*)(ws + WS_U);
  run_gemm(WV, (LAS unsigned char*)smem, (const bf16_t*)(ws + WS_H), 1024, (const bf16_t*)(ws + WS_W13) + (size_t)(l * 2 + f) * 5632 * 1024, MT_, 5632, 1024, E);
}
DI void phase_g2(int WV, int l, int f, unsigned char* smem) {
  const int gi = f == 0 ? 2 : 8;
  { KArgs a = kargs(); unsigned char* ws = a->ws; EpiResid E; E.X = (float*)(ws + WS_X); E.gate = (const float*)(ws + WS_MOD) + (size_t)l * 9216 + gi * 1024; E.scale = 0.5f;
    run_gemm(WV, (LAS unsigned char*)smem, (const bf16_t*)(ws + WS_U), 2816, (const bf16_t*)(ws + WS_W2) + (size_t)(l * 2 + f) * 1024 * 2816, L_, 1024, 2816, E); }
  if (!(l == DEPTH_ - 1 && f == 1)) { KArgs a = kargs(); unsigned char* ws = a->ws; CtxResid e; e.Xc = (float*)(ws + WS_X) + (size_t)L_ * 1024; e.gate = (const float*)(ws + WS_MOD) + (size_t)(4 + l) * 9216 + gi * 1024; e.scale = 0.5f;
    ctx_gemm32(WV, (const bf16_t*)(ws + WS_U) + (size_t)L_ * 2816, 2816, (const bf16_t*)(ws + WS_W2) + (size_t)(l * 2 + f) * 1024 * 2816, 2816, 1024, smem, e); }
}

DI unsigned xcc_id() { return (unsigned)__builtin_amdgcn_s_getreg((3 << 11) | 20) & 0xFu; }
DI void grid_bar(int WV, unsigned& gen, unsigned xcc, unsigned nloc, unsigned nx) {
  asm volatile("s_waitcnt vmcnt(0)" ::: "memory");
  __syncthreads();
  gen += 1;
  if (ltid() == 0) {
    unsigned* bar = (unsigned*)(kargs()->ws + WS_BAR);
    const unsigned old = __hip_atomic_fetch_add(bar + 320 + 16 * xcc, 1u, __ATOMIC_RELAXED, __HIP_MEMORY_SCOPE_AGENT);
    if (old + 1u == gen * nloc) {
      __builtin_amdgcn_fence(__ATOMIC_RELEASE, "agent");
      asm volatile("s_waitcnt vmcnt(0)" ::: "memory");
      __hip_atomic_fetch_add(bar + 640, 1u, __ATOMIC_RELAXED, __HIP_MEMORY_SCOPE_AGENT);
    }
    const unsigned target = gen * nx;
    while (__hip_atomic_load(bar + 640, __ATOMIC_RELAXED, __HIP_MEMORY_SCOPE_AGENT) < target) __builtin_amdgcn_s_sleep(1);
    __builtin_amdgcn_fence(__ATOMIC_ACQUIRE, "agent");
    asm volatile("s_waitcnt vmcnt(0)" ::: "memory");
  }
  __syncthreads();
}

__global__ void __launch_bounds__(512, 2) mega(Args a_unused) {
  extern __shared__ __attribute__((aligned(16))) unsigned char smem[];
  cg::grid_group grid = cg::this_grid();
  const int WV = __builtin_amdgcn_readfirstlane((int)(threadIdx.x >> 6));
  const unsigned xcc = xcc_id();
  if (threadIdx.x == 0) __hip_atomic_fetch_add((unsigned*)(kargs()->ws + WS_BAR) + 16 + 16 * xcc, 1u, __ATOMIC_RELAXED, __HIP_MEMORY_SCOPE_AGENT);
#ifndef NO_PRO
  prologue(WV, kargs(), smem);
#ifdef PROBE_PRO
  __syncthreads(); prologue(WV, kargs(), smem);
#endif
#endif
  grid.sync();
  unsigned gen = 0, nloc = 1, nx = 0;
  { const unsigned* cen = (const unsigned*)(kargs()->ws + WS_BAR) + 16;
    for (int j = 0; j < 16; ++j) { const unsigned cj = __hip_atomic_load(cen + 16 * j, __ATOMIC_RELAXED, __HIP_MEMORY_SCOPE_AGENT); nx += cj ? 1u : 0u; if ((unsigned)j == xcc) nloc = cj; }
    nloc = __builtin_amdgcn_readfirstlane(nloc); nx = __builtin_amdgcn_readfirstlane(nx); }
#pragma unroll 1
  for (int l = 0; l < DEPTH_; ++l) {
#pragma unroll 1
    for (int f = 0; f < 2; ++f) {
      if (f == 1) {
        norm_phase(WV, kargs(), l, 1, false);
        grid_bar(WV, gen, xcc, nloc, nx);
        phase_win(WV, l, smem);
#ifdef PROBE_WIN
        phase_win(WV, l, smem);
#endif
        grid_bar(WV, gen, xcc, nloc, nx);
#ifndef NO_MIXA
        fourier_tables(WV, smem); __syncthreads(); fourier_stage1(WV, kargs(), smem); if (l < DEPTH_ - 1) fourier_ctx(WV, kargs(), smem); __syncthreads(); ret_states(WV, kargs(), l, smem);
#ifdef PROBE_RS
        __syncthreads(); ret_states(WV, kargs(), l, smem);
#endif
#ifdef PROBE_F1
        __syncthreads(); fourier_tables(WV, smem); __syncthreads(); fourier_stage1(WV, kargs(), smem);
#endif
#ifdef PROBE_FC
        __syncthreads(); fourier_ctx(WV, kargs(), smem);
#endif
#ifdef PROBE_MIXA
        __syncthreads();
        fourier_tables(WV, smem); __syncthreads(); fourier_stage1(WV, kargs(), smem); fourier_ctx(WV, kargs(), smem); __syncthreads(); ret_states(WV, kargs(), l, smem);
#endif
#endif
        grid_bar(WV, gen, xcc, nloc, nx);
#ifndef NO_MIXB
        ret_scan(WV, kargs(), l); __syncthreads(); fourier_tables(WV, smem); __syncthreads(); fourier_stage2(WV, kargs(), smem);
#ifdef PROBE_MIXB
        __syncthreads();
        ret_scan(WV, kargs(), l); __syncthreads(); fourier_tables(WV, smem); __syncthreads(); fourier_stage2(WV, kargs(), smem);
#endif
#endif
        grid_bar(WV, gen, xcc, nloc, nx);
#ifndef NO_RETOUT
        ret_out(WV, kargs(), l, smem); __syncthreads();
#ifdef PROBE_RET
        ret_out(WV, kargs(), l, smem); __syncthreads();
#endif
#endif
#ifndef NO_ATTN
        attn_phase<0>(WV, kargs(), l, l < DEPTH_ - 1, smem);
#ifdef PROBE_ATTN
        __syncthreads(); attn_phase<PROBE_ATTN>(WV, kargs(), l, l < DEPTH_ - 1, smem);
#endif
#endif
        grid_bar(WV, gen, xcc, nloc, nx);
        phase_merge(WV, l, smem);
#ifdef PROBE_MERGE
        phase_merge(WV, l, smem);
#endif
        grid_bar(WV, gen, xcc, nloc, nx);
        phase_wo(WV, l, smem);
        grid_bar(WV, gen, xcc, nloc, nx);
      }
      norm_phase(WV, kargs(), l, f == 0 ? 0 : 2, l == 0 && f == 0);
      grid_bar(WV, gen, xcc, nloc, nx);
      phase_g1(WV, l, f, smem);
#ifdef PROBE_G1
      phase_g1(WV, l, f, smem);
#endif
#ifdef PROBE_G1NULL
      { KArgs a = kargs(); unsigned char* ws = a->ws; EpiNull E; E.U = (float*)a->out;
        run_gemm(WV, (LAS unsigned char*)smem, (const bf16_t*)(ws + WS_H), 1024, (const bf16_t*)(ws + WS_W13) + (size_t)(l * 2 + f) * 5632 * 1024, MT_, 5632, 1024, E); }
#endif
      grid_bar(WV, gen, xcc, nloc, nx);
      phase_g2(WV, l, f, smem);
      grid_bar(WV, gen, xcc, nloc, nx);
    }
  }
  final_norm(WV, kargs());
}

extern "C" void kernel_launch(void* const* d_in, const int* in_sizes, int n_in, void* d_out, int out_size, void* d_ws, size_t ws_size, hipStream_t stream) {
  static int grid = 0;
  if (grid == 0) {
    int dev = 0, cus = 0, per_cu = 0;
    (void)hipGetDevice(&dev); (void)hipDeviceGetAttribute(&cus, hipDeviceAttributeMultiprocessorCount, dev);
    if (hipFuncSetAttribute((const void*)mega, hipFuncAttributeMaxDynamicSharedMemorySize, LDS_BYTES) != hipSuccess) fprintf(stderr, "kernel_launch: hipFuncSetAttribute failed\n");
    if (hipOccupancyMaxActiveBlocksPerMultiprocessor(&per_cu, (const void*)mega, 512, LDS_BYTES) != hipSuccess || per_cu < 1) fprintf(stderr, "kernel_launch: occupancy query says %d blocks per CU\n", per_cu);
    (void)hipGetLastError();
    grid = cus > 0 ? cus : 256;
    if (ws_size < WS_END) { fprintf(stderr, "kernel_launch: workspace too small: %zu < %zu\n", ws_size, (size_t)WS_END); }
  }
  Args a{};
  for (int i = 0; i < 19; ++i) a.in[i] = (const float*)d_in[i];
  a.out = (float*)d_out; a.ws = (unsigned char*)d_ws;
  (void)hipMemsetAsync((unsigned char*)d_ws + WS_BAR, 0, 8192, stream);
  void* args[] = {&a};
  hipError_t e = hipLaunchCooperativeKernel((const void*)mega, dim3(grid), dim3(512), args, LDS_BYTES, stream);
  if (e != hipSuccess) fprintf(stderr, "kernel_launch: cooperative launch failed: %s (grid %d)\n", hipGetErrorString(e), grid);
}
```
